# Optimizing an MI355X kernel written in HIP

```python
import jax, jax.numpy as jnp
from jax import lax
import numpy as np

D_MODEL = 1024
BATCH = 32
SEQ = 2048
DEPTH = 4

MEM_LEN = 256
POOL_WIDTH = D_MODEL // 4
POOL_GROUPS = 4
POOL_WINDOWS = (2, 4, 8, 16)
HEAD_DIM = 64
ATTN_WIDTH = 3 * D_MODEL // 8
ATTN_HEADS = ATTN_WIDTH // HEAD_DIM
DILATED_PATTERNS = ((128, 1), (512, 4), (2048, 16))
ATTN_BLOCK = 128
LRU_WIDTH = 3 * D_MODEL // 8
LRU_BLOCKS = 6
LRU_CONV = 4
LRU_C = 8.0
MIX_WIDTH = POOL_WIDTH + ATTN_WIDTH + LRU_WIDTH
IN_WIDTH = POOL_WIDTH + 3 * ATTN_WIDTH + 2 * LRU_WIDTH
MEM_HEADS = 4
MEM_HEAD_DIM = D_MODEL // MEM_HEADS
D_FF = 2816
FFN_CONV = 3
EPS = 1e-6

kernel_name = 'hybrid_pool_dilattn_rglru_convffn'


def rmsnorm(x, g):
    xf = x.astype(jnp.float32)
    xf = xf * lax.rsqrt(jnp.mean(xf * xf, axis=-1, keepdims=True) + EPS)
    return (xf * g.astype(jnp.float32)).astype(x.dtype)


def causal_dwconv(x, w, b):
    K = w.shape[0]
    S = x.shape[1]
    xp = jnp.pad(x, ((0, 0), (K - 1, 0), (0, 0)))
    out = b
    for k in range(K):
        out = out + w[k] * xp[:, K - 1 - k:K - 1 - k + S]
    return out


def alibi_slopes(n):
    return jnp.asarray([2.0 ** (-8.0 * (h + 1) / n) for h in range(n)], dtype=jnp.float32)


def pool_mixer(u, pool_w, pool_scale):
    B, S, _ = u.shape
    gw = POOL_WIDTH // POOL_GROUPS
    uf = u.astype(jnp.float32)
    csum = jnp.cumsum(uf, axis=1)
    cp = jnp.concatenate([jnp.zeros_like(csum[:, :1]), csum], axis=1)
    outs = []
    for g, w in enumerate(POOL_WINDOWS):
        sl = slice(g * gw, (g + 1) * gw)
        end = cp[:, 1:, sl]
        start = jnp.concatenate([jnp.zeros((B, w - 1, gw), jnp.float32), cp[:, :S - w + 1, sl]], axis=1)
        count = jnp.minimum(jnp.arange(1, S + 1), w).astype(jnp.float32)[None, :, None]
        outs.append((end - start) / count - uf[:, :, sl])
    pooled = jnp.stack(outs, axis=2)
    mixed = jnp.einsum('bsgc,gcd->bsgd', pooled, pool_w.astype(jnp.float32)).reshape(B, S, POOL_WIDTH)
    return (mixed * pool_scale.astype(jnp.float32)).astype(u.dtype)


def sliding_window_attn(q, k, v, slopes_step, window):
    N, L, H, hd = q.shape
    Q = ATTN_BLOCK
    nb = -(-L // Q)
    Lp = nb * Q
    pad = ((0, 0), (0, Lp - L), (0, 0), (0, 0))
    q, k, v = jnp.pad(q, pad), jnp.pad(k, pad), jnp.pad(v, pad)
    qb = q.reshape(N, nb, Q, H, hd)

    def with_prev(t):
        cur = t.reshape(N, nb, Q, H, hd)
        prev = jnp.concatenate([jnp.zeros_like(cur[:, :1]), cur[:, :-1]], axis=1)
        return jnp.concatenate([prev, cur], axis=2)

    kb, vb = with_prev(k), with_prev(v)
    s = jnp.einsum('nbqhd,nbkhd->nbhqk', qb, kb) * (hd ** -0.5)
    dist = Q + jnp.arange(Q)[:, None] - jnp.arange(2 * Q)[None, :]
    key_pos = jnp.arange(nb)[:, None] * Q - Q + jnp.arange(2 * Q)[None, :]
    valid = ((dist >= 0) & (dist <= window))[None, :, :] & (key_pos >= 0)[:, None, :]
    s = s - slopes_step[:, None, None] * dist.astype(jnp.float32)
    s = jnp.where(valid[None, :, None], s, -jnp.inf)
    m = jnp.max(s, axis=-1, keepdims=True)
    p = jnp.exp(s - m)
    den = jnp.sum(p, axis=-1, keepdims=True)
    o = jnp.einsum('nbhqk,nbkhd->nbqhd', p, vb) / jnp.transpose(den, (0, 1, 3, 2, 4))
    lse = jnp.transpose((m + jnp.log(den))[..., 0], (0, 1, 3, 2))
    return o.reshape(N, Lp, H, hd)[:, :L], lse.reshape(N, Lp, H)[:, :L]


def dilated_attention(q, k, v, slopes):
    B, S, H, hd = q.shape
    outs, lses = [], []
    for window, d in DILATED_PATTERNS:
        L = S // d

        def to_sub(t):
            return t.reshape(B, L, d, H, hd).transpose(0, 2, 1, 3, 4).reshape(B * d, L, H, hd)

        o, lse = sliding_window_attn(to_sub(q), to_sub(k), to_sub(v), slopes * d, window // d)
        outs.append(o.reshape(B, d, L, H, hd).transpose(0, 2, 1, 3, 4).reshape(B, S, H, hd))
        lses.append(lse.reshape(B, d, L, H).transpose(0, 2, 1, 3).reshape(B, S, H))
    wts = jax.nn.softmax(jnp.stack(lses, axis=0), axis=0)
    return jnp.sum(wts[..., None] * jnp.stack(outs, axis=0), axis=0)


def rg_lru(x, w_a, b_a, w_x, b_x, lam):
    B, S, C = x.shape
    xb = x.reshape(B, S, LRU_BLOCKS, C // LRU_BLOCKS)
    r = jax.nn.sigmoid(jnp.einsum('bsgc,gcd->bsgd', xb, w_a.astype(jnp.float32)).reshape(B, S, C) + b_a.astype(jnp.float32))
    i = jax.nn.sigmoid(jnp.einsum('bsgc,gcd->bsgd', xb, w_x.astype(jnp.float32)).reshape(B, S, C) + b_x.astype(jnp.float32))
    log_a = -LRU_C * r * jax.nn.softplus(-lam.astype(jnp.float32))
    a = jnp.exp(log_a)
    bterm = jnp.sqrt(-jnp.expm1(2.0 * log_a)) * (i * x)

    def combine(c1, c2):
        a1, b1 = c1
        a2, b2 = c2
        return a1 * a2, a2 * b1 + b2

    _, h = lax.associative_scan(combine, (a, bterm), axis=1)
    return h


def mixer_block(h, w_in, pool_w, pool_scale, q_gain, k_gain, lru_conv_w, lru_conv_b,
                lru_wa, lru_ba, lru_wx, lru_bx, lru_lambda, w_out, slopes):
    B, S, _ = h.shape
    P, A, R = POOL_WIDTH, ATTN_WIDTH, LRU_WIDTH
    proj = jnp.einsum('bsd,de->bse', h, w_in)
    u_pool, q, k, v, x_lru, y_lru = jnp.split(proj, [P, P + A, P + 2 * A, P + 3 * A, P + 3 * A + R], axis=-1)
    out_pool = pool_mixer(u_pool, pool_w, pool_scale)
    qh = rmsnorm(q.reshape(B, S, ATTN_HEADS, HEAD_DIM), q_gain).astype(jnp.float32)
    kh = rmsnorm(k.reshape(B, S, ATTN_HEADS, HEAD_DIM), k_gain).astype(jnp.float32)
    vh = v.reshape(B, S, ATTN_HEADS, HEAD_DIM).astype(jnp.float32)
    out_attn = dilated_attention(qh, kh, vh, slopes).reshape(B, S, A).astype(h.dtype)
    xc = causal_dwconv(x_lru, lru_conv_w, lru_conv_b).astype(jnp.float32)
    hr = rg_lru(xc, lru_wa, lru_ba, lru_wx, lru_bx, lru_lambda)
    out_lru = (hr * jax.nn.gelu(y_lru.astype(jnp.float32))).astype(h.dtype)
    mixed = jnp.concatenate([out_pool, out_attn, out_lru], axis=-1)
    return jnp.einsum('bse,ed->bsd', mixed, w_out)


def memory_attn(h, mem_n, w_q, w_kv, qg, kg, w_o):
    B, S, _ = h.shape
    M = mem_n.shape[1]
    q = rmsnorm(jnp.einsum('bsd,de->bse', h, w_q).reshape(B, S, MEM_HEADS, MEM_HEAD_DIM), qg)
    k, v = jnp.split(jnp.einsum('bmd,de->bme', mem_n, w_kv), 2, axis=-1)
    k = rmsnorm(k.reshape(B, M, MEM_HEADS, MEM_HEAD_DIM), kg)
    v = v.reshape(B, M, MEM_HEADS, MEM_HEAD_DIM)
    s = jnp.einsum('bshd,bmhd->bhsm', q.astype(jnp.float32), k.astype(jnp.float32)) * (MEM_HEAD_DIM ** -0.5)
    p = jax.nn.softmax(s, axis=-1)
    o = jnp.einsum('bhsm,bmhd->bshd', p, v.astype(jnp.float32)).reshape(B, S, D_MODEL).astype(h.dtype)
    return jnp.einsum('bse,ed->bsd', o, w_o)


def conv_ffn(h, w_up, conv_w, conv_b, w_down):
    g, u = jnp.split(jnp.einsum('bsd,df->bsf', h, w_up), 2, axis=-1)
    g = causal_dwconv(g, conv_w, conv_b)
    return jnp.einsum('bsf,fd->bsd', jax.nn.gelu(g) * u, w_down)


def setup_inputs(seed: int = 0) -> dict:
    key = jax.random.key(seed)
    ks = jax.random.split(key, 32)
    L = DEPTH
    gw = POOL_WIDTH // POOL_GROUPS
    bw = LRU_WIDTH // LRU_BLOCKS

    def nrm(k, shape, scale):
        return jax.random.normal(k, shape, jnp.float32) * scale

    a0 = jax.random.uniform(ks[14], (L, LRU_WIDTH), jnp.float32, 0.9, 0.999)
    return {
        'x': nrm(ks[0], (BATCH, SEQ, D_MODEL), 1.0),
        'mem': nrm(ks[1], (BATCH, MEM_LEN, D_MODEL), 1.0),
        'norm_mix': 1.0 + nrm(ks[2], (L, D_MODEL), 0.1),
        'w_in': nrm(ks[3], (L, D_MODEL, IN_WIDTH), D_MODEL ** -0.5),
        'pool_w': nrm(ks[4], (L, POOL_GROUPS, gw, gw), gw ** -0.5),
        'pool_scale': 1.0 + nrm(ks[5], (L, POOL_WIDTH), 0.1),
        'q_gain': 1.0 + nrm(ks[6], (L, HEAD_DIM), 0.1),
        'k_gain': 1.0 + nrm(ks[7], (L, HEAD_DIM), 0.1),
        'lru_conv_w': nrm(ks[8], (L, LRU_CONV, LRU_WIDTH), LRU_CONV ** -0.5),
        'lru_conv_b': nrm(ks[9], (L, LRU_WIDTH), 0.02),
        'lru_wa': nrm(ks[10], (L, LRU_BLOCKS, bw, bw), bw ** -0.5),
        'lru_ba': nrm(ks[11], (L, LRU_WIDTH), 0.02),
        'lru_wx': nrm(ks[12], (L, LRU_BLOCKS, bw, bw), bw ** -0.5),
        'lru_bx': nrm(ks[13], (L, LRU_WIDTH), 0.02),
        'lru_lambda': jnp.log(a0) - jnp.log1p(-a0),
        'w_out': nrm(ks[15], (L, MIX_WIDTH, D_MODEL), MIX_WIDTH ** -0.5),
        'norm_mem': 1.0 + nrm(ks[16], (L, D_MODEL), 0.1),
        'norm_memkv': 1.0 + nrm(ks[17], (L, D_MODEL), 0.1),
        'w_q_mem': nrm(ks[18], (L, D_MODEL, D_MODEL), D_MODEL ** -0.5),
        'w_kv_mem': nrm(ks[19], (L, D_MODEL, 2 * D_MODEL), D_MODEL ** -0.5),
        'mq_gain': 1.0 + nrm(ks[20], (L, MEM_HEAD_DIM), 0.1),
        'mk_gain': 1.0 + nrm(ks[21], (L, MEM_HEAD_DIM), 0.1),
        'w_o_mem': nrm(ks[22], (L, D_MODEL, D_MODEL), D_MODEL ** -0.5),
        'norm_ffn': 1.0 + nrm(ks[23], (L, D_MODEL), 0.1),
        'w_up': nrm(ks[24], (L, D_MODEL, 2 * D_FF), D_MODEL ** -0.5),
        'ffn_conv_w': nrm(ks[25], (L, FFN_CONV, D_FF), FFN_CONV ** -0.5),
        'ffn_conv_b': nrm(ks[26], (L, D_FF), 0.02),
        'w_down': nrm(ks[27], (L, D_FF, D_MODEL), D_FF ** -0.5),
    }


def reference(x, mem, norm_mix, w_in, pool_w, pool_scale, q_gain, k_gain, lru_conv_w, lru_conv_b,
              lru_wa, lru_ba, lru_wx, lru_bx, lru_lambda, w_out, norm_mem, norm_memkv, w_q_mem,
              w_kv_mem, mq_gain, mk_gain, w_o_mem, norm_ffn, w_up, ffn_conv_w, ffn_conv_b, w_down):
    slopes = alibi_slopes(ATTN_HEADS)
    h = x
    for l in range(DEPTH):
        h = h + mixer_block(rmsnorm(h, norm_mix[l]), w_in[l], pool_w[l], pool_scale[l], q_gain[l], k_gain[l],
                            lru_conv_w[l], lru_conv_b[l], lru_wa[l], lru_ba[l], lru_wx[l], lru_bx[l],
                            lru_lambda[l], w_out[l], slopes)
        h = h + memory_attn(rmsnorm(h, norm_mem[l]), rmsnorm(mem, norm_memkv[l]), w_q_mem[l], w_kv_mem[l],
                            mq_gain[l], mk_gain[l], w_o_mem[l])
        h = h + conv_ffn(rmsnorm(h, norm_ffn[l]), w_up[l], ffn_conv_w[l], ffn_conv_b[l], w_down[l])
    return h
```

```cpp
#include <hip/hip_runtime.h>
#include <hip/hip_cooperative_groups.h>
#include <cstdio>
#include <cstdint>
namespace cg = cooperative_groups;
namespace pg8 {
#define PG8_LAS __attribute__((address_space(3)))
typedef unsigned short bf16_t;
typedef short bf16x8 __attribute__((ext_vector_type(8)));
typedef float f32x4 __attribute__((ext_vector_type(4)));
typedef unsigned u32x4 __attribute__((ext_vector_type(4)));
constexpr int BM = 256, BK = 64, HALF = 128, HTB = HALF * BK * 2  , STAGE_BYTES = 8 * HTB, NXCD = 8, WGM = 8;

__host__ __device__ __forceinline__ int lds_byte(int r, int c) { const int st = (r >> 4) * 2 + (c >> 5), rr = r & 15, cc = c & 31, ob = rr * 64 + cc * 2; return st * 1024 + (ob ^ (((ob >> 9) & 1) << 5)); }
__host__ __device__ __forceinline__ void stage_rc(int b, int& R, int& C) { const int st = b / 1024, sb = b % 1024, swz = sb ^ (((sb >> 9) & 1) << 5); R = (st >> 1) * 16 + swz / 64; C = (st & 1) * 32 + (swz % 64) / 2; }
__host__ __device__ __forceinline__ int perm32(int rho) { const int n = rho >> 4, i = rho & 15; return 8 * (i >> 2) + 4 * n + (i & 3); }

struct Unit { int pm, pn; };
struct Gemm { const bf16_t* A; const bf16_t* Bt; int M, N, K; };

struct StaticOrder {
    int nM, nN, nwg, G, c;
    __host__ __device__ void init(int M, int N, int G_, int c_) { nM = M / BM; nN = N / BM; nwg = nM * nN; G = G_; c = c_; }
    __host__ __device__ bool next(int i, Unit& u) const {
        const long L = (long)i * G + c; if (L >= nwg) return false;
        int wgid = (int)L; { const int q = nwg / NXCD, r = nwg % NXCD, xcd = wgid % NXCD, off = wgid / NXCD; wgid = (xcd < r ? xcd * (q + 1) : r * (q + 1) + (xcd - r) * q) + off; }
        const int nig = WGM * nN, gid = wgid / nig, fm = gid * WGM, gsz = (nM - fm) < WGM ? (nM - fm) : WGM;
        u.pm = fm + ((wgid % nig) % gsz); u.pn = (wgid % nig) / gsz; return true;
    }
    __device__ __forceinline__ void a_ready(const Unit&) const {}
    __device__ __forceinline__ void done(const Unit&) const {}
};

__device__ __forceinline__ unsigned cvt_pk_bf16(float lo, float hi) { unsigned r; asm volatile("v_cvt_pk_bf16_f32 %0, %1, %2" : "=v"(r) : "v"(lo), "v"(hi)); return r; }
typedef float f32x2 __attribute__((ext_vector_type(2)));
template <class Epi, class Sched, bool ALIGN_EPI = false, bool SP2 = false>
__device__ __forceinline__ void gemm_phase(PG8_LAS unsigned char* lds, const Gemm g, const Sched& S, const Epi& E) {
    int tid_ = threadIdx.x; asm volatile("" : "+v"(tid_));
    const int tid = tid_, wid = __builtin_amdgcn_readfirstlane(tid >> 6), lane = tid & 63, wr = wid >> 2, wc = wid & 3, fr = lane & 15, fq = lane >> 4;
    const int K = g.K, nt = K / BK;
    unsigned voffA[2], voffB[2];
#pragma unroll
    for (int i = 0; i < 2; ++i) { int R, C; stage_rc(tid * 16 + i * 8192, R, C); const int Rb = Epi::PERM ? ((R & ~31) + perm32(R & 31)) : R;
        voffA[i] = (unsigned)(R * K + C) * 2u; voffB[i] = (unsigned)(Rb * K + C) * 2u; }
    const size_t kstep = (size_t)(BK * 2);
    const size_t hstep = (size_t)HALF * K * 2;
    const size_t tstep = 2 * hstep;
    const unsigned ldsw = (unsigned)wid * 1024u;
    const int aoff = lds_byte(wr * 64 + fr, fq * 8), boff = lds_byte(wc * 32 + fr, fq * 8);
#define PG8_SA(b, h) (((b) * 2 + (h)) * HTB)
#define PG8_SB(b, h) ((4 + (b) * 2 + (h)) * HTB)
#define PG8_STAGE(bufoff, gbase, voff) do { _Pragma("unroll") for (int _i = 0; _i < 2; ++_i) \
        __builtin_amdgcn_global_load_lds((const unsigned*)((const char*)(gbase) + (voff)[_i]), (PG8_LAS unsigned*)(lds + (bufoff) + ldsw + _i * 8192), 16, 0, 0); } while (0)
#define PG8_LDA(dst, b, h) do { _Pragma("unroll") for (int m = 0; m < 4; ++m) _Pragma("unroll") for (int k = 0; k < 2; ++k) dst[m][k] = *(const PG8_LAS bf16x8*)(lds + PG8_SA(b, h) + aoff + m * 2048 + k * 1024); } while (0)
#define PG8_LDB(dst, b, h) do { _Pragma("unroll") for (int n = 0; n < 2; ++n) _Pragma("unroll") for (int k = 0; k < 2; ++k) dst[n][k] = *(const PG8_LAS bf16x8*)(lds + PG8_SB(b, h) + boff + n * 2048 + k * 1024); } while (0)
#define PG8_MMA(ai, bj, At, Bt) do { __builtin_amdgcn_s_setprio(1); _Pragma("unroll") for (int m = 0; m < 4; ++m) _Pragma("unroll") for (int n = 0; n < 2; ++n) _Pragma("unroll") for (int k = 0; k < 2; ++k) \
        acc[ai][bj][m][n] = __builtin_amdgcn_mfma_f32_16x16x32_bf16(Bt[n][k], At[m][k], acc[ai][bj][m][n], 0, 0, 0); __builtin_amdgcn_s_setprio(0); } while (0)
#define PG8_WAIT_V(n) asm volatile("s_waitcnt vmcnt(" #n ")" ::: "memory")
#define PG8_WAIT_L(n) asm volatile("s_waitcnt lgkmcnt(" #n ")" ::: "memory")
#define PG8_BAR __builtin_amdgcn_s_barrier()
#define PG8_SCHED __builtin_amdgcn_sched_barrier(0)
    Unit cur, nxt; int ui = 0;
    if (!S.next(0, cur)) return;
    f32x4 acc[2][2][4][2];
#pragma unroll
    for (int a = 0; a < 2; ++a)
#pragma unroll
        for (int b = 0; b < 2; ++b)
#pragma unroll
            for (int m = 0; m < 4; ++m)
#pragma unroll
                for (int n = 0; n < 2; ++n) acc[a][b][m][n] = (f32x4){0.f, 0.f, 0.f, 0.f};
    bf16x8 At[4][2], B0[2][2], B1[2][2];
    const char* cA = (const char*)g.A + (size_t)cur.pm * tstep; const char* cB = (const char*)g.Bt + (size_t)cur.pn * tstep;
    S.a_ready(cur);
    if constexpr (SP2) {
        PG8_STAGE(PG8_SB(0, 0), cB, voffB); PG8_STAGE(PG8_SB(0, 1), cB + hstep, voffB); PG8_STAGE(PG8_SA(0, 0), cA, voffA); PG8_STAGE(PG8_SA(0, 1), cA + hstep, voffA);
        if (wr == 1) PG8_BAR;
        PG8_WAIT_V(2); PG8_BAR;
        PG8_STAGE(PG8_SB(1, 0), cB + kstep, voffB); PG8_STAGE(PG8_SA(1, 0), cA + kstep, voffA); PG8_STAGE(PG8_SB(1, 1), cB + hstep + kstep, voffB);
        PG8_WAIT_V(6); PG8_BAR;
    } else {
        PG8_STAGE(PG8_SB(0, 0), cB, voffB); PG8_STAGE(PG8_SA(0, 0), cA, voffA); PG8_STAGE(PG8_SB(0, 1), cB + hstep, voffB); PG8_STAGE(PG8_SA(0, 1), cA + hstep, voffA);
        if (wr == 1) PG8_BAR;
        PG8_WAIT_V(4); PG8_BAR;
        PG8_STAGE(PG8_SB(1, 0), cB + kstep, voffB); PG8_STAGE(PG8_SA(1, 0), cA + kstep, voffA); PG8_STAGE(PG8_SB(1, 1), cB + hstep + kstep, voffB);
        PG8_WAIT_V(6); PG8_BAR;
    }
    for (;;) {
        const bool has_next = S.next(ui + 1, nxt);
        const char* nA = has_next ? (const char*)g.A + (size_t)nxt.pm * tstep : cA; const char* nB = has_next ? (const char*)g.Bt + (size_t)nxt.pn * tstep : cB;
        for (int t = 0; t < nt; t += 2) {
            const bool last = (t == nt - 2);
            const char* a1 = cA + (size_t)(t + 1) * kstep;
            const char* a2 = last ? nA : cA + (size_t)(t + 2) * kstep; const char* b2 = last ? nB : cB + (size_t)(t + 2) * kstep;
            const char* a3 = a2 + kstep; const char* b3 = b2 + kstep;
            if (last && has_next) S.a_ready(nxt);
            if constexpr (SP2) {
            PG8_LDB(B0, 0, 0); PG8_LDB(B1, 0, 1); PG8_SCHED; PG8_LDA(At, 0, 0); PG8_STAGE(PG8_SA(1, 1), a1 + hstep, voffA);
            PG8_WAIT_V(8); PG8_WAIT_L(0); PG8_BAR; PG8_MMA(0, 0, At, B0); PG8_MMA(0, 1, At, B1); PG8_BAR; PG8_SCHED;
            PG8_LDA(At, 0, 1); PG8_STAGE(PG8_SB(0, 0), b2, voffB); PG8_STAGE(PG8_SB(0, 1), b2 + hstep, voffB); PG8_STAGE(PG8_SA(0, 0), a2, voffA);
            PG8_WAIT_V(8); PG8_WAIT_L(0); PG8_BAR; PG8_MMA(1, 0, At, B0); PG8_MMA(1, 1, At, B1); PG8_BAR; PG8_SCHED;
            PG8_LDB(B0, 1, 0); PG8_LDB(B1, 1, 1); PG8_SCHED; PG8_LDA(At, 1, 0); PG8_STAGE(PG8_SA(0, 1), a2 + hstep, voffA);
            PG8_WAIT_V(8); PG8_WAIT_L(0); PG8_BAR; PG8_MMA(0, 0, At, B0); PG8_MMA(0, 1, At, B1); PG8_BAR; PG8_SCHED;
            PG8_LDA(At, 1, 1); PG8_STAGE(PG8_SB(1, 0), b3, voffB); PG8_STAGE(PG8_SB(1, 1), b3 + hstep, voffB); PG8_STAGE(PG8_SA(1, 0), a3, voffA);
            PG8_WAIT_V(8); PG8_WAIT_L(0); PG8_BAR; PG8_MMA(1, 0, At, B0); PG8_MMA(1, 1, At, B1); PG8_BAR; PG8_SCHED;
            } else {
            PG8_LDB(B0, 0, 0); PG8_SCHED; PG8_LDA(At, 0, 0); PG8_STAGE(PG8_SA(1, 1), a1 + hstep, voffA);
            PG8_WAIT_L(8); PG8_BAR; PG8_WAIT_L(0); PG8_MMA(0, 0, At, B0); PG8_BAR; PG8_SCHED;
            PG8_LDB(B1, 0, 1); PG8_STAGE(PG8_SB(0, 0), b2, voffB);
            PG8_BAR; PG8_WAIT_L(0); PG8_MMA(0, 1, At, B1); PG8_BAR;
            PG8_LDA(At, 0, 1); PG8_STAGE(PG8_SA(0, 0), a2, voffA);
            PG8_BAR; PG8_WAIT_L(0); PG8_MMA(1, 0, At, B0); PG8_BAR; PG8_SCHED;
            PG8_STAGE(PG8_SB(0, 1), b2 + hstep, voffB);
            PG8_WAIT_V(6); PG8_BAR; PG8_MMA(1, 1, At, B1); PG8_BAR;
            PG8_LDB(B0, 1, 0); PG8_SCHED; PG8_LDA(At, 1, 0); PG8_STAGE(PG8_SA(0, 1), a2 + hstep, voffA);
            PG8_WAIT_L(8); PG8_BAR; PG8_WAIT_L(0); PG8_MMA(0, 0, At, B0); PG8_BAR; PG8_SCHED;
            PG8_LDB(B1, 1, 1); PG8_STAGE(PG8_SB(1, 0), b3, voffB);
            PG8_BAR; PG8_WAIT_L(0); PG8_MMA(0, 1, At, B1); PG8_BAR;
            PG8_LDA(At, 1, 1); PG8_STAGE(PG8_SA(1, 0), a3, voffA);
            PG8_BAR; PG8_WAIT_L(0); PG8_MMA(1, 0, At, B0); PG8_BAR; PG8_SCHED;
            PG8_STAGE(PG8_SB(1, 1), b3 + hstep, voffB);
            PG8_WAIT_V(6); PG8_BAR; PG8_MMA(1, 1, At, B1); PG8_BAR;
            }
        }
        if constexpr (ALIGN_EPI) { if (wr == 0) PG8_BAR; }
        if constexpr (!Epi::AFTER_DRAIN) { E(acc, cur, wr, wc, fr, fq); S.done(cur); }
        if (!has_next) break;
#pragma unroll
        for (int a = 0; a < 2; ++a)
#pragma unroll
            for (int b = 0; b < 2; ++b)
#pragma unroll
                for (int m = 0; m < 4; ++m)
#pragma unroll
                    for (int n = 0; n < 2; ++n) acc[a][b][m][n] = (f32x4){0.f, 0.f, 0.f, 0.f};
        cur = nxt; cA = nA; cB = nB; ++ui;
        if constexpr (ALIGN_EPI) { if (wr == 1) PG8_BAR; }
    }
    PG8_WAIT_V(0);
    if constexpr (!ALIGN_EPI) { if (wr == 0) PG8_BAR; }
    PG8_BAR;
    if constexpr (Epi::AFTER_DRAIN) { E.fused(acc, cur, wr, wc, fr, fq, lds, wid, lane); S.done(cur); }
#undef PG8_SA
#undef PG8_SB
#undef PG8_STAGE
#undef PG8_LDA
#undef PG8_LDB
#undef PG8_MMA
#undef PG8_WAIT_V
#undef PG8_WAIT_L
#undef PG8_BAR
#undef PG8_SCHED
}
}

using pg8::bf16_t; using pg8::bf16x8; using pg8::f32x4; using pg8::u32x4;
typedef unsigned u32x2 __attribute__((ext_vector_type(2)));
typedef short s16x4 __attribute__((ext_vector_type(4)));
#define LAS __attribute__((address_space(3)))

constexpr int NTHREADS = 512;
constexpr int MTOK = 65536, DM = 1024, SEQ = 2048, NBATCH = 32, DEPTH = 4;
constexpr int NPROJ = 2304;
constexpr int INW = 2176;
constexpr int DFF = 2816, DFF2 = 5632;
constexpr int MEMROWS = 8192;
constexpr int MHALF = 32768;
constexpr float EPSF = 1e-6f;
constexpr float LOG2E = 1.4426950408889634f;
constexpr int LDS_BYTES = 155648;
constexpr int LDS_UNIT_OFF = 155648 - 64;
constexpr int LDS_TBL_OFF = 155648 - 512;

constexpr size_t MiB = 1u << 20;
constexpr size_t WS_CTL = 0;
constexpr size_t WS_ST = 1 * MiB;
constexpr size_t WS_STM = 5 * MiB;
constexpr size_t WS_CS = 5 * MiB + 512 * 1024;
constexpr size_t WS_KST = 6 * MiB;
constexpr size_t WS_QST = 14 * MiB;
constexpr size_t WS_MEMB = 22 * MiB;
constexpr size_t WS_W = 38 * MiB;
constexpr size_t W_LAYER = 27 * MiB;
constexpr size_t W_IN = 0, W_OUT = (size_t)(4.5 * MiB), W_Q = (size_t)(6.5 * MiB), W_O = (size_t)(8.5 * MiB), W_UP = (size_t)(10.5 * MiB), W_DOWN = (size_t)(21.5 * MiB);
constexpr size_t WS_WKV = WS_W + 4 * W_LAYER;
constexpr size_t WS_HB = 162 * MiB;
constexpr size_t WS_KV = 290 * MiB;
constexpr size_t WS_BIG = 418 * MiB;
constexpr size_t WS_PROJ = WS_BIG;
constexpr size_t WS_MIXED = WS_BIG + 288 * MiB;
constexpr size_t WS_QM = WS_MIXED + 128 * MiB;
constexpr size_t WS_GU = WS_BIG;
constexpr size_t WS_ACT = WS_BIG + 352 * MiB;
constexpr size_t WS_END = WS_QM + 128 * MiB;
static_assert(WS_WKV + 16 * MiB <= WS_HB, "ws map");
static_assert(WS_ACT + 176 * MiB <= WS_END, "ws map");

struct Args { const float* in[28]; float* out; unsigned char* ws; };
struct Ctx { LAS const unsigned long long* tbl; float* out; unsigned char* ws; };
__device__ __forceinline__ const float* inptr(const Ctx& c, int i) {
    const unsigned long long v = c.tbl[i];
    const unsigned lo = __builtin_amdgcn_readfirstlane((unsigned)v), hi = __builtin_amdgcn_readfirstlane((unsigned)(v >> 32));
    return (const float*)(((unsigned long long)hi << 32) | lo);
}

__device__ __forceinline__ float bf2f(unsigned short b) { return __uint_as_float(((unsigned)b) << 16); }
__device__ __forceinline__ float bflo(unsigned w) { return __uint_as_float(w << 16); }
__device__ __forceinline__ float bfhi(unsigned w) { return __uint_as_float(w & 0xffff0000u); }
__device__ __forceinline__ unsigned pkbf(float lo, float hi) { unsigned r; asm("v_cvt_pk_bf16_f32 %0, %1, %2" : "=v"(r) : "v"(lo), "v"(hi)); return r; }
__device__ __forceinline__ unsigned short f2bf(float f) { return (unsigned short)(pkbf(f, 0.f) & 0xffffu); }
__device__ __forceinline__ float wave_sum(float v) {
#pragma unroll
    for (int o = 1; o < 64; o <<= 1) v += __shfl_xor(v, o);
    return v;
}
__device__ __forceinline__ float sigmoidf_(float x) { return 1.0f / (1.0f + __expf(-x)); }
__device__ __forceinline__ float gelu_tanh(float x) {
    const float u = 0.7978845608028654f * (x + 0.044715f * x * x * x);
    return x / (1.0f + __expf(-2.0f * u));
}
__device__ __forceinline__ int tid_l() { int t = threadIdx.x; asm volatile("" : "+v"(t)); return t; }
__device__ __forceinline__ s16x4 vtr(LAS const unsigned char* p) {
    typedef short v4i16_t __attribute__((ext_vector_type(4)));
    return __builtin_bit_cast(s16x4, __builtin_amdgcn_ds_read_tr16_b64_v4i16((LAS v4i16_t*)p));
}

template <bool QKN> struct EpiBf {
    static constexpr bool PERM = true, AFTER_DRAIN = false;
    bf16_t* O; int ldc; const float* st; float* pst; int npg; const float* cs; const float* qg; const float* kg;
    __device__ __forceinline__ void operator()(const f32x4 (&acc)[2][2][4][2], const pg8::Unit& u, int wr, int wc, int fr, int fq) const {
        int kind = 0; const float* gsel = nullptr;
        if (QKN) { const int c0 = u.pn * 256 + 64 * wc; if (c0 >= 256 && c0 < 640) { kind = 1; gsel = qg; } else if (c0 >= 640 && c0 < 1024) { kind = 2; gsel = kg; } }
#pragma unroll
        for (int ai = 0; ai < 2; ++ai)
#pragma unroll
            for (int m = 0; m < 4; ++m) {
                const int r = u.pm * 256 + ai * 128 + wr * 64 + m * 16 + fr;
                const f32x4* sp = (const f32x4*)(st + (size_t)r * 16);
                const f32x4 s0 = sp[0], s1 = sp[1], s2 = sp[2], s3 = sp[3];
                const float ssum = ((s0[0] + s0[1]) + (s0[2] + s0[3])) + ((s1[0] + s1[1]) + (s1[2] + s1[3])) + ((s2[0] + s2[1]) + (s2[2] + s2[3])) + ((s3[0] + s3[1]) + (s3[2] + s3[3]));
                const float rs = rsqrtf(ssum * (1.0f / 1024.0f) + EPSF);
                f32x4 v[2][2];
#pragma unroll
                for (int bj = 0; bj < 2; ++bj)
#pragma unroll
                    for (int n = 0; n < 2; ++n) v[bj][n] = acc[ai][bj][m][n] * rs;
                if (QKN) {
                    if (kind != 0) {
                        float ss = 0.f;
#pragma unroll
                        for (int bj = 0; bj < 2; ++bj)
#pragma unroll
                            for (int n = 0; n < 2; ++n) ss += (v[bj][n][0] * v[bj][n][0] + v[bj][n][1] * v[bj][n][1]) + (v[bj][n][2] * v[bj][n][2] + v[bj][n][3] * v[bj][n][3]);
                        ss += __shfl_xor(ss, 16); ss += __shfl_xor(ss, 32);
                        float rn = rsqrtf(ss * (1.0f / 64.0f) + EPSF);
                        if (kind == 1) rn *= 0.125f * LOG2E;
#pragma unroll
                        for (int bj = 0; bj < 2; ++bj)
#pragma unroll
                            for (int n = 0; n < 2; ++n) { const f32x4 gv = *(const f32x4*)(gsel + 32 * bj + 8 * fq + 4 * n); v[bj][n] = v[bj][n] * rn * gv; }
                    }
                } else {
                    if (pst) {
#pragma unroll
                        for (int bj = 0; bj < 2; ++bj) {
                            float ss = (v[bj][0][0] * v[bj][0][0] + v[bj][0][1] * v[bj][0][1]) + (v[bj][0][2] * v[bj][0][2] + v[bj][0][3] * v[bj][0][3])
                                     + (v[bj][1][0] * v[bj][1][0] + v[bj][1][1] * v[bj][1][1]) + (v[bj][1][2] * v[bj][1][2] + v[bj][1][3] * v[bj][1][3]);
                            ss += __shfl_xor(ss, 16); ss += __shfl_xor(ss, 32);
                            if (fq == 0) pst[(size_t)r * npg + (u.pn * 8 + bj * 4 + wc)] = ss;
                        }
                    }
                    if (cs) {
#pragma unroll
                        for (int bj = 0; bj < 2; ++bj)
#pragma unroll
                            for (int n = 0; n < 2; ++n) { const f32x4 cv = *(const f32x4*)(cs + u.pn * 256 + bj * 128 + wc * 32 + 8 * fq + 4 * n); v[bj][n] = v[bj][n] * cv; }
                    }
                }
#pragma unroll
                for (int bj = 0; bj < 2; ++bj) {
                    const int col = QKN ? (u.pn * 256 + 64 * wc + 32 * bj + 8 * fq) : (u.pn * 256 + 128 * bj + 32 * wc + 8 * fq);
                    u32x4 w; w.x = pkbf(v[bj][0][0], v[bj][0][1]); w.y = pkbf(v[bj][0][2], v[bj][0][3]); w.z = pkbf(v[bj][1][0], v[bj][1][1]); w.w = pkbf(v[bj][1][2], v[bj][1][3]);
                    *(u32x4*)(O + (size_t)r * ldc + col) = w;
                }
                asm volatile("" ::: "memory");
            }
    }
};

struct EpiRes {
    static constexpr bool PERM = false, AFTER_DRAIN = false;
    const float* resid; float* out; bf16_t* hb; float* st;
    __device__ __forceinline__ void operator()(const f32x4 (&acc)[2][2][4][2], const pg8::Unit& u, int wr, int wc, int fr, int fq) const {
#pragma unroll
        for (int ai = 0; ai < 2; ++ai)
#pragma unroll
            for (int m = 0; m < 4; ++m) {
                const int r = u.pm * 256 + ai * 128 + wr * 64 + m * 16 + fr;
                float ss = 0.f;
#pragma unroll
                for (int bj = 0; bj < 2; ++bj)
#pragma unroll
                    for (int n = 0; n < 2; ++n) {
                        const size_t off = (size_t)r * DM + (u.pn * 256 + bj * 128 + wc * 32 + n * 16 + 4 * fq);
                        const f32x4 v = *(const f32x4*)(resid + off) + acc[ai][bj][m][n];
                        *(f32x4*)(out + off) = v;
                        u32x2 w; w.x = pkbf(v[0], v[1]); w.y = pkbf(v[2], v[3]);
                        *(u32x2*)(hb + off) = w;
                        ss += (v[0] * v[0] + v[1] * v[1]) + (v[2] * v[2] + v[3] * v[3]);
                    }
                ss += __shfl_xor(ss, 16); ss += __shfl_xor(ss, 32);
                if (fq == 0) st[(size_t)r * 16 + u.pn * 4 + wc] = ss;
                asm volatile("" ::: "memory");
            }
    }
};

template <class Epi>
__device__ __forceinline__ void run_gemm(LAS unsigned char* lds, const bf16_t* A, const bf16_t* Bt, int M, int N, int K, const Epi& E) {
    pg8::Gemm g{A, Bt, M, N, K}; pg8::StaticOrder S; S.init(M, N, (int)gridDim.x, (int)blockIdx.x);
    pg8::gemm_phase<Epi, pg8::StaticOrder, true, true>(lds, g, S, E);
}

__device__ __forceinline__ void transpose_item(const float* W, int ldw, int K, const float* gain, bf16_t* WT, int dst_row0, bool zero, LAS float* scr, int k0, int n0, int lane) {
#pragma unroll 8
    for (int i = 0; i < 32; ++i) {
        const int kk = 2 * i + (lane >> 5);
        float v = 0.f;
        if (!zero) { v = W[(size_t)(k0 + kk) * ldw + n0 + (lane & 31)]; if (gain) v *= gain[k0 + kk]; }
        scr[kk * 33 + (lane & 31)] = v;
    }
    asm volatile("s_waitcnt lgkmcnt(0)" ::: "memory");
    const int c = lane & 7;
#pragma unroll
    for (int j = 0; j < 4; ++j) {
        const int n = (lane >> 3) + 8 * j; const LAS float* s = scr + (8 * c) * 33 + n;
        u32x4 o; o.x = pkbf(s[0 * 33], s[1 * 33]); o.y = pkbf(s[2 * 33], s[3 * 33]); o.z = pkbf(s[4 * 33], s[5 * 33]); o.w = pkbf(s[6 * 33], s[7 * 33]);
        *(u32x4*)(WT + (size_t)(dst_row0 + n) * K + k0 + 8 * c) = o;
    }
    asm volatile("s_waitcnt lgkmcnt(0)" ::: "memory");
}
__device__ __forceinline__ void row_to_bf16(const float* xrow, bf16_t* orow, float* strow, int lane) {
    const f32x4* xr = (const f32x4*)xrow + lane;
    f32x4 v[4]; float s = 0.f;
#pragma unroll
    for (int j = 0; j < 4; ++j) { v[j] = xr[64 * j]; s += (v[j][0] * v[j][0] + v[j][1] * v[j][1]) + (v[j][2] * v[j][2] + v[j][3] * v[j][3]); }
    s = wave_sum(s);
    u32x2* o8 = (u32x2*)orow + lane;
#pragma unroll
    for (int j = 0; j < 4; ++j) { u32x2 w; w.x = pkbf(v[j][0], v[j][1]); w.y = pkbf(v[j][2], v[j][3]); o8[64 * j] = w; }
    if (lane < 16) strow[lane] = (lane == 0) ? s : 0.f;
}
__device__ __forceinline__ void phase_prologue(const Ctx& a, LAS unsigned char* lds) {
    const int tid = tid_l(), lane = tid & 63, wave = tid >> 6;
    LAS float* scr = (LAS float*)(lds + wave * 16384);
    const int gw = blockIdx.x * 8 + wave, NGW = gridDim.x * 8;
    unsigned char* ws = a.ws;
    constexpr int I_IN = 16 * 72, I_SQ = 16 * 32, I_UP = 16 * 176, I_DN = 44 * 32, I_KV = 16 * 64;
    constexpr int I_LAYER = I_IN + 3 * I_SQ + I_UP + I_DN + I_KV;
    for (int it = gw; it < DEPTH * I_LAYER; it += NGW) {
        const int l = it / I_LAYER; int r = it % I_LAYER;
        bf16_t* wl = (bf16_t*)(ws + WS_W + (size_t)l * W_LAYER);
        if (r < I_IN) {
            const int kb = r / 72, nb = r % 72, n0 = nb * 32;
            const int dst = (n0 & ~255) + 128 * ((n0 >> 5) & 1) + 32 * ((n0 >> 6) & 3);
            transpose_item(inptr(a, 3) + (size_t)l * DM * INW, INW, DM, inptr(a, 2) + l * DM, (bf16_t*)((unsigned char*)wl + W_IN), dst, n0 >= INW, scr, kb * 64, n0, lane);
            continue;
        }
        r -= I_IN;
        if (r < I_SQ) { transpose_item(inptr(a, 15) + (size_t)l * DM * DM, DM, DM, nullptr, (bf16_t*)((unsigned char*)wl + W_OUT), (r % 32) * 32, false, scr, (r / 32) * 64, (r % 32) * 32, lane); continue; }
        r -= I_SQ;
        if (r < I_SQ) { transpose_item(inptr(a, 18) + (size_t)l * DM * DM, DM, DM, inptr(a, 16) + l * DM, (bf16_t*)((unsigned char*)wl + W_Q), (r % 32) * 32, false, scr, (r / 32) * 64, (r % 32) * 32, lane); continue; }
        r -= I_SQ;
        if (r < I_SQ) { transpose_item(inptr(a, 22) + (size_t)l * DM * DM, DM, DM, nullptr, (bf16_t*)((unsigned char*)wl + W_O), (r % 32) * 32, false, scr, (r / 32) * 64, (r % 32) * 32, lane); continue; }
        r -= I_SQ;
        if (r < I_UP) { transpose_item(inptr(a, 24) + (size_t)l * DM * DFF2, DFF2, DM, inptr(a, 23) + l * DM, (bf16_t*)((unsigned char*)wl + W_UP), (r % 176) * 32, false, scr, (r / 176) * 64, (r % 176) * 32, lane); continue; }
        r -= I_UP;
        if (r < I_DN) { transpose_item(inptr(a, 27) + (size_t)l * DFF * DM, DM, DFF, nullptr, (bf16_t*)((unsigned char*)wl + W_DOWN), (r % 32) * 32, false, scr, (r / 32) * 64, (r % 32) * 32, lane); continue; }
        r -= I_DN;
        transpose_item(inptr(a, 19) + (size_t)l * DM * 2048, 2048, DM, inptr(a, 17) + l * DM, (bf16_t*)(ws + WS_WKV), l * 2048 + (r % 64) * 32, false, scr, (r / 64) * 64, (r % 64) * 32, lane);
    }
    for (int i = blockIdx.x * NTHREADS + tid; i < DEPTH * DM; i += gridDim.x * NTHREADS) { const int l = i >> 10, dd = i & 255; ((float*)(ws + WS_CS))[i] = inptr(a, 20)[l * 256 + dd] * inptr(a, 21)[l * 256 + dd] * (0.0625f * LOG2E); }
    for (int m = gw; m < MTOK; m += NGW) row_to_bf16(inptr(a, 0) + (size_t)m * DM, (bf16_t*)(ws + WS_HB) + (size_t)m * DM, (float*)(ws + WS_ST) + (size_t)m * 16, lane);
    for (int m = gw; m < MEMROWS; m += NGW) row_to_bf16(inptr(a, 1) + (size_t)m * DM, (bf16_t*)(ws + WS_MEMB) + (size_t)m * DM, (float*)(ws + WS_STM) + (size_t)m * 16, lane);
}

__device__ __forceinline__ void lru_unit(const Ctx& a, int l, int b, int g, LAS unsigned char* lds) {
    const int tid = tid_l(), lane = tid & 63, wave = tid >> 6, l15 = lane & 15, gq = lane >> 4;
    LAS unsigned char* XCB = lds;
    LAS float* XCF = (LAS float*)(lds + 18432);
    LAS float* AA = (LAS float*)(lds + 51200);
    LAS float* BB = (LAS float*)(lds + 83968);
    LAS unsigned char* WT = lds + 116736;
    const bf16_t* proj = (const bf16_t*)(a.ws + WS_PROJ) + (size_t)b * SEQ * NPROJ;
    bf16_t* mixed = (bf16_t*)(a.ws + WS_MIXED) + (size_t)b * SEQ * DM;
    const float* wa = inptr(a, 10) + ((size_t)l * 6 + g) * 4096; const float* wx = inptr(a, 12) + ((size_t)l * 6 + g) * 4096;
    for (int k = 0; k < 16; ++k) {
        const int idx = tid + 512 * k, which = idx >> 12, cp = (idx >> 6) & 63, c = idx & 63;
        const float v = which ? wx[cp * 64 + c] : wa[cp * 64 + c];
        *(LAS unsigned short*)(WT + (which * 64 + c) * 144 + cp * 2) = f2bf(v);
    }
    const int cch = tid & 63, ch = g * 64 + cch;
    float cw[4];
#pragma unroll
    for (int j = 0; j < 4; ++j) cw[j] = inptr(a, 8)[((size_t)l * 4 + j) * 384 + ch];
    const float cb = inptr(a, 9)[l * 384 + ch];
    float gba[4], gbx[4], gsp[4];
#pragma unroll
    for (int nt = 0; nt < 4; ++nt) {
        const int c2 = l * 384 + g * 64 + 16 * nt + l15;
        gba[nt] = inptr(a, 11)[c2]; gbx[nt] = inptr(a, 13)[c2];
        const float z = -inptr(a, 14)[c2];
        gsp[nt] = 8.0f * (fmaxf(z, 0.f) + log1pf(__expf(-fabsf(z))));
    }
    float hcar = 0.f;
    __syncthreads();
#pragma unroll 1
    for (int ck = 0; ck < 16; ++ck) {
        const int t0 = ck * 128;
        for (int k = 0; k < 16; ++k) {
            const int t = (tid >> 6) + 8 * k, tt = t0 + t;
            float xc = cb;
#pragma unroll
            for (int j = 0; j < 4; ++j) if (tt - j >= 0) xc += cw[j] * bf2f(proj[(size_t)(tt - j) * NPROJ + 1408 + ch]);
            XCF[t * 64 + cch] = xc;
            *(LAS unsigned short*)(XCB + t * 144 + cch * 2) = f2bf(xc);
        }
        __syncthreads();
        {
            f32x4 acc[8];
#pragma unroll
            for (int nt = 0; nt < 8; ++nt) acc[nt] = (f32x4){0.f, 0.f, 0.f, 0.f};
#pragma unroll
            for (int ks = 0; ks < 2; ++ks) {
                const bf16x8 af = *(LAS const bf16x8*)(XCB + (16 * wave + l15) * 144 + (32 * ks + 8 * gq) * 2);
#pragma unroll
                for (int nt = 0; nt < 8; ++nt) {
                    const bf16x8 bfr = *(LAS const bf16x8*)(WT + (16 * nt + l15) * 144 + (32 * ks + 8 * gq) * 2);
                    acc[nt] = __builtin_amdgcn_mfma_f32_16x16x32_bf16(af, bfr, acc[nt], 0, 0, 0);
                }
            }
#pragma unroll
            for (int nt = 0; nt < 4; ++nt)
#pragma unroll
                for (int rg = 0; rg < 4; ++rg) {
                    const int t = 16 * wave + 4 * gq + rg, c = 16 * nt + l15;
                    const float r = sigmoidf_(acc[nt][rg] + gba[nt]), ig = sigmoidf_(acc[nt + 4][rg] + gbx[nt]);
                    const float la = -r * gsp[nt];
                    const float av = __expf(la);
                    const float xcv = XCF[t * 64 + c];
                    AA[t * 64 + c] = av;
                    BB[t * 64 + c] = sqrtf(fmaxf(-expm1f(2.0f * la), 0.f)) * (ig * xcv);
                }
        }
        __syncthreads();
        if (wave == 0) {
#pragma unroll 8
            for (int t = 0; t < 128; ++t) { hcar = AA[t * 64 + lane] * hcar + BB[t * 64 + lane]; BB[t * 64 + lane] = hcar; }
        }
        __syncthreads();
        for (int k = 0; k < 16; ++k) {
            const int t = (tid >> 6) + 8 * k, tt = t0 + t;
            const float y = bf2f(proj[(size_t)tt * NPROJ + 1792 + ch]);
            mixed[(size_t)tt * DM + 640 + ch] = f2bf(BB[t * 64 + cch] * gelu_tanh(y));
        }
    }
}

__device__ __forceinline__ void pool_unit(const Ctx& a, int l, int b, int tc, LAS unsigned char* lds) {
    const int tid = tid_l();
    LAS float* U = (LAS float*)lds;
    LAS float* P = (LAS float*)(lds + 80896);
    const int t0 = tc * 64;
    const bf16_t* proj = (const bf16_t*)(a.ws + WS_PROJ) + (size_t)b * SEQ * NPROJ;
    bf16_t* mixed = (bf16_t*)(a.ws + WS_MIXED) + (size_t)b * SEQ * DM;
    for (int k = 0; k < 40; ++k) {
        const int idx = tid + 512 * k;
        if (idx < 79 * 256) { const int tt = idx >> 8, c = idx & 255, t = t0 - 15 + tt; U[idx] = (t >= 0) ? bf2f(proj[(size_t)t * NPROJ + c]) : 0.f; }
    }
    __syncthreads();
    {
        const int c = tid & 255, half = tid >> 8, g = c >> 6, w = 2 << g;
        for (int q = 0; q < 32; ++q) {
            const int tt = half * 32 + q, t = t0 + tt;
            float s = 0.f;
            for (int j = 0; j < w; ++j) s += U[(tt + 15 - j) * 256 + c];
            const float cnt = (float)((t + 1 < w) ? (t + 1) : w);
            P[tt * 256 + c] = s / cnt - U[(tt + 15) * 256 + c];
        }
    }
    __syncthreads();
    {
        const int dcol = tid & 255, half = tid >> 8, g = dcol >> 6, dc = dcol & 63;
        const float* pw = inptr(a, 4) + ((size_t)l * 4 + g) * 4096 + dc;
        float w[64];
#pragma unroll
        for (int c = 0; c < 64; ++c) w[c] = pw[c * 64];
        const float sc = inptr(a, 5)[l * 256 + dcol];
        for (int q = 0; q < 32; ++q) {
            const int tt = half * 32 + q;
            const LAS f32x4* pr = (const LAS f32x4*)(P + tt * 256 + g * 64);
            float acc = 0.f;
#pragma unroll
            for (int c4 = 0; c4 < 16; ++c4) { const f32x4 pv = pr[c4]; acc += pv[0] * w[4 * c4] + pv[1] * w[4 * c4 + 1] + pv[2] * w[4 * c4 + 2] + pv[3] * w[4 * c4 + 3]; }
            mixed[(size_t)(t0 + tt) * DM + dcol] = f2bf(acc * sc);
        }
    }
}

__device__ __forceinline__ void dattn_unit(const Ctx& a, int b, int h, int tb, LAS unsigned char* lds) {
    const int tid = tid_l(), lane = tid & 63, wave = tid >> 6, l15 = lane & 15, gq = lane >> 4;
    LAS float* OACC = (LAS float*)lds;
    LAS float* DEN = (LAS float*)(lds + 65536);
    LAS unsigned char* vst = lds + 66560 + wave * 4608;
    const int t0 = tb * 256;
    const bf16_t* projb = (const bf16_t*)(a.ws + WS_PROJ) + (size_t)b * SEQ * NPROJ;
    bf16_t* mixed = (bf16_t*)(a.ws + WS_MIXED) + (size_t)b * SEQ * DM;
    const float slope2 = exp2f(-8.0f * (float)(h + 1) / 6.0f) * LOG2E;
    const int trq = (l15 >> 2), trp = (l15 & 3);
#pragma unroll 1
    for (int pi = 0; pi < 3; ++pi) {
        const int d = 1 << (2 * pi);
        const float sl = slope2 * (float)d;
#pragma unroll 1
        for (int ii = 0; ii < 2; ++ii) {
            const int it = 2 * wave + ii, rr = it % d, jj = it / d, tq0 = t0 + rr + 16 * d * jj;
            const bf16_t* qrow = projb + (size_t)(tq0 + d * l15) * NPROJ + 256 + h * 64 + 8 * gq;
            const bf16x8 qf0 = *(const bf16x8*)qrow, qf1 = *(const bf16x8*)(qrow + 32);
            f32x4 o[4];
#pragma unroll
            for (int dt = 0; dt < 4; ++dt) o[dt] = (f32x4){0.f, 0.f, 0.f, 0.f};
            float den = 0.f;
#pragma unroll 1
            for (int pp = 0; pp < 5; ++pp) {
#pragma unroll
                for (int ps = 0; ps < 4; ++ps) {
                    const int idx = ps * 64 + lane, row = idx >> 3, chk = idx & 7, kt = 2 * pp + (row >> 4);
                    int tk = tq0 + d * (16 * (kt - 8) + (row & 15)); tk = tk < 0 ? 0 : (tk > SEQ - 1 ? SEQ - 1 : tk);
                    const u32x4 vv = *(const u32x4*)(projb + (size_t)tk * NPROJ + 1024 + h * 64 + chk * 8);
                    *(LAS u32x4*)(vst + row * 144 + chk * 16) = vv;
                }
                float p[2][4];
#pragma unroll
                for (int T = 0; T < 2; ++T) {
                    const int kt = 2 * pp + T;
                    if (kt == 9) { p[T][0] = 0.f; p[T][1] = 0.f; p[T][2] = 0.f; p[T][3] = 0.f; continue; }
                    int tk = tq0 + d * (16 * (kt - 8) + l15); tk = tk < 0 ? 0 : tk;
                    const bf16_t* krow = projb + (size_t)tk * NPROJ + 640 + h * 64 + 8 * gq;
                    const bf16x8 k0 = *(const bf16x8*)krow, k1 = *(const bf16x8*)(krow + 32);
                    f32x4 s = __builtin_amdgcn_mfma_f32_16x16x32_bf16(k0, qf0, (f32x4){0.f, 0.f, 0.f, 0.f}, 0, 0, 0);
                    s = __builtin_amdgcn_mfma_f32_16x16x32_bf16(k1, qf1, s, 0, 0, 0);
#pragma unroll
                    for (int rg = 0; rg < 4; ++rg) {
                        const int dist = l15 + 128 - 16 * kt - 4 * gq - rg;
                        const int tkk = tq0 + d * (l15 - dist);
                        const bool valid = (dist >= 0) && (dist <= 128) && (tkk >= 0);
                        const float pv = valid ? __builtin_amdgcn_exp2f(s[rg] - sl * (float)dist) : 0.f;
                        p[T][rg] = pv; den += pv;
                    }
                }
                u32x4 pw; pw.x = pkbf(p[0][0], p[0][1]); pw.y = pkbf(p[0][2], p[0][3]); pw.z = pkbf(p[1][0], p[1][1]); pw.w = pkbf(p[1][2], p[1][3]);
                const bf16x8 pfrag = __builtin_bit_cast(bf16x8, pw);
#pragma unroll
                for (int dt = 0; dt < 4; ++dt) {
                    const s16x4 lo = vtr(vst + (4 * gq + trq) * 144 + (16 * dt + 4 * trp) * 2);
                    const s16x4 hi = vtr(vst + (16 + 4 * gq + trq) * 144 + (16 * dt + 4 * trp) * 2);
                    const bf16x8 vf = (bf16x8){lo[0], lo[1], lo[2], lo[3], hi[0], hi[1], hi[2], hi[3]};
                    o[dt] = __builtin_amdgcn_mfma_f32_16x16x32_bf16(pfrag, vf, o[dt], 0, 0, 0);
                }
            }
            den += __shfl_xor(den, 16); den += __shfl_xor(den, 32);
#pragma unroll
            for (int dt = 0; dt < 4; ++dt)
#pragma unroll
                for (int rg = 0; rg < 4; ++rg) {
                    const int tl = (tq0 - t0) + d * (4 * gq + rg), idx = tl * 64 + 16 * dt + l15;
                    if (pi == 0) OACC[idx] = o[dt][rg]; else OACC[idx] += o[dt][rg];
                }
            if (gq == 0) { const int tl = (tq0 - t0) + d * l15; if (pi == 0) DEN[tl] = den; else DEN[tl] += den; }
        }
        __syncthreads();
    }
    for (int k = 0; k < 32; ++k) {
        const int idx = tid + 512 * k, tl = idx >> 6, dc = idx & 63;
        mixed[(size_t)(t0 + tl) * DM + 256 + h * 64 + dc] = f2bf(OACC[idx] / DEN[tl]);
    }
}

__device__ __forceinline__ void phase_mixers(const Ctx& a, int l, LAS unsigned char* lds) {
    unsigned* ctr = (unsigned*)(a.ws + WS_CTL) + 64 * l;
    LAS int* sun = (LAS int*)(lds + LDS_UNIT_OFF);
    constexpr int N_LRU = 192, N_ATT = 1536, N_POOL = 1024;
    for (;;) {
        __syncthreads();
        if (threadIdx.x == 0) *sun = (int)atomicAdd(ctr, 1u);
        __syncthreads();
        const int u = *sun;
        if (u >= N_LRU + N_ATT + N_POOL) break;
        if (u < N_LRU) lru_unit(a, l, u / 6, u % 6, lds);
        else if (u < N_LRU + N_ATT) { const int v = u - N_LRU; dattn_unit(a, v / 48, (v % 48) / 8, v % 8, lds); }
        else { const int v = u - N_LRU - N_ATT; pool_unit(a, l, v / 32, v % 32, lds); }
    }
}

__device__ __forceinline__ void phase_xattn(const Ctx& a, int l, LAS unsigned char* lds) {
    const int tid = tid_l(), lane = tid & 63, wave = tid >> 6, l15 = lane & 15, gq = lane >> 4;
    LAS unsigned char* KL = lds;
    LAS unsigned char* VL = lds + 16896;
    LAS float* RK = (LAS float*)(lds + 34304);
    const bf16_t* qm = (const bf16_t*)(a.ws + WS_QM);
    const float* qst = (const float*)(a.ws + WS_QST);
    const bf16_t* kv = (const bf16_t*)(a.ws + WS_KV);
    const float* kst = (const float*)(a.ws + WS_KST);
    bf16_t* om = (bf16_t*)(a.ws + WS_MIXED);
    const int trq = (l15 >> 2), trp = (l15 & 3);
    for (int xu = blockIdx.x; xu < NBATCH * 4 * 16; xu += gridDim.x) {
        const int b = xu >> 6, h = (xu >> 4) & 3, qb = xu & 15;
        __syncthreads();
        if (tid < 256) {
            const f32x4* kp = (const f32x4*)(kst + (size_t)(b * 256 + tid) * 256 + l * 64 + h * 8);
            const f32x4 k0 = kp[0], k1 = kp[1];
            RK[tid] = rsqrtf((((k0[0] + k0[1]) + (k0[2] + k0[3])) + ((k1[0] + k1[1]) + (k1[2] + k1[3]))) * (1.0f / 256.0f) + EPSF);
        }
        const size_t qrow = (size_t)b * SEQ + qb * 128 + wave * 16 + l15;
        bf16x8 qf[8];
#pragma unroll
        for (int ks = 0; ks < 8; ++ks) qf[ks] = *(const bf16x8*)(qm + qrow * DM + h * 256 + 32 * ks + 8 * gq);
        float rq;
        { const f32x4* qp = (const f32x4*)(qst + qrow * 32 + h * 8); const f32x4 q0 = qp[0], q1 = qp[1];
          rq = rsqrtf((((q0[0] + q0[1]) + (q0[2] + q0[3])) + ((q1[0] + q1[1]) + (q1[2] + q1[3]))) * (1.0f / 256.0f) + EPSF); }
        f32x4 o[16];
#pragma unroll
        for (int dt = 0; dt < 16; ++dt) o[dt] = (f32x4){0.f, 0.f, 0.f, 0.f};
        float den = 0.f;
#pragma unroll 1
        for (int c = 0; c < 8; ++c) {
            __syncthreads();
#pragma unroll
            for (int k = 0; k < 2; ++k) {
                const int idx = tid + 512 * k, row = idx >> 5, chk = idx & 31;
                const bf16_t* src = kv + (size_t)(b * 256 + 32 * c + row) * 8192 + l * 2048 + h * 256 + chk * 8;
                const u32x4 kk = *(const u32x4*)src, vv = *(const u32x4*)(src + 1024);
                *(LAS u32x4*)(KL + row * 528 + chk * 16) = kk;
                *(LAS u32x4*)(VL + row * 544 + chk * 16) = vv;
            }
            __syncthreads();
            float p[2][4];
#pragma unroll
            for (int T = 0; T < 2; ++T) {
                f32x4 s = (f32x4){0.f, 0.f, 0.f, 0.f};
#pragma unroll
                for (int ks = 0; ks < 8; ++ks) {
                    const bf16x8 kf = *(LAS const bf16x8*)(KL + (16 * T + l15) * 528 + (32 * ks + 8 * gq) * 2);
                    s = __builtin_amdgcn_mfma_f32_16x16x32_bf16(kf, qf[ks], s, 0, 0, 0);
                }
                const f32x4 rk4 = *(LAS const f32x4*)(RK + 32 * c + 16 * T + 4 * gq);
#pragma unroll
                for (int rg = 0; rg < 4; ++rg) { const float pv = __builtin_amdgcn_exp2f(s[rg] * rq * rk4[rg]); p[T][rg] = pv; den += pv; }
            }
            u32x4 pw; pw.x = pkbf(p[0][0], p[0][1]); pw.y = pkbf(p[0][2], p[0][3]); pw.z = pkbf(p[1][0], p[1][1]); pw.w = pkbf(p[1][2], p[1][3]);
            const bf16x8 pfrag = __builtin_bit_cast(bf16x8, pw);
#pragma unroll
            for (int dt = 0; dt < 16; ++dt) {
                const s16x4 lo = vtr(VL + (4 * gq + trq) * 544 + (16 * dt + 4 * trp) * 2);
                const s16x4 hi = vtr(VL + (16 + 4 * gq + trq) * 544 + (16 * dt + 4 * trp) * 2);
                const bf16x8 vf = (bf16x8){lo[0], lo[1], lo[2], lo[3], hi[0], hi[1], hi[2], hi[3]};
                o[dt] = __builtin_amdgcn_mfma_f32_16x16x32_bf16(pfrag, vf, o[dt], 0, 0, 0);
            }
        }
        den += __shfl_xor(den, 16); den += __shfl_xor(den, 32);
        float inv[4];
#pragma unroll
        for (int rg = 0; rg < 4; ++rg) inv[rg] = 1.0f / __shfl(den, 4 * gq + rg);
        const size_t orow0 = (size_t)b * SEQ + qb * 128 + wave * 16 + 4 * gq;
#pragma unroll
        for (int dt = 0; dt < 16; ++dt)
#pragma unroll
            for (int rg = 0; rg < 4; ++rg) om[(orow0 + rg) * DM + h * 256 + 16 * dt + l15] = f2bf(o[dt][rg] * inv[rg]);
    }
}

__device__ __forceinline__ void phase_act(const Ctx& a, int l) {
    const bf16_t* gu = (const bf16_t*)(a.ws + WS_GU);
    bf16_t* act = (bf16_t*)(a.ws + WS_ACT);
    const float* cw = inptr(a, 25) + (size_t)l * 3 * DFF; const float* cb = inptr(a, 26) + (size_t)l * DFF;
    const int total = MHALF * (DFF / 8);
    for (int idx = blockIdx.x * NTHREADS + threadIdx.x; idx < total; idx += gridDim.x * NTHREADS) {
        const int row = idx / (DFF / 8), f0 = (idx % (DFF / 8)) * 8, tl = row & (SEQ - 1);
        const bf16_t* gp = gu + (size_t)row * DFF2 + f0;
        const u32x4 g0 = *(const u32x4*)gp;
        const u32x4 g1 = (tl >= 1) ? *(const u32x4*)(gp - DFF2) : (u32x4){0u, 0u, 0u, 0u};
        const u32x4 g2 = (tl >= 2) ? *(const u32x4*)(gp - 2 * DFF2) : (u32x4){0u, 0u, 0u, 0u};
        const u32x4 uu = *(const u32x4*)(gp + DFF);
        float r[8];
#pragma unroll
        for (int j = 0; j < 4; ++j) {
            const int f = f0 + 2 * j;
            const float c0 = cb[f] + cw[f] * bflo(g0[j]) + cw[DFF + f] * bflo(g1[j]) + cw[2 * DFF + f] * bflo(g2[j]);
            const float c1 = cb[f + 1] + cw[f + 1] * bfhi(g0[j]) + cw[DFF + f + 1] * bfhi(g1[j]) + cw[2 * DFF + f + 1] * bfhi(g2[j]);
            r[2 * j] = gelu_tanh(c0) * bflo(uu[j]); r[2 * j + 1] = gelu_tanh(c1) * bfhi(uu[j]);
        }
        u32x4 w; w.x = pkbf(r[0], r[1]); w.y = pkbf(r[2], r[3]); w.z = pkbf(r[4], r[5]); w.w = pkbf(r[6], r[7]);
        *(u32x4*)(act + (size_t)row * DFF + f0) = w;
    }
}

__global__ void __launch_bounds__(NTHREADS, 2) trunk_fwd(Args ka) {
    extern __shared__ __attribute__((aligned(16))) unsigned char lds_raw[];
    LAS unsigned char* lds = (LAS unsigned char*)lds_raw;
    cg::grid_group grid = cg::this_grid();
    {
        LAS unsigned long long* tw = (LAS unsigned long long*)(lds + LDS_TBL_OFF);
        if (threadIdx.x == 0) {
#pragma unroll
            for (int i = 0; i < 28; ++i) tw[i] = (unsigned long long)ka.in[i];
        }
        __syncthreads();
    }
    Ctx a; a.tbl = (LAS const unsigned long long*)(lds + LDS_TBL_OFF); a.out = ka.out; a.ws = ka.ws;
    unsigned char* ws = a.ws;
    bf16_t* hb = (bf16_t*)(ws + WS_HB);
    float* st = (float*)(ws + WS_ST);

    phase_prologue(a, lds);
    grid.sync();
    {
        EpiBf<false> E{(bf16_t*)(ws + WS_KV), 8192, (const float*)(ws + WS_STM), (float*)(ws + WS_KST), 256, nullptr, nullptr, nullptr};
        run_gemm(lds, (const bf16_t*)(ws + WS_MEMB), (const bf16_t*)(ws + WS_WKV), MEMROWS, 8192, DM, E);
    }
    for (int l = 0; l < DEPTH; ++l) {
        const unsigned char* wl = ws + WS_W + (size_t)l * W_LAYER;
        {
            EpiBf<true> E{(bf16_t*)(ws + WS_PROJ), NPROJ, st, nullptr, 0, nullptr, inptr(a, 6) + l * 64, inptr(a, 7) + l * 64};
            run_gemm(lds, hb, (const bf16_t*)(wl + W_IN), MTOK, NPROJ, DM, E);
        }
        grid.sync();
        phase_mixers(a, l, lds);
        grid.sync();
        {
            EpiRes E{l == 0 ? inptr(a, 0) : a.out, a.out, hb, st};
            run_gemm(lds, (const bf16_t*)(ws + WS_MIXED), (const bf16_t*)(wl + W_OUT), MTOK, DM, DM, E);
        }
        grid.sync();
        {
            EpiBf<false> E{(bf16_t*)(ws + WS_QM), DM, st, (float*)(ws + WS_QST), 32, (const float*)(ws + WS_CS) + l * 1024, nullptr, nullptr};
            run_gemm(lds, hb, (const bf16_t*)(wl + W_Q), MTOK, DM, DM, E);
        }
        grid.sync();
        phase_xattn(a, l, lds);
        grid.sync();
        {
            EpiRes E{a.out, a.out, hb, st};
            run_gemm(lds, (const bf16_t*)(ws + WS_MIXED), (const bf16_t*)(wl + W_O), MTOK, DM, DM, E);
        }
        grid.sync();
        for (int hf = 0; hf < 2; ++hf) {
            {
                EpiBf<false> E{(bf16_t*)(ws + WS_GU), DFF2, st + (size_t)hf * MHALF * 16, nullptr, 0, nullptr, nullptr, nullptr};
                run_gemm(lds, hb + (size_t)hf * MHALF * DM, (const bf16_t*)(wl + W_UP), MHALF, DFF2, DM, E);
            }
            grid.sync();
            phase_act(a, l);
            grid.sync();
            {
                float* oh = a.out + (size_t)hf * MHALF * DM;
                EpiRes E{oh, oh, hb + (size_t)hf * MHALF * DM, st + (size_t)hf * MHALF * 16};
                run_gemm(lds, (const bf16_t*)(ws + WS_ACT), (const bf16_t*)(wl + W_DOWN), MHALF, DM, DFF, E);
            }
            grid.sync();
        }
    }
}

extern "C" void kernel_launch(void* const* d_in, const int* in_sizes, int n_in, void* d_out, int out_size, void* d_ws, size_t ws_size, hipStream_t stream) {
    static int grid = 0;
    if (grid == 0) {
        if (n_in != 28 || in_sizes[0] != MTOK * DM || out_size != MTOK * DM || ws_size < WS_END) {
            fprintf(stderr, "kernel_launch: unexpected shapes (n_in %d, in0 %d, out %d, ws %zu; need ws >= %zu); nothing launched\n", n_in, n_in > 0 ? in_sizes[0] : -1, out_size, ws_size, (size_t)WS_END);
            grid = -1; return;
        }
        int dev = 0, cus = 0, per_cu = 0;
        hipGetDevice(&dev);
        hipDeviceGetAttribute(&cus, hipDeviceAttributeMultiprocessorCount, dev);
        if (hipFuncSetAttribute((const void*)trunk_fwd, hipFuncAttributeMaxDynamicSharedMemorySize, LDS_BYTES) != hipSuccess) { fprintf(stderr, "kernel_launch: hipFuncSetAttribute failed\n"); grid = -1; return; }
        if (hipOccupancyMaxActiveBlocksPerMultiprocessor(&per_cu, (const void*)trunk_fwd, NTHREADS, LDS_BYTES) != hipSuccess || per_cu < 1) { fprintf(stderr, "kernel_launch: occupancy query says %d blocks per CU\n", per_cu); per_cu = 1; }
        (void)hipGetLastError();
        grid = cus;
    }
    if (grid < 0) return;
    (void)hipMemsetAsync((char*)d_ws + WS_CTL, 0, 4096, stream);
    Args a{};
    for (int i = 0; i < 28; ++i) a.in[i] = (const float*)d_in[i];
    a.out = (float*)d_out; a.ws = (unsigned char*)d_ws;
    void* args[] = {&a};
    hipError_t e = hipLaunchCooperativeKernel((const void*)trunk_fwd, dim3(grid), dim3(NTHREADS), args, LDS_BYTES, stream);
    if (e != hipSuccess) fprintf(stderr, "cooperative launch failed: %s (grid %d)\n", hipGetErrorString(e), grid);
}
```

```cpp
#include <hip/hip_runtime.h>
#include <hip/hip_cooperative_groups.h>
#include <cstdio>
#include <cstdint>
namespace cg = cooperative_groups;
namespace pg8 {
#define PG8_LAS __attribute__((address_space(3)))
typedef unsigned short bf16_t;
typedef short bf16x8 __attribute__((ext_vector_type(8)));
typedef float f32x4 __attribute__((ext_vector_type(4)));
typedef unsigned u32x4 __attribute__((ext_vector_type(4)));
constexpr int BM = 256, BK = 64, HALF = 128, HTB = HALF * BK * 2  , STAGE_BYTES = 8 * HTB, NXCD = 8, WGM = 8;

__host__ __device__ __forceinline__ int lds_byte(int r, int c) { const int st = (r >> 4) * 2 + (c >> 5), rr = r & 15, cc = c & 31, ob = rr * 64 + cc * 2; return st * 1024 + (ob ^ (((ob >> 9) & 1) << 5)); }
__host__ __device__ __forceinline__ void stage_rc(int b, int& R, int& C) { const int st = b / 1024, sb = b % 1024, swz = sb ^ (((sb >> 9) & 1) << 5); R = (st >> 1) * 16 + swz / 64; C = (st & 1) * 32 + (swz % 64) / 2; }
__host__ __device__ __forceinline__ int perm32(int rho) { const int n = rho >> 4, i = rho & 15; return 8 * (i >> 2) + 4 * n + (i & 3); }

struct Unit { int pm, pn; };
struct Gemm { const bf16_t* A; const bf16_t* Bt; int M, N, K; };

struct StaticOrder {
    int nM, nN, nwg, G, c;
    __host__ __device__ void init(int M, int N, int G_, int c_) { nM = M / BM; nN = N / BM; nwg = nM * nN; G = G_; c = c_; }
    __host__ __device__ bool next(int i, Unit& u) const {
        const long L = (long)i * G + c; if (L >= nwg) return false;
        int wgid = (int)L; { const int q = nwg / NXCD, r = nwg % NXCD, xcd = wgid % NXCD, off = wgid / NXCD; wgid = (xcd < r ? xcd * (q + 1) : r * (q + 1) + (xcd - r) * q) + off; }
        const int nig = WGM * nN, gid = wgid / nig, fm = gid * WGM, gsz = (nM - fm) < WGM ? (nM - fm) : WGM;
        u.pm = fm + ((wgid % nig) % gsz); u.pn = (wgid % nig) / gsz; return true;
    }
    __device__ __forceinline__ void a_ready(const Unit&) const {}
    __device__ __forceinline__ void done(const Unit&) const {}
};

__device__ __forceinline__ unsigned cvt_pk_bf16(float lo, float hi) { unsigned r; asm volatile("v_cvt_pk_bf16_f32 %0, %1, %2" : "=v"(r) : "v"(lo), "v"(hi)); return r; }
typedef float f32x2 __attribute__((ext_vector_type(2)));
template <class Epi, class Sched, bool ALIGN_EPI = false, bool SP2 = false>
__device__ __forceinline__ void gemm_phase(PG8_LAS unsigned char* lds, const Gemm g, const Sched& S, const Epi& E) {
    int tid_ = threadIdx.x; asm volatile("" : "+v"(tid_));
    const int tid = tid_, wid = __builtin_amdgcn_readfirstlane(tid >> 6), lane = tid & 63, wr = wid >> 2, wc = wid & 3, fr = lane & 15, fq = lane >> 4;
    const int K = g.K, nt = K / BK;
    unsigned voffA[2], voffB[2];
#pragma unroll
    for (int i = 0; i < 2; ++i) { int R, C; stage_rc(tid * 16 + i * 8192, R, C); const int Rb = Epi::PERM ? ((R & ~31) + perm32(R & 31)) : R;
        voffA[i] = (unsigned)(R * K + C) * 2u; voffB[i] = (unsigned)(Rb * K + C) * 2u; }
    const size_t kstep = (size_t)(BK * 2);
    const size_t hstep = (size_t)HALF * K * 2;
    const size_t tstep = 2 * hstep;
    const unsigned ldsw = (unsigned)wid * 1024u;
    const int aoff = lds_byte(wr * 64 + fr, fq * 8), boff = lds_byte(wc * 32 + fr, fq * 8);
#define PG8_SA(b, h) (((b) * 2 + (h)) * HTB)
#define PG8_SB(b, h) ((4 + (b) * 2 + (h)) * HTB)
#define PG8_STAGE(bufoff, gbase, voff) do { _Pragma("unroll") for (int _i = 0; _i < 2; ++_i) \
        __builtin_amdgcn_global_load_lds((const unsigned*)((const char*)(gbase) + (voff)[_i]), (PG8_LAS unsigned*)(lds + (bufoff) + ldsw + _i * 8192), 16, 0, 0); } while (0)
#define PG8_LDA(dst, b, h) do { _Pragma("unroll") for (int m = 0; m < 4; ++m) _Pragma("unroll") for (int k = 0; k < 2; ++k) dst[m][k] = *(const PG8_LAS bf16x8*)(lds + PG8_SA(b, h) + aoff + m * 2048 + k * 1024); } while (0)
#define PG8_LDB(dst, b, h) do { _Pragma("unroll") for (int n = 0; n < 2; ++n) _Pragma("unroll") for (int k = 0; k < 2; ++k) dst[n][k] = *(const PG8_LAS bf16x8*)(lds + PG8_SB(b, h) + boff + n * 2048 + k * 1024); } while (0)
#define PG8_MMA(ai, bj, At, Bt) do { __builtin_amdgcn_s_setprio(1); _Pragma("unroll") for (int m = 0; m < 4; ++m) _Pragma("unroll") for (int n = 0; n < 2; ++n) _Pragma("unroll") for (int k = 0; k < 2; ++k) \
        acc[ai][bj][m][n] = __builtin_amdgcn_mfma_f32_16x16x32_bf16(Bt[n][k], At[m][k], acc[ai][bj][m][n], 0, 0, 0); __builtin_amdgcn_s_setprio(0); } while (0)
#define PG8_WAIT_V(n) asm volatile("s_waitcnt vmcnt(" #n ")" ::: "memory")
#define PG8_WAIT_L(n) asm volatile("s_waitcnt lgkmcnt(" #n ")" ::: "memory")
#define PG8_BAR __builtin_amdgcn_s_barrier()
#define PG8_SCHED __builtin_amdgcn_sched_barrier(0)
    Unit cur, nxt; int ui = 0;
    if (!S.next(0, cur)) return;
    f32x4 acc[2][2][4][2];
#pragma unroll
    for (int a = 0; a < 2; ++a)
#pragma unroll
        for (int b = 0; b < 2; ++b)
#pragma unroll
            for (int m = 0; m < 4; ++m)
#pragma unroll
                for (int n = 0; n < 2; ++n) acc[a][b][m][n] = (f32x4){0.f, 0.f, 0.f, 0.f};
    bf16x8 At[4][2], B0[2][2], B1[2][2];
    const char* cA = (const char*)g.A + (size_t)cur.pm * tstep; const char* cB = (const char*)g.Bt + (size_t)cur.pn * tstep;
    S.a_ready(cur);
    if constexpr (SP2) {
        PG8_STAGE(PG8_SB(0, 0), cB, voffB); PG8_STAGE(PG8_SB(0, 1), cB + hstep, voffB); PG8_STAGE(PG8_SA(0, 0), cA, voffA); PG8_STAGE(PG8_SA(0, 1), cA + hstep, voffA);
        if (wr == 1) PG8_BAR;
        PG8_WAIT_V(2); PG8_BAR;
        PG8_STAGE(PG8_SB(1, 0), cB + kstep, voffB); PG8_STAGE(PG8_SA(1, 0), cA + kstep, voffA); PG8_STAGE(PG8_SB(1, 1), cB + hstep + kstep, voffB);
        PG8_WAIT_V(6); PG8_BAR;
    } else {
        PG8_STAGE(PG8_SB(0, 0), cB, voffB); PG8_STAGE(PG8_SA(0, 0), cA, voffA); PG8_STAGE(PG8_SB(0, 1), cB + hstep, voffB); PG8_STAGE(PG8_SA(0, 1), cA + hstep, voffA);
        if (wr == 1) PG8_BAR;
        PG8_WAIT_V(4); PG8_BAR;
        PG8_STAGE(PG8_SB(1, 0), cB + kstep, voffB); PG8_STAGE(PG8_SA(1, 0), cA + kstep, voffA); PG8_STAGE(PG8_SB(1, 1), cB + hstep + kstep, voffB);
        PG8_WAIT_V(6); PG8_BAR;
    }
    for (;;) {
        const bool has_next = S.next(ui + 1, nxt);
        const char* nA = has_next ? (const char*)g.A + (size_t)nxt.pm * tstep : cA; const char* nB = has_next ? (const char*)g.Bt + (size_t)nxt.pn * tstep : cB;
        for (int t = 0; t < nt; t += 2) {
            const bool last = (t == nt - 2);
            const char* a1 = cA + (size_t)(t + 1) * kstep;
            const char* a2 = last ? nA : cA + (size_t)(t + 2) * kstep; const char* b2 = last ? nB : cB + (size_t)(t + 2) * kstep;
            const char* a3 = a2 + kstep; const char* b3 = b2 + kstep;
            if (last && has_next) S.a_ready(nxt);
            if constexpr (SP2) {
            PG8_LDB(B0, 0, 0); PG8_LDB(B1, 0, 1); PG8_SCHED; PG8_LDA(At, 0, 0); PG8_STAGE(PG8_SA(1, 1), a1 + hstep, voffA);
            PG8_WAIT_V(8); PG8_WAIT_L(0); PG8_BAR; PG8_MMA(0, 0, At, B0); PG8_MMA(0, 1, At, B1); PG8_BAR; PG8_SCHED;
            PG8_LDA(At, 0, 1); PG8_STAGE(PG8_SB(0, 0), b2, voffB); PG8_STAGE(PG8_SB(0, 1), b2 + hstep, voffB); PG8_STAGE(PG8_SA(0, 0), a2, voffA);
            PG8_WAIT_V(8); PG8_WAIT_L(0); PG8_BAR; PG8_MMA(1, 0, At, B0); PG8_MMA(1, 1, At, B1); PG8_BAR; PG8_SCHED;
            PG8_LDB(B0, 1, 0); PG8_LDB(B1, 1, 1); PG8_SCHED; PG8_LDA(At, 1, 0); PG8_STAGE(PG8_SA(0, 1), a2 + hstep, voffA);
            PG8_WAIT_V(8); PG8_WAIT_L(0); PG8_BAR; PG8_MMA(0, 0, At, B0); PG8_MMA(0, 1, At, B1); PG8_BAR; PG8_SCHED;
            PG8_LDA(At, 1, 1); PG8_STAGE(PG8_SB(1, 0), b3, voffB); PG8_STAGE(PG8_SB(1, 1), b3 + hstep, voffB); PG8_STAGE(PG8_SA(1, 0), a3, voffA);
            PG8_WAIT_V(8); PG8_WAIT_L(0); PG8_BAR; PG8_MMA(1, 0, At, B0); PG8_MMA(1, 1, At, B1); PG8_BAR; PG8_SCHED;
            } else {
            PG8_LDB(B0, 0, 0); PG8_SCHED; PG8_LDA(At, 0, 0); PG8_STAGE(PG8_SA(1, 1), a1 + hstep, voffA);
            PG8_WAIT_L(8); PG8_BAR; PG8_WAIT_L(0); PG8_MMA(0, 0, At, B0); PG8_BAR; PG8_SCHED;
            PG8_LDB(B1, 0, 1); PG8_STAGE(PG8_SB(0, 0), b2, voffB);
            PG8_BAR; PG8_WAIT_L(0); PG8_MMA(0, 1, At, B1); PG8_BAR;
            PG8_LDA(At, 0, 1); PG8_STAGE(PG8_SA(0, 0), a2, voffA);
            PG8_BAR; PG8_WAIT_L(0); PG8_MMA(1, 0, At, B0); PG8_BAR; PG8_SCHED;
            PG8_STAGE(PG8_SB(0, 1), b2 + hstep, voffB);
            PG8_WAIT_V(6); PG8_BAR; PG8_MMA(1, 1, At, B1); PG8_BAR;
            PG8_LDB(B0, 1, 0); PG8_SCHED; PG8_LDA(At, 1, 0); PG8_STAGE(PG8_SA(0, 1), a2 + hstep, voffA);
            PG8_WAIT_L(8); PG8_BAR; PG8_WAIT_L(0); PG8_MMA(0, 0, At, B0); PG8_BAR; PG8_SCHED;
            PG8_LDB(B1, 1, 1); PG8_STAGE(PG8_SB(1, 0), b3, voffB);
            PG8_BAR; PG8_WAIT_L(0); PG8_MMA(0, 1, At, B1); PG8_BAR;
            PG8_LDA(At, 1, 1); PG8_STAGE(PG8_SA(1, 0), a3, voffA);
            PG8_BAR; PG8_WAIT_L(0); PG8_MMA(1, 0, At, B0); PG8_BAR; PG8_SCHED;
            PG8_STAGE(PG8_SB(1, 1), b3 + hstep, voffB);
            PG8_WAIT_V(6); PG8_BAR; PG8_MMA(1, 1, At, B1); PG8_BAR;
            }
        }
        if constexpr (ALIGN_EPI) { if (wr == 0) PG8_BAR; }
        if constexpr (!Epi::AFTER_DRAIN) { E(acc, cur, wr, wc, fr, fq); S.done(cur); }
        if (!has_next) break;
#pragma unroll
        for (int a = 0; a < 2; ++a)
#pragma unroll
            for (int b = 0; b < 2; ++b)
#pragma unroll
                for (int m = 0; m < 4; ++m)
#pragma unroll
                    for (int n = 0; n < 2; ++n) acc[a][b][m][n] = (f32x4){0.f, 0.f, 0.f, 0.f};
        cur = nxt; cA = nA; cB = nB; ++ui;
        if constexpr (ALIGN_EPI) { if (wr == 1) PG8_BAR; }
    }
    PG8_WAIT_V(0);
    if constexpr (!ALIGN_EPI) { if (wr == 0) PG8_BAR; }
    PG8_BAR;
    if constexpr (Epi::AFTER_DRAIN) { E.fused(acc, cur, wr, wc, fr, fq, lds, wid, lane); S.done(cur); }
#undef PG8_SA
#undef PG8_SB
#undef PG8_STAGE
#undef PG8_LDA
#undef PG8_LDB
#undef PG8_MMA
#undef PG8_WAIT_V
#undef PG8_WAIT_L
#undef PG8_BAR
#undef PG8_SCHED
}
}

using pg8::bf16_t; using pg8::bf16x8; using pg8::f32x4; using pg8::u32x4;
typedef unsigned u32x2 __attribute__((ext_vector_type(2)));
typedef short s16x4 __attribute__((ext_vector_type(4)));
#define LAS __attribute__((address_space(3)))

constexpr int NTHREADS = 512;
constexpr int MTOK = 65536, DM = 1024, SEQ = 2048, NBATCH = 32, DEPTH = 4;
constexpr int NPROJ = 2304;
constexpr int INW = 2176;
constexpr int DFF = 2816, DFF2 = 5632;
constexpr int MEMROWS = 8192;
constexpr int MHALF = 32768;
constexpr float EPSF = 1e-6f;
constexpr float LOG2E = 1.4426950408889634f;
constexpr int LDS_BYTES = 155648;
constexpr int LDS_UNIT_OFF = 155648 - 64;
constexpr int LDS_TBL_OFF = 155648 - 512;

constexpr size_t MiB = 1u << 20;
constexpr size_t WS_CTL = 0;
constexpr size_t WS_ST = 1 * MiB;
constexpr size_t WS_STM = 5 * MiB;
constexpr size_t WS_CS = 5 * MiB + 512 * 1024;
constexpr size_t WS_KST = 6 * MiB;
constexpr size_t WS_QST = 14 * MiB;
constexpr size_t WS_MEMB = 22 * MiB;
constexpr size_t WS_W = 38 * MiB;
constexpr size_t W_LAYER = 27 * MiB;
constexpr size_t W_IN = 0, W_OUT = (size_t)(4.5 * MiB), W_Q = (size_t)(6.5 * MiB), W_O = (size_t)(8.5 * MiB), W_UP = (size_t)(10.5 * MiB), W_DOWN = (size_t)(21.5 * MiB);
constexpr size_t WS_WKV = WS_W + 4 * W_LAYER;
constexpr size_t WS_HB = 162 * MiB;
constexpr size_t WS_KV = 290 * MiB;
constexpr size_t WS_BIG = 418 * MiB;
constexpr size_t WS_PROJ = WS_BIG;
constexpr size_t WS_MIXED = WS_BIG + 288 * MiB;
constexpr size_t WS_QM = WS_MIXED + 128 * MiB;
constexpr size_t WS_GU = WS_BIG;
constexpr size_t WS_ACT = WS_BIG + 352 * MiB;
constexpr size_t WS_END = WS_QM + 128 * MiB;
static_assert(WS_WKV + 16 * MiB <= WS_HB, "ws map");
static_assert(WS_ACT + 176 * MiB <= WS_END, "ws map");

struct Args { const float* in[28]; float* out; unsigned char* ws; };
struct Ctx { LAS const unsigned long long* tbl; float* out; unsigned char* ws; };
__device__ __forceinline__ const float* inptr(const Ctx& c, int i) {
    const unsigned long long v = c.tbl[i];
    const unsigned lo = __builtin_amdgcn_readfirstlane((unsigned)v), hi = __builtin_amdgcn_readfirstlane((unsigned)(v >> 32));
    return (const float*)(((unsigned long long)hi << 32) | lo);
}

__device__ __forceinline__ float bf2f(unsigned short b) { return __uint_as_float(((unsigned)b) << 16); }
__device__ __forceinline__ float bflo(unsigned w) { return __uint_as_float(w << 16); }
__device__ __forceinline__ float bfhi(unsigned w) { return __uint_as_float(w & 0xffff0000u); }
__device__ __forceinline__ unsigned pkbf(float lo, float hi) { unsigned r; asm("v_cvt_pk_bf16_f32 %0, %1, %2" : "=v"(r) : "v"(lo), "v"(hi)); return r; }
__device__ __forceinline__ unsigned short f2bf(float f) { return (unsigned short)(pkbf(f, 0.f) & 0xffffu); }
__device__ __forceinline__ float wave_sum(float v) {
#pragma unroll
    for (int o = 1; o < 64; o <<= 1) v += __shfl_xor(v, o);
    return v;
}
__device__ __forceinline__ float sigmoidf_(float x) { return 1.0f / (1.0f + __expf(-x)); }
__device__ __forceinline__ float gelu_tanh(float x) {
    const float u = 0.7978845608028654f * (x + 0.044715f * x * x * x);
    return x / (1.0f + __expf(-2.0f * u));
}
__device__ __forceinline__ int tid_l() { int t = threadIdx.x; asm volatile("" : "+v"(t)); return t; }
__device__ __forceinline__ s16x4 vtr(LAS const unsigned char* p) {
    typedef short v4i16_t __attribute__((ext_vector_type(4)));
    return __builtin_bit_cast(s16x4, __builtin_amdgcn_ds_read_tr16_b64_v4i16((LAS v4i16_t*)p));
}

template <bool QKN> struct EpiBf {
    static constexpr bool PERM = true, AFTER_DRAIN = false;
    bf16_t* O; int ldc; const float* st; float* pst; int npg; const float* cs; const float* qg; const float* kg;
    __device__ __forceinline__ void operator()(const f32x4 (&acc)[2][2][4][2], const pg8::Unit& u, int wr, int wc, int fr, int fq) const {
        int kind = 0; const float* gsel = nullptr;
        if (QKN) { const int c0 = u.pn * 256 + 64 * wc; if (c0 >= 256 && c0 < 640) { kind = 1; gsel = qg; } else if (c0 >= 640 && c0 < 1024) { kind = 2; gsel = kg; } }
#pragma unroll
        for (int ai = 0; ai < 2; ++ai)
#pragma unroll
            for (int m = 0; m < 4; ++m) {
                const int r = u.pm * 256 + ai * 128 + wr * 64 + m * 16 + fr;
                const f32x4* sp = (const f32x4*)(st + (size_t)r * 16);
                const f32x4 s0 = sp[0], s1 = sp[1], s2 = sp[2], s3 = sp[3];
                const float ssum = ((s0[0] + s0[1]) + (s0[2] + s0[3])) + ((s1[0] + s1[1]) + (s1[2] + s1[3])) + ((s2[0] + s2[1]) + (s2[2] + s2[3])) + ((s3[0] + s3[1]) + (s3[2] + s3[3]));
                const float rs = rsqrtf(ssum * (1.0f / 1024.0f) + EPSF);
                f32x4 v[2][2];
#pragma unroll
                for (int bj = 0; bj < 2; ++bj)
#pragma unroll
                    for (int n = 0; n < 2; ++n) v[bj][n] = acc[ai][bj][m][n] * rs;
                if (QKN) {
                    if (kind != 0) {
                        float ss = 0.f;
#pragma unroll
                        for (int bj = 0; bj < 2; ++bj)
#pragma unroll
                            for (int n = 0; n < 2; ++n) ss += (v[bj][n][0] * v[bj][n][0] + v[bj][n][1] * v[bj][n][1]) + (v[bj][n][2] * v[bj][n][2] + v[bj][n][3] * v[bj][n][3]);
                        ss += __shfl_xor(ss, 16); ss += __shfl_xor(ss, 32);
                        float rn = rsqrtf(ss * (1.0f / 64.0f) + EPSF);
                        if (kind == 1) rn *= 0.125f * LOG2E;
#pragma unroll
                        for (int bj = 0; bj < 2; ++bj)
#pragma unroll
                            for (int n = 0; n < 2; ++n) { const f32x4 gv = *(const f32x4*)(gsel + 32 * bj + 8 * fq + 4 * n); v[bj][n] = v[bj][n] * rn * gv; }
                    }
                } else {
                    if (pst) {
#pragma unroll
                        for (int bj = 0; bj < 2; ++bj) {
                            float ss = (v[bj][0][0] * v[bj][0][0] + v[bj][0][1] * v[bj][0][1]) + (v[bj][0][2] * v[bj][0][2] + v[bj][0][3] * v[bj][0][3])
                                     + (v[bj][1][0] * v[bj][1][0] + v[bj][1][1] * v[bj][1][1]) + (v[bj][1][2] * v[bj][1][2] + v[bj][1][3] * v[bj][1][3]);
                            ss += __shfl_xor(ss, 16); ss += __shfl_xor(ss, 32);
                            if (fq == 0) pst[(size_t)r * npg + (u.pn * 8 + bj * 4 + wc)] = ss;
                        }
                    }
                    if (cs) {
#pragma unroll
                        for (int bj = 0; bj < 2; ++bj)
#pragma unroll
                            for (int n = 0; n < 2; ++n) { const f32x4 cv = *(const f32x4*)(cs + u.pn * 256 + bj * 128 + wc * 32 + 8 * fq + 4 * n); v[bj][n] = v[bj][n] * cv; }
                    }
                }
#pragma unroll
                for (int bj = 0; bj < 2; ++bj) {
                    const int col = QKN ? (u.pn * 256 + 64 * wc + 32 * bj + 8 * fq) : (u.pn * 256 + 128 * bj + 32 * wc + 8 * fq);
                    u32x4 w; w.x = pkbf(v[bj][0][0], v[bj][0][1]); w.y = pkbf(v[bj][0][2], v[bj][0][3]); w.z = pkbf(v[bj][1][0], v[bj][1][1]); w.w = pkbf(v[bj][1][2], v[bj][1][3]);
                    *(u32x4*)(O + (size_t)r * ldc + col) = w;
                }
                asm volatile("" ::: "memory");
            }
    }
};

struct EpiRes {
    static constexpr bool PERM = false, AFTER_DRAIN = false;
    const float* resid; float* out; bf16_t* hb; float* st;
    __device__ __forceinline__ void operator()(const f32x4 (&acc)[2][2][4][2], const pg8::Unit& u, int wr, int wc, int fr, int fq) const {
#pragma unroll
        for (int ai = 0; ai < 2; ++ai)
#pragma unroll
            for (int m = 0; m < 4; ++m) {
                const int r = u.pm * 256 + ai * 128 + wr * 64 + m * 16 + fr;
                float ss = 0.f;
#pragma unroll
                for (int bj = 0; bj < 2; ++bj)
#pragma unroll
                    for (int n = 0; n < 2; ++n) {
                        const size_t off = (size_t)r * DM + (u.pn * 256 + bj * 128 + wc * 32 + n * 16 + 4 * fq);
                        const f32x4 v = *(const f32x4*)(resid + off) + acc[ai][bj][m][n];
                        *(f32x4*)(out + off) = v;
                        u32x2 w; w.x = pkbf(v[0], v[1]); w.y = pkbf(v[2], v[3]);
                        *(u32x2*)(hb + off) = w;
                        ss += (v[0] * v[0] + v[1] * v[1]) + (v[2] * v[2] + v[3] * v[3]);
                    }
                ss += __shfl_xor(ss, 16); ss += __shfl_xor(ss, 32);
                if (fq == 0) st[(size_t)r * 16 + u.pn * 4 + wc] = ss;
                asm volatile("" ::: "memory");
            }
    }
};

template <class Epi>
__device__ __forceinline__ void run_gemm(LAS unsigned char* lds, const bf16_t* A, const bf16_t* Bt, int M, int N, int K, const Epi& E) {
    pg8::Gemm g{A, Bt, M, N, K}; pg8::StaticOrder S; S.init(M, N, (int)gridDim.x, (int)blockIdx.x);
    pg8::gemm_phase<Epi, pg8::StaticOrder, true, true>(lds, g, S, E);
}

__device__ __forceinline__ void transpose_item(const float* W, int ldw, int K, const float* gain, bf16_t* WT, int dst_row0, bool zero, LAS float* scr, int k0, int n0, int lane) {
#pragma unroll 8
    for (int i = 0; i < 32; ++i) {
        const int kk = 2 * i + (lane >> 5);
        float v = 0.f;
        if (!zero) { v = W[(size_t)(k0 + kk) * ldw + n0 + (lane & 31)]; if (gain) v *= gain[k0 + kk]; }
        scr[kk * 33 + (lane & 31)] = v;
    }
    asm volatile("s_waitcnt lgkmcnt(0)" ::: "memory");
    const int c = lane & 7;
#pragma unroll
    for (int j = 0; j < 4; ++j) {
        const int n = (lane >> 3) + 8 * j; const LAS float* s = scr + (8 * c) * 33 + n;
        u32x4 o; o.x = pkbf(s[0 * 33], s[1 * 33]); o.y = pkbf(s[2 * 33], s[3 * 33]); o.z = pkbf(s[4 * 33], s[5 * 33]); o.w = pkbf(s[6 * 33], s[7 * 33]);
        *(u32x4*)(WT + (size_t)(dst_row0 + n) * K + k0 + 8 * c) = o;
    }
    asm volatile("s_waitcnt lgkmcnt(0)" ::: "memory");
}
__device__ __forceinline__ void row_to_bf16(const float* xrow, bf16_t* orow, float* strow, int lane) {
    const f32x4* xr = (const f32x4*)xrow + lane;
    f32x4 v[4]; float s = 0.f;
#pragma unroll
    for (int j = 0; j < 4; ++j) { v[j] = xr[64 * j]; s += (v[j][0] * v[j][0] + v[j][1] * v[j][1]) + (v[j][2] * v[j][2] + v[j][3] * v[j][3]); }
    s = wave_sum(s);
    u32x2* o8 = (u32x2*)orow + lane;
#pragma unroll
    for (int j = 0; j < 4; ++j) { u32x2 w; w.x = pkbf(v[j][0], v[j][1]); w.y = pkbf(v[j][2], v[j][3]); o8[64 * j] = w; }
    if (lane < 16) strow[lane] = (lane == 0) ? s : 0.f;
}
__device__ __forceinline__ void phase_prologue(const Ctx& a, LAS unsigned char* lds) {
    const int tid = tid_l(), lane = tid & 63, wave = tid >> 6;
    LAS float* scr = (LAS float*)(lds + wave * 16384);
    const int gw = blockIdx.x * 8 + wave, NGW = gridDim.x * 8;
    unsigned char* ws = a.ws;
    constexpr int I_IN = 16 * 72, I_SQ = 16 * 32, I_UP = 16 * 176, I_DN = 44 * 32, I_KV = 16 * 64;
    constexpr int I_LAYER = I_IN + 3 * I_SQ + I_UP + I_DN + I_KV;
    for (int it = gw; it < DEPTH * I_LAYER; it += NGW) {
        const int l = it / I_LAYER; int r = it % I_LAYER;
        bf16_t* wl = (bf16_t*)(ws + WS_W + (size_t)l * W_LAYER);
        if (r < I_IN) {
            const int kb = r / 72, nb = r % 72, n0 = nb * 32;
            const int dst = (n0 & ~255) + 128 * ((n0 >> 5) & 1) + 32 * ((n0 >> 6) & 3);
            transpose_item(inptr(a, 3) + (size_t)l * DM * INW, INW, DM, inptr(a, 2) + l * DM, (bf16_t*)((unsigned char*)wl + W_IN), dst, n0 >= INW, scr, kb * 64, n0, lane);
            continue;
        }
        r -= I_IN;
        if (r < I_SQ) { transpose_item(inptr(a, 15) + (size_t)l * DM * DM, DM, DM, nullptr, (bf16_t*)((unsigned char*)wl + W_OUT), (r % 32) * 32, false, scr, (r / 32) * 64, (r % 32) * 32, lane); continue; }
        r -= I_SQ;
        if (r < I_SQ) { transpose_item(inptr(a, 18) + (size_t)l * DM * DM, DM, DM, inptr(a, 16) + l * DM, (bf16_t*)((unsigned char*)wl + W_Q), (r % 32) * 32, false, scr, (r / 32) * 64, (r % 32) * 32, lane); continue; }
        r -= I_SQ;
        if (r < I_SQ) { transpose_item(inptr(a, 22) + (size_t)l * DM * DM, DM, DM, nullptr, (bf16_t*)((unsigned char*)wl + W_O), (r % 32) * 32, false, scr, (r / 32) * 64, (r % 32) * 32, lane); continue; }
        r -= I_SQ;
        if (r < I_UP) { transpose_item(inptr(a, 24) + (size_t)l * DM * DFF2, DFF2, DM, inptr(a, 23) + l * DM, (bf16_t*)((unsigned char*)wl + W_UP), (r % 176) * 32, false, scr, (r / 176) * 64, (r % 176) * 32, lane); continue; }
        r -= I_UP;
        if (r < I_DN) { transpose_item(inptr(a, 27) + (size_t)l * DFF * DM, DM, DFF, nullptr, (bf16_t*)((unsigned char*)wl + W_DOWN), (r % 32) * 32, false, scr, (r / 32) * 64, (r % 32) * 32, lane); continue; }
        r -= I_DN;
        transpose_item(inptr(a, 19) + (size_t)l * DM * 2048, 2048, DM, inptr(a, 17) + l * DM, (bf16_t*)(ws + WS_WKV), l * 2048 + (r % 64) * 32, false, scr, (r / 64) * 64, (r % 64) * 32, lane);
    }
    for (int i = blockIdx.x * NTHREADS + tid; i < DEPTH * DM; i += gridDim.x * NTHREADS) { const int l = i >> 10, dd = i & 255; ((float*)(ws + WS_CS))[i] = inptr(a, 20)[l * 256 + dd] * inptr(a, 21)[l * 256 + dd] * (0.0625f * LOG2E); }
    for (int m = gw; m < MTOK; m += NGW) row_to_bf16(inptr(a, 0) + (size_t)m * DM, (bf16_t*)(ws + WS_HB) + (size_t)m * DM, (float*)(ws + WS_ST) + (size_t)m * 16, lane);
    for (int m = gw; m < MEMROWS; m += NGW) row_to_bf16(inptr(a, 1) + (size_t)m * DM, (bf16_t*)(ws + WS_MEMB) + (size_t)m * DM, (float*)(ws + WS_STM) + (size_t)m * 16, lane);
}

__device__ __forceinline__ void lru_unit(const Ctx& a, int l, int b, int g, LAS unsigned char* lds) {
    const int tid = tid_l(), lane = tid & 63, wave = tid >> 6, l15 = lane & 15, gq = lane >> 4;
    LAS unsigned char* XT = lds;
    LAS unsigned char* XCB = lds + 19008;
    LAS float* XCF = (LAS float*)(lds + 37440);
    LAS float* AA = (LAS float*)(lds + 70208);
    LAS float* BB = (LAS float*)(lds + 102976);
    LAS unsigned char* WT = lds + 135744;
    const bf16_t* proj = (const bf16_t*)(a.ws + WS_PROJ) + (size_t)b * SEQ * NPROJ;
    bf16_t* mixed = (bf16_t*)(a.ws + WS_MIXED) + (size_t)b * SEQ * DM;
    const float* wa = inptr(a, 10) + ((size_t)l * 6 + g) * 4096; const float* wx = inptr(a, 12) + ((size_t)l * 6 + g) * 4096;
    for (int k = 0; k < 16; ++k) {
        const int idx = tid + 512 * k, which = idx >> 12, cp = (idx >> 6) & 63, c = idx & 63;
        const float v = which ? wx[cp * 64 + c] : wa[cp * 64 + c];
        *(LAS unsigned short*)(WT + (which * 64 + c) * 144 + cp * 2) = f2bf(v);
    }
    const int cch = tid & 63, ch = g * 64 + cch;
    float cw[4];
#pragma unroll
    for (int j = 0; j < 4; ++j) cw[j] = inptr(a, 8)[((size_t)l * 4 + j) * 384 + ch];
    const float cb = inptr(a, 9)[l * 384 + ch];
    float gba[4], gbx[4], gsp[4];
#pragma unroll
    for (int nt = 0; nt < 4; ++nt) {
        const int c2 = l * 384 + g * 64 + 16 * nt + l15;
        gba[nt] = inptr(a, 11)[c2]; gbx[nt] = inptr(a, 13)[c2];
        const float z = -inptr(a, 14)[c2];
        gsp[nt] = 8.0f * (fmaxf(z, 0.f) + log1pf(__expf(-fabsf(z))));
    }
    float hcar = 0.f;
    const bf16_t* xsrc = proj + 1408 + g * 64;
    const bf16_t* ysrc = proj + 1792 + g * 64;
    u32x4 xr[3];
#pragma unroll
    for (int k = 0; k < 3; ++k) {
        const int idx = tid + 512 * k, row = idx >> 3, cv = idx & 7, tok = row - 3;
        xr[k] = (idx < 1048 && tok >= 0) ? *(const u32x4*)(xsrc + (size_t)tok * NPROJ + cv * 8) : (u32x4){0u, 0u, 0u, 0u};
    }
#pragma unroll 1
    for (int ck = 0; ck < 16; ++ck) {
        const int t0 = ck * 128;
#pragma unroll
        for (int k = 0; k < 3; ++k) { const int idx = tid + 512 * k, row = idx >> 3, cv = idx & 7; if (idx < 1048) *(LAS u32x4*)(XT + row * 144 + cv * 16) = xr[k]; }
        u32x4 yr[2];
#pragma unroll
        for (int k = 0; k < 2; ++k) { const int idx = tid + 512 * k, row = idx >> 3, cv = idx & 7; yr[k] = *(const u32x4*)(ysrc + (size_t)(t0 + row) * NPROJ + cv * 8); }
        if (ck < 15) {
#pragma unroll
            for (int k = 0; k < 3; ++k) {
                const int idx = tid + 512 * k, row = idx >> 3, cv = idx & 7, tok = t0 + 128 - 3 + row;
                xr[k] = (idx < 1048) ? *(const u32x4*)(xsrc + (size_t)tok * NPROJ + cv * 8) : (u32x4){0u, 0u, 0u, 0u};
            }
        }
        __syncthreads();
#pragma unroll 4
        for (int k = 0; k < 16; ++k) {
            const int t = (tid >> 6) + 8 * k;
            float xc = cb;
#pragma unroll
            for (int j = 0; j < 4; ++j) xc += cw[j] * bf2f(*(LAS const unsigned short*)(XT + (t + 3 - j) * 144 + cch * 2));
            XCF[t * 64 + cch] = xc;
            *(LAS unsigned short*)(XCB + t * 144 + cch * 2) = f2bf(xc);
        }
        __syncthreads();
        {
            f32x4 acc[8];
#pragma unroll
            for (int nt = 0; nt < 8; ++nt) acc[nt] = (f32x4){0.f, 0.f, 0.f, 0.f};
#pragma unroll
            for (int ks = 0; ks < 2; ++ks) {
                const bf16x8 af = *(LAS const bf16x8*)(XCB + (16 * wave + l15) * 144 + (32 * ks + 8 * gq) * 2);
#pragma unroll
                for (int nt = 0; nt < 8; ++nt) {
                    const bf16x8 bfr = *(LAS const bf16x8*)(WT + (16 * nt + l15) * 144 + (32 * ks + 8 * gq) * 2);
                    acc[nt] = __builtin_amdgcn_mfma_f32_16x16x32_bf16(af, bfr, acc[nt], 0, 0, 0);
                }
            }
#pragma unroll
            for (int nt = 0; nt < 4; ++nt)
#pragma unroll
                for (int rg = 0; rg < 4; ++rg) {
                    const int t = 16 * wave + 4 * gq + rg, c = 16 * nt + l15;
                    const float r = sigmoidf_(acc[nt][rg] + gba[nt]), ig = sigmoidf_(acc[nt + 4][rg] + gbx[nt]);
                    const float la = -r * gsp[nt];
                    const float av = __expf(la);
                    const float xcv = XCF[t * 64 + c];
                    AA[t * 64 + c] = av;
                    BB[t * 64 + c] = sqrtf(fmaxf(-expm1f(2.0f * la), 0.f)) * (ig * xcv);
                }
        }
        __syncthreads();
        if (wave == 0) {
#pragma unroll 16
            for (int t = 0; t < 128; ++t) { hcar = AA[t * 64 + lane] * hcar + BB[t * 64 + lane]; BB[t * 64 + lane] = hcar; }
        }
        __syncthreads();
#pragma unroll
        for (int k = 0; k < 2; ++k) {
            const int idx = tid + 512 * k, row = idx >> 3, cv = idx & 7;
            const f32x4 h0 = *(LAS const f32x4*)(BB + row * 64 + cv * 8), h1 = *(LAS const f32x4*)(BB + row * 64 + cv * 8 + 4);
            u32x4 w;
            w.x = pkbf(h0[0] * gelu_tanh(bflo(yr[k].x)), h0[1] * gelu_tanh(bfhi(yr[k].x)));
            w.y = pkbf(h0[2] * gelu_tanh(bflo(yr[k].y)), h0[3] * gelu_tanh(bfhi(yr[k].y)));
            w.z = pkbf(h1[0] * gelu_tanh(bflo(yr[k].z)), h1[1] * gelu_tanh(bfhi(yr[k].z)));
            w.w = pkbf(h1[2] * gelu_tanh(bflo(yr[k].w)), h1[3] * gelu_tanh(bfhi(yr[k].w)));
            *(u32x4*)(mixed + (size_t)(t0 + row) * DM + 640 + g * 64 + cv * 8) = w;
        }
    }
}

__device__ __forceinline__ void pool_unit(const Ctx& a, int l, int b, int tc, LAS unsigned char* lds) {
    const int tid = tid_l();
    LAS float* U = (LAS float*)lds;
    LAS float* P = (LAS float*)(lds + 80896);
    const int t0 = tc * 64;
    const bf16_t* proj = (const bf16_t*)(a.ws + WS_PROJ) + (size_t)b * SEQ * NPROJ;
    bf16_t* mixed = (bf16_t*)(a.ws + WS_MIXED) + (size_t)b * SEQ * DM;
    for (int k = 0; k < 40; ++k) {
        const int idx = tid + 512 * k;
        if (idx < 79 * 256) { const int tt = idx >> 8, c = idx & 255, t = t0 - 15 + tt; U[idx] = (t >= 0) ? bf2f(proj[(size_t)t * NPROJ + c]) : 0.f; }
    }
    __syncthreads();
    {
        const int c = tid & 255, half = tid >> 8, g = c >> 6, w = 2 << g;
        for (int q = 0; q < 32; ++q) {
            const int tt = half * 32 + q, t = t0 + tt;
            float s = 0.f;
            for (int j = 0; j < w; ++j) s += U[(tt + 15 - j) * 256 + c];
            const float cnt = (float)((t + 1 < w) ? (t + 1) : w);
            P[tt * 256 + c] = s / cnt - U[(tt + 15) * 256 + c];
        }
    }
    __syncthreads();
    {
        const int dcol = tid & 255, half = tid >> 8, g = dcol >> 6, dc = dcol & 63;
        const float* pw = inptr(a, 4) + ((size_t)l * 4 + g) * 4096 + dc;
        float w[64];
#pragma unroll
        for (int c = 0; c < 64; ++c) w[c] = pw[c * 64];
        const float sc = inptr(a, 5)[l * 256 + dcol];
        for (int q = 0; q < 32; ++q) {
            const int tt = half * 32 + q;
            const LAS f32x4* pr = (const LAS f32x4*)(P + tt * 256 + g * 64);
            float acc = 0.f;
#pragma unroll
            for (int c4 = 0; c4 < 16; ++c4) { const f32x4 pv = pr[c4]; acc += pv[0] * w[4 * c4] + pv[1] * w[4 * c4 + 1] + pv[2] * w[4 * c4 + 2] + pv[3] * w[4 * c4 + 3]; }
            mixed[(size_t)(t0 + tt) * DM + dcol] = f2bf(acc * sc);
        }
    }
}

__device__ __forceinline__ void dattn_unit(const Ctx& a, int b, int h, int tb, LAS unsigned char* lds) {
    const int tid = tid_l(), lane = tid & 63, wave = tid >> 6, l15 = lane & 15, gq = lane >> 4;
    LAS float* OACC = (LAS float*)lds;
    LAS float* DEN = (LAS float*)(lds + 65536);
    LAS unsigned char* vst = lds + 66560 + wave * 4608;
    const int t0 = tb * 256;
    const bf16_t* projb = (const bf16_t*)(a.ws + WS_PROJ) + (size_t)b * SEQ * NPROJ;
    bf16_t* mixed = (bf16_t*)(a.ws + WS_MIXED) + (size_t)b * SEQ * DM;
    const float slope2 = exp2f(-8.0f * (float)(h + 1) / 6.0f) * LOG2E;
    const int trq = (l15 >> 2), trp = (l15 & 3);
#pragma unroll 1
    for (int pi = 0; pi < 3; ++pi) {
        const int d = 1 << (2 * pi);
        const float sl = slope2 * (float)d;
#pragma unroll 1
        for (int ii = 0; ii < 2; ++ii) {
            const int it = 2 * wave + ii, rr = it % d, jj = it / d, tq0 = t0 + rr + 16 * d * jj;
            const bf16_t* qrow = projb + (size_t)(tq0 + d * l15) * NPROJ + 256 + h * 64 + 8 * gq;
            const bf16x8 qf0 = *(const bf16x8*)qrow, qf1 = *(const bf16x8*)(qrow + 32);
            f32x4 o[4];
#pragma unroll
            for (int dt = 0; dt < 4; ++dt) o[dt] = (f32x4){0.f, 0.f, 0.f, 0.f};
            float den = 0.f;
#pragma unroll 1
            for (int pp = 0; pp < 5; ++pp) {
#pragma unroll
                for (int ps = 0; ps < 4; ++ps) {
                    const int idx = ps * 64 + lane, row = idx >> 3, chk = idx & 7, kt = 2 * pp + (row >> 4);
                    int tk = tq0 + d * (16 * (kt - 8) + (row & 15)); tk = tk < 0 ? 0 : (tk > SEQ - 1 ? SEQ - 1 : tk);
                    const u32x4 vv = *(const u32x4*)(projb + (size_t)tk * NPROJ + 1024 + h * 64 + chk * 8);
                    *(LAS u32x4*)(vst + row * 144 + chk * 16) = vv;
                }
                float p[2][4];
#pragma unroll
                for (int T = 0; T < 2; ++T) {
                    const int kt = 2 * pp + T;
                    if (kt == 9) { p[T][0] = 0.f; p[T][1] = 0.f; p[T][2] = 0.f; p[T][3] = 0.f; continue; }
                    int tk = tq0 + d * (16 * (kt - 8) + l15); tk = tk < 0 ? 0 : tk;
                    const bf16_t* krow = projb + (size_t)tk * NPROJ + 640 + h * 64 + 8 * gq;
                    const bf16x8 k0 = *(const bf16x8*)krow, k1 = *(const bf16x8*)(krow + 32);
                    f32x4 s = __builtin_amdgcn_mfma_f32_16x16x32_bf16(k0, qf0, (f32x4){0.f, 0.f, 0.f, 0.f}, 0, 0, 0);
                    s = __builtin_amdgcn_mfma_f32_16x16x32_bf16(k1, qf1, s, 0, 0, 0);
#pragma unroll
                    for (int rg = 0; rg < 4; ++rg) {
                        const int dist = l15 + 128 - 16 * kt - 4 * gq - rg;
                        const int tkk = tq0 + d * (l15 - dist);
                        const bool valid = (dist >= 0) && (dist <= 128) && (tkk >= 0);
                        const float pv = valid ? __builtin_amdgcn_exp2f(s[rg] - sl * (float)dist) : 0.f;
                        p[T][rg] = pv; den += pv;
                    }
                }
                u32x4 pw; pw.x = pkbf(p[0][0], p[0][1]); pw.y = pkbf(p[0][2], p[0][3]); pw.z = pkbf(p[1][0], p[1][1]); pw.w = pkbf(p[1][2], p[1][3]);
                const bf16x8 pfrag = __builtin_bit_cast(bf16x8, pw);
#pragma unroll
                for (int dt = 0; dt < 4; ++dt) {
                    const s16x4 lo = vtr(vst + (4 * gq + trq) * 144 + (16 * dt + 4 * trp) * 2);
                    const s16x4 hi = vtr(vst + (16 + 4 * gq + trq) * 144 + (16 * dt + 4 * trp) * 2);
                    const bf16x8 vf = (bf16x8){lo[0], lo[1], lo[2], lo[3], hi[0], hi[1], hi[2], hi[3]};
                    o[dt] = __builtin_amdgcn_mfma_f32_16x16x32_bf16(pfrag, vf, o[dt], 0, 0, 0);
                }
            }
            den += __shfl_xor(den, 16); den += __shfl_xor(den, 32);
#pragma unroll
            for (int dt = 0; dt < 4; ++dt)
#pragma unroll
                for (int rg = 0; rg < 4; ++rg) {
                    const int tl = (tq0 - t0) + d * (4 * gq + rg), idx = tl * 64 + 16 * dt + l15;
                    if (pi == 0) OACC[idx] = o[dt][rg]; else OACC[idx] += o[dt][rg];
                }
            if (gq == 0) { const int tl = (tq0 - t0) + d * l15; if (pi == 0) DEN[tl] = den; else DEN[tl] += den; }
        }
        __syncthreads();
    }
    for (int k = 0; k < 32; ++k) {
        const int idx = tid + 512 * k, tl = idx >> 6, dc = idx & 63;
        mixed[(size_t)(t0 + tl) * DM + 256 + h * 64 + dc] = f2bf(OACC[idx] / DEN[tl]);
    }
}

__device__ __forceinline__ void phase_mixers(const Ctx& a, int l, LAS unsigned char* lds) {
    unsigned* ctr = (unsigned*)(a.ws + WS_CTL) + 64 * l;
    LAS int* sun = (LAS int*)(lds + LDS_UNIT_OFF);
    constexpr int N_LRU = 192, N_ATT = 1536, N_POOL = 1024;
    for (;;) {
        __syncthreads();
        if (threadIdx.x == 0) *sun = (int)atomicAdd(ctr, 1u);
        __syncthreads();
        const int u = *sun;
        if (u >= N_LRU + N_ATT + N_POOL) break;
        if (u < N_LRU) lru_unit(a, l, u / 6, u % 6, lds);
        else if (u < N_LRU + N_ATT) { const int v = u - N_LRU; dattn_unit(a, v / 48, (v % 48) / 8, v % 8, lds); }
        else { const int v = u - N_LRU - N_ATT; pool_unit(a, l, v / 32, v % 32, lds); }
    }
}

__device__ __forceinline__ void phase_xattn(const Ctx& a, int l, LAS unsigned char* lds) {
    const int tid = tid_l(), lane = tid & 63, wave = tid >> 6, l15 = lane & 15, gq = lane >> 4;
    LAS unsigned char* KL = lds;
    LAS unsigned char* VL = lds + 16896;
    LAS float* RK = (LAS float*)(lds + 34304);
    const bf16_t* qm = (const bf16_t*)(a.ws + WS_QM);
    const float* qst = (const float*)(a.ws + WS_QST);
    const bf16_t* kv = (const bf16_t*)(a.ws + WS_KV);
    const float* kst = (const float*)(a.ws + WS_KST);
    bf16_t* om = (bf16_t*)(a.ws + WS_MIXED);
    const int trq = (l15 >> 2), trp = (l15 & 3);
    for (int xu = blockIdx.x; xu < NBATCH * 4 * 16; xu += gridDim.x) {
        const int b = xu >> 6, h = (xu >> 4) & 3, qb = xu & 15;
        __syncthreads();
        if (tid < 256) {
            const f32x4* kp = (const f32x4*)(kst + (size_t)(b * 256 + tid) * 256 + l * 64 + h * 8);
            const f32x4 k0 = kp[0], k1 = kp[1];
            RK[tid] = rsqrtf((((k0[0] + k0[1]) + (k0[2] + k0[3])) + ((k1[0] + k1[1]) + (k1[2] + k1[3]))) * (1.0f / 256.0f) + EPSF);
        }
        const size_t qrow = (size_t)b * SEQ + qb * 128 + wave * 16 + l15;
        bf16x8 qf[8];
#pragma unroll
        for (int ks = 0; ks < 8; ++ks) qf[ks] = *(const bf16x8*)(qm + qrow * DM + h * 256 + 32 * ks + 8 * gq);
        float rq;
        { const f32x4* qp = (const f32x4*)(qst + qrow * 32 + h * 8); const f32x4 q0 = qp[0], q1 = qp[1];
          rq = rsqrtf((((q0[0] + q0[1]) + (q0[2] + q0[3])) + ((q1[0] + q1[1]) + (q1[2] + q1[3]))) * (1.0f / 256.0f) + EPSF); }
        f32x4 o[16];
#pragma unroll
        for (int dt = 0; dt < 16; ++dt) o[dt] = (f32x4){0.f, 0.f, 0.f, 0.f};
        float den = 0.f;
#pragma unroll 1
        for (int c = 0; c < 8; ++c) {
            __syncthreads();
#pragma unroll
            for (int k = 0; k < 2; ++k) {
                const int idx = tid + 512 * k, row = idx >> 5, chk = idx & 31;
                const bf16_t* src = kv + (size_t)(b * 256 + 32 * c + row) * 8192 + l * 2048 + h * 256 + chk * 8;
                const u32x4 kk = *(const u32x4*)src, vv = *(const u32x4*)(src + 1024);
                *(LAS u32x4*)(KL + row * 528 + chk * 16) = kk;
                *(LAS u32x4*)(VL + row * 544 + chk * 16) = vv;
            }
            __syncthreads();
            float p[2][4];
#pragma unroll
            for (int T = 0; T < 2; ++T) {
                f32x4 s = (f32x4){0.f, 0.f, 0.f, 0.f};
#pragma unroll
                for (int ks = 0; ks < 8; ++ks) {
                    const bf16x8 kf = *(LAS const bf16x8*)(KL + (16 * T + l15) * 528 + (32 * ks + 8 * gq) * 2);
                    s = __builtin_amdgcn_mfma_f32_16x16x32_bf16(kf, qf[ks], s, 0, 0, 0);
                }
                const f32x4 rk4 = *(LAS const f32x4*)(RK + 32 * c + 16 * T + 4 * gq);
#pragma unroll
                for (int rg = 0; rg < 4; ++rg) { const float pv = __builtin_amdgcn_exp2f(s[rg] * rq * rk4[rg]); p[T][rg] = pv; den += pv; }
            }
            u32x4 pw; pw.x = pkbf(p[0][0], p[0][1]); pw.y = pkbf(p[0][2], p[0][3]); pw.z = pkbf(p[1][0], p[1][1]); pw.w = pkbf(p[1][2], p[1][3]);
            const bf16x8 pfrag = __builtin_bit_cast(bf16x8, pw);
#pragma unroll
            for (int dt = 0; dt < 16; ++dt) {
                const s16x4 lo = vtr(VL + (4 * gq + trq) * 544 + (16 * dt + 4 * trp) * 2);
                const s16x4 hi = vtr(VL + (16 + 4 * gq + trq) * 544 + (16 * dt + 4 * trp) * 2);
                const bf16x8 vf = (bf16x8){lo[0], lo[1], lo[2], lo[3], hi[0], hi[1], hi[2], hi[3]};
                o[dt] = __builtin_amdgcn_mfma_f32_16x16x32_bf16(pfrag, vf, o[dt], 0, 0, 0);
            }
        }
        den += __shfl_xor(den, 16); den += __shfl_xor(den, 32);
        float inv[4];
#pragma unroll
        for (int rg = 0; rg < 4; ++rg) inv[rg] = 1.0f / __shfl(den, 4 * gq + rg);
        const size_t orow0 = (size_t)b * SEQ + qb * 128 + wave * 16 + 4 * gq;
#pragma unroll
        for (int dt = 0; dt < 16; ++dt)
#pragma unroll
            for (int rg = 0; rg < 4; ++rg) om[(orow0 + rg) * DM + h * 256 + 16 * dt + l15] = f2bf(o[dt][rg] * inv[rg]);
    }
}

__device__ __forceinline__ void phase_act(const Ctx& a, int l) {
    const bf16_t* gu = (const bf16_t*)(a.ws + WS_GU);
    bf16_t* act = (bf16_t*)(a.ws + WS_ACT);
    const float* cw = inptr(a, 25) + (size_t)l * 3 * DFF; const float* cb = inptr(a, 26) + (size_t)l * DFF;
    const int total = MHALF * (DFF / 8);
    for (int idx = blockIdx.x * NTHREADS + threadIdx.x; idx < total; idx += gridDim.x * NTHREADS) {
        const int row = idx / (DFF / 8), f0 = (idx % (DFF / 8)) * 8, tl = row & (SEQ - 1);
        const bf16_t* gp = gu + (size_t)row * DFF2 + f0;
        const u32x4 g0 = *(const u32x4*)gp;
        const u32x4 g1 = (tl >= 1) ? *(const u32x4*)(gp - DFF2) : (u32x4){0u, 0u, 0u, 0u};
        const u32x4 g2 = (tl >= 2) ? *(const u32x4*)(gp - 2 * DFF2) : (u32x4){0u, 0u, 0u, 0u};
        const u32x4 uu = *(const u32x4*)(gp + DFF);
        float r[8];
#pragma unroll
        for (int j = 0; j < 4; ++j) {
            const int f = f0 + 2 * j;
            const float c0 = cb[f] + cw[f] * bflo(g0[j]) + cw[DFF + f] * bflo(g1[j]) + cw[2 * DFF + f] * bflo(g2[j]);
            const float c1 = cb[f + 1] + cw[f + 1] * bfhi(g0[j]) + cw[DFF + f + 1] * bfhi(g1[j]) + cw[2 * DFF + f + 1] * bfhi(g2[j]);
            r[2 * j] = gelu_tanh(c0) * bflo(uu[j]); r[2 * j + 1] = gelu_tanh(c1) * bfhi(uu[j]);
        }
        u32x4 w; w.x = pkbf(r[0], r[1]); w.y = pkbf(r[2], r[3]); w.z = pkbf(r[4], r[5]); w.w = pkbf(r[6], r[7]);
        *(u32x4*)(act + (size_t)row * DFF + f0) = w;
    }
}

__global__ void __launch_bounds__(NTHREADS, 2) trunk_fwd(Args ka) {
    extern __shared__ __attribute__((aligned(16))) unsigned char lds_raw[];
    LAS unsigned char* lds = (LAS unsigned char*)lds_raw;
    cg::grid_group grid = cg::this_grid();
    {
        LAS unsigned long long* tw = (LAS unsigned long long*)(lds + LDS_TBL_OFF);
        if (threadIdx.x == 0) {
#pragma unroll
            for (int i = 0; i < 28; ++i) tw[i] = (unsigned long long)ka.in[i];
        }
        __syncthreads();
    }
    Ctx a; a.tbl = (LAS const unsigned long long*)(lds + LDS_TBL_OFF); a.out = ka.out; a.ws = ka.ws;
    unsigned char* ws = a.ws;
    bf16_t* hb = (bf16_t*)(ws + WS_HB);
    float* st = (float*)(ws + WS_ST);

    phase_prologue(a, lds);
    grid.sync();
    {
        EpiBf<false> E{(bf16_t*)(ws + WS_KV), 8192, (const float*)(ws + WS_STM), (float*)(ws + WS_KST), 256, nullptr, nullptr, nullptr};
        run_gemm(lds, (const bf16_t*)(ws + WS_MEMB), (const bf16_t*)(ws + WS_WKV), MEMROWS, 8192, DM, E);
    }
    for (int l = 0; l < DEPTH; ++l) {
        const unsigned char* wl = ws + WS_W + (size_t)l * W_LAYER;
        {
            EpiBf<true> E{(bf16_t*)(ws + WS_PROJ), NPROJ, st, nullptr, 0, nullptr, inptr(a, 6) + l * 64, inptr(a, 7) + l * 64};
            run_gemm(lds, hb, (const bf16_t*)(wl + W_IN), MTOK, NPROJ, DM, E);
        }
        grid.sync();
        phase_mixers(a, l, lds);
        grid.sync();
        {
            EpiRes E{l == 0 ? inptr(a, 0) : a.out, a.out, hb, st};
            run_gemm(lds, (const bf16_t*)(ws + WS_MIXED), (const bf16_t*)(wl + W_OUT), MTOK, DM, DM, E);
        }
        grid.sync();
        {
            EpiBf<false> E{(bf16_t*)(ws + WS_QM), DM, st, (float*)(ws + WS_QST), 32, (const float*)(ws + WS_CS) + l * 1024, nullptr, nullptr};
            run_gemm(lds, hb, (const bf16_t*)(wl + W_Q), MTOK, DM, DM, E);
        }
        grid.sync();
        phase_xattn(a, l, lds);
        grid.sync();
        {
            EpiRes E{a.out, a.out, hb, st};
            run_gemm(lds, (const bf16_t*)(ws + WS_MIXED), (const bf16_t*)(wl + W_O), MTOK, DM, DM, E);
        }
        grid.sync();
        for (int hf = 0; hf < 2; ++hf) {
            {
                EpiBf<false> E{(bf16_t*)(ws + WS_GU), DFF2, st + (size_t)hf * MHALF * 16, nullptr, 0, nullptr, nullptr, nullptr};
                run_gemm(lds, hb + (size_t)hf * MHALF * DM, (const bf16_t*)(wl + W_UP), MHALF, DFF2, DM, E);
            }
            grid.sync();
            phase_act(a, l);
            grid.sync();
            {
                float* oh = a.out + (size_t)hf * MHALF * DM;
                EpiRes E{oh, oh, hb + (size_t)hf * MHALF * DM, st + (size_t)hf * MHALF * 16};
                run_gemm(lds, (const bf16_t*)(ws + WS_ACT), (const bf16_t*)(wl + W_DOWN), MHALF, DM, DFF, E);
            }
            grid.sync();
        }
    }
}

extern "C" void kernel_launch(void* const* d_in, const int* in_sizes, int n_in, void* d_out, int out_size, void* d_ws, size_t ws_size, hipStream_t stream) {
    static int grid = 0;
    if (grid == 0) {
        if (n_in != 28 || in_sizes[0] != MTOK * DM || out_size != MTOK * DM || ws_size < WS_END) {
            fprintf(stderr, "kernel_launch: unexpected shapes (n_in %d, in0 %d, out %d, ws %zu; need ws >= %zu); nothing launched\n", n_in, n_in > 0 ? in_sizes[0] : -1, out_size, ws_size, (size_t)WS_END);
            grid = -1; return;
        }
        int dev = 0, cus = 0, per_cu = 0;
        hipGetDevice(&dev);
        hipDeviceGetAttribute(&cus, hipDeviceAttributeMultiprocessorCount, dev);
        if (hipFuncSetAttribute((const void*)trunk_fwd, hipFuncAttributeMaxDynamicSharedMemorySize, LDS_BYTES) != hipSuccess) { fprintf(stderr, "kernel_launch: hipFuncSetAttribute failed\n"); grid = -1; return; }
        if (hipOccupancyMaxActiveBlocksPerMultiprocessor(&per_cu, (const void*)trunk_fwd, NTHREADS, LDS_BYTES) != hipSuccess || per_cu < 1) { fprintf(stderr, "kernel_launch: occupancy query says %d blocks per CU\n", per_cu); per_cu = 1; }
        (void)hipGetLastError();
        grid = cus;
    }
    if (grid < 0) return;
    (void)hipMemsetAsync((char*)d_ws + WS_CTL, 0, 4096, stream);
    Args a{};
    for (int i = 0; i < 28; ++i) a.in[i] = (const float*)d_in[i];
    a.out = (float*)d_out; a.ws = (unsigned char*)d_ws;
    void* args[] = {&a};
    hipError_t e = hipLaunchCooperativeKernel((const void*)trunk_fwd, dim3(grid), dim3(NTHREADS), args, LDS_BYTES, stream);
    if (e != hipSuccess) fprintf(stderr, "cooperative launch failed: %s (grid %d)\n", hipGetErrorString(e), grid);
}
```

```cpp
#include <hip/hip_runtime.h>
#include <hip/hip_cooperative_groups.h>
#include <cstdio>
#include <cstdint>
namespace cg = cooperative_groups;
namespace pg8 {
#define PG8_LAS __attribute__((address_space(3)))
typedef unsigned short bf16_t;
typedef short bf16x8 __attribute__((ext_vector_type(8)));
typedef float f32x4 __attribute__((ext_vector_type(4)));
typedef unsigned u32x4 __attribute__((ext_vector_type(4)));
constexpr int BM = 256, BK = 64, HALF = 128, HTB = HALF * BK * 2  , STAGE_BYTES = 8 * HTB, NXCD = 8, WGM = 8;

__host__ __device__ __forceinline__ int lds_byte(int r, int c) { const int st = (r >> 4) * 2 + (c >> 5), rr = r & 15, cc = c & 31, ob = rr * 64 + cc * 2; return st * 1024 + (ob ^ (((ob >> 9) & 1) << 5)); }
__host__ __device__ __forceinline__ void stage_rc(int b, int& R, int& C) { const int st = b / 1024, sb = b % 1024, swz = sb ^ (((sb >> 9) & 1) << 5); R = (st >> 1) * 16 + swz / 64; C = (st & 1) * 32 + (swz % 64) / 2; }
__host__ __device__ __forceinline__ int perm32(int rho) { const int n = rho >> 4, i = rho & 15; return 8 * (i >> 2) + 4 * n + (i & 3); }

struct Unit { int pm, pn; };
struct Gemm { const bf16_t* A; const bf16_t* Bt; int M, N, K; };

struct StaticOrder {
    int nM, nN, nwg, G, c;
    __host__ __device__ void init(int M, int N, int G_, int c_) { nM = M / BM; nN = N / BM; nwg = nM * nN; G = G_; c = c_; }
    __host__ __device__ bool next(int i, Unit& u) const {
        const long L = (long)i * G + c; if (L >= nwg) return false;
        int wgid = (int)L; { const int q = nwg / NXCD, r = nwg % NXCD, xcd = wgid % NXCD, off = wgid / NXCD; wgid = (xcd < r ? xcd * (q + 1) : r * (q + 1) + (xcd - r) * q) + off; }
        const int nig = WGM * nN, gid = wgid / nig, fm = gid * WGM, gsz = (nM - fm) < WGM ? (nM - fm) : WGM;
        u.pm = fm + ((wgid % nig) % gsz); u.pn = (wgid % nig) / gsz; return true;
    }
    __device__ __forceinline__ void a_ready(const Unit&) const {}
    __device__ __forceinline__ void done(const Unit&) const {}
};

__device__ __forceinline__ unsigned cvt_pk_bf16(float lo, float hi) { unsigned r; asm volatile("v_cvt_pk_bf16_f32 %0, %1, %2" : "=v"(r) : "v"(lo), "v"(hi)); return r; }
typedef float f32x2 __attribute__((ext_vector_type(2)));
template <class Epi, class Sched, bool ALIGN_EPI = false, bool SP2 = false>
__device__ __forceinline__ void gemm_phase(int tid_in, PG8_LAS unsigned char* lds, const Gemm g, const Sched& S, const Epi& E) {
    int tid_ = tid_in; asm volatile("" : "+v"(tid_));
    const int tid = tid_, wid = __builtin_amdgcn_readfirstlane(tid >> 6), lane = tid & 63, wr = wid >> 2, wc = wid & 3, fr = lane & 15, fq = lane >> 4;
    const int K = g.K, nt = K / BK;
    unsigned voffA[2], voffB[2];
#pragma unroll
    for (int i = 0; i < 2; ++i) { int R, C; stage_rc(tid * 16 + i * 8192, R, C); const int Rb = Epi::PERM ? ((R & ~31) + perm32(R & 31)) : R;
        voffA[i] = (unsigned)(R * K + C) * 2u; voffB[i] = (unsigned)(Rb * K + C) * 2u; }
    const size_t kstep = (size_t)(BK * 2);
    const size_t hstep = (size_t)HALF * K * 2;
    const size_t tstep = 2 * hstep;
    const unsigned ldsw = (unsigned)wid * 1024u;
    const int aoff = lds_byte(wr * 64 + fr, fq * 8), boff = lds_byte(wc * 32 + fr, fq * 8);
#define PG8_SA(b, h) (((b) * 2 + (h)) * HTB)
#define PG8_SB(b, h) ((4 + (b) * 2 + (h)) * HTB)
#define PG8_STAGE(bufoff, gbase, voff) do { _Pragma("unroll") for (int _i = 0; _i < 2; ++_i) \
        __builtin_amdgcn_global_load_lds((const unsigned*)((const char*)(gbase) + (voff)[_i]), (PG8_LAS unsigned*)(lds + (bufoff) + ldsw + _i * 8192), 16, 0, 0); } while (0)
#define PG8_LDA(dst, b, h) do { _Pragma("unroll") for (int m = 0; m < 4; ++m) _Pragma("unroll") for (int k = 0; k < 2; ++k) dst[m][k] = *(const PG8_LAS bf16x8*)(lds + PG8_SA(b, h) + aoff + m * 2048 + k * 1024); } while (0)
#define PG8_LDB(dst, b, h) do { _Pragma("unroll") for (int n = 0; n < 2; ++n) _Pragma("unroll") for (int k = 0; k < 2; ++k) dst[n][k] = *(const PG8_LAS bf16x8*)(lds + PG8_SB(b, h) + boff + n * 2048 + k * 1024); } while (0)
#define PG8_MMA(ai, bj, At, Bt) do { __builtin_amdgcn_s_setprio(1); _Pragma("unroll") for (int m = 0; m < 4; ++m) _Pragma("unroll") for (int n = 0; n < 2; ++n) _Pragma("unroll") for (int k = 0; k < 2; ++k) \
        acc[ai][bj][m][n] = __builtin_amdgcn_mfma_f32_16x16x32_bf16(Bt[n][k], At[m][k], acc[ai][bj][m][n], 0, 0, 0); __builtin_amdgcn_s_setprio(0); } while (0)
#define PG8_WAIT_V(n) asm volatile("s_waitcnt vmcnt(" #n ")" ::: "memory")
#define PG8_WAIT_L(n) asm volatile("s_waitcnt lgkmcnt(" #n ")" ::: "memory")
#define PG8_BAR __builtin_amdgcn_s_barrier()
#define PG8_SCHED __builtin_amdgcn_sched_barrier(0)
    Unit cur, nxt; int ui = 0;
    if (!S.next(0, cur)) return;
    f32x4 acc[2][2][4][2];
#pragma unroll
    for (int a = 0; a < 2; ++a)
#pragma unroll
        for (int b = 0; b < 2; ++b)
#pragma unroll
            for (int m = 0; m < 4; ++m)
#pragma unroll
                for (int n = 0; n < 2; ++n) acc[a][b][m][n] = (f32x4){0.f, 0.f, 0.f, 0.f};
    bf16x8 At[4][2], B0[2][2], B1[2][2];
    const char* cA = (const char*)g.A + (size_t)cur.pm * tstep; const char* cB = (const char*)g.Bt + (size_t)cur.pn * tstep;
    S.a_ready(cur);
    if constexpr (SP2) {
        PG8_STAGE(PG8_SB(0, 0), cB, voffB); PG8_STAGE(PG8_SB(0, 1), cB + hstep, voffB); PG8_STAGE(PG8_SA(0, 0), cA, voffA); PG8_STAGE(PG8_SA(0, 1), cA + hstep, voffA);
        if (wr == 1) PG8_BAR;
        PG8_WAIT_V(2); PG8_BAR;
        PG8_STAGE(PG8_SB(1, 0), cB + kstep, voffB); PG8_STAGE(PG8_SA(1, 0), cA + kstep, voffA); PG8_STAGE(PG8_SB(1, 1), cB + hstep + kstep, voffB);
        PG8_WAIT_V(6); PG8_BAR;
    } else {
        PG8_STAGE(PG8_SB(0, 0), cB, voffB); PG8_STAGE(PG8_SA(0, 0), cA, voffA); PG8_STAGE(PG8_SB(0, 1), cB + hstep, voffB); PG8_STAGE(PG8_SA(0, 1), cA + hstep, voffA);
        if (wr == 1) PG8_BAR;
        PG8_WAIT_V(4); PG8_BAR;
        PG8_STAGE(PG8_SB(1, 0), cB + kstep, voffB); PG8_STAGE(PG8_SA(1, 0), cA + kstep, voffA); PG8_STAGE(PG8_SB(1, 1), cB + hstep + kstep, voffB);
        PG8_WAIT_V(6); PG8_BAR;
    }
    for (;;) {
        const bool has_next = S.next(ui + 1, nxt);
        const char* nA = has_next ? (const char*)g.A + (size_t)nxt.pm * tstep : cA; const char* nB = has_next ? (const char*)g.Bt + (size_t)nxt.pn * tstep : cB;
        for (int t = 0; t < nt; t += 2) {
            const bool last = (t == nt - 2);
            const char* a1 = cA + (size_t)(t + 1) * kstep;
            const char* a2 = last ? nA : cA + (size_t)(t + 2) * kstep; const char* b2 = last ? nB : cB + (size_t)(t + 2) * kstep;
            const char* a3 = a2 + kstep; const char* b3 = b2 + kstep;
            if (last && has_next) S.a_ready(nxt);
            if constexpr (SP2) {
            PG8_LDB(B0, 0, 0); PG8_LDB(B1, 0, 1); PG8_SCHED; PG8_LDA(At, 0, 0); PG8_STAGE(PG8_SA(1, 1), a1 + hstep, voffA);
            PG8_WAIT_V(8); PG8_WAIT_L(0); PG8_BAR; PG8_MMA(0, 0, At, B0); PG8_MMA(0, 1, At, B1); PG8_BAR; PG8_SCHED;
            PG8_LDA(At, 0, 1); PG8_STAGE(PG8_SB(0, 0), b2, voffB); PG8_STAGE(PG8_SB(0, 1), b2 + hstep, voffB); PG8_STAGE(PG8_SA(0, 0), a2, voffA);
            PG8_WAIT_V(8); PG8_WAIT_L(0); PG8_BAR; PG8_MMA(1, 0, At, B0); PG8_MMA(1, 1, At, B1); PG8_BAR; PG8_SCHED;
            PG8_LDB(B0, 1, 0); PG8_LDB(B1, 1, 1); PG8_SCHED; PG8_LDA(At, 1, 0); PG8_STAGE(PG8_SA(0, 1), a2 + hstep, voffA);
            PG8_WAIT_V(8); PG8_WAIT_L(0); PG8_BAR; PG8_MMA(0, 0, At, B0); PG8_MMA(0, 1, At, B1); PG8_BAR; PG8_SCHED;
            PG8_LDA(At, 1, 1); PG8_STAGE(PG8_SB(1, 0), b3, voffB); PG8_STAGE(PG8_SB(1, 1), b3 + hstep, voffB); PG8_STAGE(PG8_SA(1, 0), a3, voffA);
            PG8_WAIT_V(8); PG8_WAIT_L(0); PG8_BAR; PG8_MMA(1, 0, At, B0); PG8_MMA(1, 1, At, B1); PG8_BAR; PG8_SCHED;
            } else {
            PG8_LDB(B0, 0, 0); PG8_SCHED; PG8_LDA(At, 0, 0); PG8_STAGE(PG8_SA(1, 1), a1 + hstep, voffA);
            PG8_WAIT_L(8); PG8_BAR; PG8_WAIT_L(0); PG8_MMA(0, 0, At, B0); PG8_BAR; PG8_SCHED;
            PG8_LDB(B1, 0, 1); PG8_STAGE(PG8_SB(0, 0), b2, voffB);
            PG8_BAR; PG8_WAIT_L(0); PG8_MMA(0, 1, At, B1); PG8_BAR;
            PG8_LDA(At, 0, 1); PG8_STAGE(PG8_SA(0, 0), a2, voffA);
            PG8_BAR; PG8_WAIT_L(0); PG8_MMA(1, 0, At, B0); PG8_BAR; PG8_SCHED;
            PG8_STAGE(PG8_SB(0, 1), b2 + hstep, voffB);
            PG8_WAIT_V(6); PG8_BAR; PG8_MMA(1, 1, At, B1); PG8_BAR;
            PG8_LDB(B0, 1, 0); PG8_SCHED; PG8_LDA(At, 1, 0); PG8_STAGE(PG8_SA(0, 1), a2 + hstep, voffA);
            PG8_WAIT_L(8); PG8_BAR; PG8_WAIT_L(0); PG8_MMA(0, 0, At, B0); PG8_BAR; PG8_SCHED;
            PG8_LDB(B1, 1, 1); PG8_STAGE(PG8_SB(1, 0), b3, voffB);
            PG8_BAR; PG8_WAIT_L(0); PG8_MMA(0, 1, At, B1); PG8_BAR;
            PG8_LDA(At, 1, 1); PG8_STAGE(PG8_SA(1, 0), a3, voffA);
            PG8_BAR; PG8_WAIT_L(0); PG8_MMA(1, 0, At, B0); PG8_BAR; PG8_SCHED;
            PG8_STAGE(PG8_SB(1, 1), b3 + hstep, voffB);
            PG8_WAIT_V(6); PG8_BAR; PG8_MMA(1, 1, At, B1); PG8_BAR;
            }
        }
        if constexpr (ALIGN_EPI) { if (wr == 0) PG8_BAR; }
        if constexpr (!Epi::AFTER_DRAIN) { E(acc, cur, wr, wc, fr, fq); S.done(cur); }
        if (!has_next) break;
#pragma unroll
        for (int a = 0; a < 2; ++a)
#pragma unroll
            for (int b = 0; b < 2; ++b)
#pragma unroll
                for (int m = 0; m < 4; ++m)
#pragma unroll
                    for (int n = 0; n < 2; ++n) acc[a][b][m][n] = (f32x4){0.f, 0.f, 0.f, 0.f};
        cur = nxt; cA = nA; cB = nB; ++ui;
        if constexpr (ALIGN_EPI) { if (wr == 1) PG8_BAR; }
    }
    PG8_WAIT_V(0);
    if constexpr (!ALIGN_EPI) { if (wr == 0) PG8_BAR; }
    PG8_BAR;
    if constexpr (Epi::AFTER_DRAIN) { E.fused(acc, cur, wr, wc, fr, fq, lds, wid, lane); S.done(cur); }
#undef PG8_SA
#undef PG8_SB
#undef PG8_STAGE
#undef PG8_LDA
#undef PG8_LDB
#undef PG8_MMA
#undef PG8_WAIT_V
#undef PG8_WAIT_L
#undef PG8_BAR
#undef PG8_SCHED
}
}

using pg8::bf16_t; using pg8::bf16x8; using pg8::f32x4; using pg8::u32x4;
typedef unsigned u32x2 __attribute__((ext_vector_type(2)));
typedef short s16x4 __attribute__((ext_vector_type(4)));
#define LAS __attribute__((address_space(3)))

constexpr int NTHREADS = 512;
constexpr int MTOK = 65536, DM = 1024, SEQ = 2048, NBATCH = 32, DEPTH = 4;
constexpr int NPROJ = 2304;
constexpr int INW = 2176;
constexpr int DFF = 2816, DFF2 = 5632;
constexpr int MEMROWS = 8192;
constexpr int MHALF = 32768;
constexpr float EPSF = 1e-6f;
constexpr float LOG2E = 1.4426950408889634f;
constexpr int LDS_BYTES = 155648;
constexpr int LDS_UNIT_OFF = 155648 - 64;
constexpr int LDS_TBL_OFF = 155648 - 512;

constexpr size_t MiB = 1u << 20;
constexpr size_t WS_CTL = 0;
constexpr size_t WS_ST = 1 * MiB;
constexpr size_t WS_STM = 5 * MiB;
constexpr size_t WS_CS = 5 * MiB + 512 * 1024;
constexpr size_t WS_KST = 6 * MiB;
constexpr size_t WS_QST = 14 * MiB;
constexpr size_t WS_MEMB = 22 * MiB;
constexpr size_t WS_W = 38 * MiB;
constexpr size_t W_LAYER = 27 * MiB;
constexpr size_t W_IN = 0, W_OUT = (size_t)(4.5 * MiB), W_Q = (size_t)(6.5 * MiB), W_O = (size_t)(8.5 * MiB), W_UP = (size_t)(10.5 * MiB), W_DOWN = (size_t)(21.5 * MiB);
constexpr size_t WS_WKV = WS_W + 4 * W_LAYER;
constexpr size_t WS_HB = 162 * MiB;
constexpr size_t WS_KV = 290 * MiB;
constexpr size_t WS_BIG = 418 * MiB;
constexpr size_t WS_PROJ = WS_BIG;
constexpr size_t WS_MIXED = WS_BIG + 288 * MiB;
constexpr size_t WS_QM = WS_MIXED + 128 * MiB;
constexpr size_t WS_GU = WS_BIG;
constexpr size_t WS_ACT = WS_BIG + 352 * MiB;
constexpr size_t WS_END = WS_QM + 128 * MiB;
static_assert(WS_WKV + 16 * MiB <= WS_HB, "ws map");
static_assert(WS_ACT + 176 * MiB <= WS_END, "ws map");

struct Args { const float* in[28]; float* out; unsigned char* ws; };
struct Ctx { LAS const unsigned long long* tbl; float* out; unsigned char* ws; int wv; };
__device__ __forceinline__ const float* inptr(const Ctx& c, int i) {
    const unsigned long long v = c.tbl[i];
    const unsigned lo = __builtin_amdgcn_readfirstlane((unsigned)v), hi = __builtin_amdgcn_readfirstlane((unsigned)(v >> 32));
    return (const float*)(((unsigned long long)hi << 32) | lo);
}

__device__ __forceinline__ float bf2f(unsigned short b) { return __uint_as_float(((unsigned)b) << 16); }
__device__ __forceinline__ float bflo(unsigned w) { return __uint_as_float(w << 16); }
__device__ __forceinline__ float bfhi(unsigned w) { return __uint_as_float(w & 0xffff0000u); }
__device__ __forceinline__ unsigned pkbf(float lo, float hi) { unsigned r; asm("v_cvt_pk_bf16_f32 %0, %1, %2" : "=v"(r) : "v"(lo), "v"(hi)); return r; }
__device__ __forceinline__ unsigned short f2bf(float f) { return (unsigned short)(pkbf(f, 0.f) & 0xffffu); }
__device__ __forceinline__ float shx(float v, int lane, int m) { return __int_as_float(__builtin_amdgcn_ds_bpermute((lane ^ m) << 2, __float_as_int(v))); }
__device__ __forceinline__ float shi(float v, int src) { return __int_as_float(__builtin_amdgcn_ds_bpermute(src << 2, __float_as_int(v))); }
__device__ __forceinline__ float wave_sum(float v, int lane) {
#pragma unroll
    for (int o = 1; o < 64; o <<= 1) v += shx(v, lane, o);
    return v;
}
__device__ __forceinline__ float sigmoidf_(float x) { return 1.0f / (1.0f + __expf(-x)); }
__device__ __forceinline__ float gelu_tanh(float x) {
    const float u = 0.7978845608028654f * (x + 0.044715f * x * x * x);
    return x / (1.0f + __expf(-2.0f * u));
}
__device__ __forceinline__ LAS unsigned char* lds_l(LAS unsigned char* p) { unsigned v = (unsigned)(uintptr_t)p; asm volatile("" : "+s"(v)); return (LAS unsigned char*)(uintptr_t)v; }
__device__ __forceinline__ int tid_w(int wv) { int t = (wv << 6) + (int)__builtin_amdgcn_mbcnt_hi(~0u, __builtin_amdgcn_mbcnt_lo(~0u, 0u)); asm volatile("" : "+v"(t)); return t; }
__device__ __forceinline__ s16x4 vtr(LAS const unsigned char* p) {
    typedef short v4i16_t __attribute__((ext_vector_type(4)));
    return __builtin_bit_cast(s16x4, __builtin_amdgcn_ds_read_tr16_b64_v4i16((LAS v4i16_t*)p));
}

template <bool QKN> struct EpiBf {
    static constexpr bool PERM = true, AFTER_DRAIN = false;
    bf16_t* O; int ldc; const float* st; float* pst; int npg; const float* cs; const float* qg; const float* kg;
    __device__ __forceinline__ void operator()(const f32x4 (&acc)[2][2][4][2], const pg8::Unit& u, int wr, int wc, int fr, int fq) const {
        int kind = 0; const float* gsel = nullptr;
        if (QKN) { const int c0 = u.pn * 256 + 64 * wc; if (c0 >= 256 && c0 < 640) { kind = 1; gsel = qg; } else if (c0 >= 640 && c0 < 1024) { kind = 2; gsel = kg; } }
#pragma unroll
        for (int ai = 0; ai < 2; ++ai)
#pragma unroll
            for (int m = 0; m < 4; ++m) {
                const int r = u.pm * 256 + ai * 128 + wr * 64 + m * 16 + fr;
                const f32x4* sp = (const f32x4*)(st + (size_t)r * 16);
                const f32x4 s0 = sp[0], s1 = sp[1], s2 = sp[2], s3 = sp[3];
                const float ssum = ((s0[0] + s0[1]) + (s0[2] + s0[3])) + ((s1[0] + s1[1]) + (s1[2] + s1[3])) + ((s2[0] + s2[1]) + (s2[2] + s2[3])) + ((s3[0] + s3[1]) + (s3[2] + s3[3]));
                const float rs = rsqrtf(ssum * (1.0f / 1024.0f) + EPSF);
                f32x4 v[2][2];
#pragma unroll
                for (int bj = 0; bj < 2; ++bj)
#pragma unroll
                    for (int n = 0; n < 2; ++n) v[bj][n] = acc[ai][bj][m][n] * rs;
                if (QKN) {
                    if (kind != 0) {
                        float ss = 0.f;
#pragma unroll
                        for (int bj = 0; bj < 2; ++bj)
#pragma unroll
                            for (int n = 0; n < 2; ++n) ss += (v[bj][n][0] * v[bj][n][0] + v[bj][n][1] * v[bj][n][1]) + (v[bj][n][2] * v[bj][n][2] + v[bj][n][3] * v[bj][n][3]);
                        ss += shx(ss, fq * 16 + fr, 16); ss += shx(ss, fq * 16 + fr, 32);
                        float rn = rsqrtf(ss * (1.0f / 64.0f) + EPSF);
                        if (kind == 1) rn *= 0.125f * LOG2E;
#pragma unroll
                        for (int bj = 0; bj < 2; ++bj)
#pragma unroll
                            for (int n = 0; n < 2; ++n) { const f32x4 gv = *(const f32x4*)(gsel + 32 * bj + 8 * fq + 4 * n); v[bj][n] = v[bj][n] * rn * gv; }
                    }
                } else {
                    if (pst) {
#pragma unroll
                        for (int bj = 0; bj < 2; ++bj) {
                            float ss = (v[bj][0][0] * v[bj][0][0] + v[bj][0][1] * v[bj][0][1]) + (v[bj][0][2] * v[bj][0][2] + v[bj][0][3] * v[bj][0][3])
                                     + (v[bj][1][0] * v[bj][1][0] + v[bj][1][1] * v[bj][1][1]) + (v[bj][1][2] * v[bj][1][2] + v[bj][1][3] * v[bj][1][3]);
                            ss += shx(ss, fq * 16 + fr, 16); ss += shx(ss, fq * 16 + fr, 32);
                            if (fq == 0) pst[(size_t)r * npg + (u.pn * 8 + bj * 4 + wc)] = ss;
                        }
                    }
                    if (cs) {
#pragma unroll
                        for (int bj = 0; bj < 2; ++bj)
#pragma unroll
                            for (int n = 0; n < 2; ++n) { const f32x4 cv = *(const f32x4*)(cs + u.pn * 256 + bj * 128 + wc * 32 + 8 * fq + 4 * n); v[bj][n] = v[bj][n] * cv; }
                    }
                }
#pragma unroll
                for (int bj = 0; bj < 2; ++bj) {
                    const int col = QKN ? (u.pn * 256 + 64 * wc + 32 * bj + 8 * fq) : (u.pn * 256 + 128 * bj + 32 * wc + 8 * fq);
                    u32x4 w; w.x = pkbf(v[bj][0][0], v[bj][0][1]); w.y = pkbf(v[bj][0][2], v[bj][0][3]); w.z = pkbf(v[bj][1][0], v[bj][1][1]); w.w = pkbf(v[bj][1][2], v[bj][1][3]);
                    *(u32x4*)(O + (size_t)r * ldc + col) = w;
                }
                asm volatile("" ::: "memory");
            }
    }
};

struct EpiRes {
    static constexpr bool PERM = false, AFTER_DRAIN = false;
    const float* resid; float* out; bf16_t* hb; float* st;
    __device__ __forceinline__ void operator()(const f32x4 (&acc)[2][2][4][2], const pg8::Unit& u, int wr, int wc, int fr, int fq) const {
#pragma unroll
        for (int ai = 0; ai < 2; ++ai)
#pragma unroll
            for (int m = 0; m < 4; ++m) {
                const int r = u.pm * 256 + ai * 128 + wr * 64 + m * 16 + fr;
                float ss = 0.f;
#pragma unroll
                for (int bj = 0; bj < 2; ++bj)
#pragma unroll
                    for (int n = 0; n < 2; ++n) {
                        const size_t off = (size_t)r * DM + (u.pn * 256 + bj * 128 + wc * 32 + n * 16 + 4 * fq);
                        const f32x4 v = *(const f32x4*)(resid + off) + acc[ai][bj][m][n];
                        *(f32x4*)(out + off) = v;
                        u32x2 w; w.x = pkbf(v[0], v[1]); w.y = pkbf(v[2], v[3]);
                        *(u32x2*)(hb + off) = w;
                        ss += (v[0] * v[0] + v[1] * v[1]) + (v[2] * v[2] + v[3] * v[3]);
                    }
                ss += shx(ss, fq * 16 + fr, 16); ss += shx(ss, fq * 16 + fr, 32);
                if (fq == 0) st[(size_t)r * 16 + u.pn * 4 + wc] = ss;
                asm volatile("" ::: "memory");
            }
    }
};

template <class Epi>
__device__ __forceinline__ void run_gemm(int wv, LAS unsigned char* lds, const bf16_t* A, const bf16_t* Bt, int M, int N, int K, const Epi& E) {
    pg8::Gemm g{A, Bt, M, N, K}; pg8::StaticOrder S; S.init(M, N, (int)gridDim.x, (int)blockIdx.x);
    pg8::gemm_phase<Epi, pg8::StaticOrder, true, true>(tid_w(wv), lds_l(lds), g, S, E);
}

__device__ __forceinline__ void transpose_item(const float* W, int ldw, int K, const float* gain, bf16_t* WT, int dst_row0, bool zero, LAS float* scr, int k0, int n0, int lane) {
#pragma unroll 8
    for (int i = 0; i < 32; ++i) {
        const int kk = 2 * i + (lane >> 5);
        float v = 0.f;
        if (!zero) { v = W[(size_t)(k0 + kk) * ldw + n0 + (lane & 31)]; if (gain) v *= gain[k0 + kk]; }
        scr[kk * 33 + (lane & 31)] = v;
    }
    asm volatile("s_waitcnt lgkmcnt(0)" ::: "memory");
    const int c = lane & 7;
#pragma unroll
    for (int j = 0; j < 4; ++j) {
        const int n = (lane >> 3) + 8 * j; const LAS float* s = scr + (8 * c) * 33 + n;
        u32x4 o; o.x = pkbf(s[0 * 33], s[1 * 33]); o.y = pkbf(s[2 * 33], s[3 * 33]); o.z = pkbf(s[4 * 33], s[5 * 33]); o.w = pkbf(s[6 * 33], s[7 * 33]);
        *(u32x4*)(WT + (size_t)(dst_row0 + n) * K + k0 + 8 * c) = o;
    }
    asm volatile("s_waitcnt lgkmcnt(0)" ::: "memory");
}
__device__ __forceinline__ void row_to_bf16(const float* xrow, bf16_t* orow, float* strow, int lane) {
    const f32x4* xr = (const f32x4*)xrow + lane;
    f32x4 v[4]; float s = 0.f;
#pragma unroll
    for (int j = 0; j < 4; ++j) { v[j] = xr[64 * j]; s += (v[j][0] * v[j][0] + v[j][1] * v[j][1]) + (v[j][2] * v[j][2] + v[j][3] * v[j][3]); }
    s = wave_sum(s, lane);
    u32x2* o8 = (u32x2*)orow + lane;
#pragma unroll
    for (int j = 0; j < 4; ++j) { u32x2 w; w.x = pkbf(v[j][0], v[j][1]); w.y = pkbf(v[j][2], v[j][3]); o8[64 * j] = w; }
    if (lane < 16) strow[lane] = (lane == 0) ? s : 0.f;
}
__device__ __forceinline__ void phase_prologue(const Ctx& a, LAS unsigned char* lds) {
    lds = lds_l(lds);
    const int tid = tid_w(a.wv), lane = tid & 63, wave = tid >> 6;
    LAS float* scr = (LAS float*)(lds + wave * 16384);
    const int gw = blockIdx.x * 8 + wave, NGW = gridDim.x * 8;
    unsigned char* ws = a.ws;
    constexpr int I_IN = 16 * 72, I_SQ = 16 * 32, I_UP = 16 * 176, I_DN = 44 * 32, I_KV = 16 * 64;
    constexpr int I_LAYER = I_IN + 3 * I_SQ + I_UP + I_DN + I_KV;
    for (int it = gw; it < DEPTH * I_LAYER; it += NGW) {
        const int l = it / I_LAYER; int r = it % I_LAYER;
        bf16_t* wl = (bf16_t*)(ws + WS_W + (size_t)l * W_LAYER);
        if (r < I_IN) {
            const int kb = r / 72, nb = r % 72, n0 = nb * 32;
            const int dst = (n0 & ~255) + 128 * ((n0 >> 5) & 1) + 32 * ((n0 >> 6) & 3);
            transpose_item(inptr(a, 3) + (size_t)l * DM * INW, INW, DM, inptr(a, 2) + l * DM, (bf16_t*)((unsigned char*)wl + W_IN), dst, n0 >= INW, scr, kb * 64, n0, lane);
            continue;
        }
        r -= I_IN;
        if (r < I_SQ) { transpose_item(inptr(a, 15) + (size_t)l * DM * DM, DM, DM, nullptr, (bf16_t*)((unsigned char*)wl + W_OUT), (r % 32) * 32, false, scr, (r / 32) * 64, (r % 32) * 32, lane); continue; }
        r -= I_SQ;
        if (r < I_SQ) { transpose_item(inptr(a, 18) + (size_t)l * DM * DM, DM, DM, inptr(a, 16) + l * DM, (bf16_t*)((unsigned char*)wl + W_Q), (r % 32) * 32, false, scr, (r / 32) * 64, (r % 32) * 32, lane); continue; }
        r -= I_SQ;
        if (r < I_SQ) { transpose_item(inptr(a, 22) + (size_t)l * DM * DM, DM, DM, nullptr, (bf16_t*)((unsigned char*)wl + W_O), (r % 32) * 32, false, scr, (r / 32) * 64, (r % 32) * 32, lane); continue; }
        r -= I_SQ;
        if (r < I_UP) { transpose_item(inptr(a, 24) + (size_t)l * DM * DFF2, DFF2, DM, inptr(a, 23) + l * DM, (bf16_t*)((unsigned char*)wl + W_UP), (r % 176) * 32, false, scr, (r / 176) * 64, (r % 176) * 32, lane); continue; }
        r -= I_UP;
        if (r < I_DN) { transpose_item(inptr(a, 27) + (size_t)l * DFF * DM, DM, DFF, nullptr, (bf16_t*)((unsigned char*)wl + W_DOWN), (r % 32) * 32, false, scr, (r / 32) * 64, (r % 32) * 32, lane); continue; }
        r -= I_DN;
        transpose_item(inptr(a, 19) + (size_t)l * DM * 2048, 2048, DM, inptr(a, 17) + l * DM, (bf16_t*)(ws + WS_WKV), l * 2048 + (r % 64) * 32, false, scr, (r / 64) * 64, (r % 64) * 32, lane);
    }
    for (int i = blockIdx.x * NTHREADS + tid; i < DEPTH * DM; i += gridDim.x * NTHREADS) { const int l = i >> 10, dd = i & 255; ((float*)(ws + WS_CS))[i] = inptr(a, 20)[l * 256 + dd] * inptr(a, 21)[l * 256 + dd] * (0.0625f * LOG2E); }
    for (int m = gw; m < MTOK; m += NGW) row_to_bf16(inptr(a, 0) + (size_t)m * DM, (bf16_t*)(ws + WS_HB) + (size_t)m * DM, (float*)(ws + WS_ST) + (size_t)m * 16, lane);
    for (int m = gw; m < MEMROWS; m += NGW) row_to_bf16(inptr(a, 1) + (size_t)m * DM, (bf16_t*)(ws + WS_MEMB) + (size_t)m * DM, (float*)(ws + WS_STM) + (size_t)m * 16, lane);
}

__device__ __forceinline__ void lru_unit(const Ctx& a, int l, int b, int g, LAS unsigned char* lds) {
    lds = lds_l(lds);
    const int tid = tid_w(a.wv), lane = tid & 63, wave = tid >> 6, l15 = lane & 15, gq = lane >> 4;
    LAS unsigned char* XT = lds;
    LAS unsigned char* XCB = lds + 19008;
    LAS float* XCF = (LAS float*)(lds + 37440);
    LAS float* AA = (LAS float*)(lds + 70208);
    LAS float* BB = (LAS float*)(lds + 102976);
    LAS unsigned char* WT = lds + 135744;
    const bf16_t* proj = (const bf16_t*)(a.ws + WS_PROJ) + (size_t)b * SEQ * NPROJ;
    bf16_t* mixed = (bf16_t*)(a.ws + WS_MIXED) + (size_t)b * SEQ * DM;
    const float* wa = inptr(a, 10) + ((size_t)l * 6 + g) * 4096; const float* wx = inptr(a, 12) + ((size_t)l * 6 + g) * 4096;
    for (int k = 0; k < 16; ++k) {
        const int idx = tid + 512 * k, which = idx >> 12, cp = (idx >> 6) & 63, c = idx & 63;
        const float v = which ? wx[cp * 64 + c] : wa[cp * 64 + c];
        *(LAS unsigned short*)(WT + (which * 64 + c) * 144 + cp * 2) = f2bf(v);
    }
    const int cch = tid & 63, ch = g * 64 + cch;
    float cw[4];
#pragma unroll
    for (int j = 0; j < 4; ++j) cw[j] = inptr(a, 8)[((size_t)l * 4 + j) * 384 + ch];
    const float cb = inptr(a, 9)[l * 384 + ch];
    float gba[4], gbx[4], gsp[4];
#pragma unroll
    for (int nt = 0; nt < 4; ++nt) {
        const int c2 = l * 384 + g * 64 + 16 * nt + l15;
        gba[nt] = inptr(a, 11)[c2]; gbx[nt] = inptr(a, 13)[c2];
        const float z = -inptr(a, 14)[c2];
        gsp[nt] = 8.0f * (fmaxf(z, 0.f) + log1pf(__expf(-fabsf(z))));
    }
    float hcar = 0.f;
    const bf16_t* xsrc = proj + 1408 + g * 64;
    const bf16_t* ysrc = proj + 1792 + g * 64;
    u32x4 xr[3];
#pragma unroll
    for (int k = 0; k < 3; ++k) {
        const int idx = tid + 512 * k, row = idx >> 3, cv = idx & 7, tok = row - 3;
        xr[k] = (idx < 1048 && tok >= 0) ? *(const u32x4*)(xsrc + (size_t)tok * NPROJ + cv * 8) : (u32x4){0u, 0u, 0u, 0u};
    }
#pragma unroll 1
    for (int ck = 0; ck < 16; ++ck) {
        const int t0 = ck * 128;
#pragma unroll
        for (int k = 0; k < 3; ++k) { const int idx = tid + 512 * k, row = idx >> 3, cv = idx & 7; if (idx < 1048) *(LAS u32x4*)(XT + row * 144 + cv * 16) = xr[k]; }
        u32x4 yr[2];
#pragma unroll
        for (int k = 0; k < 2; ++k) { const int idx = tid + 512 * k, row = idx >> 3, cv = idx & 7; yr[k] = *(const u32x4*)(ysrc + (size_t)(t0 + row) * NPROJ + cv * 8); }
        if (ck < 15) {
#pragma unroll
            for (int k = 0; k < 3; ++k) {
                const int idx = tid + 512 * k, row = idx >> 3, cv = idx & 7, tok = t0 + 128 - 3 + row;
                xr[k] = (idx < 1048) ? *(const u32x4*)(xsrc + (size_t)tok * NPROJ + cv * 8) : (u32x4){0u, 0u, 0u, 0u};
            }
        }
        __syncthreads();
#pragma unroll 4
        for (int k = 0; k < 16; ++k) {
            const int t = (tid >> 6) + 8 * k;
            float xc = cb;
#pragma unroll
            for (int j = 0; j < 4; ++j) xc += cw[j] * bf2f(*(LAS const unsigned short*)(XT + (t + 3 - j) * 144 + cch * 2));
            XCF[t * 64 + cch] = xc;
            *(LAS unsigned short*)(XCB + t * 144 + cch * 2) = f2bf(xc);
        }
        __syncthreads();
        {
            f32x4 acc[8];
#pragma unroll
            for (int nt = 0; nt < 8; ++nt) acc[nt] = (f32x4){0.f, 0.f, 0.f, 0.f};
#pragma unroll
            for (int ks = 0; ks < 2; ++ks) {
                const bf16x8 af = *(LAS const bf16x8*)(XCB + (16 * wave + l15) * 144 + (32 * ks + 8 * gq) * 2);
#pragma unroll
                for (int nt = 0; nt < 8; ++nt) {
                    const bf16x8 bfr = *(LAS const bf16x8*)(WT + (16 * nt + l15) * 144 + (32 * ks + 8 * gq) * 2);
                    acc[nt] = __builtin_amdgcn_mfma_f32_16x16x32_bf16(af, bfr, acc[nt], 0, 0, 0);
                }
            }
#pragma unroll
            for (int nt = 0; nt < 4; ++nt)
#pragma unroll
                for (int rg = 0; rg < 4; ++rg) {
                    const int t = 16 * wave + 4 * gq + rg, c = 16 * nt + l15;
                    const float r = sigmoidf_(acc[nt][rg] + gba[nt]), ig = sigmoidf_(acc[nt + 4][rg] + gbx[nt]);
                    const float la = -r * gsp[nt];
                    const float av = __expf(la);
                    const float xcv = XCF[t * 64 + c];
                    AA[t * 64 + c] = av;
                    BB[t * 64 + c] = sqrtf(fmaxf(-expm1f(2.0f * la), 0.f)) * (ig * xcv);
                }
        }
        __syncthreads();
        if (wave == 0) {
#pragma unroll 16
            for (int t = 0; t < 128; ++t) { hcar = AA[t * 64 + lane] * hcar + BB[t * 64 + lane]; BB[t * 64 + lane] = hcar; }
        }
        __syncthreads();
#pragma unroll
        for (int k = 0; k < 2; ++k) {
            const int idx = tid + 512 * k, row = idx >> 3, cv = idx & 7;
            const f32x4 h0 = *(LAS const f32x4*)(BB + row * 64 + cv * 8), h1 = *(LAS const f32x4*)(BB + row * 64 + cv * 8 + 4);
            u32x4 w;
            w.x = pkbf(h0[0] * gelu_tanh(bflo(yr[k].x)), h0[1] * gelu_tanh(bfhi(yr[k].x)));
            w.y = pkbf(h0[2] * gelu_tanh(bflo(yr[k].y)), h0[3] * gelu_tanh(bfhi(yr[k].y)));
            w.z = pkbf(h1[0] * gelu_tanh(bflo(yr[k].z)), h1[1] * gelu_tanh(bfhi(yr[k].z)));
            w.w = pkbf(h1[2] * gelu_tanh(bflo(yr[k].w)), h1[3] * gelu_tanh(bfhi(yr[k].w)));
            *(u32x4*)(mixed + (size_t)(t0 + row) * DM + 640 + g * 64 + cv * 8) = w;
        }
    }
}

__device__ __forceinline__ void pool_unit(const Ctx& a, int l, int b, int tc, LAS unsigned char* lds) {
    lds = lds_l(lds);
    const int tid = tid_w(a.wv);
    LAS float* U = (LAS float*)lds;
    LAS float* P = (LAS float*)(lds + 80896);
    const int t0 = tc * 64;
    const bf16_t* proj = (const bf16_t*)(a.ws + WS_PROJ) + (size_t)b * SEQ * NPROJ;
    bf16_t* mixed = (bf16_t*)(a.ws + WS_MIXED) + (size_t)b * SEQ * DM;
    for (int k = 0; k < 40; ++k) {
        const int idx = tid + 512 * k;
        if (idx < 79 * 256) { const int tt = idx >> 8, c = idx & 255, t = t0 - 15 + tt; U[idx] = (t >= 0) ? bf2f(proj[(size_t)t * NPROJ + c]) : 0.f; }
    }
    __syncthreads();
    {
        const int c = tid & 255, half = tid >> 8, g = c >> 6, w = 2 << g;
        for (int q = 0; q < 32; ++q) {
            const int tt = half * 32 + q, t = t0 + tt;
            float s = 0.f;
            for (int j = 0; j < w; ++j) s += U[(tt + 15 - j) * 256 + c];
            const float cnt = (float)((t + 1 < w) ? (t + 1) : w);
            P[tt * 256 + c] = s / cnt - U[(tt + 15) * 256 + c];
        }
    }
    __syncthreads();
    {
        const int dcol = tid & 255, half = tid >> 8, g = dcol >> 6, dc = dcol & 63;
        const float* pw = inptr(a, 4) + ((size_t)l * 4 + g) * 4096 + dc;
        float w[64];
#pragma unroll
        for (int c = 0; c < 64; ++c) w[c] = pw[c * 64];
        const float sc = inptr(a, 5)[l * 256 + dcol];
        for (int q = 0; q < 32; ++q) {
            const int tt = half * 32 + q;
            const LAS f32x4* pr = (const LAS f32x4*)(P + tt * 256 + g * 64);
            float acc = 0.f;
#pragma unroll
            for (int c4 = 0; c4 < 16; ++c4) { const f32x4 pv = pr[c4]; acc += pv[0] * w[4 * c4] + pv[1] * w[4 * c4 + 1] + pv[2] * w[4 * c4 + 2] + pv[3] * w[4 * c4 + 3]; }
            mixed[(size_t)(t0 + tt) * DM + dcol] = f2bf(acc * sc);
        }
    }
}

__device__ __forceinline__ void dattn_unit(const Ctx& a, int b, int h, int tb, LAS unsigned char* lds) {
    lds = lds_l(lds);
    const int tid = tid_w(a.wv), lane = tid & 63, wave = tid >> 6, l15 = lane & 15, gq = lane >> 4;
    LAS float* OACC = (LAS float*)lds;
    LAS float* DEN = (LAS float*)(lds + 65536);
    LAS unsigned char* vst = lds + 66560 + wave * 4608;
    const int t0 = tb * 256;
    const bf16_t* projb = (const bf16_t*)(a.ws + WS_PROJ) + (size_t)b * SEQ * NPROJ;
    bf16_t* mixed = (bf16_t*)(a.ws + WS_MIXED) + (size_t)b * SEQ * DM;
    const float slope2 = exp2f(-8.0f * (float)(h + 1) / 6.0f) * LOG2E;
    const int trq = (l15 >> 2), trp = (l15 & 3);
#pragma unroll 1
    for (int pi = 0; pi < 3; ++pi) {
        const int d = 1 << (2 * pi);
        const float sl = slope2 * (float)d;
#pragma unroll 1
        for (int ii = 0; ii < 2; ++ii) {
            const int it = 2 * wave + ii, rr = it % d, jj = it / d, tq0 = t0 + rr + 16 * d * jj;
            const unsigned char* pbytes = (const unsigned char*)projb;
            const unsigned qoff = (unsigned)(tq0 + d * l15) * (unsigned)(NPROJ * 2) + (unsigned)((256 + h * 64 + 8 * gq) * 2);
            const bf16x8 qf0 = *(const bf16x8*)(pbytes + qoff), qf1 = *(const bf16x8*)(pbytes + qoff + 64);
            bf16x8 kf[6][2];
#define DATTN_KLOAD(KT) do { if ((KT) < 9) { int tk = tq0 + d * (16 * ((KT) - 8) + l15); tk = tk < 0 ? 0 : tk; \
                const unsigned koff = (unsigned)tk * (unsigned)(NPROJ * 2) + (unsigned)((640 + h * 64 + 8 * gq) * 2); \
                kf[(KT) % 6][0] = *(const bf16x8*)(pbytes + koff); kf[(KT) % 6][1] = *(const bf16x8*)(pbytes + koff + 64); } } while (0)
            DATTN_KLOAD(0); DATTN_KLOAD(1); DATTN_KLOAD(2); DATTN_KLOAD(3); DATTN_KLOAD(4); DATTN_KLOAD(5);
            u32x4 vreg[2][4];
#define DATTN_VLOAD(PP) do { _Pragma("unroll") for (int ps = 0; ps < 4; ++ps) { \
                    const int idx = ps * 64 + lane, row = idx >> 3, chk = idx & 7, kt = 2 * (PP) + (row >> 4); \
                    int tk = tq0 + d * (16 * (kt - 8) + (row & 15)); tk = tk < 0 ? 0 : (tk > SEQ - 1 ? SEQ - 1 : tk); \
                    vreg[(PP) % 2][ps] = *(const u32x4*)(pbytes + ((unsigned)tk * (unsigned)(NPROJ * 2) + (unsigned)((1024 + h * 64 + chk * 8) * 2))); } } while (0)
            DATTN_VLOAD(0); DATTN_VLOAD(1);
            f32x4 o[4];
#pragma unroll
            for (int dt = 0; dt < 4; ++dt) o[dt] = (f32x4){0.f, 0.f, 0.f, 0.f};
            float den = 0.f;
            int dbase = l15 + 128 - 4 * gq; asm volatile("" : "+v"(dbase));
            float fbase = (float)dbase; asm volatile("" : "+v"(fbase));
#pragma unroll
            for (int pp = 0; pp < 5; ++pp) {
#pragma unroll
                for (int ps = 0; ps < 4; ++ps) { const int idx = ps * 64 + lane, row = idx >> 3, chk = idx & 7; *(LAS u32x4*)(vst + row * 144 + chk * 16) = vreg[pp % 2][ps]; }
                if (pp + 2 < 5) { asm volatile("" ::: "memory"); DATTN_VLOAD(pp + 2); }
                const bool skip = (tq0 + d * (16 * (2 * pp + 1 - 8) + 15) < 0);
                f32x4 sacc[2];
#pragma unroll
                for (int T = 0; T < 2; ++T) {
                    const int kt = 2 * pp + T;
                    sacc[T] = (f32x4){0.f, 0.f, 0.f, 0.f};
                    if (kt < 9 && !skip) {
                        sacc[T] = __builtin_amdgcn_mfma_f32_16x16x32_bf16(kf[kt % 6][0], qf0, sacc[T], 0, 0, 0);
                        sacc[T] = __builtin_amdgcn_mfma_f32_16x16x32_bf16(kf[kt % 6][1], qf1, sacc[T], 0, 0, 0);
                    }
                }
                if (pp + 3 < 5) { asm volatile("" ::: "memory"); DATTN_KLOAD(2 * pp + 6); DATTN_KLOAD(2 * pp + 7); }
                if (skip) continue;
                float p[2][4];
#pragma unroll
                for (int T = 0; T < 2; ++T) {
                    const int kt = 2 * pp + T;
#pragma unroll
                    for (int rg = 0; rg < 4; ++rg) {
                        const int dist = dbase - (16 * kt + rg);
                        const int tkk = tq0 + d * (l15 - dist);
                        const bool valid = (kt < 9) && (dist >= 0) && (dist <= 128) && (tkk >= 0);
                        const float pv = valid ? __builtin_amdgcn_exp2f(sacc[T][rg] - sl * (fbase - (float)(16 * kt + rg))) : 0.f;
                        p[T][rg] = pv; den += pv;
                    }
                }
                u32x4 pw; pw.x = pkbf(p[0][0], p[0][1]); pw.y = pkbf(p[0][2], p[0][3]); pw.z = pkbf(p[1][0], p[1][1]); pw.w = pkbf(p[1][2], p[1][3]);
                const bf16x8 pfrag = __builtin_bit_cast(bf16x8, pw);
#pragma unroll
                for (int dt = 0; dt < 4; ++dt) {
                    const s16x4 lo = vtr(vst + (4 * gq + trq) * 144 + (16 * dt + 4 * trp) * 2);
                    const s16x4 hi = vtr(vst + (16 + 4 * gq + trq) * 144 + (16 * dt + 4 * trp) * 2);
                    const bf16x8 vf = (bf16x8){lo[0], lo[1], lo[2], lo[3], hi[0], hi[1], hi[2], hi[3]};
                    o[dt] = __builtin_amdgcn_mfma_f32_16x16x32_bf16(pfrag, vf, o[dt], 0, 0, 0);
                }
            }
            den += shx(den, lane, 16); den += shx(den, lane, 32);
#pragma unroll
            for (int dt = 0; dt < 4; ++dt)
#pragma unroll
                for (int rg = 0; rg < 4; ++rg) {
                    const int tl = (tq0 - t0) + d * (4 * gq + rg), idx = tl * 64 + 16 * dt + l15;
                    if (pi == 0) OACC[idx] = o[dt][rg]; else OACC[idx] += o[dt][rg];
                }
            if (gq == 0) { const int tl = (tq0 - t0) + d * l15; if (pi == 0) DEN[tl] = den; else DEN[tl] += den; }
        }
        __syncthreads();
    }
    for (int k = 0; k < 32; ++k) {
        const int idx = tid + 512 * k, tl = idx >> 6, dc = idx & 63;
        mixed[(size_t)(t0 + tl) * DM + 256 + h * 64 + dc] = f2bf(OACC[idx] / DEN[tl]);
    }
}

__device__ __forceinline__ void phase_mixers(const Ctx& a, int l, LAS unsigned char* lds) {
    unsigned* ctr = (unsigned*)(a.ws + WS_CTL) + 64 * l;
    lds = lds_l(lds);
    LAS int* sun = (LAS int*)(lds + LDS_UNIT_OFF);
    constexpr int N_LRU = 192, N_ATT = 1536, N_POOL = 1024;
    for (;;) {
        __syncthreads();
        if (tid_w(a.wv) == 0) *sun = (int)atomicAdd(ctr, 1u);
        __syncthreads();
        const int u = *sun;
        if (u >= N_LRU + N_ATT + N_POOL) break;
        if (u < N_LRU) lru_unit(a, l, u / 6, u % 6, lds);
        else if (u < N_LRU + N_ATT) { const int v = u - N_LRU; dattn_unit(a, v / 48, (v % 48) / 8, v % 8, lds); }
        else { const int v = u - N_LRU - N_ATT; pool_unit(a, l, v / 32, v % 32, lds); }
    }
}

__device__ __forceinline__ void phase_xattn(const Ctx& a, int l, LAS unsigned char* lds) {
    lds = lds_l(lds);
    const int tid = tid_w(a.wv), lane = tid & 63, wave = tid >> 6, l15 = lane & 15, gq = lane >> 4;
    LAS unsigned char* KL = lds;
    LAS unsigned char* VL = lds + 16896;
    LAS float* RK = (LAS float*)(lds + 34304);
    const bf16_t* qm = (const bf16_t*)(a.ws + WS_QM);
    const float* qst = (const float*)(a.ws + WS_QST);
    const bf16_t* kv = (const bf16_t*)(a.ws + WS_KV);
    const float* kst = (const float*)(a.ws + WS_KST);
    bf16_t* om = (bf16_t*)(a.ws + WS_MIXED);
    const int trq = (l15 >> 2), trp = (l15 & 3);
    for (int xu = blockIdx.x; xu < NBATCH * 4 * 16; xu += gridDim.x) {
        const int b = xu >> 6, h = (xu >> 4) & 3, qb = xu & 15;
        __syncthreads();
        if (tid < 256) {
            const f32x4* kp = (const f32x4*)(kst + (size_t)(b * 256 + tid) * 256 + l * 64 + h * 8);
            const f32x4 k0 = kp[0], k1 = kp[1];
            RK[tid] = rsqrtf((((k0[0] + k0[1]) + (k0[2] + k0[3])) + ((k1[0] + k1[1]) + (k1[2] + k1[3]))) * (1.0f / 256.0f) + EPSF);
        }
        const size_t qrow = (size_t)b * SEQ + qb * 128 + wave * 16 + l15;
        bf16x8 qf[8];
#pragma unroll
        for (int ks = 0; ks < 8; ++ks) qf[ks] = *(const bf16x8*)(qm + qrow * DM + h * 256 + 32 * ks + 8 * gq);
        float rq;
        { const f32x4* qp = (const f32x4*)(qst + qrow * 32 + h * 8); const f32x4 q0 = qp[0], q1 = qp[1];
          rq = rsqrtf((((q0[0] + q0[1]) + (q0[2] + q0[3])) + ((q1[0] + q1[1]) + (q1[2] + q1[3]))) * (1.0f / 256.0f) + EPSF); }
        f32x4 o[16];
#pragma unroll
        for (int dt = 0; dt < 16; ++dt) o[dt] = (f32x4){0.f, 0.f, 0.f, 0.f};
        float den = 0.f;
#pragma unroll 1
        for (int c = 0; c < 8; ++c) {
            __syncthreads();
#pragma unroll
            for (int k = 0; k < 2; ++k) {
                const int idx = tid + 512 * k, row = idx >> 5, chk = idx & 31;
                const bf16_t* src = kv + (size_t)(b * 256 + 32 * c + row) * 8192 + l * 2048 + h * 256 + chk * 8;
                const u32x4 kk = *(const u32x4*)src, vv = *(const u32x4*)(src + 1024);
                *(LAS u32x4*)(KL + row * 528 + chk * 16) = kk;
                *(LAS u32x4*)(VL + row * 544 + chk * 16) = vv;
            }
            __syncthreads();
            float p[2][4];
#pragma unroll
            for (int T = 0; T < 2; ++T) {
                f32x4 s = (f32x4){0.f, 0.f, 0.f, 0.f};
#pragma unroll
                for (int ks = 0; ks < 8; ++ks) {
                    const bf16x8 kf = *(LAS const bf16x8*)(KL + (16 * T + l15) * 528 + (32 * ks + 8 * gq) * 2);
                    s = __builtin_amdgcn_mfma_f32_16x16x32_bf16(kf, qf[ks], s, 0, 0, 0);
                }
                const f32x4 rk4 = *(LAS const f32x4*)(RK + 32 * c + 16 * T + 4 * gq);
#pragma unroll
                for (int rg = 0; rg < 4; ++rg) { const float pv = __builtin_amdgcn_exp2f(s[rg] * rq * rk4[rg]); p[T][rg] = pv; den += pv; }
            }
            u32x4 pw; pw.x = pkbf(p[0][0], p[0][1]); pw.y = pkbf(p[0][2], p[0][3]); pw.z = pkbf(p[1][0], p[1][1]); pw.w = pkbf(p[1][2], p[1][3]);
            const bf16x8 pfrag = __builtin_bit_cast(bf16x8, pw);
#pragma unroll
            for (int dt = 0; dt < 16; ++dt) {
                const s16x4 lo = vtr(VL + (4 * gq + trq) * 544 + (16 * dt + 4 * trp) * 2);
                const s16x4 hi = vtr(VL + (16 + 4 * gq + trq) * 544 + (16 * dt + 4 * trp) * 2);
                const bf16x8 vf = (bf16x8){lo[0], lo[1], lo[2], lo[3], hi[0], hi[1], hi[2], hi[3]};
                o[dt] = __builtin_amdgcn_mfma_f32_16x16x32_bf16(pfrag, vf, o[dt], 0, 0, 0);
            }
        }
        den += shx(den, lane, 16); den += shx(den, lane, 32);
        float inv[4];
#pragma unroll
        for (int rg = 0; rg < 4; ++rg) inv[rg] = 1.0f / shi(den, 4 * gq + rg);
        const size_t orow0 = (size_t)b * SEQ + qb * 128 + wave * 16 + 4 * gq;
#pragma unroll
        for (int dt = 0; dt < 16; ++dt)
#pragma unroll
            for (int rg = 0; rg < 4; ++rg) om[(orow0 + rg) * DM + h * 256 + 16 * dt + l15] = f2bf(o[dt][rg] * inv[rg]);
    }
}

__device__ __forceinline__ void phase_act(const Ctx& a, int l) {
    const bf16_t* gu = (const bf16_t*)(a.ws + WS_GU);
    bf16_t* act = (bf16_t*)(a.ws + WS_ACT);
    const float* cw = inptr(a, 25) + (size_t)l * 3 * DFF; const float* cb = inptr(a, 26) + (size_t)l * DFF;
    const int total = MHALF * (DFF / 8);
    for (int idx = blockIdx.x * NTHREADS + tid_w(a.wv); idx < total; idx += gridDim.x * NTHREADS) {
        const int row = idx / (DFF / 8), f0 = (idx % (DFF / 8)) * 8, tl = row & (SEQ - 1);
        const bf16_t* gp = gu + (size_t)row * DFF2 + f0;
        const u32x4 g0 = *(const u32x4*)gp;
        const u32x4 g1 = (tl >= 1) ? *(const u32x4*)(gp - DFF2) : (u32x4){0u, 0u, 0u, 0u};
        const u32x4 g2 = (tl >= 2) ? *(const u32x4*)(gp - 2 * DFF2) : (u32x4){0u, 0u, 0u, 0u};
        const u32x4 uu = *(const u32x4*)(gp + DFF);
        float r[8];
#pragma unroll
        for (int j = 0; j < 4; ++j) {
            const int f = f0 + 2 * j;
            const float c0 = cb[f] + cw[f] * bflo(g0[j]) + cw[DFF + f] * bflo(g1[j]) + cw[2 * DFF + f] * bflo(g2[j]);
            const float c1 = cb[f + 1] + cw[f + 1] * bfhi(g0[j]) + cw[DFF + f + 1] * bfhi(g1[j]) + cw[2 * DFF + f + 1] * bfhi(g2[j]);
            r[2 * j] = gelu_tanh(c0) * bflo(uu[j]); r[2 * j + 1] = gelu_tanh(c1) * bfhi(uu[j]);
        }
        u32x4 w; w.x = pkbf(r[0], r[1]); w.y = pkbf(r[2], r[3]); w.z = pkbf(r[4], r[5]); w.w = pkbf(r[6], r[7]);
        *(u32x4*)(act + (size_t)row * DFF + f0) = w;
    }
}

__global__ void __launch_bounds__(NTHREADS, 2) trunk_fwd(Args ka) {
    extern __shared__ __attribute__((aligned(16))) unsigned char lds_raw[];
    LAS unsigned char* lds = (LAS unsigned char*)lds_raw;
    cg::grid_group grid = cg::this_grid();
    {
        LAS unsigned long long* tw = (LAS unsigned long long*)(lds + LDS_TBL_OFF);
        if (threadIdx.x == 0) {
#pragma unroll
            for (int i = 0; i < 28; ++i) tw[i] = (unsigned long long)ka.in[i];
        }
        __syncthreads();
    }
    Ctx a; a.tbl = (LAS const unsigned long long*)(lds + LDS_TBL_OFF); a.out = ka.out; a.ws = ka.ws; a.wv = __builtin_amdgcn_readfirstlane((int)(threadIdx.x >> 6));
    unsigned char* ws = a.ws;
    bf16_t* hb = (bf16_t*)(ws + WS_HB);
    float* st = (float*)(ws + WS_ST);

    phase_prologue(a, lds);
    grid.sync();
    {
        EpiBf<false> E{(bf16_t*)(ws + WS_KV), 8192, (const float*)(ws + WS_STM), (float*)(ws + WS_KST), 256, nullptr, nullptr, nullptr};
        run_gemm(a.wv, lds, (const bf16_t*)(ws + WS_MEMB), (const bf16_t*)(ws + WS_WKV), MEMROWS, 8192, DM, E);
    }
    for (int l = 0; l < DEPTH; ++l) {
        const unsigned char* wl = ws + WS_W + (size_t)l * W_LAYER;
        {
            EpiBf<true> E{(bf16_t*)(ws + WS_PROJ), NPROJ, st, nullptr, 0, nullptr, inptr(a, 6) + l * 64, inptr(a, 7) + l * 64};
            run_gemm(a.wv, lds, hb, (const bf16_t*)(wl + W_IN), MTOK, NPROJ, DM, E);
        }
        grid.sync();
        phase_mixers(a, l, lds);
        grid.sync();
        {
            EpiRes E{l == 0 ? inptr(a, 0) : a.out, a.out, hb, st};
            run_gemm(a.wv, lds, (const bf16_t*)(ws + WS_MIXED), (const bf16_t*)(wl + W_OUT), MTOK, DM, DM, E);
        }
        grid.sync();
        {
            EpiBf<false> E{(bf16_t*)(ws + WS_QM), DM, st, (float*)(ws + WS_QST), 32, (const float*)(ws + WS_CS) + l * 1024, nullptr, nullptr};
            run_gemm(a.wv, lds, hb, (const bf16_t*)(wl + W_Q), MTOK, DM, DM, E);
        }
        grid.sync();
        phase_xattn(a, l, lds);
        grid.sync();
        {
            EpiRes E{a.out, a.out, hb, st};
            run_gemm(a.wv, lds, (const bf16_t*)(ws + WS_MIXED), (const bf16_t*)(wl + W_O), MTOK, DM, DM, E);
        }
        grid.sync();
        for (int hf = 0; hf < 2; ++hf) {
            {
                EpiBf<false> E{(bf16_t*)(ws + WS_GU), DFF2, st + (size_t)hf * MHALF * 16, nullptr, 0, nullptr, nullptr, nullptr};
                run_gemm(a.wv, lds, hb + (size_t)hf * MHALF * DM, (const bf16_t*)(wl + W_UP), MHALF, DFF2, DM, E);
            }
            grid.sync();
            phase_act(a, l);
            grid.sync();
            {
                float* oh = a.out + (size_t)hf * MHALF * DM;
                EpiRes E{oh, oh, hb + (size_t)hf * MHALF * DM, st + (size_t)hf * MHALF * 16};
                run_gemm(a.wv, lds, (const bf16_t*)(ws + WS_ACT), (const bf16_t*)(wl + W_DOWN), MHALF, DM, DFF, E);
            }
            grid.sync();
        }
    }
}

extern "C" void kernel_launch(void* const* d_in, const int* in_sizes, int n_in, void* d_out, int out_size, void* d_ws, size_t ws_size, hipStream_t stream) {
    static int grid = 0;
    if (grid == 0) {
        if (n_in != 28 || in_sizes[0] != MTOK * DM || out_size != MTOK * DM || ws_size < WS_END) {
            fprintf(stderr, "kernel_launch: unexpected shapes (n_in %d, in0 %d, out %d, ws %zu; need ws >= %zu); nothing launched\n", n_in, n_in > 0 ? in_sizes[0] : -1, out_size, ws_size, (size_t)WS_END);
            grid = -1; return;
        }
        int dev = 0, cus = 0, per_cu = 0;
        hipGetDevice(&dev);
        hipDeviceGetAttribute(&cus, hipDeviceAttributeMultiprocessorCount, dev);
        if (hipFuncSetAttribute((const void*)trunk_fwd, hipFuncAttributeMaxDynamicSharedMemorySize, LDS_BYTES) != hipSuccess) { fprintf(stderr, "kernel_launch: hipFuncSetAttribute failed\n"); grid = -1; return; }
        if (hipOccupancyMaxActiveBlocksPerMultiprocessor(&per_cu, (const void*)trunk_fwd, NTHREADS, LDS_BYTES) != hipSuccess || per_cu < 1) { fprintf(stderr, "kernel_launch: occupancy query says %d blocks per CU\n", per_cu); per_cu = 1; }
        (void)hipGetLastError();
        grid = cus;
    }
    if (grid < 0) return;
    (void)hipMemsetAsync((char*)d_ws + WS_CTL, 0, 4096, stream);
    Args a{};
    for (int i = 0; i < 28; ++i) a.in[i] = (const float*)d_in[i];
    a.out = (float*)d_out; a.ws = (unsigned char*)d_ws;
    void* args[] = {&a};
    hipError_t e = hipLaunchCooperativeKernel((const void*)trunk_fwd, dim3(grid), dim3(NTHREADS), args, LDS_BYTES, stream);
    if (e != hipSuccess) fprintf(stderr, "cooperative launch failed: %s (grid %d)\n", hipGetErrorString(e), grid);
}
```

```cpp
#include <hip/hip_runtime.h>
#include <hip/hip_cooperative_groups.h>
#include <cstdio>
#include <cstdint>
namespace cg = cooperative_groups;
namespace pg8 {
#define PG8_LAS __attribute__((address_space(3)))
typedef unsigned short bf16_t;
typedef short bf16x8 __attribute__((ext_vector_type(8)));
typedef float f32x4 __attribute__((ext_vector_type(4)));
typedef unsigned u32x4 __attribute__((ext_vector_type(4)));
constexpr int BM = 256, BK = 64, HALF = 128, HTB = HALF * BK * 2  , STAGE_BYTES = 8 * HTB, NXCD = 8, WGM = 8;

__host__ __device__ __forceinline__ int lds_byte(int r, int c) { const int st = (r >> 4) * 2 + (c >> 5), rr = r & 15, cc = c & 31, ob = rr * 64 + cc * 2; return st * 1024 + (ob ^ (((ob >> 9) & 1) << 5)); }
__host__ __device__ __forceinline__ void stage_rc(int b, int& R, int& C) { const int st = b / 1024, sb = b % 1024, swz = sb ^ (((sb >> 9) & 1) << 5); R = (st >> 1) * 16 + swz / 64; C = (st & 1) * 32 + (swz % 64) / 2; }
__host__ __device__ __forceinline__ int perm32(int rho) { const int n = rho >> 4, i = rho & 15; return 8 * (i >> 2) + 4 * n + (i & 3); }

struct Unit { int pm, pn; };
struct Gemm { const bf16_t* A; const bf16_t* Bt; int M, N, K; };

struct StaticOrder {
    int nM, nN, nwg, G, c;
    __host__ __device__ void init(int M, int N, int G_, int c_) { nM = M / BM; nN = N / BM; nwg = nM * nN; G = G_; c = c_; }
    __host__ __device__ bool next(int i, Unit& u) const {
        const long L = (long)i * G + c; if (L >= nwg) return false;
        int wgid = (int)L; { const int q = nwg / NXCD, r = nwg % NXCD, xcd = wgid % NXCD, off = wgid / NXCD; wgid = (xcd < r ? xcd * (q + 1) : r * (q + 1) + (xcd - r) * q) + off; }
        const int nig = WGM * nN, gid = wgid / nig, fm = gid * WGM, gsz = (nM - fm) < WGM ? (nM - fm) : WGM;
        u.pm = fm + ((wgid % nig) % gsz); u.pn = (wgid % nig) / gsz; return true;
    }
    __device__ __forceinline__ void a_ready(const Unit&) const {}
    __device__ __forceinline__ void done(const Unit&) const {}
};

__device__ __forceinline__ unsigned cvt_pk_bf16(float lo, float hi) { unsigned r; asm volatile("v_cvt_pk_bf16_f32 %0, %1, %2" : "=v"(r) : "v"(lo), "v"(hi)); return r; }
typedef float f32x2 __attribute__((ext_vector_type(2)));
template <class Epi, class Sched, bool ALIGN_EPI = false, bool SP2 = false>
__device__ __forceinline__ void gemm_phase(int tid_in, PG8_LAS unsigned char* lds, const Gemm g, const Sched& S, const Epi& E) {
    int tid_ = tid_in; asm volatile("" : "+v"(tid_));
    const int tid = tid_, wid = __builtin_amdgcn_readfirstlane(tid >> 6), lane = tid & 63, wr = wid >> 2, wc = wid & 3, fr = lane & 15, fq = lane >> 4;
    const int K = g.K, nt = K / BK;
    unsigned voffA[2], voffB[2];
#pragma unroll
    for (int i = 0; i < 2; ++i) { int R, C; stage_rc(tid * 16 + i * 8192, R, C); const int Rb = Epi::PERM ? ((R & ~31) + perm32(R & 31)) : R;
        voffA[i] = (unsigned)(R * K + C) * 2u; voffB[i] = (unsigned)(Rb * K + C) * 2u; }
    const size_t kstep = (size_t)(BK * 2);
    const size_t hstep = (size_t)HALF * K * 2;
    const size_t tstep = 2 * hstep;
    const unsigned ldsw = (unsigned)wid * 1024u;
    const int aoff = lds_byte(wr * 64 + fr, fq * 8), boff = lds_byte(wc * 32 + fr, fq * 8);
#define PG8_SA(b, h) (((b) * 2 + (h)) * HTB)
#define PG8_SB(b, h) ((4 + (b) * 2 + (h)) * HTB)
#define PG8_STAGE(bufoff, gbase, voff) do { _Pragma("unroll") for (int _i = 0; _i < 2; ++_i) \
        __builtin_amdgcn_global_load_lds((const unsigned*)((const char*)(gbase) + (voff)[_i]), (PG8_LAS unsigned*)(lds + (bufoff) + ldsw + _i * 8192), 16, 0, 0); } while (0)
#define PG8_LDA(dst, b, h) do { _Pragma("unroll") for (int m = 0; m < 4; ++m) _Pragma("unroll") for (int k = 0; k < 2; ++k) dst[m][k] = *(const PG8_LAS bf16x8*)(lds + PG8_SA(b, h) + aoff + m * 2048 + k * 1024); } while (0)
#define PG8_LDB(dst, b, h) do { _Pragma("unroll") for (int n = 0; n < 2; ++n) _Pragma("unroll") for (int k = 0; k < 2; ++k) dst[n][k] = *(const PG8_LAS bf16x8*)(lds + PG8_SB(b, h) + boff + n * 2048 + k * 1024); } while (0)
#define PG8_MMA(ai, bj, At, Bt) do { __builtin_amdgcn_s_setprio(1); _Pragma("unroll") for (int m = 0; m < 4; ++m) _Pragma("unroll") for (int n = 0; n < 2; ++n) _Pragma("unroll") for (int k = 0; k < 2; ++k) \
        acc[ai][bj][m][n] = __builtin_amdgcn_mfma_f32_16x16x32_bf16(Bt[n][k], At[m][k], acc[ai][bj][m][n], 0, 0, 0); __builtin_amdgcn_s_setprio(0); } while (0)
#define PG8_WAIT_V(n) asm volatile("s_waitcnt vmcnt(" #n ")" ::: "memory")
#define PG8_WAIT_L(n) asm volatile("s_waitcnt lgkmcnt(" #n ")" ::: "memory")
#define PG8_BAR __builtin_amdgcn_s_barrier()
#define PG8_SCHED __builtin_amdgcn_sched_barrier(0)
    Unit cur, nxt; int ui = 0;
    if (!S.next(0, cur)) return;
    f32x4 acc[2][2][4][2];
#pragma unroll
    for (int a = 0; a < 2; ++a)
#pragma unroll
        for (int b = 0; b < 2; ++b)
#pragma unroll
            for (int m = 0; m < 4; ++m)
#pragma unroll
                for (int n = 0; n < 2; ++n) acc[a][b][m][n] = (f32x4){0.f, 0.f, 0.f, 0.f};
    bf16x8 At[4][2], B0[2][2], B1[2][2];
    const char* cA = (const char*)g.A + (size_t)cur.pm * tstep; const char* cB = (const char*)g.Bt + (size_t)cur.pn * tstep;
    S.a_ready(cur);
    if constexpr (SP2) {
        PG8_STAGE(PG8_SB(0, 0), cB, voffB); PG8_STAGE(PG8_SB(0, 1), cB + hstep, voffB); PG8_STAGE(PG8_SA(0, 0), cA, voffA); PG8_STAGE(PG8_SA(0, 1), cA + hstep, voffA);
        if (wr == 1) PG8_BAR;
        PG8_WAIT_V(2); PG8_BAR;
        PG8_STAGE(PG8_SB(1, 0), cB + kstep, voffB); PG8_STAGE(PG8_SA(1, 0), cA + kstep, voffA); PG8_STAGE(PG8_SB(1, 1), cB + hstep + kstep, voffB);
        PG8_WAIT_V(6); PG8_BAR;
    } else {
        PG8_STAGE(PG8_SB(0, 0), cB, voffB); PG8_STAGE(PG8_SA(0, 0), cA, voffA); PG8_STAGE(PG8_SB(0, 1), cB + hstep, voffB); PG8_STAGE(PG8_SA(0, 1), cA + hstep, voffA);
        if (wr == 1) PG8_BAR;
        PG8_WAIT_V(4); PG8_BAR;
        PG8_STAGE(PG8_SB(1, 0), cB + kstep, voffB); PG8_STAGE(PG8_SA(1, 0), cA + kstep, voffA); PG8_STAGE(PG8_SB(1, 1), cB + hstep + kstep, voffB);
        PG8_WAIT_V(6); PG8_BAR;
    }
    for (;;) {
        const bool has_next = S.next(ui + 1, nxt);
        const char* nA = has_next ? (const char*)g.A + (size_t)nxt.pm * tstep : cA; const char* nB = has_next ? (const char*)g.Bt + (size_t)nxt.pn * tstep : cB;
        for (int t = 0; t < nt; t += 2) {
            const bool last = (t == nt - 2);
            const char* a1 = cA + (size_t)(t + 1) * kstep;
            const char* a2 = last ? nA : cA + (size_t)(t + 2) * kstep; const char* b2 = last ? nB : cB + (size_t)(t + 2) * kstep;
            const char* a3 = a2 + kstep; const char* b3 = b2 + kstep;
            if (last && has_next) S.a_ready(nxt);
            if constexpr (SP2) {
            PG8_LDB(B0, 0, 0); PG8_LDB(B1, 0, 1); PG8_SCHED; PG8_LDA(At, 0, 0); PG8_STAGE(PG8_SA(1, 1), a1 + hstep, voffA);
            PG8_WAIT_V(8); PG8_WAIT_L(0); PG8_BAR; PG8_MMA(0, 0, At, B0); PG8_MMA(0, 1, At, B1); PG8_BAR; PG8_SCHED;
            PG8_LDA(At, 0, 1); PG8_STAGE(PG8_SB(0, 0), b2, voffB); PG8_STAGE(PG8_SB(0, 1), b2 + hstep, voffB); PG8_STAGE(PG8_SA(0, 0), a2, voffA);
            PG8_WAIT_V(8); PG8_WAIT_L(0); PG8_BAR; PG8_MMA(1, 0, At, B0); PG8_MMA(1, 1, At, B1); PG8_BAR; PG8_SCHED;
            PG8_LDB(B0, 1, 0); PG8_LDB(B1, 1, 1); PG8_SCHED; PG8_LDA(At, 1, 0); PG8_STAGE(PG8_SA(0, 1), a2 + hstep, voffA);
            PG8_WAIT_V(8); PG8_WAIT_L(0); PG8_BAR; PG8_MMA(0, 0, At, B0); PG8_MMA(0, 1, At, B1); PG8_BAR; PG8_SCHED;
            PG8_LDA(At, 1, 1); PG8_STAGE(PG8_SB(1, 0), b3, voffB); PG8_STAGE(PG8_SB(1, 1), b3 + hstep, voffB); PG8_STAGE(PG8_SA(1, 0), a3, voffA);
            PG8_WAIT_V(8); PG8_WAIT_L(0); PG8_BAR; PG8_MMA(1, 0, At, B0); PG8_MMA(1, 1, At, B1); PG8_BAR; PG8_SCHED;
            } else {
            PG8_LDB(B0, 0, 0); PG8_SCHED; PG8_LDA(At, 0, 0); PG8_STAGE(PG8_SA(1, 1), a1 + hstep, voffA);
            PG8_WAIT_L(8); PG8_BAR; PG8_WAIT_L(0); PG8_MMA(0, 0, At, B0); PG8_BAR; PG8_SCHED;
            PG8_LDB(B1, 0, 1); PG8_STAGE(PG8_SB(0, 0), b2, voffB);
            PG8_BAR; PG8_WAIT_L(0); PG8_MMA(0, 1, At, B1); PG8_BAR;
            PG8_LDA(At, 0, 1); PG8_STAGE(PG8_SA(0, 0), a2, voffA);
            PG8_BAR; PG8_WAIT_L(0); PG8_MMA(1, 0, At, B0); PG8_BAR; PG8_SCHED;
            PG8_STAGE(PG8_SB(0, 1), b2 + hstep, voffB);
            PG8_WAIT_V(6); PG8_BAR; PG8_MMA(1, 1, At, B1); PG8_BAR;
            PG8_LDB(B0, 1, 0); PG8_SCHED; PG8_LDA(At, 1, 0); PG8_STAGE(PG8_SA(0, 1), a2 + hstep, voffA);
            PG8_WAIT_L(8); PG8_BAR; PG8_WAIT_L(0); PG8_MMA(0, 0, At, B0); PG8_BAR; PG8_SCHED;
            PG8_LDB(B1, 1, 1); PG8_STAGE(PG8_SB(1, 0), b3, voffB);
            PG8_BAR; PG8_WAIT_L(0); PG8_MMA(0, 1, At, B1); PG8_BAR;
            PG8_LDA(At, 1, 1); PG8_STAGE(PG8_SA(1, 0), a3, voffA);
            PG8_BAR; PG8_WAIT_L(0); PG8_MMA(1, 0, At, B0); PG8_BAR; PG8_SCHED;
            PG8_STAGE(PG8_SB(1, 1), b3 + hstep, voffB);
            PG8_WAIT_V(6); PG8_BAR; PG8_MMA(1, 1, At, B1); PG8_BAR;
            }
        }
        if constexpr (ALIGN_EPI) { if (wr == 0) PG8_BAR; }
        if constexpr (!Epi::AFTER_DRAIN) { E(acc, cur, wr, wc, fr, fq); S.done(cur); }
        if (!has_next) break;
#pragma unroll
        for (int a = 0; a < 2; ++a)
#pragma unroll
            for (int b = 0; b < 2; ++b)
#pragma unroll
                for (int m = 0; m < 4; ++m)
#pragma unroll
                    for (int n = 0; n < 2; ++n) acc[a][b][m][n] = (f32x4){0.f, 0.f, 0.f, 0.f};
        cur = nxt; cA = nA; cB = nB; ++ui;
        if constexpr (ALIGN_EPI) { if (wr == 1) PG8_BAR; }
    }
    PG8_WAIT_V(0);
    if constexpr (!ALIGN_EPI) { if (wr == 0) PG8_BAR; }
    PG8_BAR;
    if constexpr (Epi::AFTER_DRAIN) { E.fused(acc, cur, wr, wc, fr, fq, lds, wid, lane); S.done(cur); }
#undef PG8_SA
#undef PG8_SB
#undef PG8_STAGE
#undef PG8_LDA
#undef PG8_LDB
#undef PG8_MMA
#undef PG8_WAIT_V
#undef PG8_WAIT_L
#undef PG8_BAR
#undef PG8_SCHED
}
}

using pg8::bf16_t; using pg8::bf16x8; using pg8::f32x4; using pg8::u32x4;
typedef unsigned u32x2 __attribute__((ext_vector_type(2)));
typedef short s16x4 __attribute__((ext_vector_type(4)));
#define LAS __attribute__((address_space(3)))

constexpr int NTHREADS = 512;
constexpr int MTOK = 65536, DM = 1024, SEQ = 2048, NBATCH = 32, DEPTH = 4;
constexpr int NPROJ = 2304;
constexpr int INW = 2176;
constexpr int DFF = 2816, DFF2 = 5632;
constexpr int MEMROWS = 8192;
constexpr int MHALF = 32768;
constexpr float EPSF = 1e-6f;
constexpr float LOG2E = 1.4426950408889634f;
constexpr int LDS_BYTES = 155648;
constexpr int LDS_UNIT_OFF = 155648 - 64;
constexpr int LDS_TBL_OFF = 155648 - 512;

constexpr size_t MiB = 1u << 20;
constexpr size_t WS_CTL = 0;
constexpr size_t WS_ST = 1 * MiB;
constexpr size_t WS_STM = 5 * MiB;
constexpr size_t WS_CS = 5 * MiB + 512 * 1024;
constexpr size_t WS_KST = 6 * MiB;
constexpr size_t WS_QST = 14 * MiB;
constexpr size_t WS_MEMB = 22 * MiB;
constexpr size_t WS_W = 38 * MiB;
constexpr size_t W_LAYER = 27 * MiB;
constexpr size_t W_IN = 0, W_OUT = (size_t)(4.5 * MiB), W_Q = (size_t)(6.5 * MiB), W_O = (size_t)(8.5 * MiB), W_UP = (size_t)(10.5 * MiB), W_DOWN = (size_t)(21.5 * MiB);
constexpr size_t WS_WKV = WS_W + 4 * W_LAYER;
constexpr size_t WS_HB = 162 * MiB;
constexpr size_t WS_KV = 290 * MiB;
constexpr size_t WS_BIG = 418 * MiB;
constexpr size_t WS_PROJ = WS_BIG;
constexpr size_t WS_MIXED = WS_BIG + 288 * MiB;
constexpr size_t WS_QM = WS_MIXED + 128 * MiB;
constexpr size_t WS_GU = WS_BIG;
constexpr size_t WS_ACT = WS_BIG + 352 * MiB;
constexpr size_t WS_END = WS_QM + 128 * MiB;
static_assert(WS_WKV + 16 * MiB <= WS_HB, "ws map");
static_assert(WS_ACT + 176 * MiB <= WS_END, "ws map");

struct Args { const float* in[28]; float* out; unsigned char* ws; };
struct Ctx { LAS const unsigned long long* tbl; float* out; unsigned char* ws; int wv; };
__device__ __forceinline__ const float* inptr(const Ctx& c, int i) {
    const unsigned long long v = c.tbl[i];
    const unsigned lo = __builtin_amdgcn_readfirstlane((unsigned)v), hi = __builtin_amdgcn_readfirstlane((unsigned)(v >> 32));
    return (const float*)(((unsigned long long)hi << 32) | lo);
}

__device__ __forceinline__ float bf2f(unsigned short b) { return __uint_as_float(((unsigned)b) << 16); }
__device__ __forceinline__ float bflo(unsigned w) { return __uint_as_float(w << 16); }
__device__ __forceinline__ float bfhi(unsigned w) { return __uint_as_float(w & 0xffff0000u); }
__device__ __forceinline__ unsigned pkbf(float lo, float hi) { unsigned r; asm("v_cvt_pk_bf16_f32 %0, %1, %2" : "=v"(r) : "v"(lo), "v"(hi)); return r; }
__device__ __forceinline__ unsigned short f2bf(float f) { return (unsigned short)(pkbf(f, 0.f) & 0xffffu); }
__device__ __forceinline__ float shx(float v, int lane, int m) { return __int_as_float(__builtin_amdgcn_ds_bpermute((lane ^ m) << 2, __float_as_int(v))); }
__device__ __forceinline__ float shi(float v, int src) { return __int_as_float(__builtin_amdgcn_ds_bpermute(src << 2, __float_as_int(v))); }
__device__ __forceinline__ float wave_sum(float v, int lane) {
#pragma unroll
    for (int o = 1; o < 64; o <<= 1) v += shx(v, lane, o);
    return v;
}
__device__ __forceinline__ float sigmoidf_(float x) { return __builtin_amdgcn_rcpf(1.0f + __builtin_amdgcn_exp2f(-LOG2E * x)); }
__device__ __forceinline__ float gelu_tanh(float x) {
    const float u2 = (-2.0f * 0.7978845608028654f * LOG2E) * (x + 0.044715f * x * x * x);
    return x * __builtin_amdgcn_rcpf(1.0f + __builtin_amdgcn_exp2f(u2));
}
__device__ __forceinline__ LAS unsigned char* lds_l(LAS unsigned char* p) { unsigned v = (unsigned)(uintptr_t)p; asm volatile("" : "+s"(v)); return (LAS unsigned char*)(uintptr_t)v; }
__device__ __forceinline__ int tid_w(int wv) { int t = (wv << 6) + (int)__builtin_amdgcn_mbcnt_hi(~0u, __builtin_amdgcn_mbcnt_lo(~0u, 0u)); asm volatile("" : "+v"(t)); return t; }
__device__ __forceinline__ s16x4 vtr(LAS const unsigned char* p) {
    typedef short v4i16_t __attribute__((ext_vector_type(4)));
    return __builtin_bit_cast(s16x4, __builtin_amdgcn_ds_read_tr16_b64_v4i16((LAS v4i16_t*)p));
}

template <bool QKN> struct EpiBf {
    static constexpr bool PERM = true, AFTER_DRAIN = false;
    bf16_t* O; int ldc; const float* st; float* pst; int npg; const float* cs; const float* qg; const float* kg;
    __device__ __forceinline__ void operator()(const f32x4 (&acc)[2][2][4][2], const pg8::Unit& u, int wr, int wc, int fr, int fq) const {
        int kind = 0; const float* gsel = nullptr;
        if (QKN) { const int c0 = u.pn * 256 + 64 * wc; if (c0 >= 256 && c0 < 640) { kind = 1; gsel = qg; } else if (c0 >= 640 && c0 < 1024) { kind = 2; gsel = kg; } }
#pragma unroll
        for (int ai = 0; ai < 2; ++ai)
#pragma unroll
            for (int m = 0; m < 4; ++m) {
                const int r = u.pm * 256 + ai * 128 + wr * 64 + m * 16 + fr;
                const f32x4* sp = (const f32x4*)(st + (size_t)r * 16);
                const f32x4 s0 = sp[0], s1 = sp[1], s2 = sp[2], s3 = sp[3];
                const float ssum = ((s0[0] + s0[1]) + (s0[2] + s0[3])) + ((s1[0] + s1[1]) + (s1[2] + s1[3])) + ((s2[0] + s2[1]) + (s2[2] + s2[3])) + ((s3[0] + s3[1]) + (s3[2] + s3[3]));
                const float rs = rsqrtf(ssum * (1.0f / 1024.0f) + EPSF);
                f32x4 v[2][2];
#pragma unroll
                for (int bj = 0; bj < 2; ++bj)
#pragma unroll
                    for (int n = 0; n < 2; ++n) v[bj][n] = acc[ai][bj][m][n] * rs;
                if (QKN) {
                    if (kind != 0) {
                        float ss = 0.f;
#pragma unroll
                        for (int bj = 0; bj < 2; ++bj)
#pragma unroll
                            for (int n = 0; n < 2; ++n) ss += (v[bj][n][0] * v[bj][n][0] + v[bj][n][1] * v[bj][n][1]) + (v[bj][n][2] * v[bj][n][2] + v[bj][n][3] * v[bj][n][3]);
                        ss += shx(ss, fq * 16 + fr, 16); ss += shx(ss, fq * 16 + fr, 32);
                        float rn = rsqrtf(ss * (1.0f / 64.0f) + EPSF);
                        if (kind == 1) rn *= 0.125f * LOG2E;
#pragma unroll
                        for (int bj = 0; bj < 2; ++bj)
#pragma unroll
                            for (int n = 0; n < 2; ++n) { const f32x4 gv = *(const f32x4*)(gsel + 32 * bj + 8 * fq + 4 * n); v[bj][n] = v[bj][n] * rn * gv; }
                    }
                } else {
                    if (pst) {
#pragma unroll
                        for (int bj = 0; bj < 2; ++bj) {
                            float ss = (v[bj][0][0] * v[bj][0][0] + v[bj][0][1] * v[bj][0][1]) + (v[bj][0][2] * v[bj][0][2] + v[bj][0][3] * v[bj][0][3])
                                     + (v[bj][1][0] * v[bj][1][0] + v[bj][1][1] * v[bj][1][1]) + (v[bj][1][2] * v[bj][1][2] + v[bj][1][3] * v[bj][1][3]);
                            ss += shx(ss, fq * 16 + fr, 16); ss += shx(ss, fq * 16 + fr, 32);
                            if (fq == 0) pst[(size_t)r * npg + (u.pn * 8 + bj * 4 + wc)] = ss;
                        }
                    }
                    if (cs) {
#pragma unroll
                        for (int bj = 0; bj < 2; ++bj)
#pragma unroll
                            for (int n = 0; n < 2; ++n) { const f32x4 cv = *(const f32x4*)(cs + u.pn * 256 + bj * 128 + wc * 32 + 8 * fq + 4 * n); v[bj][n] = v[bj][n] * cv; }
                    }
                }
#pragma unroll
                for (int bj = 0; bj < 2; ++bj) {
                    const int col = QKN ? (u.pn * 256 + 64 * wc + 32 * bj + 8 * fq) : (u.pn * 256 + 128 * bj + 32 * wc + 8 * fq);
                    u32x4 w; w.x = pkbf(v[bj][0][0], v[bj][0][1]); w.y = pkbf(v[bj][0][2], v[bj][0][3]); w.z = pkbf(v[bj][1][0], v[bj][1][1]); w.w = pkbf(v[bj][1][2], v[bj][1][3]);
                    *(u32x4*)(O + (size_t)r * ldc + col) = w;
                }
                asm volatile("" ::: "memory");
            }
    }
};

struct EpiRes {
    static constexpr bool PERM = false, AFTER_DRAIN = false;
    const float* resid; float* out; bf16_t* hb; float* st;
    __device__ __forceinline__ void operator()(const f32x4 (&acc)[2][2][4][2], const pg8::Unit& u, int wr, int wc, int fr, int fq) const {
#pragma unroll
        for (int ai = 0; ai < 2; ++ai)
#pragma unroll
            for (int m = 0; m < 4; ++m) {
                const int r = u.pm * 256 + ai * 128 + wr * 64 + m * 16 + fr;
                float ss = 0.f;
#pragma unroll
                for (int bj = 0; bj < 2; ++bj)
#pragma unroll
                    for (int n = 0; n < 2; ++n) {
                        const size_t off = (size_t)r * DM + (u.pn * 256 + bj * 128 + wc * 32 + n * 16 + 4 * fq);
                        const f32x4 v = *(const f32x4*)(resid + off) + acc[ai][bj][m][n];
                        *(f32x4*)(out + off) = v;
                        u32x2 w; w.x = pkbf(v[0], v[1]); w.y = pkbf(v[2], v[3]);
                        *(u32x2*)(hb + off) = w;
                        ss += (v[0] * v[0] + v[1] * v[1]) + (v[2] * v[2] + v[3] * v[3]);
                    }
                ss += shx(ss, fq * 16 + fr, 16); ss += shx(ss, fq * 16 + fr, 32);
                if (fq == 0) st[(size_t)r * 16 + u.pn * 4 + wc] = ss;
                asm volatile("" ::: "memory");
            }
    }
};

template <class Epi>
__device__ __forceinline__ void run_gemm(int wv, LAS unsigned char* lds, const bf16_t* A, const bf16_t* Bt, int M, int N, int K, const Epi& E) {
    pg8::Gemm g{A, Bt, M, N, K}; pg8::StaticOrder S; S.init(M, N, (int)gridDim.x, (int)blockIdx.x);
    pg8::gemm_phase<Epi, pg8::StaticOrder, true, true>(tid_w(wv), lds_l(lds), g, S, E);
}

__device__ __forceinline__ void transpose_item(const float* W, int ldw, int K, const float* gain, bf16_t* WT, int dst_row0, bool zero, LAS float* scr, int k0, int n0, int lane) {
#pragma unroll 8
    for (int i = 0; i < 32; ++i) {
        const int kk = 2 * i + (lane >> 5);
        float v = 0.f;
        if (!zero) { v = W[(size_t)(k0 + kk) * ldw + n0 + (lane & 31)]; if (gain) v *= gain[k0 + kk]; }
        scr[kk * 33 + (lane & 31)] = v;
    }
    asm volatile("s_waitcnt lgkmcnt(0)" ::: "memory");
    const int c = lane & 7;
#pragma unroll
    for (int j = 0; j < 4; ++j) {
        const int n = (lane >> 3) + 8 * j; const LAS float* s = scr + (8 * c) * 33 + n;
        u32x4 o; o.x = pkbf(s[0 * 33], s[1 * 33]); o.y = pkbf(s[2 * 33], s[3 * 33]); o.z = pkbf(s[4 * 33], s[5 * 33]); o.w = pkbf(s[6 * 33], s[7 * 33]);
        *(u32x4*)(WT + (size_t)(dst_row0 + n) * K + k0 + 8 * c) = o;
    }
    asm volatile("s_waitcnt lgkmcnt(0)" ::: "memory");
}
__device__ __forceinline__ void row_to_bf16(const float* xrow, bf16_t* orow, float* strow, int lane) {
    const f32x4* xr = (const f32x4*)xrow + lane;
    f32x4 v[4]; float s = 0.f;
#pragma unroll
    for (int j = 0; j < 4; ++j) { v[j] = xr[64 * j]; s += (v[j][0] * v[j][0] + v[j][1] * v[j][1]) + (v[j][2] * v[j][2] + v[j][3] * v[j][3]); }
    s = wave_sum(s, lane);
    u32x2* o8 = (u32x2*)orow + lane;
#pragma unroll
    for (int j = 0; j < 4; ++j) { u32x2 w; w.x = pkbf(v[j][0], v[j][1]); w.y = pkbf(v[j][2], v[j][3]); o8[64 * j] = w; }
    if (lane < 16) strow[lane] = (lane == 0) ? s : 0.f;
}
__device__ __forceinline__ void phase_prologue(const Ctx& a, LAS unsigned char* lds) {
    lds = lds_l(lds);
    const int tid = tid_w(a.wv), lane = tid & 63, wave = tid >> 6;
    LAS float* scr = (LAS float*)(lds + wave * 16384);
    const int gw = blockIdx.x * 8 + wave, NGW = gridDim.x * 8;
    unsigned char* ws = a.ws;
    constexpr int I_IN = 16 * 72, I_SQ = 16 * 32, I_UP = 16 * 176, I_DN = 44 * 32, I_KV = 16 * 64;
    constexpr int I_LAYER = I_IN + 3 * I_SQ + I_UP + I_DN + I_KV;
    for (int it = gw; it < DEPTH * I_LAYER; it += NGW) {
        const int l = it / I_LAYER; int r = it % I_LAYER;
        bf16_t* wl = (bf16_t*)(ws + WS_W + (size_t)l * W_LAYER);
        if (r < I_IN) {
            const int kb = r / 72, nb = r % 72, n0 = nb * 32;
            const int dst = (n0 & ~255) + 128 * ((n0 >> 5) & 1) + 32 * ((n0 >> 6) & 3);
            transpose_item(inptr(a, 3) + (size_t)l * DM * INW, INW, DM, inptr(a, 2) + l * DM, (bf16_t*)((unsigned char*)wl + W_IN), dst, n0 >= INW, scr, kb * 64, n0, lane);
            continue;
        }
        r -= I_IN;
        if (r < I_SQ) { transpose_item(inptr(a, 15) + (size_t)l * DM * DM, DM, DM, nullptr, (bf16_t*)((unsigned char*)wl + W_OUT), (r % 32) * 32, false, scr, (r / 32) * 64, (r % 32) * 32, lane); continue; }
        r -= I_SQ;
        if (r < I_SQ) { transpose_item(inptr(a, 18) + (size_t)l * DM * DM, DM, DM, inptr(a, 16) + l * DM, (bf16_t*)((unsigned char*)wl + W_Q), (r % 32) * 32, false, scr, (r / 32) * 64, (r % 32) * 32, lane); continue; }
        r -= I_SQ;
        if (r < I_SQ) { transpose_item(inptr(a, 22) + (size_t)l * DM * DM, DM, DM, nullptr, (bf16_t*)((unsigned char*)wl + W_O), (r % 32) * 32, false, scr, (r / 32) * 64, (r % 32) * 32, lane); continue; }
        r -= I_SQ;
        if (r < I_UP) { transpose_item(inptr(a, 24) + (size_t)l * DM * DFF2, DFF2, DM, inptr(a, 23) + l * DM, (bf16_t*)((unsigned char*)wl + W_UP), (r % 176) * 32, false, scr, (r / 176) * 64, (r % 176) * 32, lane); continue; }
        r -= I_UP;
        if (r < I_DN) { transpose_item(inptr(a, 27) + (size_t)l * DFF * DM, DM, DFF, nullptr, (bf16_t*)((unsigned char*)wl + W_DOWN), (r % 32) * 32, false, scr, (r / 32) * 64, (r % 32) * 32, lane); continue; }
        r -= I_DN;
        transpose_item(inptr(a, 19) + (size_t)l * DM * 2048, 2048, DM, inptr(a, 17) + l * DM, (bf16_t*)(ws + WS_WKV), l * 2048 + (r % 64) * 32, false, scr, (r / 64) * 64, (r % 64) * 32, lane);
    }
    for (int i = blockIdx.x * NTHREADS + tid; i < DEPTH * DM; i += gridDim.x * NTHREADS) { const int l = i >> 10, dd = i & 255; ((float*)(ws + WS_CS))[i] = inptr(a, 20)[l * 256 + dd] * inptr(a, 21)[l * 256 + dd] * (0.0625f * LOG2E); }
    for (int m = gw; m < MTOK; m += NGW) row_to_bf16(inptr(a, 0) + (size_t)m * DM, (bf16_t*)(ws + WS_HB) + (size_t)m * DM, (float*)(ws + WS_ST) + (size_t)m * 16, lane);
    for (int m = gw; m < MEMROWS; m += NGW) row_to_bf16(inptr(a, 1) + (size_t)m * DM, (bf16_t*)(ws + WS_MEMB) + (size_t)m * DM, (float*)(ws + WS_STM) + (size_t)m * 16, lane);
}

__device__ __forceinline__ void lru_unit(const Ctx& a, int l, int b, int g, LAS unsigned char* lds) {
    lds = lds_l(lds);
    const int tid = tid_w(a.wv), lane = tid & 63, wave = tid >> 6, l15 = lane & 15, gq = lane >> 4;
    LAS unsigned char* XT = lds;
    LAS unsigned char* XCB = lds + 19008;
    LAS float* XCF = (LAS float*)(lds + 37440);
    LAS float* AA = (LAS float*)(lds + 70208);
    LAS float* BB = (LAS float*)(lds + 102976);
    LAS unsigned char* WT = lds + 135744;
    const bf16_t* proj = (const bf16_t*)(a.ws + WS_PROJ) + (size_t)b * SEQ * NPROJ;
    bf16_t* mixed = (bf16_t*)(a.ws + WS_MIXED) + (size_t)b * SEQ * DM;
    const float* wa = inptr(a, 10) + ((size_t)l * 6 + g) * 4096; const float* wx = inptr(a, 12) + ((size_t)l * 6 + g) * 4096;
    for (int k = 0; k < 16; ++k) {
        const int idx = tid + 512 * k, which = idx >> 12, cp = (idx >> 6) & 63, c = idx & 63;
        const float v = which ? wx[cp * 64 + c] : wa[cp * 64 + c];
        *(LAS unsigned short*)(WT + (which * 64 + c) * 144 + cp * 2) = f2bf(v);
    }
    const int cch = tid & 63, ch = g * 64 + cch;
    float cw[4];
#pragma unroll
    for (int j = 0; j < 4; ++j) cw[j] = inptr(a, 8)[((size_t)l * 4 + j) * 384 + ch];
    const float cb = inptr(a, 9)[l * 384 + ch];
    float gba[4], gbx[4], gsp[4];
#pragma unroll
    for (int nt = 0; nt < 4; ++nt) {
        const int c2 = l * 384 + g * 64 + 16 * nt + l15;
        gba[nt] = inptr(a, 11)[c2]; gbx[nt] = inptr(a, 13)[c2];
        const float z = -inptr(a, 14)[c2];
        gsp[nt] = (8.0f * LOG2E) * (fmaxf(z, 0.f) + log1pf(__expf(-fabsf(z))));
    }
    float hcar = 0.f;
    const bf16_t* xsrc = proj + 1408 + g * 64;
    const bf16_t* ysrc = proj + 1792 + g * 64;
    u32x4 xr[3];
#pragma unroll
    for (int k = 0; k < 3; ++k) {
        const int idx = tid + 512 * k, row = idx >> 3, cv = idx & 7, tok = row - 3;
        xr[k] = (idx < 1048 && tok >= 0) ? *(const u32x4*)(xsrc + (size_t)tok * NPROJ + cv * 8) : (u32x4){0u, 0u, 0u, 0u};
    }
#pragma unroll 1
    for (int ck = 0; ck < 16; ++ck) {
        const int t0 = ck * 128;
#pragma unroll
        for (int k = 0; k < 3; ++k) { const int idx = tid + 512 * k, row = idx >> 3, cv = idx & 7; if (idx < 1048) *(LAS u32x4*)(XT + row * 144 + cv * 16) = xr[k]; }
        u32x4 yr[2];
#pragma unroll
        for (int k = 0; k < 2; ++k) { const int idx = tid + 512 * k, row = idx >> 3, cv = idx & 7; yr[k] = *(const u32x4*)(ysrc + (size_t)(t0 + row) * NPROJ + cv * 8); }
        if (ck < 15) {
#pragma unroll
            for (int k = 0; k < 3; ++k) {
                const int idx = tid + 512 * k, row = idx >> 3, cv = idx & 7, tok = t0 + 128 - 3 + row;
                xr[k] = (idx < 1048) ? *(const u32x4*)(xsrc + (size_t)tok * NPROJ + cv * 8) : (u32x4){0u, 0u, 0u, 0u};
            }
        }
        __syncthreads();
#pragma unroll 4
        for (int k = 0; k < 16; ++k) {
            const int t = (tid >> 6) + 8 * k;
            float xc = cb;
#pragma unroll
            for (int j = 0; j < 4; ++j) xc += cw[j] * bf2f(*(LAS const unsigned short*)(XT + (t + 3 - j) * 144 + cch * 2));
            XCF[t * 64 + cch] = xc;
            *(LAS unsigned short*)(XCB + t * 144 + cch * 2) = f2bf(xc);
        }
        __syncthreads();
        {
            f32x4 acc[8];
#pragma unroll
            for (int nt = 0; nt < 8; ++nt) acc[nt] = (f32x4){0.f, 0.f, 0.f, 0.f};
#pragma unroll
            for (int ks = 0; ks < 2; ++ks) {
                const bf16x8 af = *(LAS const bf16x8*)(XCB + (16 * wave + l15) * 144 + (32 * ks + 8 * gq) * 2);
#pragma unroll
                for (int nt = 0; nt < 8; ++nt) {
                    const bf16x8 bfr = *(LAS const bf16x8*)(WT + (16 * nt + l15) * 144 + (32 * ks + 8 * gq) * 2);
                    acc[nt] = __builtin_amdgcn_mfma_f32_16x16x32_bf16(af, bfr, acc[nt], 0, 0, 0);
                }
            }
#pragma unroll
            for (int nt = 0; nt < 4; ++nt)
#pragma unroll
                for (int rg = 0; rg < 4; ++rg) {
                    const int t = 16 * wave + 4 * gq + rg, c = 16 * nt + l15;
                    const float r = sigmoidf_(acc[nt][rg] + gba[nt]), ig = sigmoidf_(acc[nt + 4][rg] + gbx[nt]);
                    const float av = __builtin_amdgcn_exp2f(-r * gsp[nt]);
                    const float xcv = XCF[t * 64 + c];
                    AA[t * 64 + c] = av;
                    BB[t * 64 + c] = __builtin_amdgcn_sqrtf(fmaxf(1.0f - av * av, 0.f)) * (ig * xcv);
                }
        }
        __syncthreads();
        if (wave == 0) {
#pragma unroll 16
            for (int t = 0; t < 128; ++t) { hcar = AA[t * 64 + lane] * hcar + BB[t * 64 + lane]; BB[t * 64 + lane] = hcar; }
        }
        __syncthreads();
#pragma unroll
        for (int k = 0; k < 2; ++k) {
            const int idx = tid + 512 * k, row = idx >> 3, cv = idx & 7;
            const f32x4 h0 = *(LAS const f32x4*)(BB + row * 64 + cv * 8), h1 = *(LAS const f32x4*)(BB + row * 64 + cv * 8 + 4);
            u32x4 w;
            w.x = pkbf(h0[0] * gelu_tanh(bflo(yr[k].x)), h0[1] * gelu_tanh(bfhi(yr[k].x)));
            w.y = pkbf(h0[2] * gelu_tanh(bflo(yr[k].y)), h0[3] * gelu_tanh(bfhi(yr[k].y)));
            w.z = pkbf(h1[0] * gelu_tanh(bflo(yr[k].z)), h1[1] * gelu_tanh(bfhi(yr[k].z)));
            w.w = pkbf(h1[2] * gelu_tanh(bflo(yr[k].w)), h1[3] * gelu_tanh(bfhi(yr[k].w)));
            *(u32x4*)(mixed + (size_t)(t0 + row) * DM + 640 + g * 64 + cv * 8) = w;
        }
    }
}

__device__ __forceinline__ void pool_unit(const Ctx& a, int l, int b, int tc, LAS unsigned char* lds) {
    lds = lds_l(lds);
    const int tid = tid_w(a.wv);
    LAS float* U = (LAS float*)lds;
    LAS float* P = (LAS float*)(lds + 80896);
    const int t0 = tc * 64;
    const bf16_t* proj = (const bf16_t*)(a.ws + WS_PROJ) + (size_t)b * SEQ * NPROJ;
    bf16_t* mixed = (bf16_t*)(a.ws + WS_MIXED) + (size_t)b * SEQ * DM;
    for (int k = 0; k < 40; ++k) {
        const int idx = tid + 512 * k;
        if (idx < 79 * 256) { const int tt = idx >> 8, c = idx & 255, t = t0 - 15 + tt; U[idx] = (t >= 0) ? bf2f(proj[(size_t)t * NPROJ + c]) : 0.f; }
    }
    __syncthreads();
    {
        const int c = tid & 255, half = tid >> 8, g = c >> 6, w = 2 << g;
        for (int q = 0; q < 32; ++q) {
            const int tt = half * 32 + q, t = t0 + tt;
            float s = 0.f;
            for (int j = 0; j < w; ++j) s += U[(tt + 15 - j) * 256 + c];
            const float cnt = (float)((t + 1 < w) ? (t + 1) : w);
            P[tt * 256 + c] = s / cnt - U[(tt + 15) * 256 + c];
        }
    }
    __syncthreads();
    {
        const int dcol = tid & 255, half = tid >> 8, g = dcol >> 6, dc = dcol & 63;
        const float* pw = inptr(a, 4) + ((size_t)l * 4 + g) * 4096 + dc;
        float w[64];
#pragma unroll
        for (int c = 0; c < 64; ++c) w[c] = pw[c * 64];
        const float sc = inptr(a, 5)[l * 256 + dcol];
        for (int q = 0; q < 32; ++q) {
            const int tt = half * 32 + q;
            const LAS f32x4* pr = (const LAS f32x4*)(P + tt * 256 + g * 64);
            float acc = 0.f;
#pragma unroll
            for (int c4 = 0; c4 < 16; ++c4) { const f32x4 pv = pr[c4]; acc += pv[0] * w[4 * c4] + pv[1] * w[4 * c4 + 1] + pv[2] * w[4 * c4 + 2] + pv[3] * w[4 * c4 + 3]; }
            mixed[(size_t)(t0 + tt) * DM + dcol] = f2bf(acc * sc);
        }
    }
}

__device__ __forceinline__ void dattn_unit(const Ctx& a, int b, int h, int tb, LAS unsigned char* lds) {
    lds = lds_l(lds);
    const int tid = tid_w(a.wv), lane = tid & 63, wave = tid >> 6, l15 = lane & 15, gq = lane >> 4;
    LAS float* OACC = (LAS float*)lds;
    LAS float* DEN = (LAS float*)(lds + 65536);
    LAS unsigned char* vst = lds + 66560 + wave * 4608;
    const int t0 = tb * 256;
    const bf16_t* projb = (const bf16_t*)(a.ws + WS_PROJ) + (size_t)b * SEQ * NPROJ;
    bf16_t* mixed = (bf16_t*)(a.ws + WS_MIXED) + (size_t)b * SEQ * DM;
    const float slope2 = exp2f(-8.0f * (float)(h + 1) / 6.0f) * LOG2E;
    const int trq = (l15 >> 2), trp = (l15 & 3);
#pragma unroll 1
    for (int pi = 0; pi < 3; ++pi) {
        const int d = 1 << (2 * pi);
        const float sl = slope2 * (float)d;
#pragma unroll 1
        for (int ii = 0; ii < 2; ++ii) {
            const int it = 2 * wave + ii, rr = it % d, jj = it / d, tq0 = t0 + rr + 16 * d * jj;
            const unsigned char* pbytes = (const unsigned char*)projb;
            const unsigned qoff = (unsigned)(tq0 + d * l15) * (unsigned)(NPROJ * 2) + (unsigned)((256 + h * 64 + 8 * gq) * 2);
            const bf16x8 qf0 = *(const bf16x8*)(pbytes + qoff), qf1 = *(const bf16x8*)(pbytes + qoff + 64);
            bf16x8 kf[6][2];
#define DATTN_KLOAD(KT) do { if ((KT) < 9) { int tk = tq0 + d * (16 * ((KT) - 8) + l15); tk = tk < 0 ? 0 : tk; \
                const unsigned koff = (unsigned)tk * (unsigned)(NPROJ * 2) + (unsigned)((640 + h * 64 + 8 * gq) * 2); \
                kf[(KT) % 6][0] = *(const bf16x8*)(pbytes + koff); kf[(KT) % 6][1] = *(const bf16x8*)(pbytes + koff + 64); } } while (0)
            DATTN_KLOAD(0); DATTN_KLOAD(1); DATTN_KLOAD(2); DATTN_KLOAD(3); DATTN_KLOAD(4); DATTN_KLOAD(5);
            u32x4 vreg[2][4];
#define DATTN_VLOAD(PP) do { _Pragma("unroll") for (int ps = 0; ps < 4; ++ps) { \
                    const int idx = ps * 64 + lane, row = idx >> 3, chk = idx & 7, kt = 2 * (PP) + (row >> 4); \
                    int tk = tq0 + d * (16 * (kt - 8) + (row & 15)); tk = tk < 0 ? 0 : (tk > SEQ - 1 ? SEQ - 1 : tk); \
                    vreg[(PP) % 2][ps] = *(const u32x4*)(pbytes + ((unsigned)tk * (unsigned)(NPROJ * 2) + (unsigned)((1024 + h * 64 + chk * 8) * 2))); } } while (0)
            DATTN_VLOAD(0); DATTN_VLOAD(1);
            f32x4 o[4];
#pragma unroll
            for (int dt = 0; dt < 4; ++dt) o[dt] = (f32x4){0.f, 0.f, 0.f, 0.f};
            float den = 0.f;
            int dbase = l15 + 128 - 4 * gq; asm volatile("" : "+v"(dbase));
            float fbase = (float)dbase; asm volatile("" : "+v"(fbase));
#pragma unroll
            for (int pp = 0; pp < 5; ++pp) {
#pragma unroll
                for (int ps = 0; ps < 4; ++ps) { const int idx = ps * 64 + lane, row = idx >> 3, chk = idx & 7; *(LAS u32x4*)(vst + row * 144 + chk * 16) = vreg[pp % 2][ps]; }
                if (pp + 2 < 5) { asm volatile("" ::: "memory"); DATTN_VLOAD(pp + 2); }
                const bool skip = (tq0 + d * (16 * (2 * pp + 1 - 8) + 15) < 0);
                f32x4 sacc[2];
#pragma unroll
                for (int T = 0; T < 2; ++T) {
                    const int kt = 2 * pp + T;
                    sacc[T] = (f32x4){0.f, 0.f, 0.f, 0.f};
                    if (kt < 9 && !skip) {
                        sacc[T] = __builtin_amdgcn_mfma_f32_16x16x32_bf16(kf[kt % 6][0], qf0, sacc[T], 0, 0, 0);
                        sacc[T] = __builtin_amdgcn_mfma_f32_16x16x32_bf16(kf[kt % 6][1], qf1, sacc[T], 0, 0, 0);
                    }
                }
                if (pp + 3 < 5) { asm volatile("" ::: "memory"); DATTN_KLOAD(2 * pp + 6); DATTN_KLOAD(2 * pp + 7); }
                if (skip) continue;
                float p[2][4];
#pragma unroll
                for (int T = 0; T < 2; ++T) {
                    const int kt = 2 * pp + T;
#pragma unroll
                    for (int rg = 0; rg < 4; ++rg) {
                        const int dist = dbase - (16 * kt + rg);
                        const int tkk = tq0 + d * (l15 - dist);
                        const bool valid = (kt < 9) && (dist >= 0) && (dist <= 128) && (tkk >= 0);
                        const float pv = valid ? __builtin_amdgcn_exp2f(sacc[T][rg] - sl * (fbase - (float)(16 * kt + rg))) : 0.f;
                        p[T][rg] = pv; den += pv;
                    }
                }
                u32x4 pw; pw.x = pkbf(p[0][0], p[0][1]); pw.y = pkbf(p[0][2], p[0][3]); pw.z = pkbf(p[1][0], p[1][1]); pw.w = pkbf(p[1][2], p[1][3]);
                const bf16x8 pfrag = __builtin_bit_cast(bf16x8, pw);
#pragma unroll
                for (int dt = 0; dt < 4; ++dt) {
                    const s16x4 lo = vtr(vst + (4 * gq + trq) * 144 + (16 * dt + 4 * trp) * 2);
                    const s16x4 hi = vtr(vst + (16 + 4 * gq + trq) * 144 + (16 * dt + 4 * trp) * 2);
                    const bf16x8 vf = (bf16x8){lo[0], lo[1], lo[2], lo[3], hi[0], hi[1], hi[2], hi[3]};
                    o[dt] = __builtin_amdgcn_mfma_f32_16x16x32_bf16(pfrag, vf, o[dt], 0, 0, 0);
                }
            }
            den += shx(den, lane, 16); den += shx(den, lane, 32);
#pragma unroll
            for (int dt = 0; dt < 4; ++dt)
#pragma unroll
                for (int rg = 0; rg < 4; ++rg) {
                    const int tl = (tq0 - t0) + d * (4 * gq + rg), idx = tl * 64 + 16 * dt + l15;
                    if (pi == 0) OACC[idx] = o[dt][rg]; else OACC[idx] += o[dt][rg];
                }
            if (gq == 0) { const int tl = (tq0 - t0) + d * l15; if (pi == 0) DEN[tl] = den; else DEN[tl] += den; }
        }
        __syncthreads();
    }
    for (int k = 0; k < 32; ++k) {
        const int idx = tid + 512 * k, tl = idx >> 6, dc = idx & 63;
        mixed[(size_t)(t0 + tl) * DM + 256 + h * 64 + dc] = f2bf(OACC[idx] * __builtin_amdgcn_rcpf(DEN[tl]));
    }
}

__device__ __forceinline__ void phase_mixers(const Ctx& a, int l, LAS unsigned char* lds) {
    unsigned* ctr = (unsigned*)(a.ws + WS_CTL) + 64 * l;
    lds = lds_l(lds);
    LAS int* sun = (LAS int*)(lds + LDS_UNIT_OFF);
    constexpr int N_LRU = 192, N_ATT = 1536, N_POOL = 1024;
    for (;;) {
        __syncthreads();
        if (tid_w(a.wv) == 0) *sun = (int)atomicAdd(ctr, 1u);
        __syncthreads();
        const int u = *sun;
        if (u >= N_LRU + N_ATT + N_POOL) break;
        if (u < N_LRU) lru_unit(a, l, u / 6, u % 6, lds);
        else if (u < N_LRU + N_ATT) { const int v = u - N_LRU; dattn_unit(a, v / 48, (v % 48) / 8, v % 8, lds); }
        else { const int v = u - N_LRU - N_ATT; pool_unit(a, l, v / 32, v % 32, lds); }
    }
}

__device__ __forceinline__ void phase_xattn(const Ctx& a, int l, LAS unsigned char* lds) {
    lds = lds_l(lds);
    const int tid = tid_w(a.wv), lane = tid & 63, wave = tid >> 6, l15 = lane & 15, gq = lane >> 4;
    LAS unsigned char* KL = lds;
    LAS unsigned char* VL = lds + 16896;
    LAS float* RK = (LAS float*)(lds + 34304);
    const bf16_t* qm = (const bf16_t*)(a.ws + WS_QM);
    const float* qst = (const float*)(a.ws + WS_QST);
    const bf16_t* kv = (const bf16_t*)(a.ws + WS_KV);
    const float* kst = (const float*)(a.ws + WS_KST);
    bf16_t* om = (bf16_t*)(a.ws + WS_MIXED);
    const int trq = (l15 >> 2), trp = (l15 & 3);
    for (int xu = blockIdx.x; xu < NBATCH * 4 * 16; xu += gridDim.x) {
        const int b = xu >> 6, h = (xu >> 4) & 3, qb = xu & 15;
        __syncthreads();
        if (tid < 256) {
            const f32x4* kp = (const f32x4*)(kst + (size_t)(b * 256 + tid) * 256 + l * 64 + h * 8);
            const f32x4 k0 = kp[0], k1 = kp[1];
            RK[tid] = rsqrtf((((k0[0] + k0[1]) + (k0[2] + k0[3])) + ((k1[0] + k1[1]) + (k1[2] + k1[3]))) * (1.0f / 256.0f) + EPSF);
        }
        const size_t qrow = (size_t)b * SEQ + qb * 128 + wave * 16 + l15;
        bf16x8 qf[8];
#pragma unroll
        for (int ks = 0; ks < 8; ++ks) qf[ks] = *(const bf16x8*)(qm + qrow * DM + h * 256 + 32 * ks + 8 * gq);
        float rq;
        { const f32x4* qp = (const f32x4*)(qst + qrow * 32 + h * 8); const f32x4 q0 = qp[0], q1 = qp[1];
          rq = rsqrtf((((q0[0] + q0[1]) + (q0[2] + q0[3])) + ((q1[0] + q1[1]) + (q1[2] + q1[3]))) * (1.0f / 256.0f) + EPSF); }
        f32x4 o[16];
#pragma unroll
        for (int dt = 0; dt < 16; ++dt) o[dt] = (f32x4){0.f, 0.f, 0.f, 0.f};
        float den = 0.f;
#pragma unroll 1
        for (int c = 0; c < 8; ++c) {
            __syncthreads();
#pragma unroll
            for (int k = 0; k < 2; ++k) {
                const int idx = tid + 512 * k, row = idx >> 5, chk = idx & 31;
                const bf16_t* src = kv + (size_t)(b * 256 + 32 * c + row) * 8192 + l * 2048 + h * 256 + chk * 8;
                const u32x4 kk = *(const u32x4*)src, vv = *(const u32x4*)(src + 1024);
                *(LAS u32x4*)(KL + row * 528 + chk * 16) = kk;
                *(LAS u32x4*)(VL + row * 544 + chk * 16) = vv;
            }
            __syncthreads();
            float p[2][4];
#pragma unroll
            for (int T = 0; T < 2; ++T) {
                f32x4 s = (f32x4){0.f, 0.f, 0.f, 0.f};
#pragma unroll
                for (int ks = 0; ks < 8; ++ks) {
                    const bf16x8 kf = *(LAS const bf16x8*)(KL + (16 * T + l15) * 528 + (32 * ks + 8 * gq) * 2);
                    s = __builtin_amdgcn_mfma_f32_16x16x32_bf16(kf, qf[ks], s, 0, 0, 0);
                }
                const f32x4 rk4 = *(LAS const f32x4*)(RK + 32 * c + 16 * T + 4 * gq);
#pragma unroll
                for (int rg = 0; rg < 4; ++rg) { const float pv = __builtin_amdgcn_exp2f(s[rg] * rq * rk4[rg]); p[T][rg] = pv; den += pv; }
            }
            u32x4 pw; pw.x = pkbf(p[0][0], p[0][1]); pw.y = pkbf(p[0][2], p[0][3]); pw.z = pkbf(p[1][0], p[1][1]); pw.w = pkbf(p[1][2], p[1][3]);
            const bf16x8 pfrag = __builtin_bit_cast(bf16x8, pw);
#pragma unroll
            for (int dt = 0; dt < 16; ++dt) {
                const s16x4 lo = vtr(VL + (4 * gq + trq) * 544 + (16 * dt + 4 * trp) * 2);
                const s16x4 hi = vtr(VL + (16 + 4 * gq + trq) * 544 + (16 * dt + 4 * trp) * 2);
                const bf16x8 vf = (bf16x8){lo[0], lo[1], lo[2], lo[3], hi[0], hi[1], hi[2], hi[3]};
                o[dt] = __builtin_amdgcn_mfma_f32_16x16x32_bf16(pfrag, vf, o[dt], 0, 0, 0);
            }
        }
        den += shx(den, lane, 16); den += shx(den, lane, 32);
        float inv[4];
#pragma unroll
        for (int rg = 0; rg < 4; ++rg) inv[rg] = 1.0f / shi(den, 4 * gq + rg);
        const size_t orow0 = (size_t)b * SEQ + qb * 128 + wave * 16 + 4 * gq;
#pragma unroll
        for (int dt = 0; dt < 16; ++dt)
#pragma unroll
            for (int rg = 0; rg < 4; ++rg) om[(orow0 + rg) * DM + h * 256 + 16 * dt + l15] = f2bf(o[dt][rg] * inv[rg]);
    }
}

__device__ __forceinline__ void phase_act(const Ctx& a, int l) {
    const bf16_t* gu = (const bf16_t*)(a.ws + WS_GU);
    bf16_t* act = (bf16_t*)(a.ws + WS_ACT);
    const float* cw = inptr(a, 25) + (size_t)l * 3 * DFF; const float* cb = inptr(a, 26) + (size_t)l * DFF;
    const int total = MHALF * (DFF / 8);
    for (int idx = blockIdx.x * NTHREADS + tid_w(a.wv); idx < total; idx += gridDim.x * NTHREADS) {
        const int row = idx / (DFF / 8), f0 = (idx % (DFF / 8)) * 8, tl = row & (SEQ - 1);
        const bf16_t* gp = gu + (size_t)row * DFF2 + f0;
        const u32x4 g0 = *(const u32x4*)gp;
        const u32x4 g1 = (tl >= 1) ? *(const u32x4*)(gp - DFF2) : (u32x4){0u, 0u, 0u, 0u};
        const u32x4 g2 = (tl >= 2) ? *(const u32x4*)(gp - 2 * DFF2) : (u32x4){0u, 0u, 0u, 0u};
        const u32x4 uu = *(const u32x4*)(gp + DFF);
        float r[8];
#pragma unroll
        for (int j = 0; j < 4; ++j) {
            const int f = f0 + 2 * j;
            const float c0 = cb[f] + cw[f] * bflo(g0[j]) + cw[DFF + f] * bflo(g1[j]) + cw[2 * DFF + f] * bflo(g2[j]);
            const float c1 = cb[f + 1] + cw[f + 1] * bfhi(g0[j]) + cw[DFF + f + 1] * bfhi(g1[j]) + cw[2 * DFF + f + 1] * bfhi(g2[j]);
            r[2 * j] = gelu_tanh(c0) * bflo(uu[j]); r[2 * j + 1] = gelu_tanh(c1) * bfhi(uu[j]);
        }
        u32x4 w; w.x = pkbf(r[0], r[1]); w.y = pkbf(r[2], r[3]); w.z = pkbf(r[4], r[5]); w.w = pkbf(r[6], r[7]);
        *(u32x4*)(act + (size_t)row * DFF + f0) = w;
    }
}

__global__ void __launch_bounds__(NTHREADS, 2) trunk_fwd(Args ka) {
    extern __shared__ __attribute__((aligned(16))) unsigned char lds_raw[];
    LAS unsigned char* lds = (LAS unsigned char*)lds_raw;
    cg::grid_group grid = cg::this_grid();
    {
        LAS unsigned long long* tw = (LAS unsigned long long*)(lds + LDS_TBL_OFF);
        if (threadIdx.x == 0) {
#pragma unroll
            for (int i = 0; i < 28; ++i) tw[i] = (unsigned long long)ka.in[i];
        }
        __syncthreads();
    }
    Ctx a; a.tbl = (LAS const unsigned long long*)(lds + LDS_TBL_OFF); a.out = ka.out; a.ws = ka.ws; a.wv = __builtin_amdgcn_readfirstlane((int)(threadIdx.x >> 6));
    unsigned char* ws = a.ws;
    bf16_t* hb = (bf16_t*)(ws + WS_HB);
    float* st = (float*)(ws + WS_ST);

    phase_prologue(a, lds);
    grid.sync();
    {
        EpiBf<false> E{(bf16_t*)(ws + WS_KV), 8192, (const float*)(ws + WS_STM), (float*)(ws + WS_KST), 256, nullptr, nullptr, nullptr};
        run_gemm(a.wv, lds, (const bf16_t*)(ws + WS_MEMB), (const bf16_t*)(ws + WS_WKV), MEMROWS, 8192, DM, E);
    }
    for (int l = 0; l < DEPTH; ++l) {
        const unsigned char* wl = ws + WS_W + (size_t)l * W_LAYER;
        {
            EpiBf<true> E{(bf16_t*)(ws + WS_PROJ), NPROJ, st, nullptr, 0, nullptr, inptr(a, 6) + l * 64, inptr(a, 7) + l * 64};
            run_gemm(a.wv, lds, hb, (const bf16_t*)(wl + W_IN), MTOK, NPROJ, DM, E);
        }
        grid.sync();
        phase_mixers(a, l, lds);
        grid.sync();
        {
            EpiRes E{l == 0 ? inptr(a, 0) : a.out, a.out, hb, st};
            run_gemm(a.wv, lds, (const bf16_t*)(ws + WS_MIXED), (const bf16_t*)(wl + W_OUT), MTOK, DM, DM, E);
        }
        grid.sync();
        {
            EpiBf<false> E{(bf16_t*)(ws + WS_QM), DM, st, (float*)(ws + WS_QST), 32, (const float*)(ws + WS_CS) + l * 1024, nullptr, nullptr};
            run_gemm(a.wv, lds, hb, (const bf16_t*)(wl + W_Q), MTOK, DM, DM, E);
        }
        grid.sync();
        phase_xattn(a, l, lds);
        grid.sync();
        {
            EpiRes E{a.out, a.out, hb, st};
            run_gemm(a.wv, lds, (const bf16_t*)(ws + WS_MIXED), (const bf16_t*)(wl + W_O), MTOK, DM, DM, E);
        }
        grid.sync();
        for (int hf = 0; hf < 2; ++hf) {
            {
                EpiBf<false> E{(bf16_t*)(ws + WS_GU), DFF2, st + (size_t)hf * MHALF * 16, nullptr, 0, nullptr, nullptr, nullptr};
                run_gemm(a.wv, lds, hb + (size_t)hf * MHALF * DM, (const bf16_t*)(wl + W_UP), MHALF, DFF2, DM, E);
            }
            grid.sync();
            phase_act(a, l);
            grid.sync();
            {
                float* oh = a.out + (size_t)hf * MHALF * DM;
                EpiRes E{oh, oh, hb + (size_t)hf * MHALF * DM, st + (size_t)hf * MHALF * 16};
                run_gemm(a.wv, lds, (const bf16_t*)(ws + WS_ACT), (const bf16_t*)(wl + W_DOWN), MHALF, DM, DFF, E);
            }
            grid.sync();
        }
    }
}

extern "C" void kernel_launch(void* const* d_in, const int* in_sizes, int n_in, void* d_out, int out_size, void* d_ws, size_t ws_size, hipStream_t stream) {
    static int grid = 0;
    if (grid == 0) {
        if (n_in != 28 || in_sizes[0] != MTOK * DM || out_size != MTOK * DM || ws_size < WS_END) {
            fprintf(stderr, "kernel_launch: unexpected shapes (n_in %d, in0 %d, out %d, ws %zu; need ws >= %zu); nothing launched\n", n_in, n_in > 0 ? in_sizes[0] : -1, out_size, ws_size, (size_t)WS_END);
            grid = -1; return;
        }
        int dev = 0, cus = 0, per_cu = 0;
        hipGetDevice(&dev);
        hipDeviceGetAttribute(&cus, hipDeviceAttributeMultiprocessorCount, dev);
        if (hipFuncSetAttribute((const void*)trunk_fwd, hipFuncAttributeMaxDynamicSharedMemorySize, LDS_BYTES) != hipSuccess) { fprintf(stderr, "kernel_launch: hipFuncSetAttribute failed\n"); grid = -1; return; }
        if (hipOccupancyMaxActiveBlocksPerMultiprocessor(&per_cu, (const void*)trunk_fwd, NTHREADS, LDS_BYTES) != hipSuccess || per_cu < 1) { fprintf(stderr, "kernel_launch: occupancy query says %d blocks per CU\n", per_cu); per_cu = 1; }
        (void)hipGetLastError();
        grid = cus;
    }
    if (grid < 0) return;
    (void)hipMemsetAsync((char*)d_ws + WS_CTL, 0, 4096, stream);
    Args a{};
    for (int i = 0; i < 28; ++i) a.in[i] = (const float*)d_in[i];
    a.out = (float*)d_out; a.ws = (unsigned char*)d_ws;
    void* args[] = {&a};
    hipError_t e = hipLaunchCooperativeKernel((const void*)trunk_fwd, dim3(grid), dim3(NTHREADS), args, LDS_BYTES, stream);
    if (e != hipSuccess) fprintf(stderr, "cooperative launch failed: %s (grid %d)\n", hipGetErrorString(e), grid);
}
```

```cpp
#include <hip/hip_runtime.h>
#include <hip/hip_cooperative_groups.h>
#include <cstdio>
#include <cstdint>
namespace cg = cooperative_groups;
namespace pg8 {
#define PG8_LAS __attribute__((address_space(3)))
typedef unsigned short bf16_t;
typedef short bf16x8 __attribute__((ext_vector_type(8)));
typedef float f32x4 __attribute__((ext_vector_type(4)));
typedef unsigned u32x4 __attribute__((ext_vector_type(4)));
constexpr int BM = 256, BK = 64, HALF = 128, HTB = HALF * BK * 2  , STAGE_BYTES = 8 * HTB, NXCD = 8, WGM = 8;

__host__ __device__ __forceinline__ int lds_byte(int r, int c) { const int st = (r >> 4) * 2 + (c >> 5), rr = r & 15, cc = c & 31, ob = rr * 64 + cc * 2; return st * 1024 + (ob ^ (((ob >> 9) & 1) << 5)); }
__host__ __device__ __forceinline__ void stage_rc(int b, int& R, int& C) { const int st = b / 1024, sb = b % 1024, swz = sb ^ (((sb >> 9) & 1) << 5); R = (st >> 1) * 16 + swz / 64; C = (st & 1) * 32 + (swz % 64) / 2; }
__host__ __device__ __forceinline__ int perm32(int rho) { const int n = rho >> 4, i = rho & 15; return 8 * (i >> 2) + 4 * n + (i & 3); }

struct Unit { int pm, pn; };
struct Gemm { const bf16_t* A; const bf16_t* Bt; int M, N, K; };

struct StaticOrder {
    int nM, nN, nwg, G, c;
    __host__ __device__ void init(int M, int N, int G_, int c_) { nM = M / BM; nN = N / BM; nwg = nM * nN; G = G_; c = c_; }
    __host__ __device__ bool next(int i, Unit& u) const {
        const long L = (long)i * G + c; if (L >= nwg) return false;
        int wgid = (int)L; { const int q = nwg / NXCD, r = nwg % NXCD, xcd = wgid % NXCD, off = wgid / NXCD; wgid = (xcd < r ? xcd * (q + 1) : r * (q + 1) + (xcd - r) * q) + off; }
        const int nig = WGM * nN, gid = wgid / nig, fm = gid * WGM, gsz = (nM - fm) < WGM ? (nM - fm) : WGM;
        u.pm = fm + ((wgid % nig) % gsz); u.pn = (wgid % nig) / gsz; return true;
    }
    __device__ __forceinline__ void a_ready(const Unit&) const {}
    __device__ __forceinline__ void done(const Unit&) const {}
};

__device__ __forceinline__ unsigned cvt_pk_bf16(float lo, float hi) { unsigned r; asm volatile("v_cvt_pk_bf16_f32 %0, %1, %2" : "=v"(r) : "v"(lo), "v"(hi)); return r; }
typedef float f32x2 __attribute__((ext_vector_type(2)));
template <class Epi, class Sched, bool ALIGN_EPI = false, bool SP2 = false>
__device__ __forceinline__ void gemm_phase(int tid_in, PG8_LAS unsigned char* lds, const Gemm g, const Sched& S, const Epi& E) {
    int tid_ = tid_in; asm volatile("" : "+v"(tid_));
    const int tid = tid_, wid = __builtin_amdgcn_readfirstlane(tid >> 6), lane = tid & 63, wr = wid >> 2, wc = wid & 3, fr = lane & 15, fq = lane >> 4;
    const int K = g.K, nt = K / BK;
    unsigned voffA[2], voffB[2];
#pragma unroll
    for (int i = 0; i < 2; ++i) { int R, C; stage_rc(tid * 16 + i * 8192, R, C); const int Rb = Epi::PERM ? ((R & ~31) + perm32(R & 31)) : R;
        voffA[i] = (unsigned)(R * K + C) * 2u; voffB[i] = (unsigned)(Rb * K + C) * 2u; }
    const size_t kstep = (size_t)(BK * 2);
    const size_t hstep = (size_t)HALF * K * 2;
    const size_t tstep = 2 * hstep;
    const unsigned ldsw = (unsigned)wid * 1024u;
    const int aoff = lds_byte(wr * 64 + fr, fq * 8), boff = lds_byte(wc * 32 + fr, fq * 8);
#define PG8_SA(b, h) (((b) * 2 + (h)) * HTB)
#define PG8_SB(b, h) ((4 + (b) * 2 + (h)) * HTB)
#define PG8_STAGE(bufoff, gbase, voff) do { _Pragma("unroll") for (int _i = 0; _i < 2; ++_i) \
        __builtin_amdgcn_global_load_lds((const unsigned*)((const char*)(gbase) + (voff)[_i]), (PG8_LAS unsigned*)(lds + (bufoff) + ldsw + _i * 8192), 16, 0, 0); } while (0)
#define PG8_LDA(dst, b, h) do { _Pragma("unroll") for (int m = 0; m < 4; ++m) _Pragma("unroll") for (int k = 0; k < 2; ++k) dst[m][k] = *(const PG8_LAS bf16x8*)(lds + PG8_SA(b, h) + aoff + m * 2048 + k * 1024); } while (0)
#define PG8_LDB(dst, b, h) do { _Pragma("unroll") for (int n = 0; n < 2; ++n) _Pragma("unroll") for (int k = 0; k < 2; ++k) dst[n][k] = *(const PG8_LAS bf16x8*)(lds + PG8_SB(b, h) + boff + n * 2048 + k * 1024); } while (0)
#define PG8_MMA(ai, bj, At, Bt) do { __builtin_amdgcn_s_setprio(1); _Pragma("unroll") for (int m = 0; m < 4; ++m) _Pragma("unroll") for (int n = 0; n < 2; ++n) _Pragma("unroll") for (int k = 0; k < 2; ++k) \
        acc[ai][bj][m][n] = __builtin_amdgcn_mfma_f32_16x16x32_bf16(Bt[n][k], At[m][k], acc[ai][bj][m][n], 0, 0, 0); __builtin_amdgcn_s_setprio(0); } while (0)
#define PG8_WAIT_V(n) asm volatile("s_waitcnt vmcnt(" #n ")" ::: "memory")
#define PG8_WAIT_L(n) asm volatile("s_waitcnt lgkmcnt(" #n ")" ::: "memory")
#define PG8_BAR __builtin_amdgcn_s_barrier()
#define PG8_SCHED __builtin_amdgcn_sched_barrier(0)
    Unit cur, nxt; int ui = 0;
    if (!S.next(0, cur)) return;
    f32x4 acc[2][2][4][2];
#pragma unroll
    for (int a = 0; a < 2; ++a)
#pragma unroll
        for (int b = 0; b < 2; ++b)
#pragma unroll
            for (int m = 0; m < 4; ++m)
#pragma unroll
                for (int n = 0; n < 2; ++n) acc[a][b][m][n] = (f32x4){0.f, 0.f, 0.f, 0.f};
    bf16x8 At[4][2], B0[2][2], B1[2][2];
    const char* cA = (const char*)g.A + (size_t)cur.pm * tstep; const char* cB = (const char*)g.Bt + (size_t)cur.pn * tstep;
    S.a_ready(cur);
    if constexpr (SP2) {
        PG8_STAGE(PG8_SB(0, 0), cB, voffB); PG8_STAGE(PG8_SB(0, 1), cB + hstep, voffB); PG8_STAGE(PG8_SA(0, 0), cA, voffA); PG8_STAGE(PG8_SA(0, 1), cA + hstep, voffA);
        if (wr == 1) PG8_BAR;
        PG8_WAIT_V(2); PG8_BAR;
        PG8_STAGE(PG8_SB(1, 0), cB + kstep, voffB); PG8_STAGE(PG8_SA(1, 0), cA + kstep, voffA); PG8_STAGE(PG8_SB(1, 1), cB + hstep + kstep, voffB);
        PG8_WAIT_V(6); PG8_BAR;
    } else {
        PG8_STAGE(PG8_SB(0, 0), cB, voffB); PG8_STAGE(PG8_SA(0, 0), cA, voffA); PG8_STAGE(PG8_SB(0, 1), cB + hstep, voffB); PG8_STAGE(PG8_SA(0, 1), cA + hstep, voffA);
        if (wr == 1) PG8_BAR;
        PG8_WAIT_V(4); PG8_BAR;
        PG8_STAGE(PG8_SB(1, 0), cB + kstep, voffB); PG8_STAGE(PG8_SA(1, 0), cA + kstep, voffA); PG8_STAGE(PG8_SB(1, 1), cB + hstep + kstep, voffB);
        PG8_WAIT_V(6); PG8_BAR;
    }
    for (;;) {
        const bool has_next = S.next(ui + 1, nxt);
        const char* nA = has_next ? (const char*)g.A + (size_t)nxt.pm * tstep : cA; const char* nB = has_next ? (const char*)g.Bt + (size_t)nxt.pn * tstep : cB;
        for (int t = 0; t < nt; t += 2) {
            const bool last = (t == nt - 2);
            const char* a1 = cA + (size_t)(t + 1) * kstep;
            const char* a2 = last ? nA : cA + (size_t)(t + 2) * kstep; const char* b2 = last ? nB : cB + (size_t)(t + 2) * kstep;
            const char* a3 = a2 + kstep; const char* b3 = b2 + kstep;
            if (last && has_next) S.a_ready(nxt);
            if constexpr (SP2) {
            PG8_LDB(B0, 0, 0); PG8_LDB(B1, 0, 1); PG8_SCHED; PG8_LDA(At, 0, 0); PG8_STAGE(PG8_SA(1, 1), a1 + hstep, voffA);
            PG8_WAIT_V(8); PG8_WAIT_L(0); PG8_BAR; PG8_MMA(0, 0, At, B0); PG8_MMA(0, 1, At, B1); PG8_BAR; PG8_SCHED;
            PG8_LDA(At, 0, 1); PG8_STAGE(PG8_SB(0, 0), b2, voffB); PG8_STAGE(PG8_SB(0, 1), b2 + hstep, voffB); PG8_STAGE(PG8_SA(0, 0), a2, voffA);
            PG8_WAIT_V(8); PG8_WAIT_L(0); PG8_BAR; PG8_MMA(1, 0, At, B0); PG8_MMA(1, 1, At, B1); PG8_BAR; PG8_SCHED;
            PG8_LDB(B0, 1, 0); PG8_LDB(B1, 1, 1); PG8_SCHED; PG8_LDA(At, 1, 0); PG8_STAGE(PG8_SA(0, 1), a2 + hstep, voffA);
            PG8_WAIT_V(8); PG8_WAIT_L(0); PG8_BAR; PG8_MMA(0, 0, At, B0); PG8_MMA(0, 1, At, B1); PG8_BAR; PG8_SCHED;
            PG8_LDA(At, 1, 1); PG8_STAGE(PG8_SB(1, 0), b3, voffB); PG8_STAGE(PG8_SB(1, 1), b3 + hstep, voffB); PG8_STAGE(PG8_SA(1, 0), a3, voffA);
            PG8_WAIT_V(8); PG8_WAIT_L(0); PG8_BAR; PG8_MMA(1, 0, At, B0); PG8_MMA(1, 1, At, B1); PG8_BAR; PG8_SCHED;
            } else {
            PG8_LDB(B0, 0, 0); PG8_SCHED; PG8_LDA(At, 0, 0); PG8_STAGE(PG8_SA(1, 1), a1 + hstep, voffA);
            PG8_WAIT_L(8); PG8_BAR; PG8_WAIT_L(0); PG8_MMA(0, 0, At, B0); PG8_BAR; PG8_SCHED;
            PG8_LDB(B1, 0, 1); PG8_STAGE(PG8_SB(0, 0), b2, voffB);
            PG8_BAR; PG8_WAIT_L(0); PG8_MMA(0, 1, At, B1); PG8_BAR;
            PG8_LDA(At, 0, 1); PG8_STAGE(PG8_SA(0, 0), a2, voffA);
            PG8_BAR; PG8_WAIT_L(0); PG8_MMA(1, 0, At, B0); PG8_BAR; PG8_SCHED;
            PG8_STAGE(PG8_SB(0, 1), b2 + hstep, voffB);
            PG8_WAIT_V(6); PG8_BAR; PG8_MMA(1, 1, At, B1); PG8_BAR;
            PG8_LDB(B0, 1, 0); PG8_SCHED; PG8_LDA(At, 1, 0); PG8_STAGE(PG8_SA(0, 1), a2 + hstep, voffA);
            PG8_WAIT_L(8); PG8_BAR; PG8_WAIT_L(0); PG8_MMA(0, 0, At, B0); PG8_BAR; PG8_SCHED;
            PG8_LDB(B1, 1, 1); PG8_STAGE(PG8_SB(1, 0), b3, voffB);
            PG8_BAR; PG8_WAIT_L(0); PG8_MMA(0, 1, At, B1); PG8_BAR;
            PG8_LDA(At, 1, 1); PG8_STAGE(PG8_SA(1, 0), a3, voffA);
            PG8_BAR; PG8_WAIT_L(0); PG8_MMA(1, 0, At, B0); PG8_BAR; PG8_SCHED;
            PG8_STAGE(PG8_SB(1, 1), b3 + hstep, voffB);
            PG8_WAIT_V(6); PG8_BAR; PG8_MMA(1, 1, At, B1); PG8_BAR;
            }
        }
        if constexpr (ALIGN_EPI) { if (wr == 0) PG8_BAR; }
        if constexpr (!Epi::AFTER_DRAIN) { E(acc, cur, wr, wc, fr, fq); S.done(cur); }
        if (!has_next) break;
#pragma unroll
        for (int a = 0; a < 2; ++a)
#pragma unroll
            for (int b = 0; b < 2; ++b)
#pragma unroll
                for (int m = 0; m < 4; ++m)
#pragma unroll
                    for (int n = 0; n < 2; ++n) acc[a][b][m][n] = (f32x4){0.f, 0.f, 0.f, 0.f};
        cur = nxt; cA = nA; cB = nB; ++ui;
        if constexpr (ALIGN_EPI) { if (wr == 1) PG8_BAR; }
    }
    PG8_WAIT_V(0);
    if constexpr (!ALIGN_EPI) { if (wr == 0) PG8_BAR; }
    PG8_BAR;
    if constexpr (Epi::AFTER_DRAIN) { E.fused(acc, cur, wr, wc, fr, fq, lds, wid, lane); S.done(cur); }
#undef PG8_SA
#undef PG8_SB
#undef PG8_STAGE
#undef PG8_LDA
#undef PG8_LDB
#undef PG8_MMA
#undef PG8_WAIT_V
#undef PG8_WAIT_L
#undef PG8_BAR
#undef PG8_SCHED
}
}

using pg8::bf16_t; using pg8::bf16x8; using pg8::f32x4; using pg8::u32x4;
typedef unsigned u32x2 __attribute__((ext_vector_type(2)));
typedef short s16x4 __attribute__((ext_vector_type(4)));
#define LAS __attribute__((address_space(3)))

constexpr int NTHREADS = 512;
constexpr int MTOK = 65536, DM = 1024, SEQ = 2048, NBATCH = 32, DEPTH = 4;
constexpr int NPROJ = 2304;
constexpr int INW = 2176;
constexpr int DFF = 2816, DFF2 = 5632;
constexpr int MEMROWS = 8192;
constexpr int MHALF = 32768;
constexpr float EPSF = 1e-6f;
constexpr float LOG2E = 1.4426950408889634f;
constexpr int LDS_BYTES = 155648;
constexpr int LDS_UNIT_OFF = 155648 - 64;
constexpr int LDS_TBL_OFF = 155648 - 512;

constexpr size_t MiB = 1u << 20;
constexpr size_t WS_CTL = 0;
constexpr size_t WS_ST = 1 * MiB;
constexpr size_t WS_STM = 5 * MiB;
constexpr size_t WS_CS = 5 * MiB + 512 * 1024;
constexpr size_t WS_KST = 6 * MiB;
constexpr size_t WS_QST = 14 * MiB;
constexpr size_t WS_MEMB = 22 * MiB;
constexpr size_t WS_W = 38 * MiB;
constexpr size_t W_LAYER = 27 * MiB;
constexpr size_t W_IN = 0, W_OUT = (size_t)(4.5 * MiB), W_Q = (size_t)(6.5 * MiB), W_O = (size_t)(8.5 * MiB), W_UP = (size_t)(10.5 * MiB), W_DOWN = (size_t)(21.5 * MiB);
constexpr size_t WS_WKV = WS_W + 4 * W_LAYER;
constexpr size_t WS_HB = 162 * MiB;
constexpr size_t WS_KV = 290 * MiB;
constexpr size_t WS_BIG = 418 * MiB;
constexpr size_t WS_PROJ = WS_BIG;
constexpr size_t WS_MIXED = WS_BIG + 288 * MiB;
constexpr size_t WS_QM = WS_MIXED + 128 * MiB;
constexpr size_t WS_GU = WS_BIG;
constexpr size_t WS_ACT = WS_BIG + 352 * MiB;
constexpr size_t WS_END = WS_QM + 128 * MiB;
static_assert(WS_WKV + 16 * MiB <= WS_HB, "ws map");
static_assert(WS_ACT + 176 * MiB <= WS_END, "ws map");

struct Args { const float* in[28]; float* out; unsigned char* ws; };
struct Ctx { LAS const unsigned long long* tbl; float* out; unsigned char* ws; int wv; };
__device__ __forceinline__ const float* inptr(const Ctx& c, int i) {
    const unsigned long long v = c.tbl[i];
    const unsigned lo = __builtin_amdgcn_readfirstlane((unsigned)v), hi = __builtin_amdgcn_readfirstlane((unsigned)(v >> 32));
    return (const float*)(((unsigned long long)hi << 32) | lo);
}

__device__ __forceinline__ float bf2f(unsigned short b) { return __uint_as_float(((unsigned)b) << 16); }
__device__ __forceinline__ float bflo(unsigned w) { return __uint_as_float(w << 16); }
__device__ __forceinline__ float bfhi(unsigned w) { return __uint_as_float(w & 0xffff0000u); }
__device__ __forceinline__ unsigned pkbf(float lo, float hi) { unsigned r; asm("v_cvt_pk_bf16_f32 %0, %1, %2" : "=v"(r) : "v"(lo), "v"(hi)); return r; }
__device__ __forceinline__ unsigned short f2bf(float f) { return (unsigned short)(pkbf(f, 0.f) & 0xffffu); }
__device__ __forceinline__ float shx(float v, int lane, int m) { return __int_as_float(__builtin_amdgcn_ds_bpermute((lane ^ m) << 2, __float_as_int(v))); }
__device__ __forceinline__ float shi(float v, int src) { return __int_as_float(__builtin_amdgcn_ds_bpermute(src << 2, __float_as_int(v))); }
__device__ __forceinline__ float wave_sum(float v, int lane) {
#pragma unroll
    for (int o = 1; o < 64; o <<= 1) v += shx(v, lane, o);
    return v;
}
__device__ __forceinline__ float sigmoidf_(float x) { return __builtin_amdgcn_rcpf(1.0f + __builtin_amdgcn_exp2f(-LOG2E * x)); }
__device__ __forceinline__ float gelu_tanh(float x) {
    const float u2 = (-2.0f * 0.7978845608028654f * LOG2E) * (x + 0.044715f * x * x * x);
    return x * __builtin_amdgcn_rcpf(1.0f + __builtin_amdgcn_exp2f(u2));
}
__device__ __forceinline__ LAS unsigned char* lds_l(LAS unsigned char* p) { unsigned v = (unsigned)(uintptr_t)p; asm volatile("" : "+s"(v)); return (LAS unsigned char*)(uintptr_t)v; }
__device__ __forceinline__ int tid_w(int wv) { int t = (wv << 6) + (int)__builtin_amdgcn_mbcnt_hi(~0u, __builtin_amdgcn_mbcnt_lo(~0u, 0u)); asm volatile("" : "+v"(t)); return t; }
__device__ __forceinline__ s16x4 vtr(LAS const unsigned char* p) {
    typedef short v4i16_t __attribute__((ext_vector_type(4)));
    return __builtin_bit_cast(s16x4, __builtin_amdgcn_ds_read_tr16_b64_v4i16((LAS v4i16_t*)p));
}

#define LBAR() do { asm volatile("s_waitcnt lgkmcnt(0)" ::: "memory"); __builtin_amdgcn_s_barrier(); asm volatile("" ::: "memory"); } while (0)

template <bool QKN> struct EpiBf {
    static constexpr bool PERM = true, AFTER_DRAIN = false;
    bf16_t* O; int ldc; const float* st; float* pst; int npg; const float* cs; const float* qg; const float* kg;
    __device__ __forceinline__ void operator()(const f32x4 (&acc)[2][2][4][2], const pg8::Unit& u, int wr, int wc, int fr, int fq) const {
        int kind = 0; const float* gsel = nullptr;
        if (QKN) { const int c0 = u.pn * 256 + 64 * wc; if (c0 >= 256 && c0 < 640) { kind = 1; gsel = qg; } else if (c0 >= 640 && c0 < 1024) { kind = 2; gsel = kg; } }
#pragma unroll
        for (int ai = 0; ai < 2; ++ai)
#pragma unroll
            for (int m = 0; m < 4; ++m) {
                const int r = u.pm * 256 + ai * 128 + wr * 64 + m * 16 + fr;
                const f32x4* sp = (const f32x4*)(st + (size_t)r * 16);
                const f32x4 s0 = sp[0], s1 = sp[1], s2 = sp[2], s3 = sp[3];
                const float ssum = ((s0[0] + s0[1]) + (s0[2] + s0[3])) + ((s1[0] + s1[1]) + (s1[2] + s1[3])) + ((s2[0] + s2[1]) + (s2[2] + s2[3])) + ((s3[0] + s3[1]) + (s3[2] + s3[3]));
                const float rs = rsqrtf(ssum * (1.0f / 1024.0f) + EPSF);
                f32x4 v[2][2];
#pragma unroll
                for (int bj = 0; bj < 2; ++bj)
#pragma unroll
                    for (int n = 0; n < 2; ++n) v[bj][n] = acc[ai][bj][m][n] * rs;
                if (QKN) {
                    if (kind != 0) {
                        float ss = 0.f;
#pragma unroll
                        for (int bj = 0; bj < 2; ++bj)
#pragma unroll
                            for (int n = 0; n < 2; ++n) ss += (v[bj][n][0] * v[bj][n][0] + v[bj][n][1] * v[bj][n][1]) + (v[bj][n][2] * v[bj][n][2] + v[bj][n][3] * v[bj][n][3]);
                        ss += shx(ss, fq * 16 + fr, 16); ss += shx(ss, fq * 16 + fr, 32);
                        float rn = rsqrtf(ss * (1.0f / 64.0f) + EPSF);
                        if (kind == 1) rn *= 0.125f * LOG2E;
#pragma unroll
                        for (int bj = 0; bj < 2; ++bj)
#pragma unroll
                            for (int n = 0; n < 2; ++n) { const f32x4 gv = *(const f32x4*)(gsel + 32 * bj + 8 * fq + 4 * n); v[bj][n] = v[bj][n] * rn * gv; }
                    }
                } else {
                    if (pst) {
#pragma unroll
                        for (int bj = 0; bj < 2; ++bj) {
                            float ss = (v[bj][0][0] * v[bj][0][0] + v[bj][0][1] * v[bj][0][1]) + (v[bj][0][2] * v[bj][0][2] + v[bj][0][3] * v[bj][0][3])
                                     + (v[bj][1][0] * v[bj][1][0] + v[bj][1][1] * v[bj][1][1]) + (v[bj][1][2] * v[bj][1][2] + v[bj][1][3] * v[bj][1][3]);
                            ss += shx(ss, fq * 16 + fr, 16); ss += shx(ss, fq * 16 + fr, 32);
                            if (fq == 0) pst[(size_t)r * npg + (u.pn * 8 + bj * 4 + wc)] = ss;
                        }
                    }
                    if (cs) {
#pragma unroll
                        for (int bj = 0; bj < 2; ++bj)
#pragma unroll
                            for (int n = 0; n < 2; ++n) { const f32x4 cv = *(const f32x4*)(cs + u.pn * 256 + bj * 128 + wc * 32 + 8 * fq + 4 * n); v[bj][n] = v[bj][n] * cv; }
                    }
                }
#pragma unroll
                for (int bj = 0; bj < 2; ++bj) {
                    const int col = QKN ? (u.pn * 256 + 64 * wc + 32 * bj + 8 * fq) : (u.pn * 256 + 128 * bj + 32 * wc + 8 * fq);
                    u32x4 w; w.x = pkbf(v[bj][0][0], v[bj][0][1]); w.y = pkbf(v[bj][0][2], v[bj][0][3]); w.z = pkbf(v[bj][1][0], v[bj][1][1]); w.w = pkbf(v[bj][1][2], v[bj][1][3]);
                    *(u32x4*)(O + (size_t)r * ldc + col) = w;
                }
                asm volatile("" ::: "memory");
            }
    }
};

struct EpiRes {
    static constexpr bool PERM = false, AFTER_DRAIN = false;
    const float* resid; float* out; bf16_t* hb; float* st;
    __device__ __forceinline__ void operator()(const f32x4 (&acc)[2][2][4][2], const pg8::Unit& u, int wr, int wc, int fr, int fq) const {
#pragma unroll
        for (int ai = 0; ai < 2; ++ai)
#pragma unroll
            for (int m = 0; m < 4; ++m) {
                const int r = u.pm * 256 + ai * 128 + wr * 64 + m * 16 + fr;
                float ss = 0.f;
#pragma unroll
                for (int bj = 0; bj < 2; ++bj)
#pragma unroll
                    for (int n = 0; n < 2; ++n) {
                        const size_t off = (size_t)r * DM + (u.pn * 256 + bj * 128 + wc * 32 + n * 16 + 4 * fq);
                        const f32x4 v = *(const f32x4*)(resid + off) + acc[ai][bj][m][n];
                        *(f32x4*)(out + off) = v;
                        u32x2 w; w.x = pkbf(v[0], v[1]); w.y = pkbf(v[2], v[3]);
                        *(u32x2*)(hb + off) = w;
                        ss += (v[0] * v[0] + v[1] * v[1]) + (v[2] * v[2] + v[3] * v[3]);
                    }
                ss += shx(ss, fq * 16 + fr, 16); ss += shx(ss, fq * 16 + fr, 32);
                if (fq == 0) st[(size_t)r * 16 + u.pn * 4 + wc] = ss;
                asm volatile("" ::: "memory");
            }
    }
};

template <class Epi>
__device__ __forceinline__ void run_gemm(int wv, LAS unsigned char* lds, const bf16_t* A, const bf16_t* Bt, int M, int N, int K, const Epi& E) {
    pg8::Gemm g{A, Bt, M, N, K}; pg8::StaticOrder S; S.init(M, N, (int)gridDim.x, (int)blockIdx.x);
    pg8::gemm_phase<Epi, pg8::StaticOrder, true, true>(tid_w(wv), lds_l(lds), g, S, E);
}

__device__ __forceinline__ void transpose_item(const float* W, int ldw, int K, const float* gain, bf16_t* WT, int dst_row0, bool zero, LAS float* scr, int k0, int n0, int lane) {
#pragma unroll 8
    for (int i = 0; i < 32; ++i) {
        const int kk = 2 * i + (lane >> 5);
        float v = 0.f;
        if (!zero) { v = W[(size_t)(k0 + kk) * ldw + n0 + (lane & 31)]; if (gain) v *= gain[k0 + kk]; }
        scr[kk * 33 + (lane & 31)] = v;
    }
    asm volatile("s_waitcnt lgkmcnt(0)" ::: "memory");
    const int c = lane & 7;
#pragma unroll
    for (int j = 0; j < 4; ++j) {
        const int n = (lane >> 3) + 8 * j; const LAS float* s = scr + (8 * c) * 33 + n;
        u32x4 o; o.x = pkbf(s[0 * 33], s[1 * 33]); o.y = pkbf(s[2 * 33], s[3 * 33]); o.z = pkbf(s[4 * 33], s[5 * 33]); o.w = pkbf(s[6 * 33], s[7 * 33]);
        *(u32x4*)(WT + (size_t)(dst_row0 + n) * K + k0 + 8 * c) = o;
    }
    asm volatile("s_waitcnt lgkmcnt(0)" ::: "memory");
}
__device__ __forceinline__ void row_to_bf16(const float* xrow, bf16_t* orow, float* strow, int lane) {
    const f32x4* xr = (const f32x4*)xrow + lane;
    f32x4 v[4]; float s = 0.f;
#pragma unroll
    for (int j = 0; j < 4; ++j) { v[j] = xr[64 * j]; s += (v[j][0] * v[j][0] + v[j][1] * v[j][1]) + (v[j][2] * v[j][2] + v[j][3] * v[j][3]); }
    s = wave_sum(s, lane);
    u32x2* o8 = (u32x2*)orow + lane;
#pragma unroll
    for (int j = 0; j < 4; ++j) { u32x2 w; w.x = pkbf(v[j][0], v[j][1]); w.y = pkbf(v[j][2], v[j][3]); o8[64 * j] = w; }
    if (lane < 16) strow[lane] = (lane == 0) ? s : 0.f;
}
__device__ __forceinline__ void phase_prologue(const Ctx& a, LAS unsigned char* lds) {
    lds = lds_l(lds);
    const int tid = tid_w(a.wv), lane = tid & 63, wave = tid >> 6;
    LAS float* scr = (LAS float*)(lds + wave * 16384);
    const int gw = blockIdx.x * 8 + wave, NGW = gridDim.x * 8;
    unsigned char* ws = a.ws;
    constexpr int I_IN = 16 * 72, I_SQ = 16 * 32, I_UP = 16 * 176, I_DN = 44 * 32, I_KV = 16 * 64;
    constexpr int I_LAYER = I_IN + 3 * I_SQ + I_UP + I_DN + I_KV;
    for (int it = gw; it < DEPTH * I_LAYER; it += NGW) {
        const int l = it / I_LAYER; int r = it % I_LAYER;
        bf16_t* wl = (bf16_t*)(ws + WS_W + (size_t)l * W_LAYER);
        if (r < I_IN) {
            const int kb = r / 72, nb = r % 72, n0 = nb * 32;
            const int dst = (n0 & ~255) + 128 * ((n0 >> 5) & 1) + 32 * ((n0 >> 6) & 3);
            transpose_item(inptr(a, 3) + (size_t)l * DM * INW, INW, DM, inptr(a, 2) + l * DM, (bf16_t*)((unsigned char*)wl + W_IN), dst, n0 >= INW, scr, kb * 64, n0, lane);
            continue;
        }
        r -= I_IN;
        if (r < I_SQ) { transpose_item(inptr(a, 15) + (size_t)l * DM * DM, DM, DM, nullptr, (bf16_t*)((unsigned char*)wl + W_OUT), (r % 32) * 32, false, scr, (r / 32) * 64, (r % 32) * 32, lane); continue; }
        r -= I_SQ;
        if (r < I_SQ) { transpose_item(inptr(a, 18) + (size_t)l * DM * DM, DM, DM, inptr(a, 16) + l * DM, (bf16_t*)((unsigned char*)wl + W_Q), (r % 32) * 32, false, scr, (r / 32) * 64, (r % 32) * 32, lane); continue; }
        r -= I_SQ;
        if (r < I_SQ) { transpose_item(inptr(a, 22) + (size_t)l * DM * DM, DM, DM, nullptr, (bf16_t*)((unsigned char*)wl + W_O), (r % 32) * 32, false, scr, (r / 32) * 64, (r % 32) * 32, lane); continue; }
        r -= I_SQ;
        if (r < I_UP) { transpose_item(inptr(a, 24) + (size_t)l * DM * DFF2, DFF2, DM, inptr(a, 23) + l * DM, (bf16_t*)((unsigned char*)wl + W_UP), (r % 176) * 32, false, scr, (r / 176) * 64, (r % 176) * 32, lane); continue; }
        r -= I_UP;
        if (r < I_DN) { transpose_item(inptr(a, 27) + (size_t)l * DFF * DM, DM, DFF, nullptr, (bf16_t*)((unsigned char*)wl + W_DOWN), (r % 32) * 32, false, scr, (r / 32) * 64, (r % 32) * 32, lane); continue; }
        r -= I_DN;
        transpose_item(inptr(a, 19) + (size_t)l * DM * 2048, 2048, DM, inptr(a, 17) + l * DM, (bf16_t*)(ws + WS_WKV), l * 2048 + (r % 64) * 32, false, scr, (r / 64) * 64, (r % 64) * 32, lane);
    }
    for (int i = blockIdx.x * NTHREADS + tid; i < DEPTH * DM; i += gridDim.x * NTHREADS) { const int l = i >> 10, dd = i & 255; ((float*)(ws + WS_CS))[i] = inptr(a, 20)[l * 256 + dd] * inptr(a, 21)[l * 256 + dd] * (0.0625f * LOG2E); }
    for (int m = gw; m < MTOK; m += NGW) row_to_bf16(inptr(a, 0) + (size_t)m * DM, (bf16_t*)(ws + WS_HB) + (size_t)m * DM, (float*)(ws + WS_ST) + (size_t)m * 16, lane);
    for (int m = gw; m < MEMROWS; m += NGW) row_to_bf16(inptr(a, 1) + (size_t)m * DM, (bf16_t*)(ws + WS_MEMB) + (size_t)m * DM, (float*)(ws + WS_STM) + (size_t)m * 16, lane);
}

__device__ __forceinline__ void lru_unit(const Ctx& a, int l, int b, int g, LAS unsigned char* lds) {
    lds = lds_l(lds);
    const int tid = tid_w(a.wv), lane = tid & 63, wave = tid >> 6, l15 = lane & 15, gq = lane >> 4;
    LAS unsigned char* XT = lds;
    LAS unsigned char* XCB = lds + 19008;
    LAS float* XCF = (LAS float*)(lds + 37440);
    LAS float* AA = (LAS float*)(lds + 70208);
    LAS float* BB = (LAS float*)(lds + 102976);
    LAS unsigned char* WT = lds + 135744;
    const bf16_t* proj = (const bf16_t*)(a.ws + WS_PROJ) + (size_t)b * SEQ * NPROJ;
    bf16_t* mixed = (bf16_t*)(a.ws + WS_MIXED) + (size_t)b * SEQ * DM;
    const float* wa = inptr(a, 10) + ((size_t)l * 6 + g) * 4096; const float* wx = inptr(a, 12) + ((size_t)l * 6 + g) * 4096;
    for (int k = 0; k < 16; ++k) {
        const int idx = tid + 512 * k, which = idx >> 12, cp = (idx >> 6) & 63, c = idx & 63;
        const float v = which ? wx[cp * 64 + c] : wa[cp * 64 + c];
        *(LAS unsigned short*)(WT + (which * 64 + c) * 144 + cp * 2) = f2bf(v);
    }
    const int cch = tid & 63, ch = g * 64 + cch;
    float cw[4];
#pragma unroll
    for (int j = 0; j < 4; ++j) cw[j] = inptr(a, 8)[((size_t)l * 4 + j) * 384 + ch];
    const float cb = inptr(a, 9)[l * 384 + ch];
    float gba[4], gbx[4], gsp[4];
#pragma unroll
    for (int nt = 0; nt < 4; ++nt) {
        const int c2 = l * 384 + g * 64 + 16 * nt + l15;
        gba[nt] = inptr(a, 11)[c2]; gbx[nt] = inptr(a, 13)[c2];
        const float z = -inptr(a, 14)[c2];
        gsp[nt] = (8.0f * LOG2E) * (fmaxf(z, 0.f) + log1pf(__expf(-fabsf(z))));
    }
    float hcar = 0.f;
    const bf16_t* xsrc = proj + 1408 + g * 64;
    const bf16_t* ysrc = proj + 1792 + g * 64;
    u32x4 xr[3];
#pragma unroll
    for (int k = 0; k < 3; ++k) {
        const int idx = tid + 512 * k, row = idx >> 3, cv = idx & 7, tok = row - 3;
        xr[k] = (idx < 1048 && tok >= 0) ? *(const u32x4*)(xsrc + (size_t)tok * NPROJ + cv * 8) : (u32x4){0u, 0u, 0u, 0u};
    }
#pragma unroll 1
    for (int ck = 0; ck < 16; ++ck) {
        const int t0 = ck * 128;
#pragma unroll
        for (int k = 0; k < 3; ++k) { const int idx = tid + 512 * k, row = idx >> 3, cv = idx & 7; if (idx < 1048) *(LAS u32x4*)(XT + row * 144 + cv * 16) = xr[k]; }
        u32x4 yr[2];
#pragma unroll
        for (int k = 0; k < 2; ++k) { const int idx = tid + 512 * k, row = idx >> 3, cv = idx & 7; yr[k] = *(const u32x4*)(ysrc + (size_t)(t0 + row) * NPROJ + cv * 8); }
        if (ck < 15) {
#pragma unroll
            for (int k = 0; k < 3; ++k) {
                const int idx = tid + 512 * k, row = idx >> 3, cv = idx & 7, tok = t0 + 128 - 3 + row;
                xr[k] = (idx < 1048) ? *(const u32x4*)(xsrc + (size_t)tok * NPROJ + cv * 8) : (u32x4){0u, 0u, 0u, 0u};
            }
        }
        LBAR();
#pragma unroll 4
        for (int k = 0; k < 16; ++k) {
            const int t = (tid >> 6) + 8 * k;
            float xc = cb;
#pragma unroll
            for (int j = 0; j < 4; ++j) xc += cw[j] * bf2f(*(LAS const unsigned short*)(XT + (t + 3 - j) * 144 + cch * 2));
            XCF[t * 64 + cch] = xc;
            *(LAS unsigned short*)(XCB + t * 144 + cch * 2) = f2bf(xc);
        }
        LBAR();
        {
            f32x4 acc[8];
#pragma unroll
            for (int nt = 0; nt < 8; ++nt) acc[nt] = (f32x4){0.f, 0.f, 0.f, 0.f};
#pragma unroll
            for (int ks = 0; ks < 2; ++ks) {
                const bf16x8 af = *(LAS const bf16x8*)(XCB + (16 * wave + l15) * 144 + (32 * ks + 8 * gq) * 2);
#pragma unroll
                for (int nt = 0; nt < 8; ++nt) {
                    const bf16x8 bfr = *(LAS const bf16x8*)(WT + (16 * nt + l15) * 144 + (32 * ks + 8 * gq) * 2);
                    acc[nt] = __builtin_amdgcn_mfma_f32_16x16x32_bf16(af, bfr, acc[nt], 0, 0, 0);
                }
            }
#pragma unroll
            for (int nt = 0; nt < 4; ++nt)
#pragma unroll
                for (int rg = 0; rg < 4; ++rg) {
                    const int t = 16 * wave + 4 * gq + rg, c = 16 * nt + l15;
                    const float r = sigmoidf_(acc[nt][rg] + gba[nt]), ig = sigmoidf_(acc[nt + 4][rg] + gbx[nt]);
                    const float av = __builtin_amdgcn_exp2f(-r * gsp[nt]);
                    const float xcv = XCF[t * 64 + c];
                    AA[t * 64 + c] = av;
                    BB[t * 64 + c] = __builtin_amdgcn_sqrtf(fmaxf(1.0f - av * av, 0.f)) * (ig * xcv);
                }
        }
        LBAR();
        if (wave == 0) {
#pragma unroll 16
            for (int t = 0; t < 128; ++t) { hcar = AA[t * 64 + lane] * hcar + BB[t * 64 + lane]; BB[t * 64 + lane] = hcar; }
        }
        LBAR();
#pragma unroll
        for (int k = 0; k < 2; ++k) {
            const int idx = tid + 512 * k, row = idx >> 3, cv = idx & 7;
            const f32x4 h0 = *(LAS const f32x4*)(BB + row * 64 + cv * 8), h1 = *(LAS const f32x4*)(BB + row * 64 + cv * 8 + 4);
            u32x4 w;
            w.x = pkbf(h0[0] * gelu_tanh(bflo(yr[k].x)), h0[1] * gelu_tanh(bfhi(yr[k].x)));
            w.y = pkbf(h0[2] * gelu_tanh(bflo(yr[k].y)), h0[3] * gelu_tanh(bfhi(yr[k].y)));
            w.z = pkbf(h1[0] * gelu_tanh(bflo(yr[k].z)), h1[1] * gelu_tanh(bfhi(yr[k].z)));
            w.w = pkbf(h1[2] * gelu_tanh(bflo(yr[k].w)), h1[3] * gelu_tanh(bfhi(yr[k].w)));
            *(u32x4*)(mixed + (size_t)(t0 + row) * DM + 640 + g * 64 + cv * 8) = w;
        }
    }
}

__device__ __forceinline__ void pool_unit(const Ctx& a, int l, int b, int tc, LAS unsigned char* lds) {
    lds = lds_l(lds);
    const int tid = tid_w(a.wv);
    LAS float* U = (LAS float*)lds;
    LAS float* P = (LAS float*)(lds + 80896);
    const int t0 = tc * 64;
    const bf16_t* proj = (const bf16_t*)(a.ws + WS_PROJ) + (size_t)b * SEQ * NPROJ;
    bf16_t* mixed = (bf16_t*)(a.ws + WS_MIXED) + (size_t)b * SEQ * DM;
    for (int k = 0; k < 40; ++k) {
        const int idx = tid + 512 * k;
        if (idx < 79 * 256) { const int tt = idx >> 8, c = idx & 255, t = t0 - 15 + tt; U[idx] = (t >= 0) ? bf2f(proj[(size_t)t * NPROJ + c]) : 0.f; }
    }
    __syncthreads();
    {
        const int c = tid & 255, half = tid >> 8, g = c >> 6, w = 2 << g;
        for (int q = 0; q < 32; ++q) {
            const int tt = half * 32 + q, t = t0 + tt;
            float s = 0.f;
            for (int j = 0; j < w; ++j) s += U[(tt + 15 - j) * 256 + c];
            const float cnt = (float)((t + 1 < w) ? (t + 1) : w);
            P[tt * 256 + c] = s / cnt - U[(tt + 15) * 256 + c];
        }
    }
    __syncthreads();
    {
        const int dcol = tid & 255, half = tid >> 8, g = dcol >> 6, dc = dcol & 63;
        const float* pw = inptr(a, 4) + ((size_t)l * 4 + g) * 4096 + dc;
        float w[64];
#pragma unroll
        for (int c = 0; c < 64; ++c) w[c] = pw[c * 64];
        const float sc = inptr(a, 5)[l * 256 + dcol];
        for (int q = 0; q < 32; ++q) {
            const int tt = half * 32 + q;
            const LAS f32x4* pr = (const LAS f32x4*)(P + tt * 256 + g * 64);
            float acc = 0.f;
#pragma unroll
            for (int c4 = 0; c4 < 16; ++c4) { const f32x4 pv = pr[c4]; acc += pv[0] * w[4 * c4] + pv[1] * w[4 * c4 + 1] + pv[2] * w[4 * c4 + 2] + pv[3] * w[4 * c4 + 3]; }
            mixed[(size_t)(t0 + tt) * DM + dcol] = f2bf(acc * sc);
        }
    }
}

__device__ __forceinline__ void dattn_unit(const Ctx& a, int b, int h, int tb, LAS unsigned char* lds) {
    lds = lds_l(lds);
    const int tid = tid_w(a.wv), lane = tid & 63, wave = tid >> 6, l15 = lane & 15, gq = lane >> 4;
    LAS float* OACC = (LAS float*)lds;
    LAS float* DEN = (LAS float*)(lds + 65536);
    LAS unsigned char* vst = lds + 66560 + wave * 4608;
    const int t0 = tb * 256;
    const bf16_t* projb = (const bf16_t*)(a.ws + WS_PROJ) + (size_t)b * SEQ * NPROJ;
    bf16_t* mixed = (bf16_t*)(a.ws + WS_MIXED) + (size_t)b * SEQ * DM;
    const float slope2 = exp2f(-8.0f * (float)(h + 1) / 6.0f) * LOG2E;
    const int trq = (l15 >> 2), trp = (l15 & 3);
#pragma unroll 1
    for (int pi = 0; pi < 3; ++pi) {
        const int d = 1 << (2 * pi);
        const float sl = slope2 * (float)d;
#pragma unroll 1
        for (int ii = 0; ii < 2; ++ii) {
            const int it = 2 * wave + ii, rr = it % d, jj = it / d, tq0 = t0 + rr + 16 * d * jj;
            const unsigned char* pbytes = (const unsigned char*)projb;
            const unsigned qoff = (unsigned)(tq0 + d * l15) * (unsigned)(NPROJ * 2) + (unsigned)((256 + h * 64 + 8 * gq) * 2);
            const bf16x8 qf0 = *(const bf16x8*)(pbytes + qoff), qf1 = *(const bf16x8*)(pbytes + qoff + 64);
            bf16x8 kf[6][2];
#define DATTN_KLOAD(KT) do { if ((KT) < 9) { int tk = tq0 + d * (16 * ((KT) - 8) + l15); tk = tk < 0 ? 0 : tk; \
                const unsigned koff = (unsigned)tk * (unsigned)(NPROJ * 2) + (unsigned)((640 + h * 64 + 8 * gq) * 2); \
                kf[(KT) % 6][0] = *(const bf16x8*)(pbytes + koff); kf[(KT) % 6][1] = *(const bf16x8*)(pbytes + koff + 64); } } while (0)
            DATTN_KLOAD(0); DATTN_KLOAD(1); DATTN_KLOAD(2); DATTN_KLOAD(3); DATTN_KLOAD(4); DATTN_KLOAD(5);
            u32x4 vreg[2][4];
#define DATTN_VLOAD(PP) do { _Pragma("unroll") for (int ps = 0; ps < 4; ++ps) { \
                    const int idx = ps * 64 + lane, row = idx >> 3, chk = idx & 7, kt = 2 * (PP) + (row >> 4); \
                    int tk = tq0 + d * (16 * (kt - 8) + (row & 15)); tk = tk < 0 ? 0 : (tk > SEQ - 1 ? SEQ - 1 : tk); \
                    vreg[(PP) % 2][ps] = *(const u32x4*)(pbytes + ((unsigned)tk * (unsigned)(NPROJ * 2) + (unsigned)((1024 + h * 64 + chk * 8) * 2))); } } while (0)
            DATTN_VLOAD(0); DATTN_VLOAD(1);
            f32x4 o[4];
#pragma unroll
            for (int dt = 0; dt < 4; ++dt) o[dt] = (f32x4){0.f, 0.f, 0.f, 0.f};
            float den = 0.f;
            int dbase = l15 + 128 - 4 * gq; asm volatile("" : "+v"(dbase));
            float fbase = (float)dbase; asm volatile("" : "+v"(fbase));
#pragma unroll
            for (int pp = 0; pp < 5; ++pp) {
#pragma unroll
                for (int ps = 0; ps < 4; ++ps) { const int idx = ps * 64 + lane, row = idx >> 3, chk = idx & 7; *(LAS u32x4*)(vst + row * 144 + chk * 16) = vreg[pp % 2][ps]; }
                if (pp + 2 < 5) { asm volatile("" ::: "memory"); DATTN_VLOAD(pp + 2); }
                const bool skip = (tq0 + d * (16 * (2 * pp + 1 - 8) + 15) < 0);
                f32x4 sacc[2];
#pragma unroll
                for (int T = 0; T < 2; ++T) {
                    const int kt = 2 * pp + T;
                    sacc[T] = (f32x4){0.f, 0.f, 0.f, 0.f};
                    if (kt < 9 && !skip) {
                        sacc[T] = __builtin_amdgcn_mfma_f32_16x16x32_bf16(kf[kt % 6][0], qf0, sacc[T], 0, 0, 0);
                        sacc[T] = __builtin_amdgcn_mfma_f32_16x16x32_bf16(kf[kt % 6][1], qf1, sacc[T], 0, 0, 0);
                    }
                }
                if (pp + 3 < 5) { asm volatile("" ::: "memory"); DATTN_KLOAD(2 * pp + 6); DATTN_KLOAD(2 * pp + 7); }
                if (skip) continue;
                float p[2][4];
#pragma unroll
                for (int T = 0; T < 2; ++T) {
                    const int kt = 2 * pp + T;
#pragma unroll
                    for (int rg = 0; rg < 4; ++rg) {
                        const int dist = dbase - (16 * kt + rg);
                        const int tkk = tq0 + d * (l15 - dist);
                        const bool valid = (kt < 9) && (dist >= 0) && (dist <= 128) && (tkk >= 0);
                        const float pv = valid ? __builtin_amdgcn_exp2f(sacc[T][rg] - sl * (fbase - (float)(16 * kt + rg))) : 0.f;
                        p[T][rg] = pv; den += pv;
                    }
                }
                u32x4 pw; pw.x = pkbf(p[0][0], p[0][1]); pw.y = pkbf(p[0][2], p[0][3]); pw.z = pkbf(p[1][0], p[1][1]); pw.w = pkbf(p[1][2], p[1][3]);
                const bf16x8 pfrag = __builtin_bit_cast(bf16x8, pw);
#pragma unroll
                for (int dt = 0; dt < 4; ++dt) {
                    const s16x4 lo = vtr(vst + (4 * gq + trq) * 144 + (16 * dt + 4 * trp) * 2);
                    const s16x4 hi = vtr(vst + (16 + 4 * gq + trq) * 144 + (16 * dt + 4 * trp) * 2);
                    const bf16x8 vf = (bf16x8){lo[0], lo[1], lo[2], lo[3], hi[0], hi[1], hi[2], hi[3]};
                    o[dt] = __builtin_amdgcn_mfma_f32_16x16x32_bf16(pfrag, vf, o[dt], 0, 0, 0);
                }
            }
            den += shx(den, lane, 16); den += shx(den, lane, 32);
#pragma unroll
            for (int dt = 0; dt < 4; ++dt)
#pragma unroll
                for (int rg = 0; rg < 4; ++rg) {
                    const int tl = (tq0 - t0) + d * (4 * gq + rg), idx = tl * 64 + 16 * dt + l15;
                    if (pi == 0) OACC[idx] = o[dt][rg]; else OACC[idx] += o[dt][rg];
                }
            if (gq == 0) { const int tl = (tq0 - t0) + d * l15; if (pi == 0) DEN[tl] = den; else DEN[tl] += den; }
        }
        LBAR();
    }
    for (int k = 0; k < 32; ++k) {
        const int idx = tid + 512 * k, tl = idx >> 6, dc = idx & 63;
        mixed[(size_t)(t0 + tl) * DM + 256 + h * 64 + dc] = f2bf(OACC[idx] * __builtin_amdgcn_rcpf(DEN[tl]));
    }
}

__device__ __forceinline__ void phase_mixers(const Ctx& a, int l, LAS unsigned char* lds) {
    unsigned* ctr = (unsigned*)(a.ws + WS_CTL) + 64 * l;
    lds = lds_l(lds);
    LAS int* sun = (LAS int*)(lds + LDS_UNIT_OFF);
    constexpr int N_LRU = 192, N_ATT = 1536, N_POOL = 1024;
    for (;;) {
        __syncthreads();
        if (tid_w(a.wv) == 0) *sun = (int)atomicAdd(ctr, 1u);
        __syncthreads();
        const int u = *sun;
        if (u >= N_LRU + N_ATT + N_POOL) break;
        if (u < N_LRU) lru_unit(a, l, u / 6, u % 6, lds);
        else if (u < N_LRU + N_ATT) { const int v = u - N_LRU; dattn_unit(a, v / 48, (v % 48) / 8, v % 8, lds); }
        else { const int v = u - N_LRU - N_ATT; pool_unit(a, l, v / 32, v % 32, lds); }
    }
}

__device__ __forceinline__ void phase_xattn(const Ctx& a, int l, LAS unsigned char* lds) {
    lds = lds_l(lds);
    const int tid = tid_w(a.wv), lane = tid & 63, wave = tid >> 6, l15 = lane & 15, gq = lane >> 4;
    LAS unsigned char* KL = lds;
    LAS unsigned char* VL = lds + 16896;
    LAS float* RK = (LAS float*)(lds + 34304);
    const bf16_t* qm = (const bf16_t*)(a.ws + WS_QM);
    const float* qst = (const float*)(a.ws + WS_QST);
    const bf16_t* kv = (const bf16_t*)(a.ws + WS_KV);
    const float* kst = (const float*)(a.ws + WS_KST);
    bf16_t* om = (bf16_t*)(a.ws + WS_MIXED);
    const int trq = (l15 >> 2), trp = (l15 & 3);
    for (int xu = blockIdx.x; xu < NBATCH * 4 * 16; xu += gridDim.x) {
        const int b = xu >> 6, h = (xu >> 4) & 3, qb = xu & 15;
        LBAR();
        if (tid < 256) {
            const f32x4* kp = (const f32x4*)(kst + (size_t)(b * 256 + tid) * 256 + l * 64 + h * 8);
            const f32x4 k0 = kp[0], k1 = kp[1];
            RK[tid] = rsqrtf((((k0[0] + k0[1]) + (k0[2] + k0[3])) + ((k1[0] + k1[1]) + (k1[2] + k1[3]))) * (1.0f / 256.0f) + EPSF);
        }
        const size_t qrow = (size_t)b * SEQ + qb * 128 + wave * 16 + l15;
        bf16x8 qf[8];
#pragma unroll
        for (int ks = 0; ks < 8; ++ks) qf[ks] = *(const bf16x8*)(qm + qrow * DM + h * 256 + 32 * ks + 8 * gq);
        float rq;
        { const f32x4* qp = (const f32x4*)(qst + qrow * 32 + h * 8); const f32x4 q0 = qp[0], q1 = qp[1];
          rq = rsqrtf((((q0[0] + q0[1]) + (q0[2] + q0[3])) + ((q1[0] + q1[1]) + (q1[2] + q1[3]))) * (1.0f / 256.0f) + EPSF); }
        f32x4 o[16];
#pragma unroll
        for (int dt = 0; dt < 16; ++dt) o[dt] = (f32x4){0.f, 0.f, 0.f, 0.f};
        float den = 0.f;
        const bf16_t* kvb = kv + (size_t)(b * 256) * 8192 + l * 2048 + h * 256;
        u32x4 kpre[2], vpre[2];
#pragma unroll
        for (int k = 0; k < 2; ++k) {
            const int idx = tid + 512 * k, row = idx >> 5, chk = idx & 31;
            const bf16_t* src = kvb + (size_t)row * 8192 + chk * 8;
            kpre[k] = *(const u32x4*)src; vpre[k] = *(const u32x4*)(src + 1024);
        }
#pragma unroll 1
        for (int c = 0; c < 8; ++c) {
            LBAR();
#pragma unroll
            for (int k = 0; k < 2; ++k) {
                const int idx = tid + 512 * k, row = idx >> 5, chk = idx & 31;
                *(LAS u32x4*)(KL + row * 528 + chk * 16) = kpre[k];
                *(LAS u32x4*)(VL + row * 544 + chk * 16) = vpre[k];
            }
            if (c < 7) {
#pragma unroll
                for (int k = 0; k < 2; ++k) {
                    const int idx = tid + 512 * k, row = idx >> 5, chk = idx & 31;
                    const bf16_t* src = kvb + (size_t)(32 * (c + 1) + row) * 8192 + chk * 8;
                    kpre[k] = *(const u32x4*)src; vpre[k] = *(const u32x4*)(src + 1024);
                }
            }
            LBAR();
            float p[2][4];
#pragma unroll
            for (int T = 0; T < 2; ++T) {
                f32x4 s = (f32x4){0.f, 0.f, 0.f, 0.f};
#pragma unroll
                for (int ks = 0; ks < 8; ++ks) {
                    const bf16x8 kf = *(LAS const bf16x8*)(KL + (16 * T + l15) * 528 + (32 * ks + 8 * gq) * 2);
                    s = __builtin_amdgcn_mfma_f32_16x16x32_bf16(kf, qf[ks], s, 0, 0, 0);
                }
                const f32x4 rk4 = *(LAS const f32x4*)(RK + 32 * c + 16 * T + 4 * gq);
#pragma unroll
                for (int rg = 0; rg < 4; ++rg) { const float pv = __builtin_amdgcn_exp2f(s[rg] * rq * rk4[rg]); p[T][rg] = pv; den += pv; }
            }
            u32x4 pw; pw.x = pkbf(p[0][0], p[0][1]); pw.y = pkbf(p[0][2], p[0][3]); pw.z = pkbf(p[1][0], p[1][1]); pw.w = pkbf(p[1][2], p[1][3]);
            const bf16x8 pfrag = __builtin_bit_cast(bf16x8, pw);
#pragma unroll
            for (int dt = 0; dt < 16; ++dt) {
                const s16x4 lo = vtr(VL + (4 * gq + trq) * 544 + (16 * dt + 4 * trp) * 2);
                const s16x4 hi = vtr(VL + (16 + 4 * gq + trq) * 544 + (16 * dt + 4 * trp) * 2);
                const bf16x8 vf = (bf16x8){lo[0], lo[1], lo[2], lo[3], hi[0], hi[1], hi[2], hi[3]};
                o[dt] = __builtin_amdgcn_mfma_f32_16x16x32_bf16(pfrag, vf, o[dt], 0, 0, 0);
            }
        }
        den += shx(den, lane, 16); den += shx(den, lane, 32);
        float inv[4];
#pragma unroll
        for (int rg = 0; rg < 4; ++rg) inv[rg] = 1.0f / shi(den, 4 * gq + rg);
        const size_t orow0 = (size_t)b * SEQ + qb * 128 + wave * 16 + 4 * gq;
#pragma unroll
        for (int dt = 0; dt < 16; ++dt)
#pragma unroll
            for (int rg = 0; rg < 4; ++rg) om[(orow0 + rg) * DM + h * 256 + 16 * dt + l15] = f2bf(o[dt][rg] * inv[rg]);
    }
}

__device__ __forceinline__ void phase_act(const Ctx& a, int l) {
    const bf16_t* gu = (const bf16_t*)(a.ws + WS_GU);
    bf16_t* act = (bf16_t*)(a.ws + WS_ACT);
    const float* cw = inptr(a, 25) + (size_t)l * 3 * DFF; const float* cb = inptr(a, 26) + (size_t)l * DFF;
    const int total = MHALF * (DFF / 8);
    for (int idx = blockIdx.x * NTHREADS + tid_w(a.wv); idx < total; idx += gridDim.x * NTHREADS) {
        const int row = idx / (DFF / 8), f0 = (idx % (DFF / 8)) * 8, tl = row & (SEQ - 1);
        const bf16_t* gp = gu + (size_t)row * DFF2 + f0;
        const u32x4 g0 = *(const u32x4*)gp;
        const u32x4 g1 = (tl >= 1) ? *(const u32x4*)(gp - DFF2) : (u32x4){0u, 0u, 0u, 0u};
        const u32x4 g2 = (tl >= 2) ? *(const u32x4*)(gp - 2 * DFF2) : (u32x4){0u, 0u, 0u, 0u};
        const u32x4 uu = *(const u32x4*)(gp + DFF);
        float r[8];
#pragma unroll
        for (int j = 0; j < 4; ++j) {
            const int f = f0 + 2 * j;
            const float c0 = cb[f] + cw[f] * bflo(g0[j]) + cw[DFF + f] * bflo(g1[j]) + cw[2 * DFF + f] * bflo(g2[j]);
            const float c1 = cb[f + 1] + cw[f + 1] * bfhi(g0[j]) + cw[DFF + f + 1] * bfhi(g1[j]) + cw[2 * DFF + f + 1] * bfhi(g2[j]);
            r[2 * j] = gelu_tanh(c0) * bflo(uu[j]); r[2 * j + 1] = gelu_tanh(c1) * bfhi(uu[j]);
        }
        u32x4 w; w.x = pkbf(r[0], r[1]); w.y = pkbf(r[2], r[3]); w.z = pkbf(r[4], r[5]); w.w = pkbf(r[6], r[7]);
        *(u32x4*)(act + (size_t)row * DFF + f0) = w;
    }
}

__global__ void __launch_bounds__(NTHREADS, 2) trunk_fwd(Args ka) {
    extern __shared__ __attribute__((aligned(16))) unsigned char lds_raw[];
    LAS unsigned char* lds = (LAS unsigned char*)lds_raw;
    cg::grid_group grid = cg::this_grid();
    {
        LAS unsigned long long* tw = (LAS unsigned long long*)(lds + LDS_TBL_OFF);
        if (threadIdx.x == 0) {
#pragma unroll
            for (int i = 0; i < 28; ++i) tw[i] = (unsigned long long)ka.in[i];
        }
        __syncthreads();
    }
    Ctx a; a.tbl = (LAS const unsigned long long*)(lds + LDS_TBL_OFF); a.out = ka.out; a.ws = ka.ws; a.wv = __builtin_amdgcn_readfirstlane((int)(threadIdx.x >> 6));
    unsigned char* ws = a.ws;
    bf16_t* hb = (bf16_t*)(ws + WS_HB);
    float* st = (float*)(ws + WS_ST);

    phase_prologue(a, lds);
    grid.sync();
    {
        EpiBf<false> E{(bf16_t*)(ws + WS_KV), 8192, (const float*)(ws + WS_STM), (float*)(ws + WS_KST), 256, nullptr, nullptr, nullptr};
        run_gemm(a.wv, lds, (const bf16_t*)(ws + WS_MEMB), (const bf16_t*)(ws + WS_WKV), MEMROWS, 8192, DM, E);
    }
    for (int l = 0; l < DEPTH; ++l) {
        const unsigned char* wl = ws + WS_W + (size_t)l * W_LAYER;
        {
            EpiBf<true> E{(bf16_t*)(ws + WS_PROJ), NPROJ, st, nullptr, 0, nullptr, inptr(a, 6) + l * 64, inptr(a, 7) + l * 64};
            run_gemm(a.wv, lds, hb, (const bf16_t*)(wl + W_IN), MTOK, NPROJ, DM, E);
        }
        grid.sync();
        phase_mixers(a, l, lds);
        grid.sync();
        {
            EpiRes E{l == 0 ? inptr(a, 0) : a.out, a.out, hb, st};
            run_gemm(a.wv, lds, (const bf16_t*)(ws + WS_MIXED), (const bf16_t*)(wl + W_OUT), MTOK, DM, DM, E);
        }
        grid.sync();
        {
            EpiBf<false> E{(bf16_t*)(ws + WS_QM), DM, st, (float*)(ws + WS_QST), 32, (const float*)(ws + WS_CS) + l * 1024, nullptr, nullptr};
            run_gemm(a.wv, lds, hb, (const bf16_t*)(wl + W_Q), MTOK, DM, DM, E);
        }
        grid.sync();
        phase_xattn(a, l, lds);
        grid.sync();
        {
            EpiRes E{a.out, a.out, hb, st};
            run_gemm(a.wv, lds, (const bf16_t*)(ws + WS_MIXED), (const bf16_t*)(wl + W_O), MTOK, DM, DM, E);
        }
        grid.sync();
        for (int hf = 0; hf < 2; ++hf) {
            {
                EpiBf<false> E{(bf16_t*)(ws + WS_GU), DFF2, st + (size_t)hf * MHALF * 16, nullptr, 0, nullptr, nullptr, nullptr};
                run_gemm(a.wv, lds, hb + (size_t)hf * MHALF * DM, (const bf16_t*)(wl + W_UP), MHALF, DFF2, DM, E);
            }
            grid.sync();
            phase_act(a, l);
            grid.sync();
            {
                float* oh = a.out + (size_t)hf * MHALF * DM;
                EpiRes E{oh, oh, hb + (size_t)hf * MHALF * DM, st + (size_t)hf * MHALF * 16};
                run_gemm(a.wv, lds, (const bf16_t*)(ws + WS_ACT), (const bf16_t*)(wl + W_DOWN), MHALF, DM, DFF, E);
            }
            grid.sync();
        }
    }
}

extern "C" void kernel_launch(void* const* d_in, const int* in_sizes, int n_in, void* d_out, int out_size, void* d_ws, size_t ws_size, hipStream_t stream) {
    static int grid = 0;
    if (grid == 0) {
        if (n_in != 28 || in_sizes[0] != MTOK * DM || out_size != MTOK * DM || ws_size < WS_END) {
            fprintf(stderr, "kernel_launch: unexpected shapes (n_in %d, in0 %d, out %d, ws %zu; need ws >= %zu); nothing launched\n", n_in, n_in > 0 ? in_sizes[0] : -1, out_size, ws_size, (size_t)WS_END);
            grid = -1; return;
        }
        int dev = 0, cus = 0, per_cu = 0;
        hipGetDevice(&dev);
        hipDeviceGetAttribute(&cus, hipDeviceAttributeMultiprocessorCount, dev);
        if (hipFuncSetAttribute((const void*)trunk_fwd, hipFuncAttributeMaxDynamicSharedMemorySize, LDS_BYTES) != hipSuccess) { fprintf(stderr, "kernel_launch: hipFuncSetAttribute failed\n"); grid = -1; return; }
        if (hipOccupancyMaxActiveBlocksPerMultiprocessor(&per_cu, (const void*)trunk_fwd, NTHREADS, LDS_BYTES) != hipSuccess || per_cu < 1) { fprintf(stderr, "kernel_launch: occupancy query says %d blocks per CU\n", per_cu); per_cu = 1; }
        (void)hipGetLastError();
        grid = cus;
    }
    if (grid < 0) return;
    (void)hipMemsetAsync((char*)d_ws + WS_CTL, 0, 4096, stream);
    Args a{};
    for (int i = 0; i < 28; ++i) a.in[i] = (const float*)d_in[i];
    a.out = (float*)d_out; a.ws = (unsigned char*)d_ws;
    void* args[] = {&a};
    hipError_t e = hipLaunchCooperativeKernel((const void*)trunk_fwd, dim3(grid), dim3(NTHREADS), args, LDS_BYTES, stream);
    if (e != hipSuccess) fprintf(stderr, "cooperative launch failed: %s (grid %d)\n", hipGetErrorString(e), grid);
}
```

```cpp
#include <hip/hip_runtime.h>
#include <hip/hip_cooperative_groups.h>
#include <cstdio>
#include <cstdint>
namespace cg = cooperative_groups;
namespace pg8 {
#define PG8_LAS __attribute__((address_space(3)))
typedef unsigned short bf16_t;
typedef short bf16x8 __attribute__((ext_vector_type(8)));
typedef float f32x4 __attribute__((ext_vector_type(4)));
typedef unsigned u32x4 __attribute__((ext_vector_type(4)));
constexpr int BM = 256, BK = 64, HALF = 128, HTB = HALF * BK * 2  , STAGE_BYTES = 8 * HTB, NXCD = 8, WGM = 8;

__host__ __device__ __forceinline__ int lds_byte(int r, int c) { const int st = (r >> 4) * 2 + (c >> 5), rr = r & 15, cc = c & 31, ob = rr * 64 + cc * 2; return st * 1024 + (ob ^ (((ob >> 9) & 1) << 5)); }
__host__ __device__ __forceinline__ void stage_rc(int b, int& R, int& C) { const int st = b / 1024, sb = b % 1024, swz = sb ^ (((sb >> 9) & 1) << 5); R = (st >> 1) * 16 + swz / 64; C = (st & 1) * 32 + (swz % 64) / 2; }
__host__ __device__ __forceinline__ int perm32(int rho) { const int n = rho >> 4, i = rho & 15; return 8 * (i >> 2) + 4 * n + (i & 3); }

struct Unit { int pm, pn; };
struct Gemm { const bf16_t* A; const bf16_t* Bt; int M, N, K; };

struct StaticOrder {
    int nM, nN, nwg, G, c;
    __host__ __device__ void init(int M, int N, int G_, int c_) { nM = M / BM; nN = N / BM; nwg = nM * nN; G = G_; c = c_; }
    __host__ __device__ bool next(int i, Unit& u) const {
        const long L = (long)i * G + c; if (L >= nwg) return false;
        int wgid = (int)L; { const int q = nwg / NXCD, r = nwg % NXCD, xcd = wgid % NXCD, off = wgid / NXCD; wgid = (xcd < r ? xcd * (q + 1) : r * (q + 1) + (xcd - r) * q) + off; }
        const int nig = WGM * nN, gid = wgid / nig, fm = gid * WGM, gsz = (nM - fm) < WGM ? (nM - fm) : WGM;
        u.pm = fm + ((wgid % nig) % gsz); u.pn = (wgid % nig) / gsz; return true;
    }
    __device__ __forceinline__ void a_ready(const Unit&) const {}
    __device__ __forceinline__ void done(const Unit&) const {}
};

__device__ __forceinline__ unsigned cvt_pk_bf16(float lo, float hi) { unsigned r; asm volatile("v_cvt_pk_bf16_f32 %0, %1, %2" : "=v"(r) : "v"(lo), "v"(hi)); return r; }
typedef float f32x2 __attribute__((ext_vector_type(2)));
template <class Epi, class Sched, bool ALIGN_EPI = false, bool SP2 = false, bool APERM = false>
__device__ __forceinline__ void gemm_phase(int tid_in, PG8_LAS unsigned char* lds, const Gemm g, const Sched& S, const Epi& E) {
    int tid_ = tid_in; asm volatile("" : "+v"(tid_));
    const int tid = tid_, wid = __builtin_amdgcn_readfirstlane(tid >> 6), lane = tid & 63, wr = wid >> 2, wc = wid & 3, fr = lane & 15, fq = lane >> 4;
    const int K = g.K, nt = K / BK;
    unsigned voffA[2], voffB[2];
#pragma unroll
    for (int i = 0; i < 2; ++i) { int R, C; stage_rc(tid * 16 + i * 8192, R, C); const int Rb = Epi::PERM ? ((R & ~31) + perm32(R & 31)) : R;
        const int Ra = APERM ? ((16 * (R >> 6) + (R & 15)) * 8 + ((R >> 4) & 3)) : R;
        voffA[i] = (unsigned)(Ra * K + C) * 2u; voffB[i] = (unsigned)(Rb * K + C) * 2u; }
    const size_t kstep = (size_t)(BK * 2);
    const size_t hstep = (size_t)HALF * K * 2;
    const size_t tstep = 2 * hstep;
    const size_t hstepA = APERM ? (size_t)4 * K * 2 : hstep;
    const unsigned ldsw = (unsigned)wid * 1024u;
    const int aoff = lds_byte(wr * 64 + fr, fq * 8), boff = lds_byte(wc * 32 + fr, fq * 8);
#define PG8_SA(b, h) (((b) * 2 + (h)) * HTB)
#define PG8_SB(b, h) ((4 + (b) * 2 + (h)) * HTB)
#define PG8_STAGE(bufoff, gbase, voff) do { _Pragma("unroll") for (int _i = 0; _i < 2; ++_i) \
        __builtin_amdgcn_global_load_lds((const unsigned*)((const char*)(gbase) + (voff)[_i]), (PG8_LAS unsigned*)(lds + (bufoff) + ldsw + _i * 8192), 16, 0, 0); } while (0)
#define PG8_LDA(dst, b, h) do { _Pragma("unroll") for (int m = 0; m < 4; ++m) _Pragma("unroll") for (int k = 0; k < 2; ++k) dst[m][k] = *(const PG8_LAS bf16x8*)(lds + PG8_SA(b, h) + aoff + m * 2048 + k * 1024); } while (0)
#define PG8_LDB(dst, b, h) do { _Pragma("unroll") for (int n = 0; n < 2; ++n) _Pragma("unroll") for (int k = 0; k < 2; ++k) dst[n][k] = *(const PG8_LAS bf16x8*)(lds + PG8_SB(b, h) + boff + n * 2048 + k * 1024); } while (0)
#define PG8_MMA(ai, bj, At, Bt) do { __builtin_amdgcn_s_setprio(1); _Pragma("unroll") for (int m = 0; m < 4; ++m) _Pragma("unroll") for (int n = 0; n < 2; ++n) _Pragma("unroll") for (int k = 0; k < 2; ++k) \
        acc[ai][bj][m][n] = __builtin_amdgcn_mfma_f32_16x16x32_bf16(Bt[n][k], At[m][k], acc[ai][bj][m][n], 0, 0, 0); __builtin_amdgcn_s_setprio(0); } while (0)
#define PG8_WAIT_V(n) asm volatile("s_waitcnt vmcnt(" #n ")" ::: "memory")
#define PG8_WAIT_L(n) asm volatile("s_waitcnt lgkmcnt(" #n ")" ::: "memory")
#define PG8_BAR __builtin_amdgcn_s_barrier()
#define PG8_SCHED __builtin_amdgcn_sched_barrier(0)
    Unit cur, nxt; int ui = 0;
    if (!S.next(0, cur)) return;
    f32x4 acc[2][2][4][2];
#pragma unroll
    for (int a = 0; a < 2; ++a)
#pragma unroll
        for (int b = 0; b < 2; ++b)
#pragma unroll
            for (int m = 0; m < 4; ++m)
#pragma unroll
                for (int n = 0; n < 2; ++n) acc[a][b][m][n] = (f32x4){0.f, 0.f, 0.f, 0.f};
    bf16x8 At[4][2], B0[2][2], B1[2][2];
    const char* cA = (const char*)g.A + (size_t)cur.pm * tstep; const char* cB = (const char*)g.Bt + (size_t)cur.pn * tstep;
    S.a_ready(cur);
    if constexpr (SP2) {
        PG8_STAGE(PG8_SB(0, 0), cB, voffB); PG8_STAGE(PG8_SB(0, 1), cB + hstep, voffB); PG8_STAGE(PG8_SA(0, 0), cA, voffA); PG8_STAGE(PG8_SA(0, 1), cA + hstepA, voffA);
        if (wr == 1) PG8_BAR;
        PG8_WAIT_V(2); PG8_BAR;
        PG8_STAGE(PG8_SB(1, 0), cB + kstep, voffB); PG8_STAGE(PG8_SA(1, 0), cA + kstep, voffA); PG8_STAGE(PG8_SB(1, 1), cB + hstep + kstep, voffB);
        PG8_WAIT_V(6); PG8_BAR;
    } else {
        PG8_STAGE(PG8_SB(0, 0), cB, voffB); PG8_STAGE(PG8_SA(0, 0), cA, voffA); PG8_STAGE(PG8_SB(0, 1), cB + hstep, voffB); PG8_STAGE(PG8_SA(0, 1), cA + hstepA, voffA);
        if (wr == 1) PG8_BAR;
        PG8_WAIT_V(4); PG8_BAR;
        PG8_STAGE(PG8_SB(1, 0), cB + kstep, voffB); PG8_STAGE(PG8_SA(1, 0), cA + kstep, voffA); PG8_STAGE(PG8_SB(1, 1), cB + hstep + kstep, voffB);
        PG8_WAIT_V(6); PG8_BAR;
    }
    for (;;) {
        const bool has_next = S.next(ui + 1, nxt);
        const char* nA = has_next ? (const char*)g.A + (size_t)nxt.pm * tstep : cA; const char* nB = has_next ? (const char*)g.Bt + (size_t)nxt.pn * tstep : cB;
        for (int t = 0; t < nt; t += 2) {
            const bool last = (t == nt - 2);
            const char* a1 = cA + (size_t)(t + 1) * kstep;
            const char* a2 = last ? nA : cA + (size_t)(t + 2) * kstep; const char* b2 = last ? nB : cB + (size_t)(t + 2) * kstep;
            const char* a3 = a2 + kstep; const char* b3 = b2 + kstep;
            if (last && has_next) S.a_ready(nxt);
            if constexpr (SP2) {
            PG8_LDB(B0, 0, 0); PG8_LDB(B1, 0, 1); PG8_SCHED; PG8_LDA(At, 0, 0); PG8_STAGE(PG8_SA(1, 1), a1 + hstepA, voffA);
            PG8_WAIT_V(8); PG8_WAIT_L(0); PG8_BAR; PG8_MMA(0, 0, At, B0); PG8_MMA(0, 1, At, B1); PG8_BAR; PG8_SCHED;
            PG8_LDA(At, 0, 1); PG8_STAGE(PG8_SB(0, 0), b2, voffB); PG8_STAGE(PG8_SB(0, 1), b2 + hstep, voffB); PG8_STAGE(PG8_SA(0, 0), a2, voffA);
            PG8_WAIT_V(8); PG8_WAIT_L(0); PG8_BAR; PG8_MMA(1, 0, At, B0); PG8_MMA(1, 1, At, B1); PG8_BAR; PG8_SCHED;
            PG8_LDB(B0, 1, 0); PG8_LDB(B1, 1, 1); PG8_SCHED; PG8_LDA(At, 1, 0); PG8_STAGE(PG8_SA(0, 1), a2 + hstepA, voffA);
            PG8_WAIT_V(8); PG8_WAIT_L(0); PG8_BAR; PG8_MMA(0, 0, At, B0); PG8_MMA(0, 1, At, B1); PG8_BAR; PG8_SCHED;
            PG8_LDA(At, 1, 1); PG8_STAGE(PG8_SB(1, 0), b3, voffB); PG8_STAGE(PG8_SB(1, 1), b3 + hstep, voffB); PG8_STAGE(PG8_SA(1, 0), a3, voffA);
            PG8_WAIT_V(8); PG8_WAIT_L(0); PG8_BAR; PG8_MMA(1, 0, At, B0); PG8_MMA(1, 1, At, B1); PG8_BAR; PG8_SCHED;
            } else {
            PG8_LDB(B0, 0, 0); PG8_SCHED; PG8_LDA(At, 0, 0); PG8_STAGE(PG8_SA(1, 1), a1 + hstepA, voffA);
            PG8_WAIT_L(8); PG8_BAR; PG8_WAIT_L(0); PG8_MMA(0, 0, At, B0); PG8_BAR; PG8_SCHED;
            PG8_LDB(B1, 0, 1); PG8_STAGE(PG8_SB(0, 0), b2, voffB);
            PG8_BAR; PG8_WAIT_L(0); PG8_MMA(0, 1, At, B1); PG8_BAR;
            PG8_LDA(At, 0, 1); PG8_STAGE(PG8_SA(0, 0), a2, voffA);
            PG8_BAR; PG8_WAIT_L(0); PG8_MMA(1, 0, At, B0); PG8_BAR; PG8_SCHED;
            PG8_STAGE(PG8_SB(0, 1), b2 + hstep, voffB);
            PG8_WAIT_V(6); PG8_BAR; PG8_MMA(1, 1, At, B1); PG8_BAR;
            PG8_LDB(B0, 1, 0); PG8_SCHED; PG8_LDA(At, 1, 0); PG8_STAGE(PG8_SA(0, 1), a2 + hstepA, voffA);
            PG8_WAIT_L(8); PG8_BAR; PG8_WAIT_L(0); PG8_MMA(0, 0, At, B0); PG8_BAR; PG8_SCHED;
            PG8_LDB(B1, 1, 1); PG8_STAGE(PG8_SB(1, 0), b3, voffB);
            PG8_BAR; PG8_WAIT_L(0); PG8_MMA(0, 1, At, B1); PG8_BAR;
            PG8_LDA(At, 1, 1); PG8_STAGE(PG8_SA(1, 0), a3, voffA);
            PG8_BAR; PG8_WAIT_L(0); PG8_MMA(1, 0, At, B0); PG8_BAR; PG8_SCHED;
            PG8_STAGE(PG8_SB(1, 1), b3 + hstep, voffB);
            PG8_WAIT_V(6); PG8_BAR; PG8_MMA(1, 1, At, B1); PG8_BAR;
            }
        }
        if constexpr (ALIGN_EPI) { if (wr == 0) PG8_BAR; }
        if constexpr (!Epi::AFTER_DRAIN) { E(acc, cur, wr, wc, fr, fq); S.done(cur); }
        if (!has_next) break;
#pragma unroll
        for (int a = 0; a < 2; ++a)
#pragma unroll
            for (int b = 0; b < 2; ++b)
#pragma unroll
                for (int m = 0; m < 4; ++m)
#pragma unroll
                    for (int n = 0; n < 2; ++n) acc[a][b][m][n] = (f32x4){0.f, 0.f, 0.f, 0.f};
        cur = nxt; cA = nA; cB = nB; ++ui;
        if constexpr (ALIGN_EPI) { if (wr == 1) PG8_BAR; }
    }
    PG8_WAIT_V(0);
    if constexpr (!ALIGN_EPI) { if (wr == 0) PG8_BAR; }
    PG8_BAR;
    if constexpr (Epi::AFTER_DRAIN) { E.fused(acc, cur, wr, wc, fr, fq, lds, wid, lane); S.done(cur); }
#undef PG8_SA
#undef PG8_SB
#undef PG8_STAGE
#undef PG8_LDA
#undef PG8_LDB
#undef PG8_MMA
#undef PG8_WAIT_V
#undef PG8_WAIT_L
#undef PG8_BAR
#undef PG8_SCHED
}
}

using pg8::bf16_t; using pg8::bf16x8; using pg8::f32x4; using pg8::u32x4;
typedef unsigned u32x2 __attribute__((ext_vector_type(2)));
typedef short s16x4 __attribute__((ext_vector_type(4)));
#define LAS __attribute__((address_space(3)))

constexpr int NTHREADS = 512;
constexpr int MTOK = 65536, DM = 1024, SEQ = 2048, NBATCH = 32, DEPTH = 4;
constexpr int NPROJ = 2304;
constexpr int INW = 2176;
constexpr int DFF = 2816, DFF2 = 5632;
constexpr int MEMROWS = 8192;
constexpr int MHALF = 32768;
constexpr float EPSF = 1e-6f;
constexpr float LOG2E = 1.4426950408889634f;
constexpr int LDS_BYTES = 155648;
constexpr int LDS_UNIT_OFF = 155648 - 64;
constexpr int LDS_TBL_OFF = 155648 - 512;

constexpr size_t MiB = 1u << 20;
constexpr size_t WS_CTL = 0;
constexpr size_t WS_ST = 1 * MiB;
constexpr size_t WS_STM = 5 * MiB;
constexpr size_t WS_CS = 5 * MiB + 512 * 1024;
constexpr size_t WS_KST = 6 * MiB;
constexpr size_t WS_QST = 14 * MiB;
constexpr size_t WS_MEMB = 22 * MiB;
constexpr size_t WS_W = 38 * MiB;
constexpr size_t W_LAYER = 27 * MiB;
constexpr size_t W_IN = 0, W_OUT = (size_t)(4.5 * MiB), W_Q = (size_t)(6.5 * MiB), W_O = (size_t)(8.5 * MiB), W_UP = (size_t)(10.5 * MiB), W_DOWN = (size_t)(21.5 * MiB);
constexpr size_t WS_WKV = WS_W + 4 * W_LAYER;
constexpr size_t WS_HB = 162 * MiB;
constexpr size_t WS_KV = 290 * MiB;
constexpr size_t WS_BIG = 418 * MiB;
constexpr size_t WS_PROJ = WS_BIG;
constexpr size_t WS_MIXED = WS_BIG + 288 * MiB;
constexpr size_t WS_QM = WS_MIXED + 128 * MiB;
constexpr size_t WS_ACT = WS_BIG;
constexpr size_t WS_SG = WS_BIG + 352 * MiB;
constexpr size_t WS_SU = WS_BIG + 376 * MiB;
constexpr size_t WS_END = WS_QM + 128 * MiB;
static_assert(WS_WKV + 16 * MiB <= WS_HB, "ws map");
static_assert(WS_SU + 12 * MiB <= WS_END, "ws map");

struct Args { const float* in[28]; float* out; unsigned char* ws; };
struct Ctx { LAS const unsigned long long* tbl; float* out; unsigned char* ws; int wv; };
__device__ __forceinline__ const float* inptr(const Ctx& c, int i) {
    const unsigned long long v = c.tbl[i];
    const unsigned lo = __builtin_amdgcn_readfirstlane((unsigned)v), hi = __builtin_amdgcn_readfirstlane((unsigned)(v >> 32));
    return (const float*)(((unsigned long long)hi << 32) | lo);
}

__device__ __forceinline__ float bf2f(unsigned short b) { return __uint_as_float(((unsigned)b) << 16); }
__device__ __forceinline__ float bflo(unsigned w) { return __uint_as_float(w << 16); }
__device__ __forceinline__ float bfhi(unsigned w) { return __uint_as_float(w & 0xffff0000u); }
__device__ __forceinline__ unsigned pkbf(float lo, float hi) { unsigned r; asm("v_cvt_pk_bf16_f32 %0, %1, %2" : "=v"(r) : "v"(lo), "v"(hi)); return r; }
__device__ __forceinline__ unsigned short f2bf(float f) { return (unsigned short)(pkbf(f, 0.f) & 0xffffu); }
__device__ __forceinline__ float shx(float v, int lane, int m) { return __int_as_float(__builtin_amdgcn_ds_bpermute((lane ^ m) << 2, __float_as_int(v))); }
__device__ __forceinline__ float shi(float v, int src) { return __int_as_float(__builtin_amdgcn_ds_bpermute(src << 2, __float_as_int(v))); }
__device__ __forceinline__ float wave_sum(float v, int lane) {
#pragma unroll
    for (int o = 1; o < 64; o <<= 1) v += shx(v, lane, o);
    return v;
}
__device__ __forceinline__ float sigmoidf_(float x) { return __builtin_amdgcn_rcpf(1.0f + __builtin_amdgcn_exp2f(-LOG2E * x)); }
__device__ __forceinline__ float gelu_tanh(float x) {
    const float u2 = (-2.0f * 0.7978845608028654f * LOG2E) * (x + 0.044715f * x * x * x);
    return x * __builtin_amdgcn_rcpf(1.0f + __builtin_amdgcn_exp2f(u2));
}
__device__ __forceinline__ LAS unsigned char* lds_l(LAS unsigned char* p) { unsigned v = (unsigned)(uintptr_t)p; asm volatile("" : "+s"(v)); return (LAS unsigned char*)(uintptr_t)v; }
__device__ __forceinline__ int tid_w(int wv) { int t = (wv << 6) + (int)__builtin_amdgcn_mbcnt_hi(~0u, __builtin_amdgcn_mbcnt_lo(~0u, 0u)); asm volatile("" : "+v"(t)); return t; }
__device__ __forceinline__ s16x4 vtr(LAS const unsigned char* p) {
    typedef short v4i16_t __attribute__((ext_vector_type(4)));
    return __builtin_bit_cast(s16x4, __builtin_amdgcn_ds_read_tr16_b64_v4i16((LAS v4i16_t*)p));
}

#define LBAR() do { asm volatile("s_waitcnt lgkmcnt(0)" ::: "memory"); __builtin_amdgcn_s_barrier(); asm volatile("" ::: "memory"); } while (0)

template <bool QKN> struct EpiBf {
    static constexpr bool PERM = true, AFTER_DRAIN = false;
    bf16_t* O; int ldc; const float* st; float* pst; int npg; const float* cs; const float* qg; const float* kg;
    __device__ __forceinline__ void operator()(const f32x4 (&acc)[2][2][4][2], const pg8::Unit& u, int wr, int wc, int fr, int fq) const {
        int kind = 0; const float* gsel = nullptr;
        if (QKN) { const int c0 = u.pn * 256 + 64 * wc; if (c0 >= 256 && c0 < 640) { kind = 1; gsel = qg; } else if (c0 >= 640 && c0 < 1024) { kind = 2; gsel = kg; } }
#pragma unroll
        for (int ai = 0; ai < 2; ++ai)
#pragma unroll
            for (int m = 0; m < 4; ++m) {
                const int r = u.pm * 256 + ai * 128 + wr * 64 + m * 16 + fr;
                const f32x4* sp = (const f32x4*)(st + (size_t)r * 16);
                const f32x4 s0 = sp[0], s1 = sp[1], s2 = sp[2], s3 = sp[3];
                const float ssum = ((s0[0] + s0[1]) + (s0[2] + s0[3])) + ((s1[0] + s1[1]) + (s1[2] + s1[3])) + ((s2[0] + s2[1]) + (s2[2] + s2[3])) + ((s3[0] + s3[1]) + (s3[2] + s3[3]));
                const float rs = rsqrtf(ssum * (1.0f / 1024.0f) + EPSF);
                f32x4 v[2][2];
#pragma unroll
                for (int bj = 0; bj < 2; ++bj)
#pragma unroll
                    for (int n = 0; n < 2; ++n) v[bj][n] = acc[ai][bj][m][n] * rs;
                if (QKN) {
                    if (kind != 0) {
                        float ss = 0.f;
#pragma unroll
                        for (int bj = 0; bj < 2; ++bj)
#pragma unroll
                            for (int n = 0; n < 2; ++n) ss += (v[bj][n][0] * v[bj][n][0] + v[bj][n][1] * v[bj][n][1]) + (v[bj][n][2] * v[bj][n][2] + v[bj][n][3] * v[bj][n][3]);
                        ss += shx(ss, fq * 16 + fr, 16); ss += shx(ss, fq * 16 + fr, 32);
                        float rn = rsqrtf(ss * (1.0f / 64.0f) + EPSF);
                        if (kind == 1) rn *= 0.125f * LOG2E;
#pragma unroll
                        for (int bj = 0; bj < 2; ++bj)
#pragma unroll
                            for (int n = 0; n < 2; ++n) { const f32x4 gv = *(const f32x4*)(gsel + 32 * bj + 8 * fq + 4 * n); v[bj][n] = v[bj][n] * rn * gv; }
                    }
                } else {
                    if (pst) {
#pragma unroll
                        for (int bj = 0; bj < 2; ++bj) {
                            float ss = (v[bj][0][0] * v[bj][0][0] + v[bj][0][1] * v[bj][0][1]) + (v[bj][0][2] * v[bj][0][2] + v[bj][0][3] * v[bj][0][3])
                                     + (v[bj][1][0] * v[bj][1][0] + v[bj][1][1] * v[bj][1][1]) + (v[bj][1][2] * v[bj][1][2] + v[bj][1][3] * v[bj][1][3]);
                            ss += shx(ss, fq * 16 + fr, 16); ss += shx(ss, fq * 16 + fr, 32);
                            if (fq == 0) pst[(size_t)r * npg + (u.pn * 8 + bj * 4 + wc)] = ss;
                        }
                    }
                    if (cs) {
#pragma unroll
                        for (int bj = 0; bj < 2; ++bj)
#pragma unroll
                            for (int n = 0; n < 2; ++n) { const f32x4 cv = *(const f32x4*)(cs + u.pn * 256 + bj * 128 + wc * 32 + 8 * fq + 4 * n); v[bj][n] = v[bj][n] * cv; }
                    }
                }
#pragma unroll
                for (int bj = 0; bj < 2; ++bj) {
                    const int col = QKN ? (u.pn * 256 + 64 * wc + 32 * bj + 8 * fq) : (u.pn * 256 + 128 * bj + 32 * wc + 8 * fq);
                    u32x4 w; w.x = pkbf(v[bj][0][0], v[bj][0][1]); w.y = pkbf(v[bj][0][2], v[bj][0][3]); w.z = pkbf(v[bj][1][0], v[bj][1][1]); w.w = pkbf(v[bj][1][2], v[bj][1][3]);
                    *(u32x4*)(O + (size_t)r * ldc + col) = w;
                }
                asm volatile("" ::: "memory");
            }
    }
};

struct EpiRes {
    static constexpr bool PERM = false, AFTER_DRAIN = false;
    const float* resid; float* out; bf16_t* hb; float* st;
    __device__ __forceinline__ void operator()(const f32x4 (&acc)[2][2][4][2], const pg8::Unit& u, int wr, int wc, int fr, int fq) const {
#pragma unroll
        for (int ai = 0; ai < 2; ++ai)
#pragma unroll
            for (int m = 0; m < 4; ++m) {
                const int r = u.pm * 256 + ai * 128 + wr * 64 + m * 16 + fr;
                float ss = 0.f;
#pragma unroll
                for (int bj = 0; bj < 2; ++bj)
#pragma unroll
                    for (int n = 0; n < 2; ++n) {
                        const size_t off = (size_t)r * DM + (u.pn * 256 + bj * 128 + wc * 32 + n * 16 + 4 * fq);
                        const f32x4 v = *(const f32x4*)(resid + off) + acc[ai][bj][m][n];
                        *(f32x4*)(out + off) = v;
                        u32x2 w; w.x = pkbf(v[0], v[1]); w.y = pkbf(v[2], v[3]);
                        *(u32x2*)(hb + off) = w;
                        ss += (v[0] * v[0] + v[1] * v[1]) + (v[2] * v[2] + v[3] * v[3]);
                    }
                ss += shx(ss, fq * 16 + fr, 16); ss += shx(ss, fq * 16 + fr, 32);
                if (fq == 0) st[(size_t)r * 16 + u.pn * 4 + wc] = ss;
                asm volatile("" ::: "memory");
            }
    }
};


struct EpiAct {
    static constexpr bool PERM = true, AFTER_DRAIN = false;
    bf16_t* act; const float* st; const float* cw; const float* cb; float* sg; float* su;
    __device__ __forceinline__ void operator()(const f32x4 (&acc)[2][2][4][2], const pg8::Unit& u, int wr, int wc, int fr, int fq) const {
        const int lane = fq * 16 + fr;
        const int tok0 = u.pm * 256 + (16 * wr + fr) * 8;
        const int f0 = u.pn * 128 + 32 * wc + 8 * fq;
        float rloc[2], rs[8];
#pragma unroll
        for (int k = 0; k < 2; ++k) {
            const f32x4* sp = (const f32x4*)(st + (size_t)(tok0 + 2 * fq + k) * 16);
            const f32x4 s0 = sp[0], s1 = sp[1], s2 = sp[2], s3 = sp[3];
            const float ssum = ((s0[0] + s0[1]) + (s0[2] + s0[3])) + ((s1[0] + s1[1]) + (s1[2] + s1[3])) + ((s2[0] + s2[1]) + (s2[2] + s2[3])) + ((s3[0] + s3[1]) + (s3[2] + s3[3]));
            rloc[k] = rsqrtf(ssum * (1.0f / 1024.0f) + EPSF);
        }
#pragma unroll
        for (int e = 0; e < 8; ++e) rs[e] = shi(rloc[e & 1], (e >> 1) * 16 + fr);
        float* sgp = sg + ((size_t)u.pm * 8 + wr * 4) * DFF + f0;
        float* sup = su + ((size_t)u.pm * 4 + wr * 2) * DFF + f0;
#pragma unroll
        for (int n = 0; n < 2; ++n) {
            unsigned res[8][2];
#pragma unroll
            for (int ip = 0; ip < 2; ++ip) {
                float av[2][8];
#pragma unroll
                for (int ic = 0; ic < 2; ++ic) {
                    const int i = 2 * ip + ic, c = 4 * n + i;
                    float g[8], uu[8];
#pragma unroll
                    for (int e = 0; e < 8; ++e) { g[e] = acc[e >> 2][0][e & 3][n][i] * rs[e]; uu[e] = acc[e >> 2][1][e & 3][n][i] * rs[e]; }
                    const float p1 = shi(g[7], lane - 1), p2 = shi(g[6], lane - 1);
                    const float w0 = cw[f0 + c], w1 = cw[DFF + f0 + c], w2 = cw[2 * DFF + f0 + c], bb = cb[f0 + c];
#pragma unroll
                    for (int e = 0; e < 8; ++e) {
                        const float gm1 = (e >= 1) ? g[e >= 1 ? e - 1 : 0] : p1;
                        const float gm2 = (e >= 2) ? g[e >= 2 ? e - 2 : 0] : (e == 1 ? p1 : p2);
                        av[ic][e] = gelu_tanh(bb + w0 * g[e] + w1 * gm1 + w2 * gm2) * uu[e];
                    }
                    if (fr == 0) { sgp[c] = g[0]; sgp[DFF + c] = g[1]; sup[c] = uu[0]; sup[DFF + c] = uu[1]; }
                    if (fr == 15) { sgp[2 * DFF + c] = g[6]; sgp[3 * DFF + c] = g[7]; }
                }
#pragma unroll
                for (int e = 0; e < 8; ++e) res[e][ip] = pkbf(av[0][e], av[1][e]);
                asm volatile("" ::: "memory");
            }
#pragma unroll
            for (int e = 0; e < 8; ++e) {
                if (fr == 0 && e < 2) continue;
                u32x2 w; w.x = res[e][0]; w.y = res[e][1];
                *(u32x2*)(act + (size_t)(tok0 + e) * DFF + f0 + 4 * n) = w;
            }
            asm volatile("" ::: "memory");
        }
    }
};

template <class Epi>
__device__ __forceinline__ void run_gemm(int wv, LAS unsigned char* lds, const bf16_t* A, const bf16_t* Bt, int M, int N, int K, const Epi& E) {
    pg8::Gemm g{A, Bt, M, N, K}; pg8::StaticOrder S; S.init(M, N, (int)gridDim.x, (int)blockIdx.x);
    pg8::gemm_phase<Epi, pg8::StaticOrder, true, true>(tid_w(wv), lds_l(lds), g, S, E);
}
template <class Epi>
__device__ __forceinline__ void run_gemm_aperm(int wv, LAS unsigned char* lds, const bf16_t* A, const bf16_t* Bt, int M, int N, int K, const Epi& E) {
    pg8::Gemm g{A, Bt, M, N, K}; pg8::StaticOrder S; S.init(M, N, (int)gridDim.x, (int)blockIdx.x);
    pg8::gemm_phase<Epi, pg8::StaticOrder, true, true, true>(tid_w(wv), lds_l(lds), g, S, E);
}

__device__ __forceinline__ void transpose_item(const float* W, int ldw, int K, const float* gain, bf16_t* WT, int dst_row0, bool zero, LAS float* scr, int k0, int n0, int lane) {
#pragma unroll 8
    for (int i = 0; i < 32; ++i) {
        const int kk = 2 * i + (lane >> 5);
        float v = 0.f;
        if (!zero) { v = W[(size_t)(k0 + kk) * ldw + n0 + (lane & 31)]; if (gain) v *= gain[k0 + kk]; }
        scr[kk * 33 + (lane & 31)] = v;
    }
    asm volatile("s_waitcnt lgkmcnt(0)" ::: "memory");
    const int c = lane & 7;
#pragma unroll
    for (int j = 0; j < 4; ++j) {
        const int n = (lane >> 3) + 8 * j; const LAS float* s = scr + (8 * c) * 33 + n;
        u32x4 o; o.x = pkbf(s[0 * 33], s[1 * 33]); o.y = pkbf(s[2 * 33], s[3 * 33]); o.z = pkbf(s[4 * 33], s[5 * 33]); o.w = pkbf(s[6 * 33], s[7 * 33]);
        *(u32x4*)(WT + (size_t)(dst_row0 + n) * K + k0 + 8 * c) = o;
    }
    asm volatile("s_waitcnt lgkmcnt(0)" ::: "memory");
}
__device__ __forceinline__ void row_to_bf16(const float* xrow, bf16_t* orow, float* strow, int lane) {
    const f32x4* xr = (const f32x4*)xrow + lane;
    f32x4 v[4]; float s = 0.f;
#pragma unroll
    for (int j = 0; j < 4; ++j) { v[j] = xr[64 * j]; s += (v[j][0] * v[j][0] + v[j][1] * v[j][1]) + (v[j][2] * v[j][2] + v[j][3] * v[j][3]); }
    s = wave_sum(s, lane);
    u32x2* o8 = (u32x2*)orow + lane;
#pragma unroll
    for (int j = 0; j < 4; ++j) { u32x2 w; w.x = pkbf(v[j][0], v[j][1]); w.y = pkbf(v[j][2], v[j][3]); o8[64 * j] = w; }
    if (lane < 16) strow[lane] = (lane == 0) ? s : 0.f;
}
__device__ __forceinline__ void phase_prologue(const Ctx& a, LAS unsigned char* lds) {
    lds = lds_l(lds);
    const int tid = tid_w(a.wv), lane = tid & 63, wave = tid >> 6;
    LAS float* scr = (LAS float*)(lds + wave * 16384);
    const int gw = blockIdx.x * 8 + wave, NGW = gridDim.x * 8;
    unsigned char* ws = a.ws;
    constexpr int I_IN = 16 * 72, I_SQ = 16 * 32, I_UP = 16 * 176, I_DN = 44 * 32, I_KV = 16 * 64;
    constexpr int I_LAYER = I_IN + 3 * I_SQ + I_UP + I_DN + I_KV;
    for (int it = gw; it < DEPTH * I_LAYER; it += NGW) {
        const int l = it / I_LAYER; int r = it % I_LAYER;
        bf16_t* wl = (bf16_t*)(ws + WS_W + (size_t)l * W_LAYER);
        if (r < I_IN) {
            const int kb = r / 72, nb = r % 72, n0 = nb * 32;
            const int dst = (n0 & ~255) + 128 * ((n0 >> 5) & 1) + 32 * ((n0 >> 6) & 3);
            transpose_item(inptr(a, 3) + (size_t)l * DM * INW, INW, DM, inptr(a, 2) + l * DM, (bf16_t*)((unsigned char*)wl + W_IN), dst, n0 >= INW, scr, kb * 64, n0, lane);
            continue;
        }
        r -= I_IN;
        if (r < I_SQ) { transpose_item(inptr(a, 15) + (size_t)l * DM * DM, DM, DM, nullptr, (bf16_t*)((unsigned char*)wl + W_OUT), (r % 32) * 32, false, scr, (r / 32) * 64, (r % 32) * 32, lane); continue; }
        r -= I_SQ;
        if (r < I_SQ) { transpose_item(inptr(a, 18) + (size_t)l * DM * DM, DM, DM, inptr(a, 16) + l * DM, (bf16_t*)((unsigned char*)wl + W_Q), (r % 32) * 32, false, scr, (r / 32) * 64, (r % 32) * 32, lane); continue; }
        r -= I_SQ;
        if (r < I_SQ) { transpose_item(inptr(a, 22) + (size_t)l * DM * DM, DM, DM, nullptr, (bf16_t*)((unsigned char*)wl + W_O), (r % 32) * 32, false, scr, (r / 32) * 64, (r % 32) * 32, lane); continue; }
        r -= I_SQ;
        if (r < I_UP) { transpose_item(inptr(a, 24) + (size_t)l * DM * DFF2, DFF2, DM, inptr(a, 23) + l * DM, (bf16_t*)((unsigned char*)wl + W_UP), ((((r % 176) * 32) % DFF) / 128) * 256 + 128 * (((r % 176) * 32) / DFF) + (((r % 176) * 32) % DFF) % 128, false, scr, (r / 176) * 64, (r % 176) * 32, lane); continue; }
        r -= I_UP;
        if (r < I_DN) { transpose_item(inptr(a, 27) + (size_t)l * DFF * DM, DM, DFF, nullptr, (bf16_t*)((unsigned char*)wl + W_DOWN), (r % 32) * 32, false, scr, (r / 32) * 64, (r % 32) * 32, lane); continue; }
        r -= I_DN;
        transpose_item(inptr(a, 19) + (size_t)l * DM * 2048, 2048, DM, inptr(a, 17) + l * DM, (bf16_t*)(ws + WS_WKV), l * 2048 + (r % 64) * 32, false, scr, (r / 64) * 64, (r % 64) * 32, lane);
    }
    for (int i = blockIdx.x * NTHREADS + tid; i < DEPTH * DM; i += gridDim.x * NTHREADS) { const int l = i >> 10, dd = i & 255; ((float*)(ws + WS_CS))[i] = inptr(a, 20)[l * 256 + dd] * inptr(a, 21)[l * 256 + dd] * (0.0625f * LOG2E); }
    for (int m = gw; m < MTOK; m += NGW) row_to_bf16(inptr(a, 0) + (size_t)m * DM, (bf16_t*)(ws + WS_HB) + (size_t)m * DM, (float*)(ws + WS_ST) + (size_t)m * 16, lane);
    for (int m = gw; m < MEMROWS; m += NGW) row_to_bf16(inptr(a, 1) + (size_t)m * DM, (bf16_t*)(ws + WS_MEMB) + (size_t)m * DM, (float*)(ws + WS_STM) + (size_t)m * 16, lane);
}

__device__ __forceinline__ void lru_unit(const Ctx& a, int l, int b, int g, LAS unsigned char* lds) {
    lds = lds_l(lds);
    const int tid = tid_w(a.wv), lane = tid & 63, wave = tid >> 6, l15 = lane & 15, gq = lane >> 4;
    LAS unsigned char* XT = lds;
    LAS unsigned char* XCB = lds + 19008;
    LAS float* XCF = (LAS float*)(lds + 37440);
    LAS float* AA = (LAS float*)(lds + 70208);
    LAS float* BB = (LAS float*)(lds + 102976);
    LAS unsigned char* WT = lds + 135744;
    const bf16_t* proj = (const bf16_t*)(a.ws + WS_PROJ) + (size_t)b * SEQ * NPROJ;
    bf16_t* mixed = (bf16_t*)(a.ws + WS_MIXED) + (size_t)b * SEQ * DM;
    const float* wa = inptr(a, 10) + ((size_t)l * 6 + g) * 4096; const float* wx = inptr(a, 12) + ((size_t)l * 6 + g) * 4096;
    for (int k = 0; k < 16; ++k) {
        const int idx = tid + 512 * k, which = idx >> 12, cp = (idx >> 6) & 63, c = idx & 63;
        const float v = which ? wx[cp * 64 + c] : wa[cp * 64 + c];
        *(LAS unsigned short*)(WT + (which * 64 + c) * 144 + cp * 2) = f2bf(v);
    }
    const int cch = tid & 63, ch = g * 64 + cch;
    float cw[4];
#pragma unroll
    for (int j = 0; j < 4; ++j) cw[j] = inptr(a, 8)[((size_t)l * 4 + j) * 384 + ch];
    const float cb = inptr(a, 9)[l * 384 + ch];
    float gba[4], gbx[4], gsp[4];
#pragma unroll
    for (int nt = 0; nt < 4; ++nt) {
        const int c2 = l * 384 + g * 64 + 16 * nt + l15;
        gba[nt] = inptr(a, 11)[c2]; gbx[nt] = inptr(a, 13)[c2];
        const float z = -inptr(a, 14)[c2];
        gsp[nt] = (8.0f * LOG2E) * (fmaxf(z, 0.f) + log1pf(__expf(-fabsf(z))));
    }
    float hcar = 0.f;
    const bf16_t* xsrc = proj + 1408 + g * 64;
    const bf16_t* ysrc = proj + 1792 + g * 64;
    u32x4 xr[3];
#pragma unroll
    for (int k = 0; k < 3; ++k) {
        const int idx = tid + 512 * k, row = idx >> 3, cv = idx & 7, tok = row - 3;
        xr[k] = (idx < 1048 && tok >= 0) ? *(const u32x4*)(xsrc + (size_t)tok * NPROJ + cv * 8) : (u32x4){0u, 0u, 0u, 0u};
    }
#pragma unroll 1
    for (int ck = 0; ck < 16; ++ck) {
        const int t0 = ck * 128;
#pragma unroll
        for (int k = 0; k < 3; ++k) { const int idx = tid + 512 * k, row = idx >> 3, cv = idx & 7; if (idx < 1048) *(LAS u32x4*)(XT + row * 144 + cv * 16) = xr[k]; }
        u32x4 yr[2];
#pragma unroll
        for (int k = 0; k < 2; ++k) { const int idx = tid + 512 * k, row = idx >> 3, cv = idx & 7; yr[k] = *(const u32x4*)(ysrc + (size_t)(t0 + row) * NPROJ + cv * 8); }
        if (ck < 15) {
#pragma unroll
            for (int k = 0; k < 3; ++k) {
                const int idx = tid + 512 * k, row = idx >> 3, cv = idx & 7, tok = t0 + 128 - 3 + row;
                xr[k] = (idx < 1048) ? *(const u32x4*)(xsrc + (size_t)tok * NPROJ + cv * 8) : (u32x4){0u, 0u, 0u, 0u};
            }
        }
        LBAR();
#pragma unroll 4
        for (int k = 0; k < 16; ++k) {
            const int t = (tid >> 6) + 8 * k;
            float xc = cb;
#pragma unroll
            for (int j = 0; j < 4; ++j) xc += cw[j] * bf2f(*(LAS const unsigned short*)(XT + (t + 3 - j) * 144 + cch * 2));
            XCF[t * 64 + cch] = xc;
            *(LAS unsigned short*)(XCB + t * 144 + cch * 2) = f2bf(xc);
        }
        LBAR();
        {
            f32x4 acc[8];
#pragma unroll
            for (int nt = 0; nt < 8; ++nt) acc[nt] = (f32x4){0.f, 0.f, 0.f, 0.f};
#pragma unroll
            for (int ks = 0; ks < 2; ++ks) {
                const bf16x8 af = *(LAS const bf16x8*)(XCB + (16 * wave + l15) * 144 + (32 * ks + 8 * gq) * 2);
#pragma unroll
                for (int nt = 0; nt < 8; ++nt) {
                    const bf16x8 bfr = *(LAS const bf16x8*)(WT + (16 * nt + l15) * 144 + (32 * ks + 8 * gq) * 2);
                    acc[nt] = __builtin_amdgcn_mfma_f32_16x16x32_bf16(af, bfr, acc[nt], 0, 0, 0);
                }
            }
#pragma unroll
            for (int nt = 0; nt < 4; ++nt)
#pragma unroll
                for (int rg = 0; rg < 4; ++rg) {
                    const int t = 16 * wave + 4 * gq + rg, c = 16 * nt + l15;
                    const float r = sigmoidf_(acc[nt][rg] + gba[nt]), ig = sigmoidf_(acc[nt + 4][rg] + gbx[nt]);
                    const float av = __builtin_amdgcn_exp2f(-r * gsp[nt]);
                    const float xcv = XCF[t * 64 + c];
                    AA[t * 64 + c] = av;
                    BB[t * 64 + c] = __builtin_amdgcn_sqrtf(fmaxf(1.0f - av * av, 0.f)) * (ig * xcv);
                }
        }
        LBAR();
        if (wave == 0) {
#pragma unroll 16
            for (int t = 0; t < 128; ++t) { hcar = AA[t * 64 + lane] * hcar + BB[t * 64 + lane]; BB[t * 64 + lane] = hcar; }
        }
        LBAR();
#pragma unroll
        for (int k = 0; k < 2; ++k) {
            const int idx = tid + 512 * k, row = idx >> 3, cv = idx & 7;
            const f32x4 h0 = *(LAS const f32x4*)(BB + row * 64 + cv * 8), h1 = *(LAS const f32x4*)(BB + row * 64 + cv * 8 + 4);
            u32x4 w;
            w.x = pkbf(h0[0] * gelu_tanh(bflo(yr[k].x)), h0[1] * gelu_tanh(bfhi(yr[k].x)));
            w.y = pkbf(h0[2] * gelu_tanh(bflo(yr[k].y)), h0[3] * gelu_tanh(bfhi(yr[k].y)));
            w.z = pkbf(h1[0] * gelu_tanh(bflo(yr[k].z)), h1[1] * gelu_tanh(bfhi(yr[k].z)));
            w.w = pkbf(h1[2] * gelu_tanh(bflo(yr[k].w)), h1[3] * gelu_tanh(bfhi(yr[k].w)));
            *(u32x4*)(mixed + (size_t)(t0 + row) * DM + 640 + g * 64 + cv * 8) = w;
        }
    }
}

__device__ __forceinline__ void pool_unit(const Ctx& a, int l, int b, int tc, LAS unsigned char* lds) {
    lds = lds_l(lds);
    const int tid = tid_w(a.wv);
    LAS float* U = (LAS float*)lds;
    LAS float* P = (LAS float*)(lds + 80896);
    const int t0 = tc * 64;
    const bf16_t* proj = (const bf16_t*)(a.ws + WS_PROJ) + (size_t)b * SEQ * NPROJ;
    bf16_t* mixed = (bf16_t*)(a.ws + WS_MIXED) + (size_t)b * SEQ * DM;
    for (int k = 0; k < 40; ++k) {
        const int idx = tid + 512 * k;
        if (idx < 79 * 256) { const int tt = idx >> 8, c = idx & 255, t = t0 - 15 + tt; U[idx] = (t >= 0) ? bf2f(proj[(size_t)t * NPROJ + c]) : 0.f; }
    }
    __syncthreads();
    {
        const int c = tid & 255, half = tid >> 8, g = c >> 6, w = 2 << g;
        for (int q = 0; q < 32; ++q) {
            const int tt = half * 32 + q, t = t0 + tt;
            float s = 0.f;
            for (int j = 0; j < w; ++j) s += U[(tt + 15 - j) * 256 + c];
            const float cnt = (float)((t + 1 < w) ? (t + 1) : w);
            P[tt * 256 + c] = s / cnt - U[(tt + 15) * 256 + c];
        }
    }
    __syncthreads();
    {
        const int dcol = tid & 255, half = tid >> 8, g = dcol >> 6, dc = dcol & 63;
        const float* pw = inptr(a, 4) + ((size_t)l * 4 + g) * 4096 + dc;
        float w[64];
#pragma unroll
        for (int c = 0; c < 64; ++c) w[c] = pw[c * 64];
        const float sc = inptr(a, 5)[l * 256 + dcol];
        for (int q = 0; q < 32; ++q) {
            const int tt = half * 32 + q;
            const LAS f32x4* pr = (const LAS f32x4*)(P + tt * 256 + g * 64);
            float acc = 0.f;
#pragma unroll
            for (int c4 = 0; c4 < 16; ++c4) { const f32x4 pv = pr[c4]; acc += pv[0] * w[4 * c4] + pv[1] * w[4 * c4 + 1] + pv[2] * w[4 * c4 + 2] + pv[3] * w[4 * c4 + 3]; }
            mixed[(size_t)(t0 + tt) * DM + dcol] = f2bf(acc * sc);
        }
    }
}

__device__ __forceinline__ void dattn_unit(const Ctx& a, int b, int h, int tb, LAS unsigned char* lds) {
    lds = lds_l(lds);
    const int tid = tid_w(a.wv), lane = tid & 63, wave = tid >> 6, l15 = lane & 15, gq = lane >> 4;
    LAS float* OACC = (LAS float*)lds;
    LAS float* DEN = (LAS float*)(lds + 65536);
    LAS unsigned char* vst = lds + 66560 + wave * 4608;
    const int t0 = tb * 256;
    const bf16_t* projb = (const bf16_t*)(a.ws + WS_PROJ) + (size_t)b * SEQ * NPROJ;
    bf16_t* mixed = (bf16_t*)(a.ws + WS_MIXED) + (size_t)b * SEQ * DM;
    const float slope2 = exp2f(-8.0f * (float)(h + 1) / 6.0f) * LOG2E;
    const int trq = (l15 >> 2), trp = (l15 & 3);
#pragma unroll 1
    for (int pi = 0; pi < 3; ++pi) {
        const int d = 1 << (2 * pi);
        const float sl = slope2 * (float)d;
#pragma unroll 1
        for (int ii = 0; ii < 2; ++ii) {
            const int it = 2 * wave + ii, rr = it % d, jj = it / d, tq0 = t0 + rr + 16 * d * jj;
            const unsigned char* pbytes = (const unsigned char*)projb;
            const unsigned qoff = (unsigned)(tq0 + d * l15) * (unsigned)(NPROJ * 2) + (unsigned)((256 + h * 64 + 8 * gq) * 2);
            const bf16x8 qf0 = *(const bf16x8*)(pbytes + qoff), qf1 = *(const bf16x8*)(pbytes + qoff + 64);
            bf16x8 kf[6][2];
#define DATTN_KLOAD(KT) do { if ((KT) < 9) { int tk = tq0 + d * (16 * ((KT) - 8) + l15); tk = tk < 0 ? 0 : tk; \
                const unsigned koff = (unsigned)tk * (unsigned)(NPROJ * 2) + (unsigned)((640 + h * 64 + 8 * gq) * 2); \
                kf[(KT) % 6][0] = *(const bf16x8*)(pbytes + koff); kf[(KT) % 6][1] = *(const bf16x8*)(pbytes + koff + 64); } } while (0)
            DATTN_KLOAD(0); DATTN_KLOAD(1); DATTN_KLOAD(2); DATTN_KLOAD(3); DATTN_KLOAD(4); DATTN_KLOAD(5);
            u32x4 vreg[2][4];
#define DATTN_VLOAD(PP) do { _Pragma("unroll") for (int ps = 0; ps < 4; ++ps) { \
                    const int idx = ps * 64 + lane, row = idx >> 3, chk = idx & 7, kt = 2 * (PP) + (row >> 4); \
                    int tk = tq0 + d * (16 * (kt - 8) + (row & 15)); tk = tk < 0 ? 0 : (tk > SEQ - 1 ? SEQ - 1 : tk); \
                    vreg[(PP) % 2][ps] = *(const u32x4*)(pbytes + ((unsigned)tk * (unsigned)(NPROJ * 2) + (unsigned)((1024 + h * 64 + chk * 8) * 2))); } } while (0)
            DATTN_VLOAD(0); DATTN_VLOAD(1);
            f32x4 o[4];
#pragma unroll
            for (int dt = 0; dt < 4; ++dt) o[dt] = (f32x4){0.f, 0.f, 0.f, 0.f};
            float den = 0.f;
            int dbase = l15 + 128 - 4 * gq; asm volatile("" : "+v"(dbase));
            float fbase = (float)dbase; asm volatile("" : "+v"(fbase));
#pragma unroll
            for (int pp = 0; pp < 5; ++pp) {
#pragma unroll
                for (int ps = 0; ps < 4; ++ps) { const int idx = ps * 64 + lane, row = idx >> 3, chk = idx & 7; *(LAS u32x4*)(vst + row * 144 + chk * 16) = vreg[pp % 2][ps]; }
                if (pp + 2 < 5) { asm volatile("" ::: "memory"); DATTN_VLOAD(pp + 2); }
                const bool skip = (tq0 + d * (16 * (2 * pp + 1 - 8) + 15) < 0);
                f32x4 sacc[2];
#pragma unroll
                for (int T = 0; T < 2; ++T) {
                    const int kt = 2 * pp + T;
                    sacc[T] = (f32x4){0.f, 0.f, 0.f, 0.f};
                    if (kt < 9 && !skip) {
                        sacc[T] = __builtin_amdgcn_mfma_f32_16x16x32_bf16(kf[kt % 6][0], qf0, sacc[T], 0, 0, 0);
                        sacc[T] = __builtin_amdgcn_mfma_f32_16x16x32_bf16(kf[kt % 6][1], qf1, sacc[T], 0, 0, 0);
                    }
                }
                if (pp + 3 < 5) { asm volatile("" ::: "memory"); DATTN_KLOAD(2 * pp + 6); DATTN_KLOAD(2 * pp + 7); }
                if (skip) continue;
                float p[2][4];
#pragma unroll
                for (int T = 0; T < 2; ++T) {
                    const int kt = 2 * pp + T;
#pragma unroll
                    for (int rg = 0; rg < 4; ++rg) {
                        const int dist = dbase - (16 * kt + rg);
                        const int tkk = tq0 + d * (l15 - dist);
                        const bool valid = (kt < 9) && (dist >= 0) && (dist <= 128) && (tkk >= 0);
                        const float pv = valid ? __builtin_amdgcn_exp2f(sacc[T][rg] - sl * (fbase - (float)(16 * kt + rg))) : 0.f;
                        p[T][rg] = pv; den += pv;
                    }
                }
                u32x4 pw; pw.x = pkbf(p[0][0], p[0][1]); pw.y = pkbf(p[0][2], p[0][3]); pw.z = pkbf(p[1][0], p[1][1]); pw.w = pkbf(p[1][2], p[1][3]);
                const bf16x8 pfrag = __builtin_bit_cast(bf16x8, pw);
#pragma unroll
                for (int dt = 0; dt < 4; ++dt) {
                    const s16x4 lo = vtr(vst + (4 * gq + trq) * 144 + (16 * dt + 4 * trp) * 2);
                    const s16x4 hi = vtr(vst + (16 + 4 * gq + trq) * 144 + (16 * dt + 4 * trp) * 2);
                    const bf16x8 vf = (bf16x8){lo[0], lo[1], lo[2], lo[3], hi[0], hi[1], hi[2], hi[3]};
                    o[dt] = __builtin_amdgcn_mfma_f32_16x16x32_bf16(pfrag, vf, o[dt], 0, 0, 0);
                }
            }
            den += shx(den, lane, 16); den += shx(den, lane, 32);
#pragma unroll
            for (int dt = 0; dt < 4; ++dt)
#pragma unroll
                for (int rg = 0; rg < 4; ++rg) {
                    const int tl = (tq0 - t0) + d * (4 * gq + rg), idx = tl * 64 + 16 * dt + l15;
                    if (pi == 0) OACC[idx] = o[dt][rg]; else OACC[idx] += o[dt][rg];
                }
            if (gq == 0) { const int tl = (tq0 - t0) + d * l15; if (pi == 0) DEN[tl] = den; else DEN[tl] += den; }
        }
        LBAR();
    }
    for (int k = 0; k < 32; ++k) {
        const int idx = tid + 512 * k, tl = idx >> 6, dc = idx & 63;
        mixed[(size_t)(t0 + tl) * DM + 256 + h * 64 + dc] = f2bf(OACC[idx] * __builtin_amdgcn_rcpf(DEN[tl]));
    }
}

__device__ __forceinline__ void phase_mixers(const Ctx& a, int l, LAS unsigned char* lds) {
    unsigned* ctr = (unsigned*)(a.ws + WS_CTL) + 64 * l;
    lds = lds_l(lds);
    LAS int* sun = (LAS int*)(lds + LDS_UNIT_OFF);
    constexpr int N_LRU = 192, N_ATT = 1536, N_POOL = 1024;
    for (;;) {
        __syncthreads();
        if (tid_w(a.wv) == 0) *sun = (int)atomicAdd(ctr, 1u);
        __syncthreads();
        const int u = *sun;
        if (u >= N_LRU + N_ATT + N_POOL) break;
        if (u < N_LRU) lru_unit(a, l, u / 6, u % 6, lds);
        else if (u < N_LRU + N_ATT) { const int v = u - N_LRU; dattn_unit(a, v / 48, (v % 48) / 8, v % 8, lds); }
        else { const int v = u - N_LRU - N_ATT; pool_unit(a, l, v / 32, v % 32, lds); }
    }
}

__device__ __forceinline__ void phase_xattn(const Ctx& a, int l, LAS unsigned char* lds) {
    lds = lds_l(lds);
    const int tid = tid_w(a.wv), lane = tid & 63, wave = tid >> 6, l15 = lane & 15, gq = lane >> 4;
    LAS unsigned char* KL = lds;
    LAS unsigned char* VL = lds + 16896;
    LAS float* RK = (LAS float*)(lds + 34304);
    const bf16_t* qm = (const bf16_t*)(a.ws + WS_QM);
    const float* qst = (const float*)(a.ws + WS_QST);
    const bf16_t* kv = (const bf16_t*)(a.ws + WS_KV);
    const float* kst = (const float*)(a.ws + WS_KST);
    bf16_t* om = (bf16_t*)(a.ws + WS_MIXED);
    const int trq = (l15 >> 2), trp = (l15 & 3);
    for (int xu = blockIdx.x; xu < NBATCH * 4 * 16; xu += gridDim.x) {
        const int b = xu >> 6, h = (xu >> 4) & 3, qb = xu & 15;
        LBAR();
        if (tid < 256) {
            const f32x4* kp = (const f32x4*)(kst + (size_t)(b * 256 + tid) * 256 + l * 64 + h * 8);
            const f32x4 k0 = kp[0], k1 = kp[1];
            RK[tid] = rsqrtf((((k0[0] + k0[1]) + (k0[2] + k0[3])) + ((k1[0] + k1[1]) + (k1[2] + k1[3]))) * (1.0f / 256.0f) + EPSF);
        }
        const size_t qrow = (size_t)b * SEQ + qb * 128 + wave * 16 + l15;
        bf16x8 qf[8];
#pragma unroll
        for (int ks = 0; ks < 8; ++ks) qf[ks] = *(const bf16x8*)(qm + qrow * DM + h * 256 + 32 * ks + 8 * gq);
        float rq;
        { const f32x4* qp = (const f32x4*)(qst + qrow * 32 + h * 8); const f32x4 q0 = qp[0], q1 = qp[1];
          rq = rsqrtf((((q0[0] + q0[1]) + (q0[2] + q0[3])) + ((q1[0] + q1[1]) + (q1[2] + q1[3]))) * (1.0f / 256.0f) + EPSF); }
        f32x4 o[16];
#pragma unroll
        for (int dt = 0; dt < 16; ++dt) o[dt] = (f32x4){0.f, 0.f, 0.f, 0.f};
        float den = 0.f;
        const bf16_t* kvb = kv + (size_t)(b * 256) * 8192 + l * 2048 + h * 256;
        u32x4 kpre[2], vpre[2];
#pragma unroll
        for (int k = 0; k < 2; ++k) {
            const int idx = tid + 512 * k, row = idx >> 5, chk = idx & 31;
            const bf16_t* src = kvb + (size_t)row * 8192 + chk * 8;
            kpre[k] = *(const u32x4*)src; vpre[k] = *(const u32x4*)(src + 1024);
        }
#pragma unroll 1
        for (int c = 0; c < 8; ++c) {
            LBAR();
#pragma unroll
            for (int k = 0; k < 2; ++k) {
                const int idx = tid + 512 * k, row = idx >> 5, chk = idx & 31;
                *(LAS u32x4*)(KL + row * 528 + chk * 16) = kpre[k];
                *(LAS u32x4*)(VL + row * 544 + chk * 16) = vpre[k];
            }
            if (c < 7) {
#pragma unroll
                for (int k = 0; k < 2; ++k) {
                    const int idx = tid + 512 * k, row = idx >> 5, chk = idx & 31;
                    const bf16_t* src = kvb + (size_t)(32 * (c + 1) + row) * 8192 + chk * 8;
                    kpre[k] = *(const u32x4*)src; vpre[k] = *(const u32x4*)(src + 1024);
                }
            }
            LBAR();
            float p[2][4];
#pragma unroll
            for (int T = 0; T < 2; ++T) {
                f32x4 s = (f32x4){0.f, 0.f, 0.f, 0.f};
#pragma unroll
                for (int ks = 0; ks < 8; ++ks) {
                    const bf16x8 kf = *(LAS const bf16x8*)(KL + (16 * T + l15) * 528 + (32 * ks + 8 * gq) * 2);
                    s = __builtin_amdgcn_mfma_f32_16x16x32_bf16(kf, qf[ks], s, 0, 0, 0);
                }
                const f32x4 rk4 = *(LAS const f32x4*)(RK + 32 * c + 16 * T + 4 * gq);
#pragma unroll
                for (int rg = 0; rg < 4; ++rg) { const float pv = __builtin_amdgcn_exp2f(s[rg] * rq * rk4[rg]); p[T][rg] = pv; den += pv; }
            }
            u32x4 pw; pw.x = pkbf(p[0][0], p[0][1]); pw.y = pkbf(p[0][2], p[0][3]); pw.z = pkbf(p[1][0], p[1][1]); pw.w = pkbf(p[1][2], p[1][3]);
            const bf16x8 pfrag = __builtin_bit_cast(bf16x8, pw);
#pragma unroll
            for (int dt = 0; dt < 16; ++dt) {
                const s16x4 lo = vtr(VL + (4 * gq + trq) * 544 + (16 * dt + 4 * trp) * 2);
                const s16x4 hi = vtr(VL + (16 + 4 * gq + trq) * 544 + (16 * dt + 4 * trp) * 2);
                const bf16x8 vf = (bf16x8){lo[0], lo[1], lo[2], lo[3], hi[0], hi[1], hi[2], hi[3]};
                o[dt] = __builtin_amdgcn_mfma_f32_16x16x32_bf16(pfrag, vf, o[dt], 0, 0, 0);
            }
        }
        den += shx(den, lane, 16); den += shx(den, lane, 32);
        float inv[4];
#pragma unroll
        for (int rg = 0; rg < 4; ++rg) inv[rg] = 1.0f / shi(den, 4 * gq + rg);
        const size_t orow0 = (size_t)b * SEQ + qb * 128 + wave * 16 + 4 * gq;
#pragma unroll
        for (int dt = 0; dt < 16; ++dt)
#pragma unroll
            for (int rg = 0; rg < 4; ++rg) om[(orow0 + rg) * DM + h * 256 + 16 * dt + l15] = f2bf(o[dt][rg] * inv[rg]);
    }
}

__device__ __forceinline__ void phase_ffn_fix(const Ctx& a, int l) {
    const float* sg = (const float*)(a.ws + WS_SG); const float* su = (const float*)(a.ws + WS_SU);
    bf16_t* act = (bf16_t*)(a.ws + WS_ACT);
    const float* cw = inptr(a, 25) + (size_t)l * 3 * DFF; const float* cb = inptr(a, 26) + (size_t)l * DFF;
    const int total = 256 * 4 * (DFF / 4);
    for (int idx = blockIdx.x * NTHREADS + tid_w(a.wv); idx < total; idx += gridDim.x * NTHREADS) {
        const int f = (idx % (DFF / 4)) * 4, j = (idx / (DFF / 4)) & 3, pm = idx / (DFF / 4) / 4, wr = j >> 1, e = j & 1;
        const float* sgt = sg + (size_t)pm * 8 * DFF + f;
        const f32x4 z = (f32x4){0.f, 0.f, 0.f, 0.f};
        const bool hasprev = (pm & 7) != 0;
        const f32x4 prev7 = hasprev ? *(const f32x4*)(sgt - (size_t)8 * DFF + 7 * DFF) : z;
        const f32x4 prev6 = hasprev ? *(const f32x4*)(sgt - (size_t)8 * DFF + 6 * DFF) : z;
        const f32x4 gc = *(const f32x4*)(sgt + (size_t)(wr * 4 + e) * DFF);
        f32x4 gm1, gm2;
        if (e == 1) { gm1 = *(const f32x4*)(sgt + (size_t)(wr * 4) * DFF); gm2 = wr ? *(const f32x4*)(sgt + (size_t)3 * DFF) : prev7; }
        else { gm1 = wr ? *(const f32x4*)(sgt + (size_t)3 * DFF) : prev7; gm2 = wr ? *(const f32x4*)(sgt + (size_t)2 * DFF) : prev6; }
        const f32x4 uu = *(const f32x4*)(su + ((size_t)pm * 4 + wr * 2 + e) * DFF + f);
        const f32x4 w0 = *(const f32x4*)(cw + f), w1 = *(const f32x4*)(cw + DFF + f), w2 = *(const f32x4*)(cw + 2 * DFF + f), bb = *(const f32x4*)(cb + f);
        float r[4];
#pragma unroll
        for (int i = 0; i < 4; ++i) r[i] = gelu_tanh(bb[i] + w0[i] * gc[i] + w1[i] * gm1[i] + w2[i] * gm2[i]) * uu[i];
        u32x2 w; w.x = pkbf(r[0], r[1]); w.y = pkbf(r[2], r[3]);
        *(u32x2*)(act + (size_t)(pm * 256 + wr * 128 + e) * DFF + f) = w;
    }
}

__global__ void __launch_bounds__(NTHREADS, 2) trunk_fwd(Args ka) {
    extern __shared__ __attribute__((aligned(16))) unsigned char lds_raw[];
    LAS unsigned char* lds = (LAS unsigned char*)lds_raw;
    cg::grid_group grid = cg::this_grid();
    {
        LAS unsigned long long* tw = (LAS unsigned long long*)(lds + LDS_TBL_OFF);
        if (threadIdx.x == 0) {
#pragma unroll
            for (int i = 0; i < 28; ++i) tw[i] = (unsigned long long)ka.in[i];
        }
        __syncthreads();
    }
    Ctx a; a.tbl = (LAS const unsigned long long*)(lds + LDS_TBL_OFF); a.out = ka.out; a.ws = ka.ws; a.wv = __builtin_amdgcn_readfirstlane((int)(threadIdx.x >> 6));
    unsigned char* ws = a.ws;
    bf16_t* hb = (bf16_t*)(ws + WS_HB);
    float* st = (float*)(ws + WS_ST);

    phase_prologue(a, lds);
    grid.sync();
    {
        EpiBf<false> E{(bf16_t*)(ws + WS_KV), 8192, (const float*)(ws + WS_STM), (float*)(ws + WS_KST), 256, nullptr, nullptr, nullptr};
        run_gemm(a.wv, lds, (const bf16_t*)(ws + WS_MEMB), (const bf16_t*)(ws + WS_WKV), MEMROWS, 8192, DM, E);
    }
    for (int l = 0; l < DEPTH; ++l) {
        const unsigned char* wl = ws + WS_W + (size_t)l * W_LAYER;
        {
            EpiBf<true> E{(bf16_t*)(ws + WS_PROJ), NPROJ, st, nullptr, 0, nullptr, inptr(a, 6) + l * 64, inptr(a, 7) + l * 64};
            run_gemm(a.wv, lds, hb, (const bf16_t*)(wl + W_IN), MTOK, NPROJ, DM, E);
        }
        grid.sync();
        phase_mixers(a, l, lds);
        grid.sync();
        {
            EpiRes E{l == 0 ? inptr(a, 0) : a.out, a.out, hb, st};
            run_gemm(a.wv, lds, (const bf16_t*)(ws + WS_MIXED), (const bf16_t*)(wl + W_OUT), MTOK, DM, DM, E);
        }
        grid.sync();
        {
            EpiBf<false> E{(bf16_t*)(ws + WS_QM), DM, st, (float*)(ws + WS_QST), 32, (const float*)(ws + WS_CS) + l * 1024, nullptr, nullptr};
            run_gemm(a.wv, lds, hb, (const bf16_t*)(wl + W_Q), MTOK, DM, DM, E);
        }
        grid.sync();
        phase_xattn(a, l, lds);
        grid.sync();
        {
            EpiRes E{a.out, a.out, hb, st};
            run_gemm(a.wv, lds, (const bf16_t*)(ws + WS_MIXED), (const bf16_t*)(wl + W_O), MTOK, DM, DM, E);
        }
        grid.sync();
        {
            EpiAct E{(bf16_t*)(ws + WS_ACT), st, inptr(a, 25) + (size_t)l * 3 * DFF, inptr(a, 26) + (size_t)l * DFF, (float*)(ws + WS_SG), (float*)(ws + WS_SU)};
            run_gemm_aperm(a.wv, lds, hb, (const bf16_t*)(wl + W_UP), MTOK, DFF2, DM, E);
        }
        grid.sync();
        phase_ffn_fix(a, l);
        grid.sync();
        {
            EpiRes E{a.out, a.out, hb, st};
            run_gemm(a.wv, lds, (const bf16_t*)(ws + WS_ACT), (const bf16_t*)(wl + W_DOWN), MTOK, DM, DFF, E);
        }
        grid.sync();
    }
}

extern "C" void kernel_launch(void* const* d_in, const int* in_sizes, int n_in, void* d_out, int out_size, void* d_ws, size_t ws_size, hipStream_t stream) {
    static int grid = 0;
    if (grid == 0) {
        if (n_in != 28 || in_sizes[0] != MTOK * DM || out_size != MTOK * DM || ws_size < WS_END) {
            fprintf(stderr, "kernel_launch: unexpected shapes (n_in %d, in0 %d, out %d, ws %zu; need ws >= %zu); nothing launched\n", n_in, n_in > 0 ? in_sizes[0] : -1, out_size, ws_size, (size_t)WS_END);
            grid = -1; return;
        }
        int dev = 0, cus = 0, per_cu = 0;
        hipGetDevice(&dev);
        hipDeviceGetAttribute(&cus, hipDeviceAttributeMultiprocessorCount, dev);
        if (hipFuncSetAttribute((const void*)trunk_fwd, hipFuncAttributeMaxDynamicSharedMemorySize, LDS_BYTES) != hipSuccess) { fprintf(stderr, "kernel_launch: hipFuncSetAttribute failed\n"); grid = -1; return; }
        if (hipOccupancyMaxActiveBlocksPerMultiprocessor(&per_cu, (const void*)trunk_fwd, NTHREADS, LDS_BYTES) != hipSuccess || per_cu < 1) { fprintf(stderr, "kernel_launch: occupancy query says %d blocks per CU\n", per_cu); per_cu = 1; }
        (void)hipGetLastError();
        grid = cus;
    }
    if (grid < 0) return;
    (void)hipMemsetAsync((char*)d_ws + WS_CTL, 0, 4096, stream);
    Args a{};
    for (int i = 0; i < 28; ++i) a.in[i] = (const float*)d_in[i];
    a.out = (float*)d_out; a.ws = (unsigned char*)d_ws;
    void* args[] = {&a};
    hipError_t e = hipLaunchCooperativeKernel((const void*)trunk_fwd, dim3(grid), dim3(NTHREADS), args, LDS_BYTES, stream);
    if (e != hipSuccess) fprintf(stderr, "cooperative launch failed: %s (grid %d)\n", hipGetErrorString(e), grid);
}
```

```cpp
#include <hip/hip_runtime.h>
#include <hip/hip_cooperative_groups.h>
#include <cstdio>
#include <cstdint>
namespace cg = cooperative_groups;
namespace pg8 {
#define PG8_LAS __attribute__((address_space(3)))
typedef unsigned short bf16_t;
typedef short bf16x8 __attribute__((ext_vector_type(8)));
typedef float f32x4 __attribute__((ext_vector_type(4)));
typedef unsigned u32x4 __attribute__((ext_vector_type(4)));
constexpr int BM = 256, BK = 64, HALF = 128, HTB = HALF * BK * 2  , STAGE_BYTES = 8 * HTB, NXCD = 8, WGM = 8;

__host__ __device__ __forceinline__ int lds_byte(int r, int c) { const int st = (r >> 4) * 2 + (c >> 5), rr = r & 15, cc = c & 31, ob = rr * 64 + cc * 2; return st * 1024 + (ob ^ (((ob >> 9) & 1) << 5)); }
__host__ __device__ __forceinline__ void stage_rc(int b, int& R, int& C) { const int st = b / 1024, sb = b % 1024, swz = sb ^ (((sb >> 9) & 1) << 5); R = (st >> 1) * 16 + swz / 64; C = (st & 1) * 32 + (swz % 64) / 2; }
__host__ __device__ __forceinline__ int perm32(int rho) { const int n = rho >> 4, i = rho & 15; return 8 * (i >> 2) + 4 * n + (i & 3); }

struct Unit { int pm, pn; };
struct Gemm { const bf16_t* A; const bf16_t* Bt; int M, N, K; };

struct StaticOrder {
    int nM, nN, nwg, G, c;
    __host__ __device__ void init(int M, int N, int G_, int c_) { nM = M / BM; nN = N / BM; nwg = nM * nN; G = G_; c = c_; }
    __host__ __device__ bool next(int i, Unit& u) const {
        const long L = (long)i * G + c; if (L >= nwg) return false;
        int wgid = (int)L; { const int q = nwg / NXCD, r = nwg % NXCD, xcd = wgid % NXCD, off = wgid / NXCD; wgid = (xcd < r ? xcd * (q + 1) : r * (q + 1) + (xcd - r) * q) + off; }
        const int nig = WGM * nN, gid = wgid / nig, fm = gid * WGM, gsz = (nM - fm) < WGM ? (nM - fm) : WGM;
        u.pm = fm + ((wgid % nig) % gsz); u.pn = (wgid % nig) / gsz; return true;
    }
    __device__ __forceinline__ void a_ready(const Unit&) const {}
    __device__ __forceinline__ void done(const Unit&) const {}
};

__device__ __forceinline__ unsigned cvt_pk_bf16(float lo, float hi) { unsigned r; asm volatile("v_cvt_pk_bf16_f32 %0, %1, %2" : "=v"(r) : "v"(lo), "v"(hi)); return r; }
typedef float f32x2 __attribute__((ext_vector_type(2)));
template <class Epi, class Sched, bool ALIGN_EPI = false, bool SP2 = false, bool APERM = false>
__device__ __forceinline__ void gemm_phase(int tid_in, PG8_LAS unsigned char* lds, const Gemm g, const Sched& S, const Epi& E) {
    int tid_ = tid_in; asm volatile("" : "+v"(tid_));
    const int tid = tid_, wid = __builtin_amdgcn_readfirstlane(tid >> 6), lane = tid & 63, wr = wid >> 2, wc = wid & 3, fr = lane & 15, fq = lane >> 4;
    const int K = g.K, nt = K / BK;
    unsigned voffA[2], voffB[2];
#pragma unroll
    for (int i = 0; i < 2; ++i) { int R, C; stage_rc(tid * 16 + i * 8192, R, C); const int Rb = Epi::PERM ? ((R & ~31) + perm32(R & 31)) : R;
        const int Ra = APERM ? ((16 * (R >> 6) + (R & 15)) * 8 + ((R >> 4) & 3)) : R;
        voffA[i] = (unsigned)(Ra * K + C) * 2u; voffB[i] = (unsigned)(Rb * K + C) * 2u; }
    const size_t kstep = (size_t)(BK * 2);
    const size_t hstep = (size_t)HALF * K * 2;
    const size_t tstep = 2 * hstep;
    const size_t hstepA = APERM ? (size_t)4 * K * 2 : hstep;
    const unsigned ldsw = (unsigned)wid * 1024u;
    const int aoff = lds_byte(wr * 64 + fr, fq * 8), boff = lds_byte(wc * 32 + fr, fq * 8);
#define PG8_SA(b, h) (((b) * 2 + (h)) * HTB)
#define PG8_SB(b, h) ((4 + (b) * 2 + (h)) * HTB)
#define PG8_STAGE(bufoff, gbase, voff) do { _Pragma("unroll") for (int _i = 0; _i < 2; ++_i) \
        __builtin_amdgcn_global_load_lds((const unsigned*)((const char*)(gbase) + (voff)[_i]), (PG8_LAS unsigned*)(lds + (bufoff) + ldsw + _i * 8192), 16, 0, 0); } while (0)
#define PG8_LDA(dst, b, h) do { _Pragma("unroll") for (int m = 0; m < 4; ++m) _Pragma("unroll") for (int k = 0; k < 2; ++k) dst[m][k] = *(const PG8_LAS bf16x8*)(lds + PG8_SA(b, h) + aoff + m * 2048 + k * 1024); } while (0)
#define PG8_LDB(dst, b, h) do { _Pragma("unroll") for (int n = 0; n < 2; ++n) _Pragma("unroll") for (int k = 0; k < 2; ++k) dst[n][k] = *(const PG8_LAS bf16x8*)(lds + PG8_SB(b, h) + boff + n * 2048 + k * 1024); } while (0)
#define PG8_MMA(ai, bj, At, Bt) do { __builtin_amdgcn_s_setprio(1); _Pragma("unroll") for (int m = 0; m < 4; ++m) _Pragma("unroll") for (int n = 0; n < 2; ++n) _Pragma("unroll") for (int k = 0; k < 2; ++k) \
        acc[ai][bj][m][n] = __builtin_amdgcn_mfma_f32_16x16x32_bf16(Bt[n][k], At[m][k], acc[ai][bj][m][n], 0, 0, 0); __builtin_amdgcn_s_setprio(0); } while (0)
#define PG8_WAIT_V(n) asm volatile("s_waitcnt vmcnt(" #n ")" ::: "memory")
#define PG8_WAIT_L(n) asm volatile("s_waitcnt lgkmcnt(" #n ")" ::: "memory")
#define PG8_BAR __builtin_amdgcn_s_barrier()
#define PG8_SCHED __builtin_amdgcn_sched_barrier(0)
    Unit cur, nxt; int ui = 0;
    if (!S.next(0, cur)) return;
    f32x4 acc[2][2][4][2];
#pragma unroll
    for (int a = 0; a < 2; ++a)
#pragma unroll
        for (int b = 0; b < 2; ++b)
#pragma unroll
            for (int m = 0; m < 4; ++m)
#pragma unroll
                for (int n = 0; n < 2; ++n) acc[a][b][m][n] = (f32x4){0.f, 0.f, 0.f, 0.f};
    bf16x8 At[4][2], B0[2][2], B1[2][2];
    const char* cA = (const char*)g.A + (size_t)cur.pm * tstep; const char* cB = (const char*)g.Bt + (size_t)cur.pn * tstep;
    S.a_ready(cur);
    if constexpr (SP2) {
        PG8_STAGE(PG8_SB(0, 0), cB, voffB); PG8_STAGE(PG8_SB(0, 1), cB + hstep, voffB); PG8_STAGE(PG8_SA(0, 0), cA, voffA); PG8_STAGE(PG8_SA(0, 1), cA + hstepA, voffA);
        if (wr == 1) PG8_BAR;
        PG8_WAIT_V(2); PG8_BAR;
        PG8_STAGE(PG8_SB(1, 0), cB + kstep, voffB); PG8_STAGE(PG8_SA(1, 0), cA + kstep, voffA); PG8_STAGE(PG8_SB(1, 1), cB + hstep + kstep, voffB);
        PG8_WAIT_V(6); PG8_BAR;
    } else {
        PG8_STAGE(PG8_SB(0, 0), cB, voffB); PG8_STAGE(PG8_SA(0, 0), cA, voffA); PG8_STAGE(PG8_SB(0, 1), cB + hstep, voffB); PG8_STAGE(PG8_SA(0, 1), cA + hstepA, voffA);
        if (wr == 1) PG8_BAR;
        PG8_WAIT_V(4); PG8_BAR;
        PG8_STAGE(PG8_SB(1, 0), cB + kstep, voffB); PG8_STAGE(PG8_SA(1, 0), cA + kstep, voffA); PG8_STAGE(PG8_SB(1, 1), cB + hstep + kstep, voffB);
        PG8_WAIT_V(6); PG8_BAR;
    }
    for (;;) {
        const bool has_next = S.next(ui + 1, nxt);
        const char* nA = has_next ? (const char*)g.A + (size_t)nxt.pm * tstep : cA; const char* nB = has_next ? (const char*)g.Bt + (size_t)nxt.pn * tstep : cB;
        for (int t = 0; t < nt; t += 2) {
            const bool last = (t == nt - 2);
            const char* a1 = cA + (size_t)(t + 1) * kstep;
            const char* a2 = last ? nA : cA + (size_t)(t + 2) * kstep; const char* b2 = last ? nB : cB + (size_t)(t + 2) * kstep;
            const char* a3 = a2 + kstep; const char* b3 = b2 + kstep;
            if (last && has_next) S.a_ready(nxt);
            if constexpr (SP2) {
            PG8_LDB(B0, 0, 0); PG8_LDB(B1, 0, 1); PG8_SCHED; PG8_LDA(At, 0, 0); PG8_STAGE(PG8_SA(1, 1), a1 + hstepA, voffA);
            PG8_WAIT_V(8); PG8_WAIT_L(0); PG8_BAR; PG8_MMA(0, 0, At, B0); PG8_MMA(0, 1, At, B1); PG8_BAR; PG8_SCHED;
            PG8_LDA(At, 0, 1); PG8_STAGE(PG8_SB(0, 0), b2, voffB); PG8_STAGE(PG8_SB(0, 1), b2 + hstep, voffB); PG8_STAGE(PG8_SA(0, 0), a2, voffA);
            PG8_WAIT_V(8); PG8_WAIT_L(0); PG8_BAR; PG8_MMA(1, 0, At, B0); PG8_MMA(1, 1, At, B1); PG8_BAR; PG8_SCHED;
            PG8_LDB(B0, 1, 0); PG8_LDB(B1, 1, 1); PG8_SCHED; PG8_LDA(At, 1, 0); PG8_STAGE(PG8_SA(0, 1), a2 + hstepA, voffA);
            PG8_WAIT_V(8); PG8_WAIT_L(0); PG8_BAR; PG8_MMA(0, 0, At, B0); PG8_MMA(0, 1, At, B1); PG8_BAR; PG8_SCHED;
            PG8_LDA(At, 1, 1); PG8_STAGE(PG8_SB(1, 0), b3, voffB); PG8_STAGE(PG8_SB(1, 1), b3 + hstep, voffB); PG8_STAGE(PG8_SA(1, 0), a3, voffA);
            PG8_WAIT_V(8); PG8_WAIT_L(0); PG8_BAR; PG8_MMA(1, 0, At, B0); PG8_MMA(1, 1, At, B1); PG8_BAR; PG8_SCHED;
            } else {
            PG8_LDB(B0, 0, 0); PG8_SCHED; PG8_LDA(At, 0, 0); PG8_STAGE(PG8_SA(1, 1), a1 + hstepA, voffA);
            PG8_WAIT_L(8); PG8_BAR; PG8_WAIT_L(0); PG8_MMA(0, 0, At, B0); PG8_BAR; PG8_SCHED;
            PG8_LDB(B1, 0, 1); PG8_STAGE(PG8_SB(0, 0), b2, voffB);
            PG8_BAR; PG8_WAIT_L(0); PG8_MMA(0, 1, At, B1); PG8_BAR;
            PG8_LDA(At, 0, 1); PG8_STAGE(PG8_SA(0, 0), a2, voffA);
            PG8_BAR; PG8_WAIT_L(0); PG8_MMA(1, 0, At, B0); PG8_BAR; PG8_SCHED;
            PG8_STAGE(PG8_SB(0, 1), b2 + hstep, voffB);
            PG8_WAIT_V(6); PG8_BAR; PG8_MMA(1, 1, At, B1); PG8_BAR;
            PG8_LDB(B0, 1, 0); PG8_SCHED; PG8_LDA(At, 1, 0); PG8_STAGE(PG8_SA(0, 1), a2 + hstepA, voffA);
            PG8_WAIT_L(8); PG8_BAR; PG8_WAIT_L(0); PG8_MMA(0, 0, At, B0); PG8_BAR; PG8_SCHED;
            PG8_LDB(B1, 1, 1); PG8_STAGE(PG8_SB(1, 0), b3, voffB);
            PG8_BAR; PG8_WAIT_L(0); PG8_MMA(0, 1, At, B1); PG8_BAR;
            PG8_LDA(At, 1, 1); PG8_STAGE(PG8_SA(1, 0), a3, voffA);
            PG8_BAR; PG8_WAIT_L(0); PG8_MMA(1, 0, At, B0); PG8_BAR; PG8_SCHED;
            PG8_STAGE(PG8_SB(1, 1), b3 + hstep, voffB);
            PG8_WAIT_V(6); PG8_BAR; PG8_MMA(1, 1, At, B1); PG8_BAR;
            }
        }
        if constexpr (ALIGN_EPI) { if (wr == 0) PG8_BAR; }
        if constexpr (!Epi::AFTER_DRAIN) { E(acc, cur, wr, wc, fr, fq); S.done(cur); }
        if (!has_next) break;
#pragma unroll
        for (int a = 0; a < 2; ++a)
#pragma unroll
            for (int b = 0; b < 2; ++b)
#pragma unroll
                for (int m = 0; m < 4; ++m)
#pragma unroll
                    for (int n = 0; n < 2; ++n) acc[a][b][m][n] = (f32x4){0.f, 0.f, 0.f, 0.f};
        cur = nxt; cA = nA; cB = nB; ++ui;
        if constexpr (ALIGN_EPI) { if (wr == 1) PG8_BAR; }
    }
    PG8_WAIT_V(0);
    if constexpr (!ALIGN_EPI) { if (wr == 0) PG8_BAR; }
    PG8_BAR;
    if constexpr (Epi::AFTER_DRAIN) { E.fused(acc, cur, wr, wc, fr, fq, lds, wid, lane); S.done(cur); }
#undef PG8_SA
#undef PG8_SB
#undef PG8_STAGE
#undef PG8_LDA
#undef PG8_LDB
#undef PG8_MMA
#undef PG8_WAIT_V
#undef PG8_WAIT_L
#undef PG8_BAR
#undef PG8_SCHED
}
}

using pg8::bf16_t; using pg8::bf16x8; using pg8::f32x4; using pg8::u32x4;
typedef unsigned u32x2 __attribute__((ext_vector_type(2)));
typedef short s16x4 __attribute__((ext_vector_type(4)));
#define LAS __attribute__((address_space(3)))

constexpr int NTHREADS = 512;
constexpr int MTOK = 65536, DM = 1024, SEQ = 2048, NBATCH = 32, DEPTH = 4;
constexpr int NPROJ = 2304;
constexpr int INW = 2176;
constexpr int DFF = 2816, DFF2 = 5632;
constexpr int MEMROWS = 8192;
constexpr int MHALF = 32768;
constexpr float EPSF = 1e-6f;
constexpr float LOG2E = 1.4426950408889634f;
constexpr int LDS_BYTES = 155648;
constexpr int LDS_UNIT_OFF = 155648 - 64;
constexpr int LDS_TBL_OFF = 155648 - 512;

constexpr size_t MiB = 1u << 20;
constexpr size_t WS_CTL = 0;
constexpr size_t WS_ST = 1 * MiB;
constexpr size_t WS_STM = 5 * MiB;
constexpr size_t WS_CS = 5 * MiB + 512 * 1024;
constexpr size_t WS_KST = 6 * MiB;
constexpr size_t WS_QST = 14 * MiB;
constexpr size_t WS_MEMB = 22 * MiB;
constexpr size_t WS_W = 38 * MiB;
constexpr size_t W_LAYER = 27 * MiB;
constexpr size_t W_IN = 0, W_OUT = (size_t)(4.5 * MiB), W_Q = (size_t)(6.5 * MiB), W_O = (size_t)(8.5 * MiB), W_UP = (size_t)(10.5 * MiB), W_DOWN = (size_t)(21.5 * MiB);
constexpr size_t WS_WKV = WS_W + 4 * W_LAYER;
constexpr size_t WS_HB = 162 * MiB;
constexpr size_t WS_KV = 290 * MiB;
constexpr size_t WS_BIG = 418 * MiB;
constexpr size_t WS_PROJ = WS_BIG;
constexpr size_t WS_MIXED = WS_BIG + 288 * MiB;
constexpr size_t WS_QM = WS_MIXED + 128 * MiB;
constexpr size_t WS_ACT = WS_BIG;
constexpr size_t WS_SG = WS_BIG + 352 * MiB;
constexpr size_t WS_SU = WS_BIG + 376 * MiB;
constexpr size_t WS_END = WS_QM + 128 * MiB;
static_assert(WS_WKV + 16 * MiB <= WS_HB, "ws map");
static_assert(WS_SU + 12 * MiB <= WS_END, "ws map");

struct Args { const float* in[28]; float* out; unsigned char* ws; };
struct Ctx { LAS const unsigned long long* tbl; float* out; unsigned char* ws; int wv; };
__device__ __forceinline__ const float* inptr(const Ctx& c, int i) {
    const unsigned long long v = c.tbl[i];
    const unsigned lo = __builtin_amdgcn_readfirstlane((unsigned)v), hi = __builtin_amdgcn_readfirstlane((unsigned)(v >> 32));
    return (const float*)(((unsigned long long)hi << 32) | lo);
}

__device__ __forceinline__ float bf2f(unsigned short b) { return __uint_as_float(((unsigned)b) << 16); }
__device__ __forceinline__ float bflo(unsigned w) { return __uint_as_float(w << 16); }
__device__ __forceinline__ float bfhi(unsigned w) { return __uint_as_float(w & 0xffff0000u); }
__device__ __forceinline__ unsigned pkbf(float lo, float hi) { unsigned r; asm("v_cvt_pk_bf16_f32 %0, %1, %2" : "=v"(r) : "v"(lo), "v"(hi)); return r; }
__device__ __forceinline__ unsigned short f2bf(float f) { return (unsigned short)(pkbf(f, 0.f) & 0xffffu); }
__device__ __forceinline__ float shx(float v, int lane, int m) { return __int_as_float(__builtin_amdgcn_ds_bpermute((lane ^ m) << 2, __float_as_int(v))); }
__device__ __forceinline__ float shi(float v, int src) { return __int_as_float(__builtin_amdgcn_ds_bpermute(src << 2, __float_as_int(v))); }
__device__ __forceinline__ float wave_sum(float v, int lane) {
#pragma unroll
    for (int o = 1; o < 64; o <<= 1) v += shx(v, lane, o);
    return v;
}
__device__ __forceinline__ float sigmoidf_(float x) { return __builtin_amdgcn_rcpf(1.0f + __builtin_amdgcn_exp2f(-LOG2E * x)); }
__device__ __forceinline__ float gelu_tanh(float x) {
    const float u2 = (-2.0f * 0.7978845608028654f * LOG2E) * (x + 0.044715f * x * x * x);
    return x * __builtin_amdgcn_rcpf(1.0f + __builtin_amdgcn_exp2f(u2));
}
__device__ __forceinline__ LAS unsigned char* lds_l(LAS unsigned char* p) { unsigned v = (unsigned)(uintptr_t)p; asm volatile("" : "+s"(v)); return (LAS unsigned char*)(uintptr_t)v; }
__device__ __forceinline__ int tid_w(int wv) { int t = (wv << 6) + (int)__builtin_amdgcn_mbcnt_hi(~0u, __builtin_amdgcn_mbcnt_lo(~0u, 0u)); asm volatile("" : "+v"(t)); return t; }
__device__ __forceinline__ s16x4 vtr(LAS const unsigned char* p) {
    typedef short v4i16_t __attribute__((ext_vector_type(4)));
    return __builtin_bit_cast(s16x4, __builtin_amdgcn_ds_read_tr16_b64_v4i16((LAS v4i16_t*)p));
}

#define LBAR() do { asm volatile("s_waitcnt lgkmcnt(0)" ::: "memory"); __builtin_amdgcn_s_barrier(); asm volatile("" ::: "memory"); } while (0)

template <bool QKN> struct EpiBf {
    static constexpr bool PERM = true, AFTER_DRAIN = false;
    bf16_t* O; int ldc; const float* st; float* pst; int npg; const float* cs; const float* qg; const float* kg;
    __device__ __forceinline__ void operator()(const f32x4 (&acc)[2][2][4][2], const pg8::Unit& u, int wr, int wc, int fr, int fq) const {
        const int lane = fq * 16 + fr;
        int kind = 0; const float* gsel = nullptr;
        if (QKN) { const int c0 = u.pn * 256 + 64 * wc; if (c0 >= 256 && c0 < 640) { kind = 1; gsel = qg; } else if (c0 >= 640 && c0 < 1024) { kind = 2; gsel = kg; } }
        const int rbase = u.pm * 256 + wr * 64 + fr;
        float rloc[2];
#pragma unroll
        for (int k = 0; k < 2; ++k) {
            const int i = 2 * fq + k, r = rbase + (i >> 2) * 128 + (i & 3) * 16;
            const f32x4* sp = (const f32x4*)(st + (size_t)r * 16);
            const f32x4 s0 = sp[0], s1 = sp[1], s2 = sp[2], s3 = sp[3];
            const float ssum = ((s0[0] + s0[1]) + (s0[2] + s0[3])) + ((s1[0] + s1[1]) + (s1[2] + s1[3])) + ((s2[0] + s2[1]) + (s2[2] + s2[3])) + ((s3[0] + s3[1]) + (s3[2] + s3[3]));
            rloc[k] = rsqrtf(ssum * (1.0f / 1024.0f) + EPSF);
        }
        f32x4 cf[2][2];
#pragma unroll
        for (int bj = 0; bj < 2; ++bj)
#pragma unroll
            for (int n = 0; n < 2; ++n) {
                cf[bj][n] = (f32x4){1.f, 1.f, 1.f, 1.f};
                if (QKN) { if (kind != 0) cf[bj][n] = *(const f32x4*)(gsel + 32 * bj + 8 * fq + 4 * n); }
                else if (cs) cf[bj][n] = *(const f32x4*)(cs + u.pn * 256 + bj * 128 + wc * 32 + 8 * fq + 4 * n);
            }
#pragma unroll
        for (int ai = 0; ai < 2; ++ai)
#pragma unroll
            for (int m = 0; m < 4; ++m) {
                const int r = rbase + ai * 128 + m * 16;
                const float rsv = shi(rloc[m & 1], (ai * 2 + (m >> 1)) * 16 + fr);
                f32x4 v[2][2];
#pragma unroll
                for (int bj = 0; bj < 2; ++bj)
#pragma unroll
                    for (int n = 0; n < 2; ++n) v[bj][n] = acc[ai][bj][m][n] * rsv;
                if (QKN) {
                    if (kind != 0) {
                        float ss = 0.f;
#pragma unroll
                        for (int bj = 0; bj < 2; ++bj)
#pragma unroll
                            for (int n = 0; n < 2; ++n) ss += (v[bj][n][0] * v[bj][n][0] + v[bj][n][1] * v[bj][n][1]) + (v[bj][n][2] * v[bj][n][2] + v[bj][n][3] * v[bj][n][3]);
                        ss += shx(ss, lane, 16); ss += shx(ss, lane, 32);
                        float rn = rsqrtf(ss * (1.0f / 64.0f) + EPSF);
                        if (kind == 1) rn *= 0.125f * LOG2E;
#pragma unroll
                        for (int bj = 0; bj < 2; ++bj)
#pragma unroll
                            for (int n = 0; n < 2; ++n) v[bj][n] = v[bj][n] * rn * cf[bj][n];
                    }
                } else {
                    if (pst) {
#pragma unroll
                        for (int bj = 0; bj < 2; ++bj) {
                            float ss = (v[bj][0][0] * v[bj][0][0] + v[bj][0][1] * v[bj][0][1]) + (v[bj][0][2] * v[bj][0][2] + v[bj][0][3] * v[bj][0][3])
                                     + (v[bj][1][0] * v[bj][1][0] + v[bj][1][1] * v[bj][1][1]) + (v[bj][1][2] * v[bj][1][2] + v[bj][1][3] * v[bj][1][3]);
                            ss += shx(ss, lane, 16); ss += shx(ss, lane, 32);
                            if (fq == 0) pst[(size_t)r * npg + (u.pn * 8 + bj * 4 + wc)] = ss;
                        }
                    }
                    if (cs) {
#pragma unroll
                        for (int bj = 0; bj < 2; ++bj)
#pragma unroll
                            for (int n = 0; n < 2; ++n) v[bj][n] = v[bj][n] * cf[bj][n];
                    }
                }
#pragma unroll
                for (int bj = 0; bj < 2; ++bj) {
                    const int col = QKN ? (u.pn * 256 + 64 * wc + 32 * bj + 8 * fq) : (u.pn * 256 + 128 * bj + 32 * wc + 8 * fq);
                    u32x4 w; w.x = pkbf(v[bj][0][0], v[bj][0][1]); w.y = pkbf(v[bj][0][2], v[bj][0][3]); w.z = pkbf(v[bj][1][0], v[bj][1][1]); w.w = pkbf(v[bj][1][2], v[bj][1][3]);
                    *(u32x4*)(O + (size_t)r * ldc + col) = w;
                }
            }
    }
};

struct EpiRes {
    static constexpr bool PERM = false, AFTER_DRAIN = false;
    const float* resid; float* out; bf16_t* hb; float* st;
    __device__ __forceinline__ void operator()(const f32x4 (&acc)[2][2][4][2], const pg8::Unit& u, int wr, int wc, int fr, int fq) const {
        const int lane = fq * 16 + fr;
        const int rbase = u.pm * 256 + wr * 64 + fr, cbase = u.pn * 256 + wc * 32 + 4 * fq;
        f32x4 pre[2][2][2];
#define EPIRES_LOAD(I) do { const size_t ro_ = (size_t)(rbase + ((I) >> 2) * 128 + ((I) & 3) * 16) * DM + cbase; \
            _Pragma("unroll") for (int bj = 0; bj < 2; ++bj) _Pragma("unroll") for (int n = 0; n < 2; ++n) pre[(I) % 2][bj][n] = *(const f32x4*)(resid + ro_ + bj * 128 + n * 16); } while (0)
        EPIRES_LOAD(0); EPIRES_LOAD(1);
#pragma unroll
        for (int i = 0; i < 8; ++i) {
            const int ai = i >> 2, m = i & 3;
            const int r = rbase + ai * 128 + m * 16;
            float ss = 0.f;
            f32x4 v[2][2];
#pragma unroll
            for (int bj = 0; bj < 2; ++bj)
#pragma unroll
                for (int n = 0; n < 2; ++n) v[bj][n] = pre[i % 2][bj][n] + acc[ai][bj][m][n];
            asm volatile("" ::: "memory");
            if (i + 2 < 8) EPIRES_LOAD(i + 2);
            asm volatile("" ::: "memory");
#pragma unroll
            for (int bj = 0; bj < 2; ++bj)
#pragma unroll
                for (int n = 0; n < 2; ++n) {
                    const size_t off = (size_t)r * DM + cbase + bj * 128 + n * 16;
                    *(f32x4*)(out + off) = v[bj][n];
                    u32x2 w; w.x = pkbf(v[bj][n][0], v[bj][n][1]); w.y = pkbf(v[bj][n][2], v[bj][n][3]);
                    *(u32x2*)(hb + off) = w;
                    ss += (v[bj][n][0] * v[bj][n][0] + v[bj][n][1] * v[bj][n][1]) + (v[bj][n][2] * v[bj][n][2] + v[bj][n][3] * v[bj][n][3]);
                }
            ss += shx(ss, lane, 16); ss += shx(ss, lane, 32);
            if (fq == 0) st[(size_t)r * 16 + u.pn * 4 + wc] = ss;
        }
#undef EPIRES_LOAD
    }
};

struct EpiAct {
    static constexpr bool PERM = true, AFTER_DRAIN = false;
    bf16_t* act; const float* st; const float* cw; const float* cb; float* sg; float* su;
    __device__ __forceinline__ void operator()(const f32x4 (&acc)[2][2][4][2], const pg8::Unit& u, int wr, int wc, int fr, int fq) const {
        const int lane = fq * 16 + fr;
        const int tok0 = u.pm * 256 + (16 * wr + fr) * 8;
        const int f0 = u.pn * 128 + 32 * wc + 8 * fq;
        float rloc[2], rs[8];
#pragma unroll
        for (int k = 0; k < 2; ++k) {
            const f32x4* sp = (const f32x4*)(st + (size_t)(tok0 + 2 * fq + k) * 16);
            const f32x4 s0 = sp[0], s1 = sp[1], s2 = sp[2], s3 = sp[3];
            const float ssum = ((s0[0] + s0[1]) + (s0[2] + s0[3])) + ((s1[0] + s1[1]) + (s1[2] + s1[3])) + ((s2[0] + s2[1]) + (s2[2] + s2[3])) + ((s3[0] + s3[1]) + (s3[2] + s3[3]));
            rloc[k] = rsqrtf(ssum * (1.0f / 1024.0f) + EPSF);
        }
#pragma unroll
        for (int e = 0; e < 8; ++e) rs[e] = shi(rloc[e & 1], (e >> 1) * 16 + fr);
        float* sgp = sg + ((size_t)u.pm * 8 + wr * 4) * DFF + f0;
        float* sup = su + ((size_t)u.pm * 4 + wr * 2) * DFF + f0;
#pragma unroll
        for (int n = 0; n < 2; ++n) {
            unsigned res[8][2];
#pragma unroll
            for (int ip = 0; ip < 2; ++ip) {
                float av[2][8];
#pragma unroll
                for (int ic = 0; ic < 2; ++ic) {
                    const int i = 2 * ip + ic, c = 4 * n + i;
                    float g[8], uu[8];
#pragma unroll
                    for (int e = 0; e < 8; ++e) { g[e] = acc[e >> 2][0][e & 3][n][i] * rs[e]; uu[e] = acc[e >> 2][1][e & 3][n][i] * rs[e]; }
                    const float p1 = shi(g[7], lane - 1), p2 = shi(g[6], lane - 1);
                    const float w0 = cw[f0 + c], w1 = cw[DFF + f0 + c], w2 = cw[2 * DFF + f0 + c], bb = cb[f0 + c];
#pragma unroll
                    for (int e = 0; e < 8; ++e) {
                        const float gm1 = (e >= 1) ? g[e >= 1 ? e - 1 : 0] : p1;
                        const float gm2 = (e >= 2) ? g[e >= 2 ? e - 2 : 0] : (e == 1 ? p1 : p2);
                        av[ic][e] = gelu_tanh(bb + w0 * g[e] + w1 * gm1 + w2 * gm2) * uu[e];
                    }
                    if (fr == 0) { sgp[c] = g[0]; sgp[DFF + c] = g[1]; sup[c] = uu[0]; sup[DFF + c] = uu[1]; }
                    if (fr == 15) { sgp[2 * DFF + c] = g[6]; sgp[3 * DFF + c] = g[7]; }
                }
#pragma unroll
                for (int e = 0; e < 8; ++e) res[e][ip] = pkbf(av[0][e], av[1][e]);
                asm volatile("" ::: "memory");
            }
#pragma unroll
            for (int e = 0; e < 8; ++e) {
                if (fr == 0 && e < 2) continue;
                u32x2 w; w.x = res[e][0]; w.y = res[e][1];
                *(u32x2*)(act + (size_t)(tok0 + e) * DFF + f0 + 4 * n) = w;
            }
            asm volatile("" ::: "memory");
        }
    }
};

template <class Epi>
__device__ __forceinline__ void run_gemm(int wv, LAS unsigned char* lds, const bf16_t* A, const bf16_t* Bt, int M, int N, int K, const Epi& E) {
    pg8::Gemm g{A, Bt, M, N, K}; pg8::StaticOrder S; S.init(M, N, (int)gridDim.x, (int)blockIdx.x);
    pg8::gemm_phase<Epi, pg8::StaticOrder, true, true>(tid_w(wv), lds_l(lds), g, S, E);
}
template <class Epi>
__device__ __forceinline__ void run_gemm_aperm(int wv, LAS unsigned char* lds, const bf16_t* A, const bf16_t* Bt, int M, int N, int K, const Epi& E) {
    pg8::Gemm g{A, Bt, M, N, K}; pg8::StaticOrder S; S.init(M, N, (int)gridDim.x, (int)blockIdx.x);
    pg8::gemm_phase<Epi, pg8::StaticOrder, true, true, true>(tid_w(wv), lds_l(lds), g, S, E);
}

__device__ __forceinline__ void transpose_item(const float* W, int ldw, int K, const float* gain, bf16_t* WT, int dst_row0, bool zero, LAS float* scr, int k0, int n0, int lane) {
#pragma unroll 8
    for (int i = 0; i < 32; ++i) {
        const int kk = 2 * i + (lane >> 5);
        float v = 0.f;
        if (!zero) { v = W[(size_t)(k0 + kk) * ldw + n0 + (lane & 31)]; if (gain) v *= gain[k0 + kk]; }
        scr[kk * 33 + (lane & 31)] = v;
    }
    asm volatile("s_waitcnt lgkmcnt(0)" ::: "memory");
    const int c = lane & 7;
#pragma unroll
    for (int j = 0; j < 4; ++j) {
        const int n = (lane >> 3) + 8 * j; const LAS float* s = scr + (8 * c) * 33 + n;
        u32x4 o; o.x = pkbf(s[0 * 33], s[1 * 33]); o.y = pkbf(s[2 * 33], s[3 * 33]); o.z = pkbf(s[4 * 33], s[5 * 33]); o.w = pkbf(s[6 * 33], s[7 * 33]);
        *(u32x4*)(WT + (size_t)(dst_row0 + n) * K + k0 + 8 * c) = o;
    }
    asm volatile("s_waitcnt lgkmcnt(0)" ::: "memory");
}
__device__ __forceinline__ void row_to_bf16(const float* xrow, bf16_t* orow, float* strow, int lane) {
    const f32x4* xr = (const f32x4*)xrow + lane;
    f32x4 v[4]; float s = 0.f;
#pragma unroll
    for (int j = 0; j < 4; ++j) { v[j] = xr[64 * j]; s += (v[j][0] * v[j][0] + v[j][1] * v[j][1]) + (v[j][2] * v[j][2] + v[j][3] * v[j][3]); }
    s = wave_sum(s, lane);
    u32x2* o8 = (u32x2*)orow + lane;
#pragma unroll
    for (int j = 0; j < 4; ++j) { u32x2 w; w.x = pkbf(v[j][0], v[j][1]); w.y = pkbf(v[j][2], v[j][3]); o8[64 * j] = w; }
    if (lane < 16) strow[lane] = (lane == 0) ? s : 0.f;
}
__device__ __forceinline__ void phase_prologue(const Ctx& a, LAS unsigned char* lds) {
    lds = lds_l(lds);
    const int tid = tid_w(a.wv), lane = tid & 63, wave = tid >> 6;
    LAS float* scr = (LAS float*)(lds + wave * 16384);
    const int gw = blockIdx.x * 8 + wave, NGW = gridDim.x * 8;
    unsigned char* ws = a.ws;
    constexpr int I_IN = 16 * 72, I_SQ = 16 * 32, I_UP = 16 * 176, I_DN = 44 * 32, I_KV = 16 * 64;
    constexpr int I_LAYER = I_IN + 3 * I_SQ + I_UP + I_DN + I_KV;
    for (int it = gw; it < DEPTH * I_LAYER; it += NGW) {
        const int l = it / I_LAYER; int r = it % I_LAYER;
        bf16_t* wl = (bf16_t*)(ws + WS_W + (size_t)l * W_LAYER);
        if (r < I_IN) {
            const int kb = r / 72, nb = r % 72, n0 = nb * 32;
            const int dst = (n0 & ~255) + 128 * ((n0 >> 5) & 1) + 32 * ((n0 >> 6) & 3);
            transpose_item(inptr(a, 3) + (size_t)l * DM * INW, INW, DM, inptr(a, 2) + l * DM, (bf16_t*)((unsigned char*)wl + W_IN), dst, n0 >= INW, scr, kb * 64, n0, lane);
            continue;
        }
        r -= I_IN;
        if (r < I_SQ) { transpose_item(inptr(a, 15) + (size_t)l * DM * DM, DM, DM, nullptr, (bf16_t*)((unsigned char*)wl + W_OUT), (r % 32) * 32, false, scr, (r / 32) * 64, (r % 32) * 32, lane); continue; }
        r -= I_SQ;
        if (r < I_SQ) { transpose_item(inptr(a, 18) + (size_t)l * DM * DM, DM, DM, inptr(a, 16) + l * DM, (bf16_t*)((unsigned char*)wl + W_Q), (r % 32) * 32, false, scr, (r / 32) * 64, (r % 32) * 32, lane); continue; }
        r -= I_SQ;
        if (r < I_SQ) { transpose_item(inptr(a, 22) + (size_t)l * DM * DM, DM, DM, nullptr, (bf16_t*)((unsigned char*)wl + W_O), (r % 32) * 32, false, scr, (r / 32) * 64, (r % 32) * 32, lane); continue; }
        r -= I_SQ;
        if (r < I_UP) { transpose_item(inptr(a, 24) + (size_t)l * DM * DFF2, DFF2, DM, inptr(a, 23) + l * DM, (bf16_t*)((unsigned char*)wl + W_UP), ((((r % 176) * 32) % DFF) / 128) * 256 + 128 * (((r % 176) * 32) / DFF) + (((r % 176) * 32) % DFF) % 128, false, scr, (r / 176) * 64, (r % 176) * 32, lane); continue; }
        r -= I_UP;
        if (r < I_DN) { transpose_item(inptr(a, 27) + (size_t)l * DFF * DM, DM, DFF, nullptr, (bf16_t*)((unsigned char*)wl + W_DOWN), (r % 32) * 32, false, scr, (r / 32) * 64, (r % 32) * 32, lane); continue; }
        r -= I_DN;
        transpose_item(inptr(a, 19) + (size_t)l * DM * 2048, 2048, DM, inptr(a, 17) + l * DM, (bf16_t*)(ws + WS_WKV), l * 2048 + (r % 64) * 32, false, scr, (r / 64) * 64, (r % 64) * 32, lane);
    }
    for (int i = blockIdx.x * NTHREADS + tid; i < DEPTH * DM; i += gridDim.x * NTHREADS) { const int l = i >> 10, dd = i & 255; ((float*)(ws + WS_CS))[i] = inptr(a, 20)[l * 256 + dd] * inptr(a, 21)[l * 256 + dd] * (0.0625f * LOG2E); }
    for (int m = gw; m < MTOK; m += NGW) row_to_bf16(inptr(a, 0) + (size_t)m * DM, (bf16_t*)(ws + WS_HB) + (size_t)m * DM, (float*)(ws + WS_ST) + (size_t)m * 16, lane);
    for (int m = gw; m < MEMROWS; m += NGW) row_to_bf16(inptr(a, 1) + (size_t)m * DM, (bf16_t*)(ws + WS_MEMB) + (size_t)m * DM, (float*)(ws + WS_STM) + (size_t)m * 16, lane);
}

__device__ __forceinline__ void lru_unit(const Ctx& a, int l, int b, int g, LAS unsigned char* lds) {
    lds = lds_l(lds);
    const int tid = tid_w(a.wv), lane = tid & 63, wave = tid >> 6, l15 = lane & 15, gq = lane >> 4;
    LAS unsigned char* XT = lds;
    LAS unsigned char* XCB = lds + 19008;
    LAS float* XCF = (LAS float*)(lds + 37440);
    LAS float* AA = (LAS float*)(lds + 70208);
    LAS float* BB = (LAS float*)(lds + 102976);
    LAS unsigned char* WT = lds + 135744;
    const bf16_t* proj = (const bf16_t*)(a.ws + WS_PROJ) + (size_t)b * SEQ * NPROJ;
    bf16_t* mixed = (bf16_t*)(a.ws + WS_MIXED) + (size_t)b * SEQ * DM;
    const float* wa = inptr(a, 10) + ((size_t)l * 6 + g) * 4096; const float* wx = inptr(a, 12) + ((size_t)l * 6 + g) * 4096;
    for (int k = 0; k < 16; ++k) {
        const int idx = tid + 512 * k, which = idx >> 12, cp = (idx >> 6) & 63, c = idx & 63;
        const float v = which ? wx[cp * 64 + c] : wa[cp * 64 + c];
        *(LAS unsigned short*)(WT + (which * 64 + c) * 144 + cp * 2) = f2bf(v);
    }
    const int cch = tid & 63, ch = g * 64 + cch;
    float cw[4];
#pragma unroll
    for (int j = 0; j < 4; ++j) cw[j] = inptr(a, 8)[((size_t)l * 4 + j) * 384 + ch];
    const float cb = inptr(a, 9)[l * 384 + ch];
    float gba[4], gbx[4], gsp[4];
#pragma unroll
    for (int nt = 0; nt < 4; ++nt) {
        const int c2 = l * 384 + g * 64 + 16 * nt + l15;
        gba[nt] = inptr(a, 11)[c2]; gbx[nt] = inptr(a, 13)[c2];
        const float z = -inptr(a, 14)[c2];
        gsp[nt] = (8.0f * LOG2E) * (fmaxf(z, 0.f) + log1pf(__expf(-fabsf(z))));
    }
    float hcar = 0.f;
    const bf16_t* xsrc = proj + 1408 + g * 64;
    const bf16_t* ysrc = proj + 1792 + g * 64;
    u32x4 xr[3];
#pragma unroll
    for (int k = 0; k < 3; ++k) {
        const int idx = tid + 512 * k, row = idx >> 3, cv = idx & 7, tok = row - 3;
        xr[k] = (idx < 1048 && tok >= 0) ? *(const u32x4*)(xsrc + (size_t)tok * NPROJ + cv * 8) : (u32x4){0u, 0u, 0u, 0u};
    }
#pragma unroll 1
    for (int ck = 0; ck < 16; ++ck) {
        const int t0 = ck * 128;
#pragma unroll
        for (int k = 0; k < 3; ++k) { const int idx = tid + 512 * k, row = idx >> 3, cv = idx & 7; if (idx < 1048) *(LAS u32x4*)(XT + row * 144 + cv * 16) = xr[k]; }
        u32x4 yr[2];
#pragma unroll
        for (int k = 0; k < 2; ++k) { const int idx = tid + 512 * k, row = idx >> 3, cv = idx & 7; yr[k] = *(const u32x4*)(ysrc + (size_t)(t0 + row) * NPROJ + cv * 8); }
        if (ck < 15) {
#pragma unroll
            for (int k = 0; k < 3; ++k) {
                const int idx = tid + 512 * k, row = idx >> 3, cv = idx & 7, tok = t0 + 128 - 3 + row;
                xr[k] = (idx < 1048) ? *(const u32x4*)(xsrc + (size_t)tok * NPROJ + cv * 8) : (u32x4){0u, 0u, 0u, 0u};
            }
        }
        LBAR();
#pragma unroll 4
        for (int k = 0; k < 16; ++k) {
            const int t = (tid >> 6) + 8 * k;
            float xc = cb;
#pragma unroll
            for (int j = 0; j < 4; ++j) xc += cw[j] * bf2f(*(LAS const unsigned short*)(XT + (t + 3 - j) * 144 + cch * 2));
            XCF[t * 64 + cch] = xc;
            *(LAS unsigned short*)(XCB + t * 144 + cch * 2) = f2bf(xc);
        }
        LBAR();
        {
            f32x4 acc[8];
#pragma unroll
            for (int nt = 0; nt < 8; ++nt) acc[nt] = (f32x4){0.f, 0.f, 0.f, 0.f};
#pragma unroll
            for (int ks = 0; ks < 2; ++ks) {
                const bf16x8 af = *(LAS const bf16x8*)(XCB + (16 * wave + l15) * 144 + (32 * ks + 8 * gq) * 2);
#pragma unroll
                for (int nt = 0; nt < 8; ++nt) {
                    const bf16x8 bfr = *(LAS const bf16x8*)(WT + (16 * nt + l15) * 144 + (32 * ks + 8 * gq) * 2);
                    acc[nt] = __builtin_amdgcn_mfma_f32_16x16x32_bf16(af, bfr, acc[nt], 0, 0, 0);
                }
            }
#pragma unroll
            for (int nt = 0; nt < 4; ++nt)
#pragma unroll
                for (int rg = 0; rg < 4; ++rg) {
                    const int t = 16 * wave + 4 * gq + rg, c = 16 * nt + l15;
                    const float r = sigmoidf_(acc[nt][rg] + gba[nt]), ig = sigmoidf_(acc[nt + 4][rg] + gbx[nt]);
                    const float av = __builtin_amdgcn_exp2f(-r * gsp[nt]);
                    const float xcv = XCF[t * 64 + c];
                    AA[t * 64 + c] = av;
                    BB[t * 64 + c] = __builtin_amdgcn_sqrtf(fmaxf(1.0f - av * av, 0.f)) * (ig * xcv);
                }
        }
        LBAR();
        if (wave == 0) {
#pragma unroll 16
            for (int t = 0; t < 128; ++t) { hcar = AA[t * 64 + lane] * hcar + BB[t * 64 + lane]; BB[t * 64 + lane] = hcar; }
        }
        LBAR();
#pragma unroll
        for (int k = 0; k < 2; ++k) {
            const int idx = tid + 512 * k, row = idx >> 3, cv = idx & 7;
            const f32x4 h0 = *(LAS const f32x4*)(BB + row * 64 + cv * 8), h1 = *(LAS const f32x4*)(BB + row * 64 + cv * 8 + 4);
            u32x4 w;
            w.x = pkbf(h0[0] * gelu_tanh(bflo(yr[k].x)), h0[1] * gelu_tanh(bfhi(yr[k].x)));
            w.y = pkbf(h0[2] * gelu_tanh(bflo(yr[k].y)), h0[3] * gelu_tanh(bfhi(yr[k].y)));
            w.z = pkbf(h1[0] * gelu_tanh(bflo(yr[k].z)), h1[1] * gelu_tanh(bfhi(yr[k].z)));
            w.w = pkbf(h1[2] * gelu_tanh(bflo(yr[k].w)), h1[3] * gelu_tanh(bfhi(yr[k].w)));
            *(u32x4*)(mixed + (size_t)(t0 + row) * DM + 640 + g * 64 + cv * 8) = w;
        }
    }
}

__device__ __forceinline__ void pool_unit(const Ctx& a, int l, int b, int tc, LAS unsigned char* lds) {
    lds = lds_l(lds);
    const int tid = tid_w(a.wv);
    LAS float* U = (LAS float*)lds;
    LAS float* P = (LAS float*)(lds + 80896);
    const int t0 = tc * 64;
    const bf16_t* proj = (const bf16_t*)(a.ws + WS_PROJ) + (size_t)b * SEQ * NPROJ;
    bf16_t* mixed = (bf16_t*)(a.ws + WS_MIXED) + (size_t)b * SEQ * DM;
    for (int k = 0; k < 40; ++k) {
        const int idx = tid + 512 * k;
        if (idx < 79 * 256) { const int tt = idx >> 8, c = idx & 255, t = t0 - 15 + tt; U[idx] = (t >= 0) ? bf2f(proj[(size_t)t * NPROJ + c]) : 0.f; }
    }
    __syncthreads();
    {
        const int c = tid & 255, half = tid >> 8, g = c >> 6, w = 2 << g;
        for (int q = 0; q < 32; ++q) {
            const int tt = half * 32 + q, t = t0 + tt;
            float s = 0.f;
            for (int j = 0; j < w; ++j) s += U[(tt + 15 - j) * 256 + c];
            const float cnt = (float)((t + 1 < w) ? (t + 1) : w);
            P[tt * 256 + c] = s / cnt - U[(tt + 15) * 256 + c];
        }
    }
    __syncthreads();
    {
        const int dcol = tid & 255, half = tid >> 8, g = dcol >> 6, dc = dcol & 63;
        const float* pw = inptr(a, 4) + ((size_t)l * 4 + g) * 4096 + dc;
        float w[64];
#pragma unroll
        for (int c = 0; c < 64; ++c) w[c] = pw[c * 64];
        const float sc = inptr(a, 5)[l * 256 + dcol];
        for (int q = 0; q < 32; ++q) {
            const int tt = half * 32 + q;
            const LAS f32x4* pr = (const LAS f32x4*)(P + tt * 256 + g * 64);
            float acc = 0.f;
#pragma unroll
            for (int c4 = 0; c4 < 16; ++c4) { const f32x4 pv = pr[c4]; acc += pv[0] * w[4 * c4] + pv[1] * w[4 * c4 + 1] + pv[2] * w[4 * c4 + 2] + pv[3] * w[4 * c4 + 3]; }
            mixed[(size_t)(t0 + tt) * DM + dcol] = f2bf(acc * sc);
        }
    }
}

__device__ __forceinline__ void dattn_unit(const Ctx& a, int b, int h, int tb, LAS unsigned char* lds) {
    lds = lds_l(lds);
    const int tid = tid_w(a.wv), lane = tid & 63, wave = tid >> 6, l15 = lane & 15, gq = lane >> 4;
    LAS float* OACC = (LAS float*)lds;
    LAS float* DEN = (LAS float*)(lds + 65536);
    LAS unsigned char* vst = lds + 66560 + wave * 4608;
    const int t0 = tb * 256;
    const bf16_t* projb = (const bf16_t*)(a.ws + WS_PROJ) + (size_t)b * SEQ * NPROJ;
    bf16_t* mixed = (bf16_t*)(a.ws + WS_MIXED) + (size_t)b * SEQ * DM;
    const float slope2 = exp2f(-8.0f * (float)(h + 1) / 6.0f) * LOG2E;
    const int trq = (l15 >> 2), trp = (l15 & 3);
#pragma unroll 1
    for (int pi = 0; pi < 3; ++pi) {
        const int d = 1 << (2 * pi);
        const float sl = slope2 * (float)d;
#pragma unroll 1
        for (int ii = 0; ii < 2; ++ii) {
            const int it = 2 * wave + ii, rr = it % d, jj = it / d, tq0 = t0 + rr + 16 * d * jj;
            const unsigned char* pbytes = (const unsigned char*)projb;
            const unsigned qoff = (unsigned)(tq0 + d * l15) * (unsigned)(NPROJ * 2) + (unsigned)((256 + h * 64 + 8 * gq) * 2);
            const bf16x8 qf0 = *(const bf16x8*)(pbytes + qoff), qf1 = *(const bf16x8*)(pbytes + qoff + 64);
            bf16x8 kf[6][2];
#define DATTN_KLOAD(KT) do { if ((KT) < 9) { int tk = tq0 + d * (16 * ((KT) - 8) + l15); tk = tk < 0 ? 0 : tk; \
                const unsigned koff = (unsigned)tk * (unsigned)(NPROJ * 2) + (unsigned)((640 + h * 64 + 8 * gq) * 2); \
                kf[(KT) % 6][0] = *(const bf16x8*)(pbytes + koff); kf[(KT) % 6][1] = *(const bf16x8*)(pbytes + koff + 64); } } while (0)
            DATTN_KLOAD(0); DATTN_KLOAD(1); DATTN_KLOAD(2); DATTN_KLOAD(3); DATTN_KLOAD(4); DATTN_KLOAD(5);
            u32x4 vreg[2][4];
#define DATTN_VLOAD(PP) do { _Pragma("unroll") for (int ps = 0; ps < 4; ++ps) { \
                    const int idx = ps * 64 + lane, row = idx >> 3, chk = idx & 7, kt = 2 * (PP) + (row >> 4); \
                    int tk = tq0 + d * (16 * (kt - 8) + (row & 15)); tk = tk < 0 ? 0 : (tk > SEQ - 1 ? SEQ - 1 : tk); \
                    vreg[(PP) % 2][ps] = *(const u32x4*)(pbytes + ((unsigned)tk * (unsigned)(NPROJ * 2) + (unsigned)((1024 + h * 64 + chk * 8) * 2))); } } while (0)
            DATTN_VLOAD(0); DATTN_VLOAD(1);
            f32x4 o[4];
#pragma unroll
            for (int dt = 0; dt < 4; ++dt) o[dt] = (f32x4){0.f, 0.f, 0.f, 0.f};
            float den = 0.f;
            int dbase = l15 + 128 - 4 * gq; asm volatile("" : "+v"(dbase));
            float fbase = (float)dbase; asm volatile("" : "+v"(fbase));
#pragma unroll
            for (int pp = 0; pp < 5; ++pp) {
#pragma unroll
                for (int ps = 0; ps < 4; ++ps) { const int idx = ps * 64 + lane, row = idx >> 3, chk = idx & 7; *(LAS u32x4*)(vst + row * 144 + chk * 16) = vreg[pp % 2][ps]; }
                if (pp + 2 < 5) { asm volatile("" ::: "memory"); DATTN_VLOAD(pp + 2); }
                const bool skip = (tq0 + d * (16 * (2 * pp + 1 - 8) + 15) < 0);
                f32x4 sacc[2];
#pragma unroll
                for (int T = 0; T < 2; ++T) {
                    const int kt = 2 * pp + T;
                    sacc[T] = (f32x4){0.f, 0.f, 0.f, 0.f};
                    if (kt < 9 && !skip) {
                        sacc[T] = __builtin_amdgcn_mfma_f32_16x16x32_bf16(kf[kt % 6][0], qf0, sacc[T], 0, 0, 0);
                        sacc[T] = __builtin_amdgcn_mfma_f32_16x16x32_bf16(kf[kt % 6][1], qf1, sacc[T], 0, 0, 0);
                    }
                }
                if (pp + 3 < 5) { asm volatile("" ::: "memory"); DATTN_KLOAD(2 * pp + 6); DATTN_KLOAD(2 * pp + 7); }
                if (skip) continue;
                float p[2][4];
#pragma unroll
                for (int T = 0; T < 2; ++T) {
                    const int kt = 2 * pp + T;
#pragma unroll
                    for (int rg = 0; rg < 4; ++rg) {
                        const int dist = dbase - (16 * kt + rg);
                        const int tkk = tq0 + d * (l15 - dist);
                        const bool valid = (kt < 9) && (dist >= 0) && (dist <= 128) && (tkk >= 0);
                        const float pv = valid ? __builtin_amdgcn_exp2f(sacc[T][rg] - sl * (fbase - (float)(16 * kt + rg))) : 0.f;
                        p[T][rg] = pv; den += pv;
                    }
                }
                u32x4 pw; pw.x = pkbf(p[0][0], p[0][1]); pw.y = pkbf(p[0][2], p[0][3]); pw.z = pkbf(p[1][0], p[1][1]); pw.w = pkbf(p[1][2], p[1][3]);
                const bf16x8 pfrag = __builtin_bit_cast(bf16x8, pw);
#pragma unroll
                for (int dt = 0; dt < 4; ++dt) {
                    const s16x4 lo = vtr(vst + (4 * gq + trq) * 144 + (16 * dt + 4 * trp) * 2);
                    const s16x4 hi = vtr(vst + (16 + 4 * gq + trq) * 144 + (16 * dt + 4 * trp) * 2);
                    const bf16x8 vf = (bf16x8){lo[0], lo[1], lo[2], lo[3], hi[0], hi[1], hi[2], hi[3]};
                    o[dt] = __builtin_amdgcn_mfma_f32_16x16x32_bf16(pfrag, vf, o[dt], 0, 0, 0);
                }
            }
            den += shx(den, lane, 16); den += shx(den, lane, 32);
#pragma unroll
            for (int dt = 0; dt < 4; ++dt)
#pragma unroll
                for (int rg = 0; rg < 4; ++rg) {
                    const int tl = (tq0 - t0) + d * (4 * gq + rg), idx = tl * 64 + 16 * dt + l15;
                    if (pi == 0) OACC[idx] = o[dt][rg]; else OACC[idx] += o[dt][rg];
                }
            if (gq == 0) { const int tl = (tq0 - t0) + d * l15; if (pi == 0) DEN[tl] = den; else DEN[tl] += den; }
        }
        LBAR();
    }
    for (int k = 0; k < 32; ++k) {
        const int idx = tid + 512 * k, tl = idx >> 6, dc = idx & 63;
        mixed[(size_t)(t0 + tl) * DM + 256 + h * 64 + dc] = f2bf(OACC[idx] * __builtin_amdgcn_rcpf(DEN[tl]));
    }
}

__device__ __forceinline__ void phase_mixers(const Ctx& a, int l, LAS unsigned char* lds) {
    unsigned* ctr = (unsigned*)(a.ws + WS_CTL) + 64 * l;
    lds = lds_l(lds);
    LAS int* sun = (LAS int*)(lds + LDS_UNIT_OFF);
    constexpr int N_LRU = 192, N_ATT = 1536, N_POOL = 1024;
    for (;;) {
        __syncthreads();
        if (tid_w(a.wv) == 0) *sun = (int)atomicAdd(ctr, 1u);
        __syncthreads();
        const int u = *sun;
        if (u >= N_LRU + N_ATT + N_POOL) break;
        if (u < N_LRU) lru_unit(a, l, u / 6, u % 6, lds);
        else if (u < N_LRU + N_ATT) { const int v = u - N_LRU; dattn_unit(a, v / 48, (v % 48) / 8, v % 8, lds); }
        else { const int v = u - N_LRU - N_ATT; pool_unit(a, l, v / 32, v % 32, lds); }
    }
}

__device__ __forceinline__ void phase_xattn(const Ctx& a, int l, LAS unsigned char* lds) {
    lds = lds_l(lds);
    const int tid = tid_w(a.wv), lane = tid & 63, wave = tid >> 6, l15 = lane & 15, gq = lane >> 4;
    LAS unsigned char* KL = lds;
    LAS unsigned char* VL = lds + 16896;
    LAS float* RK = (LAS float*)(lds + 34304);
    const bf16_t* qm = (const bf16_t*)(a.ws + WS_QM);
    const float* qst = (const float*)(a.ws + WS_QST);
    const bf16_t* kv = (const bf16_t*)(a.ws + WS_KV);
    const float* kst = (const float*)(a.ws + WS_KST);
    bf16_t* om = (bf16_t*)(a.ws + WS_MIXED);
    const int trq = (l15 >> 2), trp = (l15 & 3);
    for (int xu = blockIdx.x; xu < NBATCH * 4 * 16; xu += gridDim.x) {
        const int b = xu >> 6, h = (xu >> 4) & 3, qb = xu & 15;
        LBAR();
        if (tid < 256) {
            const f32x4* kp = (const f32x4*)(kst + (size_t)(b * 256 + tid) * 256 + l * 64 + h * 8);
            const f32x4 k0 = kp[0], k1 = kp[1];
            RK[tid] = rsqrtf((((k0[0] + k0[1]) + (k0[2] + k0[3])) + ((k1[0] + k1[1]) + (k1[2] + k1[3]))) * (1.0f / 256.0f) + EPSF);
        }
        const size_t qrow = (size_t)b * SEQ + qb * 128 + wave * 16 + l15;
        bf16x8 qf[8];
#pragma unroll
        for (int ks = 0; ks < 8; ++ks) qf[ks] = *(const bf16x8*)(qm + qrow * DM + h * 256 + 32 * ks + 8 * gq);
        float rq;
        { const f32x4* qp = (const f32x4*)(qst + qrow * 32 + h * 8); const f32x4 q0 = qp[0], q1 = qp[1];
          rq = rsqrtf((((q0[0] + q0[1]) + (q0[2] + q0[3])) + ((q1[0] + q1[1]) + (q1[2] + q1[3]))) * (1.0f / 256.0f) + EPSF); }
        f32x4 o[16];
#pragma unroll
        for (int dt = 0; dt < 16; ++dt) o[dt] = (f32x4){0.f, 0.f, 0.f, 0.f};
        float den = 0.f;
        const bf16_t* kvb = kv + (size_t)(b * 256) * 8192 + l * 2048 + h * 256;
        u32x4 kpre[2], vpre[2];
#pragma unroll
        for (int k = 0; k < 2; ++k) {
            const int idx = tid + 512 * k, row = idx >> 5, chk = idx & 31;
            const bf16_t* src = kvb + (size_t)row * 8192 + chk * 8;
            kpre[k] = *(const u32x4*)src; vpre[k] = *(const u32x4*)(src + 1024);
        }
#pragma unroll 1
        for (int c = 0; c < 8; ++c) {
            LBAR();
#pragma unroll
            for (int k = 0; k < 2; ++k) {
                const int idx = tid + 512 * k, row = idx >> 5, chk = idx & 31;
                *(LAS u32x4*)(KL + row * 528 + chk * 16) = kpre[k];
                *(LAS u32x4*)(VL + row * 544 + chk * 16) = vpre[k];
            }
            if (c < 7) {
#pragma unroll
                for (int k = 0; k < 2; ++k) {
                    const int idx = tid + 512 * k, row = idx >> 5, chk = idx & 31;
                    const bf16_t* src = kvb + (size_t)(32 * (c + 1) + row) * 8192 + chk * 8;
                    kpre[k] = *(const u32x4*)src; vpre[k] = *(const u32x4*)(src + 1024);
                }
            }
            LBAR();
            float p[2][4];
#pragma unroll
            for (int T = 0; T < 2; ++T) {
                f32x4 s = (f32x4){0.f, 0.f, 0.f, 0.f};
#pragma unroll
                for (int ks = 0; ks < 8; ++ks) {
                    const bf16x8 kf = *(LAS const bf16x8*)(KL + (16 * T + l15) * 528 + (32 * ks + 8 * gq) * 2);
                    s = __builtin_amdgcn_mfma_f32_16x16x32_bf16(kf, qf[ks], s, 0, 0, 0);
                }
                const f32x4 rk4 = *(LAS const f32x4*)(RK + 32 * c + 16 * T + 4 * gq);
#pragma unroll
                for (int rg = 0; rg < 4; ++rg) { const float pv = __builtin_amdgcn_exp2f(s[rg] * rq * rk4[rg]); p[T][rg] = pv; den += pv; }
            }
            u32x4 pw; pw.x = pkbf(p[0][0], p[0][1]); pw.y = pkbf(p[0][2], p[0][3]); pw.z = pkbf(p[1][0], p[1][1]); pw.w = pkbf(p[1][2], p[1][3]);
            const bf16x8 pfrag = __builtin_bit_cast(bf16x8, pw);
#pragma unroll
            for (int dt = 0; dt < 16; ++dt) {
                const s16x4 lo = vtr(VL + (4 * gq + trq) * 544 + (16 * dt + 4 * trp) * 2);
                const s16x4 hi = vtr(VL + (16 + 4 * gq + trq) * 544 + (16 * dt + 4 * trp) * 2);
                const bf16x8 vf = (bf16x8){lo[0], lo[1], lo[2], lo[3], hi[0], hi[1], hi[2], hi[3]};
                o[dt] = __builtin_amdgcn_mfma_f32_16x16x32_bf16(pfrag, vf, o[dt], 0, 0, 0);
            }
        }
        den += shx(den, lane, 16); den += shx(den, lane, 32);
        float inv[4];
#pragma unroll
        for (int rg = 0; rg < 4; ++rg) inv[rg] = 1.0f / shi(den, 4 * gq + rg);
        const size_t orow0 = (size_t)b * SEQ + qb * 128 + wave * 16 + 4 * gq;
#pragma unroll
        for (int dt = 0; dt < 16; ++dt)
#pragma unroll
            for (int rg = 0; rg < 4; ++rg) om[(orow0 + rg) * DM + h * 256 + 16 * dt + l15] = f2bf(o[dt][rg] * inv[rg]);
    }
}

__device__ __forceinline__ void phase_ffn_fix(const Ctx& a, int l) {
    const float* sg = (const float*)(a.ws + WS_SG); const float* su = (const float*)(a.ws + WS_SU);
    bf16_t* act = (bf16_t*)(a.ws + WS_ACT);
    const float* cw = inptr(a, 25) + (size_t)l * 3 * DFF; const float* cb = inptr(a, 26) + (size_t)l * DFF;
    const int total = 256 * 4 * (DFF / 4);
    for (int idx = blockIdx.x * NTHREADS + tid_w(a.wv); idx < total; idx += gridDim.x * NTHREADS) {
        const int f = (idx % (DFF / 4)) * 4, j = (idx / (DFF / 4)) & 3, pm = idx / (DFF / 4) / 4, wr = j >> 1, e = j & 1;
        const float* sgt = sg + (size_t)pm * 8 * DFF + f;
        const f32x4 z = (f32x4){0.f, 0.f, 0.f, 0.f};
        const bool hasprev = (pm & 7) != 0;
        const f32x4 prev7 = hasprev ? *(const f32x4*)(sgt - (size_t)8 * DFF + 7 * DFF) : z;
        const f32x4 prev6 = hasprev ? *(const f32x4*)(sgt - (size_t)8 * DFF + 6 * DFF) : z;
        const f32x4 gc = *(const f32x4*)(sgt + (size_t)(wr * 4 + e) * DFF);
        f32x4 gm1, gm2;
        if (e == 1) { gm1 = *(const f32x4*)(sgt + (size_t)(wr * 4) * DFF); gm2 = wr ? *(const f32x4*)(sgt + (size_t)3 * DFF) : prev7; }
        else { gm1 = wr ? *(const f32x4*)(sgt + (size_t)3 * DFF) : prev7; gm2 = wr ? *(const f32x4*)(sgt + (size_t)2 * DFF) : prev6; }
        const f32x4 uu = *(const f32x4*)(su + ((size_t)pm * 4 + wr * 2 + e) * DFF + f);
        const f32x4 w0 = *(const f32x4*)(cw + f), w1 = *(const f32x4*)(cw + DFF + f), w2 = *(const f32x4*)(cw + 2 * DFF + f), bb = *(const f32x4*)(cb + f);
        float r[4];
#pragma unroll
        for (int i = 0; i < 4; ++i) r[i] = gelu_tanh(bb[i] + w0[i] * gc[i] + w1[i] * gm1[i] + w2[i] * gm2[i]) * uu[i];
        u32x2 w; w.x = pkbf(r[0], r[1]); w.y = pkbf(r[2], r[3]);
        *(u32x2*)(act + (size_t)(pm * 256 + wr * 128 + e) * DFF + f) = w;
    }
}

__global__ void __launch_bounds__(NTHREADS, 2) trunk_fwd(Args ka) {
    extern __shared__ __attribute__((aligned(16))) unsigned char lds_raw[];
    LAS unsigned char* lds = (LAS unsigned char*)lds_raw;
    cg::grid_group grid = cg::this_grid();
    {
        LAS unsigned long long* tw = (LAS unsigned long long*)(lds + LDS_TBL_OFF);
        if (threadIdx.x == 0) {
#pragma unroll
            for (int i = 0; i < 28; ++i) tw[i] = (unsigned long long)ka.in[i];
        }
        __syncthreads();
    }
    Ctx a; a.tbl = (LAS const unsigned long long*)(lds + LDS_TBL_OFF); a.out = ka.out; a.ws = ka.ws; a.wv = __builtin_amdgcn_readfirstlane((int)(threadIdx.x >> 6));
    unsigned char* ws = a.ws;
    bf16_t* hb = (bf16_t*)(ws + WS_HB);
    float* st = (float*)(ws + WS_ST);

    phase_prologue(a, lds);
    grid.sync();
    {
        EpiBf<false> E{(bf16_t*)(ws + WS_KV), 8192, (const float*)(ws + WS_STM), (float*)(ws + WS_KST), 256, nullptr, nullptr, nullptr};
        run_gemm(a.wv, lds, (const bf16_t*)(ws + WS_MEMB), (const bf16_t*)(ws + WS_WKV), MEMROWS, 8192, DM, E);
    }
    for (int l = 0; l < DEPTH; ++l) {
        const unsigned char* wl = ws + WS_W + (size_t)l * W_LAYER;
        {
            EpiBf<true> E{(bf16_t*)(ws + WS_PROJ), NPROJ, st, nullptr, 0, nullptr, inptr(a, 6) + l * 64, inptr(a, 7) + l * 64};
            run_gemm(a.wv, lds, hb, (const bf16_t*)(wl + W_IN), MTOK, NPROJ, DM, E);
        }
        grid.sync();
        phase_mixers(a, l, lds);
        grid.sync();
        {
            EpiRes E{l == 0 ? inptr(a, 0) : a.out, a.out, hb, st};
            run_gemm(a.wv, lds, (const bf16_t*)(ws + WS_MIXED), (const bf16_t*)(wl + W_OUT), MTOK, DM, DM, E);
        }
        grid.sync();
        {
            EpiBf<false> E{(bf16_t*)(ws + WS_QM), DM, st, (float*)(ws + WS_QST), 32, (const float*)(ws + WS_CS) + l * 1024, nullptr, nullptr};
            run_gemm(a.wv, lds, hb, (const bf16_t*)(wl + W_Q), MTOK, DM, DM, E);
        }
        grid.sync();
        phase_xattn(a, l, lds);
        grid.sync();
        {
            EpiRes E{a.out, a.out, hb, st};
            run_gemm(a.wv, lds, (const bf16_t*)(ws + WS_MIXED), (const bf16_t*)(wl + W_O), MTOK, DM, DM, E);
        }
        grid.sync();
        {
            EpiAct E{(bf16_t*)(ws + WS_ACT), st, inptr(a, 25) + (size_t)l * 3 * DFF, inptr(a, 26) + (size_t)l * DFF, (float*)(ws + WS_SG), (float*)(ws + WS_SU)};
            run_gemm_aperm(a.wv, lds, hb, (const bf16_t*)(wl + W_UP), MTOK, DFF2, DM, E);
        }
        grid.sync();
        phase_ffn_fix(a, l);
        grid.sync();
        {
            EpiRes E{a.out, a.out, hb, st};
            run_gemm(a.wv, lds, (const bf16_t*)(ws + WS_ACT), (const bf16_t*)(wl + W_DOWN), MTOK, DM, DFF, E);
        }
        grid.sync();
    }
}

extern "C" void kernel_launch(void* const* d_in, const int* in_sizes, int n_in, void* d_out, int out_size, void* d_ws, size_t ws_size, hipStream_t stream) {
    static int grid = 0;
    if (grid == 0) {
        if (n_in != 28 || in_sizes[0] != MTOK * DM || out_size != MTOK * DM || ws_size < WS_END) {
            fprintf(stderr, "kernel_launch: unexpected shapes (n_in %d, in0 %d, out %d, ws %zu; need ws >= %zu); nothing launched\n", n_in, n_in > 0 ? in_sizes[0] : -1, out_size, ws_size, (size_t)WS_END);
            grid = -1; return;
        }
        int dev = 0, cus = 0, per_cu = 0;
        hipGetDevice(&dev);
        hipDeviceGetAttribute(&cus, hipDeviceAttributeMultiprocessorCount, dev);
        if (hipFuncSetAttribute((const void*)trunk_fwd, hipFuncAttributeMaxDynamicSharedMemorySize, LDS_BYTES) != hipSuccess) { fprintf(stderr, "kernel_launch: hipFuncSetAttribute failed\n"); grid = -1; return; }
        if (hipOccupancyMaxActiveBlocksPerMultiprocessor(&per_cu, (const void*)trunk_fwd, NTHREADS, LDS_BYTES) != hipSuccess || per_cu < 1) { fprintf(stderr, "kernel_launch: occupancy query says %d blocks per CU\n", per_cu); per_cu = 1; }
        (void)hipGetLastError();
        grid = cus;
    }
    if (grid < 0) return;
    (void)hipMemsetAsync((char*)d_ws + WS_CTL, 0, 4096, stream);
    Args a{};
    for (int i = 0; i < 28; ++i) a.in[i] = (const float*)d_in[i];
    a.out = (float*)d_out; a.ws = (unsigned char*)d_ws;
    void* args[] = {&a};
    hipError_t e = hipLaunchCooperativeKernel((const void*)trunk_fwd, dim3(grid), dim3(NTHREADS), args, LDS_BYTES, stream);
    if (e != hipSuccess) fprintf(stderr, "cooperative launch failed: %s (grid %d)\n", hipGetErrorString(e), grid);
}
```

```cpp
#include <hip/hip_runtime.h>
#include <hip/hip_cooperative_groups.h>
#include <cstdio>
#include <cstdint>
namespace cg = cooperative_groups;
namespace pg8 {
#define PG8_LAS __attribute__((address_space(3)))
typedef unsigned short bf16_t;
typedef short bf16x8 __attribute__((ext_vector_type(8)));
typedef float f32x4 __attribute__((ext_vector_type(4)));
typedef unsigned u32x4 __attribute__((ext_vector_type(4)));
constexpr int BM = 256, BK = 64, HALF = 128, HTB = HALF * BK * 2  , STAGE_BYTES = 8 * HTB, NXCD = 8, WGM = 8;

__host__ __device__ __forceinline__ int lds_byte(int r, int c) { const int st = (r >> 4) * 2 + (c >> 5), rr = r & 15, cc = c & 31, ob = rr * 64 + cc * 2; return st * 1024 + (ob ^ (((ob >> 9) & 1) << 5)); }
__host__ __device__ __forceinline__ void stage_rc(int b, int& R, int& C) { const int st = b / 1024, sb = b % 1024, swz = sb ^ (((sb >> 9) & 1) << 5); R = (st >> 1) * 16 + swz / 64; C = (st & 1) * 32 + (swz % 64) / 2; }
__host__ __device__ __forceinline__ int perm32(int rho) { const int n = rho >> 4, i = rho & 15; return 8 * (i >> 2) + 4 * n + (i & 3); }

struct Unit { int pm, pn; };
struct Gemm { const bf16_t* A; const bf16_t* Bt; int M, N, K; };

struct StaticOrder {
    int nM, nN, nwg, G, c;
    __host__ __device__ void init(int M, int N, int G_, int c_) { nM = M / BM; nN = N / BM; nwg = nM * nN; G = G_; c = c_; }
    __host__ __device__ bool next(int i, Unit& u) const {
        const long L = (long)i * G + c; if (L >= nwg) return false;
        int wgid = (int)L; { const int q = nwg / NXCD, r = nwg % NXCD, xcd = wgid % NXCD, off = wgid / NXCD; wgid = (xcd < r ? xcd * (q + 1) : r * (q + 1) + (xcd - r) * q) + off; }
        const int nig = WGM * nN, gid = wgid / nig, fm = gid * WGM, gsz = (nM - fm) < WGM ? (nM - fm) : WGM;
        u.pm = fm + ((wgid % nig) % gsz); u.pn = (wgid % nig) / gsz; return true;
    }
    __device__ __forceinline__ void a_ready(const Unit&) const {}
    __device__ __forceinline__ void done(const Unit&) const {}
};

__device__ __forceinline__ unsigned cvt_pk_bf16(float lo, float hi) { unsigned r; asm volatile("v_cvt_pk_bf16_f32 %0, %1, %2" : "=v"(r) : "v"(lo), "v"(hi)); return r; }
typedef float f32x2 __attribute__((ext_vector_type(2)));
template <class Epi, class Sched, bool ALIGN_EPI = false, bool SP2 = false, bool APERM = false>
__device__ __forceinline__ void gemm_phase(int tid_in, PG8_LAS unsigned char* lds, const Gemm g, const Sched& S, const Epi& E) {
    int tid_ = tid_in; asm volatile("" : "+v"(tid_));
    const int tid = tid_, wid = __builtin_amdgcn_readfirstlane(tid >> 6), lane = tid & 63, wr = wid >> 2, wc = wid & 3, fr = lane & 15, fq = lane >> 4;
    const int K = g.K, nt = K / BK;
    unsigned voffA[2], voffB[2];
#pragma unroll
    for (int i = 0; i < 2; ++i) { int R, C; stage_rc(tid * 16 + i * 8192, R, C); const int Rb = Epi::PERM ? ((R & ~31) + perm32(R & 31)) : R;
        const int Ra = APERM ? ((16 * (R >> 6) + (R & 15)) * 8 + ((R >> 4) & 3)) : R;
        voffA[i] = (unsigned)(Ra * K + C) * 2u; voffB[i] = (unsigned)(Rb * K + C) * 2u; }
    const size_t kstep = (size_t)(BK * 2);
    const size_t hstep = (size_t)HALF * K * 2;
    const size_t tstep = 2 * hstep;
    const size_t hstepA = APERM ? (size_t)4 * K * 2 : hstep;
    const unsigned ldsw = (unsigned)wid * 1024u;
    const int aoff = lds_byte(wr * 64 + fr, fq * 8), boff = lds_byte(wc * 32 + fr, fq * 8);
#define PG8_SA(b, h) (((b) * 2 + (h)) * HTB)
#define PG8_SB(b, h) ((4 + (b) * 2 + (h)) * HTB)
#define PG8_STAGE(bufoff, gbase, voff) do { _Pragma("unroll") for (int _i = 0; _i < 2; ++_i) \
        __builtin_amdgcn_global_load_lds((const unsigned*)((const char*)(gbase) + (voff)[_i]), (PG8_LAS unsigned*)(lds + (bufoff) + ldsw + _i * 8192), 16, 0, 0); } while (0)
#define PG8_LDA(dst, b, h) do { _Pragma("unroll") for (int m = 0; m < 4; ++m) _Pragma("unroll") for (int k = 0; k < 2; ++k) dst[m][k] = *(const PG8_LAS bf16x8*)(lds + PG8_SA(b, h) + aoff + m * 2048 + k * 1024); } while (0)
#define PG8_LDB(dst, b, h) do { _Pragma("unroll") for (int n = 0; n < 2; ++n) _Pragma("unroll") for (int k = 0; k < 2; ++k) dst[n][k] = *(const PG8_LAS bf16x8*)(lds + PG8_SB(b, h) + boff + n * 2048 + k * 1024); } while (0)
#define PG8_MMA(ai, bj, At, Bt) do { __builtin_amdgcn_s_setprio(1); _Pragma("unroll") for (int m = 0; m < 4; ++m) _Pragma("unroll") for (int n = 0; n < 2; ++n) _Pragma("unroll") for (int k = 0; k < 2; ++k) \
        acc[ai][bj][m][n] = __builtin_amdgcn_mfma_f32_16x16x32_bf16(Bt[n][k], At[m][k], acc[ai][bj][m][n], 0, 0, 0); __builtin_amdgcn_s_setprio(0); } while (0)
#define PG8_WAIT_V(n) asm volatile("s_waitcnt vmcnt(" #n ")" ::: "memory")
#define PG8_WAIT_L(n) asm volatile("s_waitcnt lgkmcnt(" #n ")" ::: "memory")
#define PG8_BAR __builtin_amdgcn_s_barrier()
#define PG8_SCHED __builtin_amdgcn_sched_barrier(0)
    Unit cur, nxt; int ui = 0;
    if (!S.next(0, cur)) return;
    f32x4 acc[2][2][4][2];
#pragma unroll
    for (int a = 0; a < 2; ++a)
#pragma unroll
        for (int b = 0; b < 2; ++b)
#pragma unroll
            for (int m = 0; m < 4; ++m)
#pragma unroll
                for (int n = 0; n < 2; ++n) acc[a][b][m][n] = (f32x4){0.f, 0.f, 0.f, 0.f};
    bf16x8 At[4][2], B0[2][2], B1[2][2];
    const char* cA = (const char*)g.A + (size_t)cur.pm * tstep; const char* cB = (const char*)g.Bt + (size_t)cur.pn * tstep;
    S.a_ready(cur);
    if constexpr (SP2) {
        PG8_STAGE(PG8_SB(0, 0), cB, voffB); PG8_STAGE(PG8_SB(0, 1), cB + hstep, voffB); PG8_STAGE(PG8_SA(0, 0), cA, voffA); PG8_STAGE(PG8_SA(0, 1), cA + hstepA, voffA);
        if (wr == 1) PG8_BAR;
        PG8_WAIT_V(2); PG8_BAR;
        PG8_STAGE(PG8_SB(1, 0), cB + kstep, voffB); PG8_STAGE(PG8_SA(1, 0), cA + kstep, voffA); PG8_STAGE(PG8_SB(1, 1), cB + hstep + kstep, voffB);
        PG8_WAIT_V(6); PG8_BAR;
    } else {
        PG8_STAGE(PG8_SB(0, 0), cB, voffB); PG8_STAGE(PG8_SA(0, 0), cA, voffA); PG8_STAGE(PG8_SB(0, 1), cB + hstep, voffB); PG8_STAGE(PG8_SA(0, 1), cA + hstepA, voffA);
        if (wr == 1) PG8_BAR;
        PG8_WAIT_V(4); PG8_BAR;
        PG8_STAGE(PG8_SB(1, 0), cB + kstep, voffB); PG8_STAGE(PG8_SA(1, 0), cA + kstep, voffA); PG8_STAGE(PG8_SB(1, 1), cB + hstep + kstep, voffB);
        PG8_WAIT_V(6); PG8_BAR;
    }
    for (;;) {
        const bool has_next = S.next(ui + 1, nxt);
        const char* nA = has_next ? (const char*)g.A + (size_t)nxt.pm * tstep : cA; const char* nB = has_next ? (const char*)g.Bt + (size_t)nxt.pn * tstep : cB;
        for (int t = 0; t < nt; t += 2) {
            const bool last = (t == nt - 2);
            const char* a1 = cA + (size_t)(t + 1) * kstep;
            const char* a2 = last ? nA : cA + (size_t)(t + 2) * kstep; const char* b2 = last ? nB : cB + (size_t)(t + 2) * kstep;
            const char* a3 = a2 + kstep; const char* b3 = b2 + kstep;
            if (last && has_next) S.a_ready(nxt);
            if constexpr (SP2) {
            PG8_LDB(B0, 0, 0); PG8_LDB(B1, 0, 1); PG8_SCHED; PG8_LDA(At, 0, 0); PG8_STAGE(PG8_SA(1, 1), a1 + hstepA, voffA);
            PG8_WAIT_V(8); PG8_WAIT_L(0); PG8_BAR; PG8_MMA(0, 0, At, B0); PG8_MMA(0, 1, At, B1); PG8_BAR; PG8_SCHED;
            PG8_LDA(At, 0, 1); PG8_STAGE(PG8_SB(0, 0), b2, voffB); PG8_STAGE(PG8_SB(0, 1), b2 + hstep, voffB); PG8_STAGE(PG8_SA(0, 0), a2, voffA);
            PG8_WAIT_V(8); PG8_WAIT_L(0); PG8_BAR; PG8_MMA(1, 0, At, B0); PG8_MMA(1, 1, At, B1); PG8_BAR; PG8_SCHED;
            PG8_LDB(B0, 1, 0); PG8_LDB(B1, 1, 1); PG8_SCHED; PG8_LDA(At, 1, 0); PG8_STAGE(PG8_SA(0, 1), a2 + hstepA, voffA);
            PG8_WAIT_V(8); PG8_WAIT_L(0); PG8_BAR; PG8_MMA(0, 0, At, B0); PG8_MMA(0, 1, At, B1); PG8_BAR; PG8_SCHED;
            PG8_LDA(At, 1, 1); PG8_STAGE(PG8_SB(1, 0), b3, voffB); PG8_STAGE(PG8_SB(1, 1), b3 + hstep, voffB); PG8_STAGE(PG8_SA(1, 0), a3, voffA);
            PG8_WAIT_V(8); PG8_WAIT_L(0); PG8_BAR; PG8_MMA(1, 0, At, B0); PG8_MMA(1, 1, At, B1); PG8_BAR; PG8_SCHED;
            } else {
            PG8_LDB(B0, 0, 0); PG8_SCHED; PG8_LDA(At, 0, 0); PG8_STAGE(PG8_SA(1, 1), a1 + hstepA, voffA);
            PG8_WAIT_L(8); PG8_BAR; PG8_WAIT_L(0); PG8_MMA(0, 0, At, B0); PG8_BAR; PG8_SCHED;
            PG8_LDB(B1, 0, 1); PG8_STAGE(PG8_SB(0, 0), b2, voffB);
            PG8_BAR; PG8_WAIT_L(0); PG8_MMA(0, 1, At, B1); PG8_BAR;
            PG8_LDA(At, 0, 1); PG8_STAGE(PG8_SA(0, 0), a2, voffA);
            PG8_BAR; PG8_WAIT_L(0); PG8_MMA(1, 0, At, B0); PG8_BAR; PG8_SCHED;
            PG8_STAGE(PG8_SB(0, 1), b2 + hstep, voffB);
            PG8_WAIT_V(6); PG8_BAR; PG8_MMA(1, 1, At, B1); PG8_BAR;
            PG8_LDB(B0, 1, 0); PG8_SCHED; PG8_LDA(At, 1, 0); PG8_STAGE(PG8_SA(0, 1), a2 + hstepA, voffA);
            PG8_WAIT_L(8); PG8_BAR; PG8_WAIT_L(0); PG8_MMA(0, 0, At, B0); PG8_BAR; PG8_SCHED;
            PG8_LDB(B1, 1, 1); PG8_STAGE(PG8_SB(1, 0), b3, voffB);
            PG8_BAR; PG8_WAIT_L(0); PG8_MMA(0, 1, At, B1); PG8_BAR;
            PG8_LDA(At, 1, 1); PG8_STAGE(PG8_SA(1, 0), a3, voffA);
            PG8_BAR; PG8_WAIT_L(0); PG8_MMA(1, 0, At, B0); PG8_BAR; PG8_SCHED;
            PG8_STAGE(PG8_SB(1, 1), b3 + hstep, voffB);
            PG8_WAIT_V(6); PG8_BAR; PG8_MMA(1, 1, At, B1); PG8_BAR;
            }
        }
        if constexpr (ALIGN_EPI) { if (wr == 0) PG8_BAR; }
        if constexpr (!Epi::AFTER_DRAIN) { E(acc, cur, wr, wc, fr, fq); S.done(cur); }
        if (!has_next) break;
#pragma unroll
        for (int a = 0; a < 2; ++a)
#pragma unroll
            for (int b = 0; b < 2; ++b)
#pragma unroll
                for (int m = 0; m < 4; ++m)
#pragma unroll
                    for (int n = 0; n < 2; ++n) acc[a][b][m][n] = (f32x4){0.f, 0.f, 0.f, 0.f};
        cur = nxt; cA = nA; cB = nB; ++ui;
        if constexpr (ALIGN_EPI) { if (wr == 1) PG8_BAR; }
    }
    PG8_WAIT_V(0);
    if constexpr (!ALIGN_EPI) { if (wr == 0) PG8_BAR; }
    PG8_BAR;
    if constexpr (Epi::AFTER_DRAIN) { E.fused(acc, cur, wr, wc, fr, fq, lds, wid, lane); S.done(cur); }
#undef PG8_SA
#undef PG8_SB
#undef PG8_STAGE
#undef PG8_LDA
#undef PG8_LDB
#undef PG8_MMA
#undef PG8_WAIT_V
#undef PG8_WAIT_L
#undef PG8_BAR
#undef PG8_SCHED
}
}

using pg8::bf16_t; using pg8::bf16x8; using pg8::f32x4; using pg8::u32x4;
typedef unsigned u32x2 __attribute__((ext_vector_type(2)));
using pg8::f32x2;
typedef short s16x4 __attribute__((ext_vector_type(4)));
#define LAS __attribute__((address_space(3)))

constexpr int NTHREADS = 512;
constexpr int MTOK = 65536, DM = 1024, SEQ = 2048, NBATCH = 32, DEPTH = 4;
constexpr int NPROJ = 2304;
constexpr int INW = 2176;
constexpr int DFF = 2816, DFF2 = 5632;
constexpr int MEMROWS = 8192;
constexpr int MHALF = 32768;
constexpr float EPSF = 1e-6f;
constexpr float LOG2E = 1.4426950408889634f;
constexpr int LDS_BYTES = 155648;
constexpr int LDS_UNIT_OFF = 155648 - 64;
constexpr int LDS_TBL_OFF = 155648 - 512;

constexpr size_t MiB = 1u << 20;
constexpr size_t WS_CTL = 0;
constexpr size_t WS_ST = 1 * MiB;
constexpr size_t WS_STM = 5 * MiB;
constexpr size_t WS_CS = 5 * MiB + 512 * 1024;
constexpr size_t WS_KST = 6 * MiB;
constexpr size_t WS_QST = 14 * MiB;
constexpr size_t WS_MEMB = 22 * MiB;
constexpr size_t WS_W = 38 * MiB;
constexpr size_t W_LAYER = 27 * MiB;
constexpr size_t W_IN = 0, W_OUT = (size_t)(4.5 * MiB), W_Q = (size_t)(6.5 * MiB), W_O = (size_t)(8.5 * MiB), W_UP = (size_t)(10.5 * MiB), W_DOWN = (size_t)(21.5 * MiB);
constexpr size_t WS_WKV = WS_W + 4 * W_LAYER;
constexpr size_t WS_HB = 162 * MiB;
constexpr size_t WS_KV = 290 * MiB;
constexpr size_t WS_BIG = 418 * MiB;
constexpr size_t WS_PROJ = WS_BIG;
constexpr size_t WS_MIXED = WS_BIG + 288 * MiB;
constexpr size_t WS_QM = WS_MIXED + 128 * MiB;
constexpr size_t WS_ACT = WS_BIG;
constexpr size_t WS_SG = WS_BIG + 352 * MiB;
constexpr size_t WS_SU = WS_BIG + 376 * MiB;
constexpr size_t WS_END = WS_QM + 128 * MiB;
static_assert(WS_WKV + 16 * MiB <= WS_HB, "ws map");
static_assert(WS_SU + 12 * MiB <= WS_END, "ws map");

struct Args { const float* in[28]; float* out; unsigned char* ws; };
struct Ctx { LAS const unsigned long long* tbl; float* out; unsigned char* ws; int wv; };
__device__ __forceinline__ const float* inptr(const Ctx& c, int i) {
    const unsigned long long v = c.tbl[i];
    const unsigned lo = __builtin_amdgcn_readfirstlane((unsigned)v), hi = __builtin_amdgcn_readfirstlane((unsigned)(v >> 32));
    return (const float*)(((unsigned long long)hi << 32) | lo);
}

__device__ __forceinline__ float bf2f(unsigned short b) { return __uint_as_float(((unsigned)b) << 16); }
__device__ __forceinline__ float bflo(unsigned w) { return __uint_as_float(w << 16); }
__device__ __forceinline__ float bfhi(unsigned w) { return __uint_as_float(w & 0xffff0000u); }
__device__ __forceinline__ unsigned pkbf(float lo, float hi) { unsigned r; asm("v_cvt_pk_bf16_f32 %0, %1, %2" : "=v"(r) : "v"(lo), "v"(hi)); return r; }
__device__ __forceinline__ unsigned short f2bf(float f) { return (unsigned short)(pkbf(f, 0.f) & 0xffffu); }
__device__ __forceinline__ float shx(float v, int lane, int m) { return __int_as_float(__builtin_amdgcn_ds_bpermute((lane ^ m) << 2, __float_as_int(v))); }
__device__ __forceinline__ float shi(float v, int src) { return __int_as_float(__builtin_amdgcn_ds_bpermute(src << 2, __float_as_int(v))); }
__device__ __forceinline__ float wave_sum(float v, int lane) {
#pragma unroll
    for (int o = 1; o < 64; o <<= 1) v += shx(v, lane, o);
    return v;
}
__device__ __forceinline__ float sigmoidf_(float x) { return __builtin_amdgcn_rcpf(1.0f + __builtin_amdgcn_exp2f(-LOG2E * x)); }
__device__ __forceinline__ float gelu_tanh(float x) {
    const float u2 = (-2.0f * 0.7978845608028654f * LOG2E) * (x + 0.044715f * x * x * x);
    return x * __builtin_amdgcn_rcpf(1.0f + __builtin_amdgcn_exp2f(u2));
}
__device__ __forceinline__ LAS unsigned char* lds_l(LAS unsigned char* p) { unsigned v = (unsigned)(uintptr_t)p; asm volatile("" : "+s"(v)); return (LAS unsigned char*)(uintptr_t)v; }
__device__ __forceinline__ int tid_w(int wv) { int t = (wv << 6) + (int)__builtin_amdgcn_mbcnt_hi(~0u, __builtin_amdgcn_mbcnt_lo(~0u, 0u)); asm volatile("" : "+v"(t)); return t; }
__device__ __forceinline__ s16x4 vtr(LAS const unsigned char* p) {
    typedef short v4i16_t __attribute__((ext_vector_type(4)));
    return __builtin_bit_cast(s16x4, __builtin_amdgcn_ds_read_tr16_b64_v4i16((LAS v4i16_t*)p));
}

#define LBAR() do { asm volatile("s_waitcnt lgkmcnt(0)" ::: "memory"); __builtin_amdgcn_s_barrier(); asm volatile("" ::: "memory"); } while (0)

template <bool QKN> struct EpiBf {
    static constexpr bool PERM = true, AFTER_DRAIN = false;
    bf16_t* O; int ldc; const float* st; float* pst; int npg; const float* cs; const float* qg; const float* kg;
    __device__ __forceinline__ void operator()(const f32x4 (&acc)[2][2][4][2], const pg8::Unit& u, int wr, int wc, int fr, int fq) const {
        const int lane = fq * 16 + fr;
        int kind = 0; const float* gsel = nullptr;
        if (QKN) { const int c0 = u.pn * 256 + 64 * wc; if (c0 >= 256 && c0 < 640) { kind = 1; gsel = qg; } else if (c0 >= 640 && c0 < 1024) { kind = 2; gsel = kg; } }
        const int rbase = u.pm * 256 + wr * 64 + fr;
        float rloc[2];
#pragma unroll
        for (int k = 0; k < 2; ++k) {
            const int i = 2 * fq + k, r = rbase + (i >> 2) * 128 + (i & 3) * 16;
            const f32x4* sp = (const f32x4*)(st + (size_t)r * 16);
            const f32x4 s0 = sp[0], s1 = sp[1], s2 = sp[2], s3 = sp[3];
            const float ssum = ((s0[0] + s0[1]) + (s0[2] + s0[3])) + ((s1[0] + s1[1]) + (s1[2] + s1[3])) + ((s2[0] + s2[1]) + (s2[2] + s2[3])) + ((s3[0] + s3[1]) + (s3[2] + s3[3]));
            rloc[k] = rsqrtf(ssum * (1.0f / 1024.0f) + EPSF);
        }
        f32x4 cf[2][2];
#pragma unroll
        for (int bj = 0; bj < 2; ++bj)
#pragma unroll
            for (int n = 0; n < 2; ++n) {
                cf[bj][n] = (f32x4){1.f, 1.f, 1.f, 1.f};
                if (QKN) { if (kind != 0) cf[bj][n] = *(const f32x4*)(gsel + 32 * bj + 8 * fq + 4 * n); }
                else if (cs) cf[bj][n] = *(const f32x4*)(cs + u.pn * 256 + bj * 128 + wc * 32 + 8 * fq + 4 * n);
            }
#pragma unroll
        for (int ai = 0; ai < 2; ++ai)
#pragma unroll
            for (int m = 0; m < 4; ++m) {
                const int r = rbase + ai * 128 + m * 16;
                const float rsv = shi(rloc[m & 1], (ai * 2 + (m >> 1)) * 16 + fr);
                f32x4 v[2][2];
#pragma unroll
                for (int bj = 0; bj < 2; ++bj)
#pragma unroll
                    for (int n = 0; n < 2; ++n) v[bj][n] = acc[ai][bj][m][n] * rsv;
                if (QKN) {
                    if (kind != 0) {
                        float ss = 0.f;
#pragma unroll
                        for (int bj = 0; bj < 2; ++bj)
#pragma unroll
                            for (int n = 0; n < 2; ++n) ss += (v[bj][n][0] * v[bj][n][0] + v[bj][n][1] * v[bj][n][1]) + (v[bj][n][2] * v[bj][n][2] + v[bj][n][3] * v[bj][n][3]);
                        ss += shx(ss, lane, 16); ss += shx(ss, lane, 32);
                        float rn = rsqrtf(ss * (1.0f / 64.0f) + EPSF);
                        if (kind == 1) rn *= 0.125f * LOG2E;
#pragma unroll
                        for (int bj = 0; bj < 2; ++bj)
#pragma unroll
                            for (int n = 0; n < 2; ++n) v[bj][n] = v[bj][n] * rn * cf[bj][n];
                    }
                } else {
                    if (pst) {
#pragma unroll
                        for (int bj = 0; bj < 2; ++bj) {
                            float ss = (v[bj][0][0] * v[bj][0][0] + v[bj][0][1] * v[bj][0][1]) + (v[bj][0][2] * v[bj][0][2] + v[bj][0][3] * v[bj][0][3])
                                     + (v[bj][1][0] * v[bj][1][0] + v[bj][1][1] * v[bj][1][1]) + (v[bj][1][2] * v[bj][1][2] + v[bj][1][3] * v[bj][1][3]);
                            ss += shx(ss, lane, 16); ss += shx(ss, lane, 32);
                            if (fq == 0) pst[(size_t)r * npg + (u.pn * 8 + bj * 4 + wc)] = ss;
                        }
                    }
                    if (cs) {
#pragma unroll
                        for (int bj = 0; bj < 2; ++bj)
#pragma unroll
                            for (int n = 0; n < 2; ++n) v[bj][n] = v[bj][n] * cf[bj][n];
                    }
                }
#pragma unroll
                for (int bj = 0; bj < 2; ++bj) {
                    const int col = QKN ? (u.pn * 256 + 64 * wc + 32 * bj + 8 * fq) : (u.pn * 256 + 128 * bj + 32 * wc + 8 * fq);
                    u32x4 w; w.x = pkbf(v[bj][0][0], v[bj][0][1]); w.y = pkbf(v[bj][0][2], v[bj][0][3]); w.z = pkbf(v[bj][1][0], v[bj][1][1]); w.w = pkbf(v[bj][1][2], v[bj][1][3]);
                    *(u32x4*)(O + (size_t)r * ldc + col) = w;
                }
            }
    }
};

struct EpiRes {
    static constexpr bool PERM = false, AFTER_DRAIN = false;
    const float* resid; float* out; bf16_t* hb; float* st;
    __device__ __forceinline__ void operator()(const f32x4 (&acc)[2][2][4][2], const pg8::Unit& u, int wr, int wc, int fr, int fq) const {
        const int lane = fq * 16 + fr;
        const int rbase = u.pm * 256 + wr * 64 + fr, cbase = u.pn * 256 + wc * 32 + 4 * fq;
        f32x4 pre[4][2][2];
#define EPIRES_LOAD(I) do { const size_t ro_ = (size_t)(rbase + ((I) >> 2) * 128 + ((I) & 3) * 16) * DM + cbase; \
            _Pragma("unroll") for (int bj = 0; bj < 2; ++bj) _Pragma("unroll") for (int n = 0; n < 2; ++n) pre[(I) % 4][bj][n] = *(const f32x4*)(resid + ro_ + bj * 128 + n * 16); } while (0)
        EPIRES_LOAD(0); EPIRES_LOAD(1); EPIRES_LOAD(2); EPIRES_LOAD(3);
#pragma unroll
        for (int i = 0; i < 8; ++i) {
            const int ai = i >> 2, m = i & 3;
            const int r = rbase + ai * 128 + m * 16;
            float ss = 0.f;
#pragma unroll
            for (int bj = 0; bj < 2; ++bj)
#pragma unroll
                for (int n = 0; n < 2; ++n) {
                    const f32x4 v = pre[i % 4][bj][n] + acc[ai][bj][m][n];
                    const size_t off = (size_t)r * DM + cbase + bj * 128 + n * 16;
                    *(f32x4*)(out + off) = v;
                    if (hb) {
                        u32x2 w; w.x = pkbf(v[0], v[1]); w.y = pkbf(v[2], v[3]);
                        *(u32x2*)(hb + off) = w;
                        ss += (v[0] * v[0] + v[1] * v[1]) + (v[2] * v[2] + v[3] * v[3]);
                    }
                }
            asm volatile("" ::: "memory");
            if (i + 4 < 8) EPIRES_LOAD(i + 4);
            asm volatile("" ::: "memory");
            if (hb) {
                ss += shx(ss, lane, 16); ss += shx(ss, lane, 32);
                if (fq == 0) st[(size_t)r * 16 + u.pn * 4 + wc] = ss;
            }
        }
#undef EPIRES_LOAD
    }
};

struct EpiAct {
    static constexpr bool PERM = true, AFTER_DRAIN = false;
    bf16_t* act; const float* st; const float* cw; const float* cb; float* sg; float* su;
    __device__ __forceinline__ void operator()(const f32x4 (&acc)[2][2][4][2], const pg8::Unit& u, int wr, int wc, int fr, int fq) const {
        const int lane = fq * 16 + fr;
        const int tok0 = u.pm * 256 + (16 * wr + fr) * 8;
        const int f0 = u.pn * 128 + 32 * wc + 8 * fq;
        f32x2 W0[4], W1[4], W2[4], BBv[4];
#pragma unroll
        for (int q = 0; q < 4; ++q) {
            W0[q] = *(const f32x2*)(cw + f0 + 2 * q); W1[q] = *(const f32x2*)(cw + DFF + f0 + 2 * q);
            W2[q] = *(const f32x2*)(cw + 2 * DFF + f0 + 2 * q); BBv[q] = *(const f32x2*)(cb + f0 + 2 * q);
        }
        float rloc[2], rs[8];
#pragma unroll
        for (int k = 0; k < 2; ++k) {
            const f32x4* sp = (const f32x4*)(st + (size_t)(tok0 + 2 * fq + k) * 16);
            const f32x4 s0 = sp[0], s1 = sp[1], s2 = sp[2], s3 = sp[3];
            const float ssum = ((s0[0] + s0[1]) + (s0[2] + s0[3])) + ((s1[0] + s1[1]) + (s1[2] + s1[3])) + ((s2[0] + s2[1]) + (s2[2] + s2[3])) + ((s3[0] + s3[1]) + (s3[2] + s3[3]));
            rloc[k] = rsqrtf(ssum * (1.0f / 1024.0f) + EPSF);
        }
#pragma unroll
        for (int e = 0; e < 8; ++e) rs[e] = shi(rloc[e & 1], (e >> 1) * 16 + fr);
        float* sgp = sg + ((size_t)u.pm * 8 + wr * 4) * DFF + f0;
        float* sup = su + ((size_t)u.pm * 4 + wr * 2) * DFF + f0;
#pragma unroll
        for (int n = 0; n < 2; ++n) {
            unsigned res[8][2];
#pragma unroll
            for (int ip = 0; ip < 2; ++ip) {
                const int c0 = 4 * n + 2 * ip;
                f32x2 g[8], uu[8];
#pragma unroll
                for (int e = 0; e < 8; ++e) {
                    const f32x2 rv = (f32x2){rs[e], rs[e]};
                    g[e] = (f32x2){acc[e >> 2][0][e & 3][n][2 * ip], acc[e >> 2][0][e & 3][n][2 * ip + 1]} * rv;
                    uu[e] = (f32x2){acc[e >> 2][1][e & 3][n][2 * ip], acc[e >> 2][1][e & 3][n][2 * ip + 1]} * rv;
                }
                const f32x2 p1 = (f32x2){shi(g[7].x, lane - 1), shi(g[7].y, lane - 1)};
                const f32x2 p2 = (f32x2){shi(g[6].x, lane - 1), shi(g[6].y, lane - 1)};
                const f32x2 w0 = W0[2 * n + ip], w1 = W1[2 * n + ip], w2 = W2[2 * n + ip], bb = BBv[2 * n + ip];
                const float K1 = -2.0f * 0.7978845608028654f * LOG2E, K2 = K1 * 0.044715f;
#pragma unroll
                for (int e = 0; e < 8; ++e) {
                    const f32x2 gm1 = (e >= 1) ? g[e >= 1 ? e - 1 : 0] : p1;
                    const f32x2 gm2 = (e >= 2) ? g[e >= 2 ? e - 2 : 0] : (e == 1 ? p1 : p2);
                    const f32x2 cvv = bb + w0 * g[e] + w1 * gm1 + w2 * gm2;
                    const f32x2 t = cvv * (cvv * cvv * K2 + K1);
                    const f32x2 dn = (f32x2){__builtin_amdgcn_exp2f(t.x), __builtin_amdgcn_exp2f(t.y)} + 1.0f;
                    const f32x2 av = cvv * (f32x2){__builtin_amdgcn_rcpf(dn.x), __builtin_amdgcn_rcpf(dn.y)} * uu[e];
                    res[e][ip] = pkbf(av.x, av.y);
                }
                if (fr == 0) { *(f32x2*)(sgp + c0) = g[0]; *(f32x2*)(sgp + DFF + c0) = g[1]; *(f32x2*)(sup + c0) = uu[0]; *(f32x2*)(sup + DFF + c0) = uu[1]; }
                if (fr == 15) { *(f32x2*)(sgp + 2 * DFF + c0) = g[6]; *(f32x2*)(sgp + 3 * DFF + c0) = g[7]; }
                asm volatile("" ::: "memory");
            }
#pragma unroll
            for (int e = 0; e < 8; ++e) {
                if (fr == 0 && e < 2) continue;
                u32x2 w; w.x = res[e][0]; w.y = res[e][1];
                *(u32x2*)(act + (size_t)(tok0 + e) * DFF + f0 + 4 * n) = w;
            }
            asm volatile("" ::: "memory");
        }
    }
};

template <class Epi>
__device__ __forceinline__ void run_gemm(int cv, int wv, LAS unsigned char* lds, const bf16_t* A, const bf16_t* Bt, int M, int N, int K, const Epi& E) {
    pg8::Gemm g{A, Bt, M, N, K}; pg8::StaticOrder S; S.init(M, N, (int)gridDim.x, cv);
    pg8::gemm_phase<Epi, pg8::StaticOrder, true, true>(tid_w(wv), lds_l(lds), g, S, E);
}
template <class Epi>
__device__ __forceinline__ void run_gemm_aperm(int cv, int wv, LAS unsigned char* lds, const bf16_t* A, const bf16_t* Bt, int M, int N, int K, const Epi& E) {
    pg8::Gemm g{A, Bt, M, N, K}; pg8::StaticOrder S; S.init(M, N, (int)gridDim.x, cv);
    pg8::gemm_phase<Epi, pg8::StaticOrder, true, true, true>(tid_w(wv), lds_l(lds), g, S, E);
}

__device__ __forceinline__ void transpose_item(const float* W, int ldw, int K, const float* gain, bf16_t* WT, int dst_row0, bool zero, LAS float* scr, int k0, int n0, int lane) {
#pragma unroll 8
    for (int i = 0; i < 32; ++i) {
        const int kk = 2 * i + (lane >> 5);
        float v = 0.f;
        if (!zero) { v = W[(size_t)(k0 + kk) * ldw + n0 + (lane & 31)]; if (gain) v *= gain[k0 + kk]; }
        scr[kk * 33 + (lane & 31)] = v;
    }
    asm volatile("s_waitcnt lgkmcnt(0)" ::: "memory");
    const int c = lane & 7;
#pragma unroll
    for (int j = 0; j < 4; ++j) {
        const int n = (lane >> 3) + 8 * j; const LAS float* s = scr + (8 * c) * 33 + n;
        u32x4 o; o.x = pkbf(s[0 * 33], s[1 * 33]); o.y = pkbf(s[2 * 33], s[3 * 33]); o.z = pkbf(s[4 * 33], s[5 * 33]); o.w = pkbf(s[6 * 33], s[7 * 33]);
        *(u32x4*)(WT + (size_t)(dst_row0 + n) * K + k0 + 8 * c) = o;
    }
    asm volatile("s_waitcnt lgkmcnt(0)" ::: "memory");
}
__device__ __forceinline__ void rows4_to_bf16(const float* x, bf16_t* o, float* stp, int m0, int mstep, int mend, int lane) {
    f32x4 v[4][4];
#pragma unroll
    for (int q = 0; q < 4; ++q) {
        const int m = m0 + q * mstep;
        const f32x4* xr = (const f32x4*)(x + (size_t)(m < mend ? m : m0) * DM) + lane;
#pragma unroll
        for (int j = 0; j < 4; ++j) v[q][j] = xr[64 * j];
    }
#pragma unroll
    for (int q = 0; q < 4; ++q) {
        const int m = m0 + q * mstep;
        float s = 0.f;
#pragma unroll
        for (int j = 0; j < 4; ++j) s += (v[q][j][0] * v[q][j][0] + v[q][j][1] * v[q][j][1]) + (v[q][j][2] * v[q][j][2] + v[q][j][3] * v[q][j][3]);
        s = wave_sum(s, lane);
        if (m < mend) {
            u32x2* o8 = (u32x2*)(o + (size_t)m * DM) + lane;
#pragma unroll
            for (int j = 0; j < 4; ++j) { u32x2 w; w.x = pkbf(v[q][j][0], v[q][j][1]); w.y = pkbf(v[q][j][2], v[q][j][3]); o8[64 * j] = w; }
            if (lane < 16) stp[(size_t)m * 16 + lane] = (lane == 0) ? s : 0.f;
        }
    }
}
__device__ __forceinline__ void phase_prologue(const Ctx& a, LAS unsigned char* lds) {
    lds = lds_l(lds);
    const int tid = tid_w(a.wv), lane = tid & 63, wave = tid >> 6;
    LAS float* scr = (LAS float*)(lds + wave * 16384);
    const int gw = blockIdx.x * 8 + wave, NGW = gridDim.x * 8;
    unsigned char* ws = a.ws;
    constexpr int I_IN = 16 * 72, I_SQ = 16 * 32, I_UP = 16 * 176, I_DN = 44 * 32, I_KV = 16 * 64;
    constexpr int I_LAYER = I_IN + 3 * I_SQ + I_UP + I_DN + I_KV;
    for (int it = gw; it < DEPTH * I_LAYER; it += NGW) {
        const int l = it / I_LAYER; int r = it % I_LAYER;
        bf16_t* wl = (bf16_t*)(ws + WS_W + (size_t)l * W_LAYER);
        if (r < I_IN) {
            const int kb = r / 72, nb = r % 72, n0 = nb * 32;
            const int dst = (n0 & ~255) + 128 * ((n0 >> 5) & 1) + 32 * ((n0 >> 6) & 3);
            transpose_item(inptr(a, 3) + (size_t)l * DM * INW, INW, DM, inptr(a, 2) + l * DM, (bf16_t*)((unsigned char*)wl + W_IN), dst, n0 >= INW, scr, kb * 64, n0, lane);
            continue;
        }
        r -= I_IN;
        if (r < I_SQ) { transpose_item(inptr(a, 15) + (size_t)l * DM * DM, DM, DM, nullptr, (bf16_t*)((unsigned char*)wl + W_OUT), (r % 32) * 32, false, scr, (r / 32) * 64, (r % 32) * 32, lane); continue; }
        r -= I_SQ;
        if (r < I_SQ) { transpose_item(inptr(a, 18) + (size_t)l * DM * DM, DM, DM, inptr(a, 16) + l * DM, (bf16_t*)((unsigned char*)wl + W_Q), (r % 32) * 32, false, scr, (r / 32) * 64, (r % 32) * 32, lane); continue; }
        r -= I_SQ;
        if (r < I_SQ) { transpose_item(inptr(a, 22) + (size_t)l * DM * DM, DM, DM, nullptr, (bf16_t*)((unsigned char*)wl + W_O), (r % 32) * 32, false, scr, (r / 32) * 64, (r % 32) * 32, lane); continue; }
        r -= I_SQ;
        if (r < I_UP) { transpose_item(inptr(a, 24) + (size_t)l * DM * DFF2, DFF2, DM, inptr(a, 23) + l * DM, (bf16_t*)((unsigned char*)wl + W_UP), ((((r % 176) * 32) % DFF) / 128) * 256 + 128 * (((r % 176) * 32) / DFF) + (((r % 176) * 32) % DFF) % 128, false, scr, (r / 176) * 64, (r % 176) * 32, lane); continue; }
        r -= I_UP;
        if (r < I_DN) { transpose_item(inptr(a, 27) + (size_t)l * DFF * DM, DM, DFF, nullptr, (bf16_t*)((unsigned char*)wl + W_DOWN), (r % 32) * 32, false, scr, (r / 32) * 64, (r % 32) * 32, lane); continue; }
        r -= I_DN;
        transpose_item(inptr(a, 19) + (size_t)l * DM * 2048, 2048, DM, inptr(a, 17) + l * DM, (bf16_t*)(ws + WS_WKV), l * 2048 + (r % 64) * 32, false, scr, (r / 64) * 64, (r % 64) * 32, lane);
    }
    for (int i = blockIdx.x * NTHREADS + tid; i < DEPTH * DM; i += gridDim.x * NTHREADS) { const int l = i >> 10, dd = i & 255; ((float*)(ws + WS_CS))[i] = inptr(a, 20)[l * 256 + dd] * inptr(a, 21)[l * 256 + dd] * (0.0625f * LOG2E); }
    for (int m = gw; m < MTOK; m += 4 * NGW) rows4_to_bf16(inptr(a, 0), (bf16_t*)(ws + WS_HB), (float*)(ws + WS_ST), m, NGW, MTOK, lane);
    for (int m = gw; m < MEMROWS; m += 4 * NGW) rows4_to_bf16(inptr(a, 1), (bf16_t*)(ws + WS_MEMB), (float*)(ws + WS_STM), m, NGW, MEMROWS, lane);
}

__device__ __forceinline__ void lru_unit(const Ctx& a, int l, int b, int g, LAS unsigned char* lds) {
    lds = lds_l(lds);
    const int tid = tid_w(a.wv), lane = tid & 63, wave = tid >> 6, l15 = lane & 15, gq = lane >> 4;
    LAS unsigned char* XT = lds;
    LAS unsigned char* XCB = lds + 19008;
    LAS float* XCF = (LAS float*)(lds + 37440);
    LAS float* AA = (LAS float*)(lds + 70208);
    LAS float* BB = (LAS float*)(lds + 102976);
    LAS unsigned char* WT = lds + 135744;
    const bf16_t* proj = (const bf16_t*)(a.ws + WS_PROJ) + (size_t)b * SEQ * NPROJ;
    bf16_t* mixed = (bf16_t*)(a.ws + WS_MIXED) + (size_t)b * SEQ * DM;
    const float* wa = inptr(a, 10) + ((size_t)l * 6 + g) * 4096; const float* wx = inptr(a, 12) + ((size_t)l * 6 + g) * 4096;
    for (int k = 0; k < 16; ++k) {
        const int idx = tid + 512 * k, which = idx >> 12, cp = (idx >> 6) & 63, c = idx & 63;
        const float v = which ? wx[cp * 64 + c] : wa[cp * 64 + c];
        *(LAS unsigned short*)(WT + (which * 64 + c) * 144 + cp * 2) = f2bf(v);
    }
    const int cch = tid & 63, ch = g * 64 + cch;
    float cw[4];
#pragma unroll
    for (int j = 0; j < 4; ++j) cw[j] = inptr(a, 8)[((size_t)l * 4 + j) * 384 + ch];
    const float cb = inptr(a, 9)[l * 384 + ch];
    float gba[4], gbx[4], gsp[4];
#pragma unroll
    for (int nt = 0; nt < 4; ++nt) {
        const int c2 = l * 384 + g * 64 + 16 * nt + l15;
        gba[nt] = inptr(a, 11)[c2]; gbx[nt] = inptr(a, 13)[c2];
        const float z = -inptr(a, 14)[c2];
        gsp[nt] = (8.0f * LOG2E) * (fmaxf(z, 0.f) + log1pf(__expf(-fabsf(z))));
    }
#pragma unroll
    for (int j = 0; j < 4; ++j) { asm volatile("" : "+v"(cw[j])); asm volatile("" : "+v"(gba[j])); asm volatile("" : "+v"(gbx[j])); asm volatile("" : "+v"(gsp[j])); }
    float cbv = cb; asm volatile("" : "+v"(cbv));
    float hcar = 0.f;
    const bf16_t* xsrc = proj + 1408 + g * 64;
    const bf16_t* ysrc = proj + 1792 + g * 64;
    u32x4 xr[3];
#pragma unroll
    for (int k = 0; k < 3; ++k) {
        const int idx = tid + 512 * k, row = idx >> 3, cv = idx & 7, tok = row - 3;
        xr[k] = (idx < 1048 && tok >= 0) ? *(const u32x4*)(xsrc + (size_t)tok * NPROJ + cv * 8) : (u32x4){0u, 0u, 0u, 0u};
    }
#pragma unroll 1
    for (int ck = 0; ck < 16; ++ck) {
        const int t0 = ck * 128;
#pragma unroll
        for (int k = 0; k < 3; ++k) { const int idx = tid + 512 * k, row = idx >> 3, cv = idx & 7; if (idx < 1048) *(LAS u32x4*)(XT + row * 144 + cv * 16) = xr[k]; }
        u32x4 yr[2];
#pragma unroll
        for (int k = 0; k < 2; ++k) { const int idx = lane + 64 * k, row = 16 * wave + (idx >> 3), cv = idx & 7; yr[k] = *(const u32x4*)(ysrc + (size_t)(t0 + row) * NPROJ + cv * 8); }
        if (ck < 15) {
#pragma unroll
            for (int k = 0; k < 3; ++k) {
                const int idx = tid + 512 * k, row = idx >> 3, cv = idx & 7, tok = t0 + 128 - 3 + row;
                xr[k] = (idx < 1048) ? *(const u32x4*)(xsrc + (size_t)tok * NPROJ + cv * 8) : (u32x4){0u, 0u, 0u, 0u};
            }
        }
        LBAR();
#pragma unroll 4
        for (int k = 0; k < 16; ++k) {
            const int t = 16 * wave + k;
            float xc = cbv;
#pragma unroll
            for (int j = 0; j < 4; ++j) xc += cw[j] * bf2f(*(LAS const unsigned short*)(XT + (t + 3 - j) * 144 + cch * 2));
            XCF[t * 64 + cch] = xc;
            *(LAS unsigned short*)(XCB + t * 144 + cch * 2) = f2bf(xc);
        }
        asm volatile("s_waitcnt lgkmcnt(0)" ::: "memory");
        {
            f32x4 acc[8];
#pragma unroll
            for (int nt = 0; nt < 8; ++nt) acc[nt] = (f32x4){0.f, 0.f, 0.f, 0.f};
#pragma unroll
            for (int ks = 0; ks < 2; ++ks) {
                const bf16x8 af = *(LAS const bf16x8*)(XCB + (16 * wave + l15) * 144 + (32 * ks + 8 * gq) * 2);
#pragma unroll
                for (int nt = 0; nt < 8; ++nt) {
                    const bf16x8 bfr = *(LAS const bf16x8*)(WT + (16 * nt + l15) * 144 + (32 * ks + 8 * gq) * 2);
                    acc[nt] = __builtin_amdgcn_mfma_f32_16x16x32_bf16(af, bfr, acc[nt], 0, 0, 0);
                }
            }
#pragma unroll
            for (int nt = 0; nt < 4; ++nt)
#pragma unroll
                for (int rg = 0; rg < 4; ++rg) {
                    const int t = 16 * wave + 4 * gq + rg, c = 16 * nt + l15;
                    const float r = sigmoidf_(acc[nt][rg] + gba[nt]), ig = sigmoidf_(acc[nt + 4][rg] + gbx[nt]);
                    const float av = __builtin_amdgcn_exp2f(-r * gsp[nt]);
                    const float xcv = XCF[t * 64 + c];
                    AA[t * 64 + c] = av;
                    BB[t * 64 + c] = __builtin_amdgcn_sqrtf(fmaxf(1.0f - av * av, 0.f)) * (ig * xcv);
                }
        }
        asm volatile("s_waitcnt lgkmcnt(0)" ::: "memory");
        {
            float av[16], bv[16];
#pragma unroll
            for (int t = 0; t < 16; ++t) { av[t] = AA[(16 * wave + t) * 64 + lane]; bv[t] = BB[(16 * wave + t) * 64 + lane]; }
            float hl = 0.f, pl = 1.f;
#pragma unroll
            for (int t = 0; t < 16; ++t) { hl = av[t] * hl + bv[t]; pl *= av[t]; bv[t] = hl; av[t] = pl; }
            { LAS float* sw = (LAS float*)(XCB + 16 * wave * 144); sw[lane] = pl; sw[64 + lane] = hl; }
            LBAR();
            float cin = hcar, mycin = 0.f;
#pragma unroll
            for (int w2 = 0; w2 < 8; ++w2) { const LAS float* sw = (const LAS float*)(XCB + 16 * w2 * 144); if (w2 == wave) mycin = cin; cin = sw[lane] * cin + sw[64 + lane]; }
            hcar = cin;
#pragma unroll
            for (int t = 0; t < 16; ++t) BB[(16 * wave + t) * 64 + lane] = bv[t] + av[t] * mycin;
        }
        asm volatile("s_waitcnt lgkmcnt(0)" ::: "memory");
#pragma unroll
        for (int k = 0; k < 2; ++k) {
            const int idx = lane + 64 * k, row = 16 * wave + (idx >> 3), cv = idx & 7;
            const f32x4 h0 = *(LAS const f32x4*)(BB + row * 64 + cv * 8), h1 = *(LAS const f32x4*)(BB + row * 64 + cv * 8 + 4);
            u32x4 w;
            w.x = pkbf(h0[0] * gelu_tanh(bflo(yr[k].x)), h0[1] * gelu_tanh(bfhi(yr[k].x)));
            w.y = pkbf(h0[2] * gelu_tanh(bflo(yr[k].y)), h0[3] * gelu_tanh(bfhi(yr[k].y)));
            w.z = pkbf(h1[0] * gelu_tanh(bflo(yr[k].z)), h1[1] * gelu_tanh(bfhi(yr[k].z)));
            w.w = pkbf(h1[2] * gelu_tanh(bflo(yr[k].w)), h1[3] * gelu_tanh(bfhi(yr[k].w)));
            *(u32x4*)(mixed + (size_t)(t0 + row) * DM + 640 + g * 64 + cv * 8) = w;
        }
    }
}

__device__ __forceinline__ void pool_unit(const Ctx& a, int l, int b, int tc, LAS unsigned char* lds) {
    lds = lds_l(lds);
    const int tid = tid_w(a.wv), lane = tid & 63, wave = tid >> 6, l15 = lane & 15, gq = lane >> 4;
    LAS float* U = (LAS float*)lds;
    LAS unsigned char* PB = lds + 80896;
    LAS unsigned char* WT = lds + 114688;
    const int t0 = tc * 64;
    const bf16_t* proj = (const bf16_t*)(a.ws + WS_PROJ) + (size_t)b * SEQ * NPROJ;
    bf16_t* mixed = (bf16_t*)(a.ws + WS_MIXED) + (size_t)b * SEQ * DM;
    for (int k = 0; k < 5; ++k) {
        const int idx = tid + 512 * k;
        if (idx < 79 * 32) {
            const int tt = idx >> 5, cv = idx & 31, t = t0 - 15 + tt;
            u32x4 v = (u32x4){0u, 0u, 0u, 0u};
            if (t >= 0) v = *(const u32x4*)(proj + (size_t)t * NPROJ + cv * 8);
            LAS f32x4* up = (LAS f32x4*)(U + tt * 256 + cv * 8);
            up[0] = (f32x4){bflo(v.x), bfhi(v.x), bflo(v.y), bfhi(v.y)};
            up[1] = (f32x4){bflo(v.z), bfhi(v.z), bflo(v.w), bfhi(v.w)};
        }
    }
    {
        const float* pw = inptr(a, 4) + (size_t)l * 16384;
        for (int k = 0; k < 32; ++k) {
            const int idx = tid + 512 * k, g = idx >> 12, c = (idx >> 6) & 63, d = idx & 63;
            *(LAS unsigned short*)(WT + (g * 64 + d) * 144 + c * 2) = f2bf(pw[idx]);
        }
    }
    LBAR();
    {
        const int c = tid & 255, half = tid >> 8, g = c >> 6, w = 2 << g;
        for (int q = 0; q < 32; ++q) {
            const int tt = half * 32 + q, t = t0 + tt;
            float s = 0.f;
            for (int j = 0; j < w; ++j) s += U[(tt + 15 - j) * 256 + c];
            const float cnt = (float)((t + 1 < w) ? (t + 1) : w);
            *(LAS unsigned short*)(PB + tt * 528 + c * 2) = f2bf(s * __builtin_amdgcn_rcpf(cnt) - U[(tt + 15) * 256 + c]);
        }
    }
    LBAR();
    {
        const int tt = wave & 3, gp = wave >> 2;
        const float* psc = inptr(a, 5) + l * 256;
#pragma unroll 1
        for (int gi = 0; gi < 2; ++gi) {
            const int g = gp * 2 + gi;
            f32x4 acc[4];
#pragma unroll
            for (int nt = 0; nt < 4; ++nt) acc[nt] = (f32x4){0.f, 0.f, 0.f, 0.f};
#pragma unroll
            for (int ks = 0; ks < 2; ++ks) {
                const bf16x8 af = *(LAS const bf16x8*)(PB + (16 * tt + l15) * 528 + (g * 64 + 32 * ks + 8 * gq) * 2);
#pragma unroll
                for (int nt = 0; nt < 4; ++nt) {
                    const bf16x8 bfr = *(LAS const bf16x8*)(WT + (g * 64 + 16 * nt + l15) * 144 + (32 * ks + 8 * gq) * 2);
                    acc[nt] = __builtin_amdgcn_mfma_f32_16x16x32_bf16(af, bfr, acc[nt], 0, 0, 0);
                }
            }
#pragma unroll
            for (int nt = 0; nt < 4; ++nt) {
                const int dcol = g * 64 + 16 * nt + l15;
                const float sc = psc[dcol];
#pragma unroll
                for (int rg = 0; rg < 4; ++rg) mixed[(size_t)(t0 + 16 * tt + 4 * gq + rg) * DM + dcol] = f2bf(acc[nt][rg] * sc);
            }
        }
    }
}

__device__ __forceinline__ void dattn_unit(const Ctx& a, int b, int h, int tb, LAS unsigned char* lds) {
    lds = lds_l(lds);
    const int tid = tid_w(a.wv), lane = tid & 63, wave = tid >> 6, l15 = lane & 15, gq = lane >> 4;
    LAS float* OACC = (LAS float*)lds;
    LAS float* DEN = (LAS float*)(lds + 65536);
    LAS unsigned char* vst = lds + 66560 + wave * 4608;
    const int t0 = tb * 256;
    const bf16_t* projb = (const bf16_t*)(a.ws + WS_PROJ) + (size_t)b * SEQ * NPROJ;
    bf16_t* mixed = (bf16_t*)(a.ws + WS_MIXED) + (size_t)b * SEQ * DM;
    const float slope2 = exp2f(-8.0f * (float)(h + 1) / 6.0f) * LOG2E;
    const int trq = (l15 >> 2), trp = (l15 & 3);
#pragma unroll 1
    for (int pi = 0; pi < 3; ++pi) {
        const int d = 1 << (2 * pi);
        const float sl = slope2 * (float)d;
#pragma unroll 1
        for (int ii = 0; ii < 2; ++ii) {
            const int it = 2 * wave + ii, rr = it % d, jj = it / d, tq0 = t0 + rr + 16 * d * jj;
            const unsigned char* pbytes = (const unsigned char*)projb;
            const unsigned qoff = (unsigned)(tq0 + d * l15) * (unsigned)(NPROJ * 2) + (unsigned)((256 + h * 64 + 8 * gq) * 2);
            const bf16x8 qf0 = *(const bf16x8*)(pbytes + qoff), qf1 = *(const bf16x8*)(pbytes + qoff + 64);
            bf16x8 kf[6][2];
            const int kmin = (640 + h * 64 + 8 * gq) * 2;
            const int koff0 = (tq0 + d * (l15 - 128)) * (NPROJ * 2) + kmin;
            const int kstep = d * 16 * (NPROJ * 2);
#define DATTN_KLOAD(KT) do { if ((KT) < 9) { int ko_ = koff0 + (KT) * kstep; ko_ = ko_ < kmin ? kmin : ko_; \
                kf[(KT) % 6][0] = *(const bf16x8*)(pbytes + (unsigned)ko_); kf[(KT) % 6][1] = *(const bf16x8*)(pbytes + (unsigned)ko_ + 64); } } while (0)
            DATTN_KLOAD(0); DATTN_KLOAD(1); DATTN_KLOAD(2); DATTN_KLOAD(3); DATTN_KLOAD(4); DATTN_KLOAD(5);
            u32x4 vreg[3][4];
            const int vmin = (1024 + h * 64 + (lane & 7) * 8) * 2, vmax = (SEQ - 1) * (NPROJ * 2) + vmin;
            const int voff0 = (tq0 + d * ((lane >> 3) - 128)) * (NPROJ * 2) + vmin;
            const int vstep = d * 8 * (NPROJ * 2);
#define DATTN_VLOAD(PP) do { _Pragma("unroll") for (int ps = 0; ps < 4; ++ps) { \
                    int vo_ = voff0 + (4 * (PP) + 2 * (ps >> 1) + (ps & 1)) * vstep; vo_ = vo_ < vmin ? vmin : (vo_ > vmax ? vmax : vo_); \
                    vreg[(PP) % 3][ps] = *(const u32x4*)(pbytes + (unsigned)vo_); } } while (0)
            DATTN_VLOAD(0); DATTN_VLOAD(1); DATTN_VLOAD(2);
            f32x4 o[4];
#pragma unroll
            for (int dt = 0; dt < 4; ++dt) o[dt] = (f32x4){0.f, 0.f, 0.f, 0.f};
            float den = 0.f;
            int dbase = l15 + 128 - 4 * gq; asm volatile("" : "+v"(dbase));
            float fbase = (float)dbase; asm volatile("" : "+v"(fbase));
            const float nb0 = -sl * fbase;
#pragma unroll
            for (int pp = 0; pp < 5; ++pp) {
                __builtin_amdgcn_sched_barrier(0);
#pragma unroll
                for (int ps = 0; ps < 4; ++ps) { const int idx = ps * 64 + lane, row = idx >> 3, chk = idx & 7; *(LAS u32x4*)(vst + row * 144 + chk * 16) = vreg[pp % 3][ps]; }
                if (pp + 3 < 5) { asm volatile("" ::: "memory"); DATTN_VLOAD(pp + 3); }
                const bool skip = (tq0 + d * (16 * (2 * pp + 1 - 8) + 15) < 0);
                f32x4 sacc[2];
#pragma unroll
                for (int T = 0; T < 2; ++T) {
                    const int kt = 2 * pp + T;
                    sacc[T] = (f32x4){0.f, 0.f, 0.f, 0.f};
                    if (kt < 9 && !skip) {
                        sacc[T] = __builtin_amdgcn_mfma_f32_16x16x32_bf16(kf[kt % 6][0], qf0, sacc[T], 0, 0, 0);
                        sacc[T] = __builtin_amdgcn_mfma_f32_16x16x32_bf16(kf[kt % 6][1], qf1, sacc[T], 0, 0, 0);
                    }
                }
                if (pp + 3 < 5) { asm volatile("" ::: "memory"); DATTN_KLOAD(2 * pp + 6); DATTN_KLOAD(2 * pp + 7); }
                if (skip) continue;
                float p[2][4];
#pragma unroll
                for (int T = 0; T < 2; ++T) {
                    const int kt = 2 * pp + T;
                    if (kt >= 9) { p[T][0] = 0.f; p[T][1] = 0.f; p[T][2] = 0.f; p[T][3] = 0.f; }
                    else if (kt == 0 || kt == 8 || (tq0 + d * 16 * (kt - 8) < 0)) {
#pragma unroll
                        for (int rg = 0; rg < 4; ++rg) {
                            const int dist = dbase - (16 * kt + rg);
                            const int tkk = tq0 + d * (l15 - dist);
                            const bool valid = (dist >= 0) && (dist <= 128) && (tkk >= 0);
                            const float pv = valid ? __builtin_amdgcn_exp2f(sacc[T][rg] + fmaf(sl, (float)(16 * kt + rg), nb0)) : 0.f;
                            p[T][rg] = pv; den += pv;
                        }
                    } else {
#pragma unroll
                        for (int rg = 0; rg < 4; ++rg) {
                            const float pv = __builtin_amdgcn_exp2f(sacc[T][rg] + fmaf(sl, (float)(16 * kt + rg), nb0));
                            p[T][rg] = pv; den += pv;
                        }
                    }
                }
                u32x4 pw; pw.x = pkbf(p[0][0], p[0][1]); pw.y = pkbf(p[0][2], p[0][3]); pw.z = pkbf(p[1][0], p[1][1]); pw.w = pkbf(p[1][2], p[1][3]);
                const bf16x8 pfrag = __builtin_bit_cast(bf16x8, pw);
#pragma unroll
                for (int dt = 0; dt < 4; ++dt) {
                    const s16x4 lo = vtr(vst + (4 * gq + trq) * 144 + (16 * dt + 4 * trp) * 2);
                    const s16x4 hi = vtr(vst + (16 + 4 * gq + trq) * 144 + (16 * dt + 4 * trp) * 2);
                    const bf16x8 vf = (bf16x8){lo[0], lo[1], lo[2], lo[3], hi[0], hi[1], hi[2], hi[3]};
                    o[dt] = __builtin_amdgcn_mfma_f32_16x16x32_bf16(pfrag, vf, o[dt], 0, 0, 0);
                }
            }
            den += shx(den, lane, 16); den += shx(den, lane, 32);
#pragma unroll
            for (int dt = 0; dt < 4; ++dt)
#pragma unroll
                for (int rg = 0; rg < 4; ++rg) {
                    const int tl = (tq0 - t0) + d * (4 * gq + rg), idx = tl * 64 + 16 * dt + l15;
                    if (pi == 0) OACC[idx] = o[dt][rg]; else OACC[idx] += o[dt][rg];
                }
            if (gq == 0) { const int tl = (tq0 - t0) + d * l15; if (pi == 0) DEN[tl] = den; else DEN[tl] += den; }
        }
        LBAR();
    }
#pragma unroll
    for (int k = 0; k < 4; ++k) {
        const int idx = tid + 512 * k, tl = idx >> 3, c8 = (idx & 7) * 8;
        const f32x4 x0 = *(LAS const f32x4*)(OACC + tl * 64 + c8), x1 = *(LAS const f32x4*)(OACC + tl * 64 + c8 + 4);
        const float r = __builtin_amdgcn_rcpf(DEN[tl]);
        u32x4 w; w.x = pkbf(x0[0] * r, x0[1] * r); w.y = pkbf(x0[2] * r, x0[3] * r); w.z = pkbf(x1[0] * r, x1[1] * r); w.w = pkbf(x1[2] * r, x1[3] * r);
        *(u32x4*)(mixed + (size_t)(t0 + tl) * DM + 256 + h * 64 + c8) = w;
    }
}

__device__ __forceinline__ void phase_mixers(const Ctx& a, int l, LAS unsigned char* lds, unsigned xq, bool steal) {
    unsigned* ctr = (unsigned*)(a.ws + WS_CTL) + 64 * l;
    lds = lds_l(lds);
    LAS int* sun = (LAS int*)(lds + LDS_UNIT_OFF);
    const unsigned nk = steal ? 8u : 1u;
    int stage = 0;
    for (;;) {
        __syncthreads();
        if (tid_w(a.wv) == 0) {
            int code = -1;
            for (; stage < 3 && code < 0; ) {
                const int nq = stage == 0 ? 24 : (stage == 1 ? 192 : 128);
                for (unsigned k = 0; k < nk && code < 0; ++k) {
                    const unsigned x2 = (xq + k) & 7u;
                    const int u = (int)atomicAdd(ctr + 8 * stage + x2, 1u);
                    if (u < nq) code = (stage == 0 ? 0 : (stage == 1 ? 1000 : 10000)) + (int)x2 * nq + u;
                }
                if (code < 0) ++stage;
            }
            *sun = code;
        }
        __syncthreads();
        const int code = *sun;
        if (code < 0) break;
        if (code < 1000) lru_unit(a, l, code / 6, code % 6, lds);
        else if (code < 10000) { const int v = code - 1000; dattn_unit(a, v / 48, (v % 48) / 8, v % 8, lds); }
        else { const int v = code - 10000; pool_unit(a, l, v / 32, v % 32, lds); }
    }
}

__device__ __forceinline__ void phase_xattn(const Ctx& a, int l, LAS unsigned char* lds, int cv) {
    lds = lds_l(lds);
    const int tid = tid_w(a.wv), lane = tid & 63, wave = tid >> 6, l15 = lane & 15, gq = lane >> 4;
    LAS unsigned char* KL = lds;
    LAS unsigned char* VL = lds + 16896;
    LAS float* RK = (LAS float*)(lds + 68608);
    const bf16_t* qm = (const bf16_t*)(a.ws + WS_QM);
    const float* qst = (const float*)(a.ws + WS_QST);
    const bf16_t* kv = (const bf16_t*)(a.ws + WS_KV);
    const float* kst = (const float*)(a.ws + WS_KST);
    bf16_t* om = (bf16_t*)(a.ws + WS_MIXED);
    const int trq = (l15 >> 2), trp = (l15 & 3);
    for (int xu = cv; xu < NBATCH * 4 * 16; xu += gridDim.x) {
        const int xr = xu >> 3, b = 4 * (xu & 7) + (xr >> 6), h = (xr >> 4) & 3, qb = xr & 15;
        LBAR();
        if (tid < 256) {
            const f32x4* kp = (const f32x4*)(kst + (size_t)(b * 256 + tid) * 256 + l * 64 + h * 8);
            const f32x4 k0 = kp[0], k1 = kp[1];
            RK[tid] = rsqrtf((((k0[0] + k0[1]) + (k0[2] + k0[3])) + ((k1[0] + k1[1]) + (k1[2] + k1[3]))) * (1.0f / 256.0f) + EPSF);
        }
        const bf16_t* kvb = kv + (size_t)(b * 256) * 8192 + l * 2048 + h * 256;
        u32x4 kpre[2], vpre[2];
#pragma unroll
        for (int k = 0; k < 2; ++k) {
            const int idx = tid + 512 * k, row = idx >> 5, chk = idx & 31;
            const bf16_t* src = kvb + (size_t)row * 8192 + chk * 8;
            kpre[k] = *(const u32x4*)src; vpre[k] = *(const u32x4*)(src + 1024);
        }
        const size_t qrow = (size_t)b * SEQ + qb * 128 + wave * 16 + l15;
        bf16x8 qf[8];
#pragma unroll
        for (int ks = 0; ks < 8; ++ks) qf[ks] = *(const bf16x8*)(qm + qrow * DM + h * 256 + 32 * ks + 8 * gq);
        float rq;
        { const f32x4* qp = (const f32x4*)(qst + qrow * 32 + h * 8); const f32x4 q0 = qp[0], q1 = qp[1];
          rq = rsqrtf((((q0[0] + q0[1]) + (q0[2] + q0[3])) + ((q1[0] + q1[1]) + (q1[2] + q1[3]))) * (1.0f / 256.0f) + EPSF); }
        f32x4 o[16];
#pragma unroll
        for (int dt = 0; dt < 16; ++dt) o[dt] = (f32x4){0.f, 0.f, 0.f, 0.f};
        float den = 0.f;
#pragma unroll
        for (int ks = 0; ks < 8; ++ks) asm volatile("" : "+v"(qf[ks]));
        asm volatile("" : "+v"(rq));
#pragma unroll
        for (int k = 0; k < 2; ++k) {
            const int idx = tid + 512 * k, row = idx >> 5, chk = idx & 31;
            *(LAS u32x4*)(KL + row * 528 + chk * 16) = kpre[k];
            *(LAS u32x4*)(VL + row * 544 + chk * 16) = vpre[k];
            const bf16_t* src = kvb + (size_t)(32 + row) * 8192 + chk * 8;
            kpre[k] = *(const u32x4*)src; vpre[k] = *(const u32x4*)(src + 1024);
        }
#pragma unroll 1
        for (int c = 0; c < 8; ++c) {
            LBAR();
            const int bo = (c & 1) * 34304, bn = 34304 - bo;
            if (c < 7) {
#pragma unroll
                for (int k = 0; k < 2; ++k) {
                    const int idx = tid + 512 * k, row = idx >> 5, chk = idx & 31;
                    *(LAS u32x4*)(KL + bn + row * 528 + chk * 16) = kpre[k];
                    *(LAS u32x4*)(VL + bn + row * 544 + chk * 16) = vpre[k];
                }
                if (c < 6) {
#pragma unroll
                    for (int k = 0; k < 2; ++k) {
                        const int idx = tid + 512 * k, row = idx >> 5, chk = idx & 31;
                        const bf16_t* src = kvb + (size_t)(32 * (c + 2) + row) * 8192 + chk * 8;
                        kpre[k] = *(const u32x4*)src; vpre[k] = *(const u32x4*)(src + 1024);
                    }
                }
            }
            LAS unsigned char* KLc = KL + bo; LAS unsigned char* VLc = VL + bo;
            float p[2][4];
#pragma unroll
            for (int T = 0; T < 2; ++T) {
                f32x4 s = (f32x4){0.f, 0.f, 0.f, 0.f};
#pragma unroll
                for (int ks = 0; ks < 8; ++ks) {
                    const bf16x8 kf = *(LAS const bf16x8*)(KLc + (16 * T + l15) * 528 + (32 * ks + 8 * gq) * 2);
                    s = __builtin_amdgcn_mfma_f32_16x16x32_bf16(kf, qf[ks], s, 0, 0, 0);
                }
                const f32x4 rk4 = *(LAS const f32x4*)(RK + 32 * c + 16 * T + 4 * gq);
#pragma unroll
                for (int rg = 0; rg < 4; ++rg) { const float pv = __builtin_amdgcn_exp2f(s[rg] * rq * rk4[rg]); p[T][rg] = pv; den += pv; }
            }
            u32x4 pw; pw.x = pkbf(p[0][0], p[0][1]); pw.y = pkbf(p[0][2], p[0][3]); pw.z = pkbf(p[1][0], p[1][1]); pw.w = pkbf(p[1][2], p[1][3]);
            const bf16x8 pfrag = __builtin_bit_cast(bf16x8, pw);
#pragma unroll
            for (int dt = 0; dt < 16; ++dt) {
                const s16x4 lo = vtr(VLc + (4 * gq + trq) * 544 + (16 * dt + 4 * trp) * 2);
                const s16x4 hi = vtr(VLc + (16 + 4 * gq + trq) * 544 + (16 * dt + 4 * trp) * 2);
                const bf16x8 vf = (bf16x8){lo[0], lo[1], lo[2], lo[3], hi[0], hi[1], hi[2], hi[3]};
                o[dt] = __builtin_amdgcn_mfma_f32_16x16x32_bf16(pfrag, vf, o[dt], 0, 0, 0);
            }
        }
        den += shx(den, lane, 16); den += shx(den, lane, 32);
        float inv[4];
#pragma unroll
        for (int rg = 0; rg < 4; ++rg) inv[rg] = 1.0f / shi(den, 4 * gq + rg);
        LAS unsigned char* OST = lds + 71680 + wave * 8448;
#pragma unroll
        for (int dt = 0; dt < 16; ++dt)
#pragma unroll
            for (int rg = 0; rg < 4; ++rg) *(LAS unsigned short*)(OST + (4 * gq + rg) * 528 + (16 * dt + l15) * 2) = f2bf(o[dt][rg] * inv[rg]);
        asm volatile("s_waitcnt lgkmcnt(0)" ::: "memory");
        const size_t orow0 = (size_t)b * SEQ + qb * 128 + wave * 16;
#pragma unroll
        for (int k = 0; k < 8; ++k) {
            const int idx = k * 64 + lane, row = idx >> 5, chk = idx & 31;
            const u32x4 w = *(LAS const u32x4*)(OST + row * 528 + chk * 16);
            *(u32x4*)(om + (orow0 + row) * DM + h * 256 + chk * 8) = w;
        }
        asm volatile("s_waitcnt lgkmcnt(0)" ::: "memory");
    }
}

__device__ __forceinline__ void phase_ffn_fix(const Ctx& a, int l, int cv) {
    const float* sg = (const float*)(a.ws + WS_SG); const float* su = (const float*)(a.ws + WS_SU);
    bf16_t* act = (bf16_t*)(a.ws + WS_ACT);
    const float* cw = inptr(a, 25) + (size_t)l * 3 * DFF; const float* cb = inptr(a, 26) + (size_t)l * DFF;
    const int per_x = 32 * 4 * (DFF / 4);
    for (int wi = (cv >> 3) * NTHREADS + tid_w(a.wv); wi < per_x; wi += (gridDim.x >> 3) * NTHREADS) {
        const int f = (wi % (DFF / 4)) * 4, j = (wi / (DFF / 4)) & 3, pm = 32 * (cv & 7) + wi / (DFF / 4) / 4, wr = j >> 1, e = j & 1;
        const float* sgt = sg + (size_t)pm * 8 * DFF + f;
        const f32x4 z = (f32x4){0.f, 0.f, 0.f, 0.f};
        const bool hasprev = (pm & 7) != 0;
        const f32x4 prev7 = hasprev ? *(const f32x4*)(sgt - (size_t)8 * DFF + 7 * DFF) : z;
        const f32x4 prev6 = hasprev ? *(const f32x4*)(sgt - (size_t)8 * DFF + 6 * DFF) : z;
        const f32x4 gc = *(const f32x4*)(sgt + (size_t)(wr * 4 + e) * DFF);
        f32x4 gm1, gm2;
        if (e == 1) { gm1 = *(const f32x4*)(sgt + (size_t)(wr * 4) * DFF); gm2 = wr ? *(const f32x4*)(sgt + (size_t)3 * DFF) : prev7; }
        else { gm1 = wr ? *(const f32x4*)(sgt + (size_t)3 * DFF) : prev7; gm2 = wr ? *(const f32x4*)(sgt + (size_t)2 * DFF) : prev6; }
        const f32x4 uu = *(const f32x4*)(su + ((size_t)pm * 4 + wr * 2 + e) * DFF + f);
        const f32x4 w0 = *(const f32x4*)(cw + f), w1 = *(const f32x4*)(cw + DFF + f), w2 = *(const f32x4*)(cw + 2 * DFF + f), bb = *(const f32x4*)(cb + f);
        float r[4];
#pragma unroll
        for (int i = 0; i < 4; ++i) r[i] = gelu_tanh(bb[i] + w0[i] * gc[i] + w1[i] * gm1[i] + w2[i] * gm2[i]) * uu[i];
        u32x2 w; w.x = pkbf(r[0], r[1]); w.y = pkbf(r[2], r[3]);
        *(u32x2*)(act + (size_t)(pm * 256 + wr * 128 + e) * DFF + f) = w;
    }
}

#define GAS __attribute__((address_space(1)))

typedef GAS unsigned gu32;
typedef GAS unsigned long long gu64;
#define RLX_AGENT __ATOMIC_RELAXED, __HIP_MEMORY_SCOPE_AGENT
#define LDS_WAIT() asm volatile("s_waitcnt lgkmcnt(0)" ::: "memory")
#define VM_WAIT() asm volatile("s_waitcnt vmcnt(0)" ::: "memory")
__device__ __forceinline__ unsigned long long rt() { return __builtin_amdgcn_s_memrealtime(); }
#define XB_TMO      128
#define XB_XCNT(j)  (256  + 64 * (j))
#define XB_XSUB(j)  (1280 + 64 * (j))
#define XB_XGEN(j)  (2304 + 64 * (j))
#define XB_TOP      3328
#define XB_TOPGEN   3392
#define XB_LSUB(j)  (3456 + 64 * (j))
#define XB_LGEN(j)  (4480 + 64 * (j))
#define XCD_BAR_WORDS 5504
#define XB_SPIN_CAP (1u << 18)

__device__ __forceinline__ unsigned xb_ld(unsigned* p)              { return __hip_atomic_load(p, __ATOMIC_RELAXED, __HIP_MEMORY_SCOPE_AGENT); }
__device__ __forceinline__ unsigned xb_add(unsigned* p, unsigned v) { return __hip_atomic_fetch_add(p, v, __ATOMIC_RELAXED, __HIP_MEMORY_SCOPE_AGENT); }
__device__ __forceinline__ unsigned xb_xcc_id() { return (unsigned)__builtin_amdgcn_s_getreg((3 << 11) | 20) & 0xFu; }
#define XB_SPIN(cond, bar) do { unsigned _sp = 0; while (cond) { __builtin_amdgcn_s_sleep(1); \
    if ((++_sp & 255u) == 0u) { if (xb_ld(&(bar)[XB_TMO])) break; if (_sp > XB_SPIN_CAP) { atomicAdd(&(bar)[XB_TMO], 1u); break; } } } } while (0)

struct XcdBarrier {
    unsigned* bar; unsigned x;
    volatile LAS unsigned* st;
};

__device__ __forceinline__ XcdBarrier xcd_barrier_post(unsigned* bar, volatile LAS unsigned* st, bool t0) {
    XcdBarrier b; b.bar = bar; b.x = xb_xcc_id(); b.st = st;
    if (t0) st[2] = xb_add(&bar[XB_XCNT(b.x)], 1u);
    return b;
}
__device__ __forceinline__ void xcd_barrier_complete(unsigned* bar, unsigned x, unsigned& nloc, unsigned& nx) {
    const unsigned G = gridDim.x * gridDim.y * gridDim.z;
    unsigned sum, cnt, mine, sp = 0u;
    for (;;) {
        sum = 0u; cnt = 0u; mine = 0u;
#pragma unroll
        for (unsigned j = 0; j < 16; ++j) { const unsigned c = xb_ld(&bar[XB_XCNT(j)]); sum += c; cnt += (c > 0u) ? 1u : 0u; mine = (j == x) ? c : mine; }
        if (sum == G) break;
        __builtin_amdgcn_s_sleep(1);
        if ((++sp & 255u) == 0u) { if (xb_ld(&bar[XB_TMO])) break; if (sp > XB_SPIN_CAP) { atomicAdd(&bar[XB_TMO], 1u); break; } }
    }
    nloc = mine > 0u ? mine : 1u; nx = cnt > 0u ? cnt : 1u;
}

__device__ __forceinline__ void xcd_barrier(const XcdBarrier& b, bool t0) {
    asm volatile("s_waitcnt vmcnt(0)" ::: "memory");
    __syncthreads();
    if (t0) {
        unsigned* bar = b.bar;
        __builtin_amdgcn_s_waitcnt(0);
        unsigned nloc = b.st[0], nx = b.st[1];
        if (nloc == 0u) { xcd_barrier_complete(bar, b.x, nloc, nx); b.st[0] = nloc; b.st[1] = nx; }
        const unsigned old = xb_add(&bar[XB_XSUB(b.x)], 1u);
        const unsigned gen = old / nloc;
        if (old + 1u == (gen + 1u) * nloc) {
            __builtin_amdgcn_fence(__ATOMIC_RELEASE, "agent");
            asm volatile("s_waitcnt vmcnt(0)" ::: "memory");
            const unsigned og = xb_add(&bar[XB_TOP], 1u);
            const unsigned tg = og / nx;
            if (og + 1u == (tg + 1u) * nx) xb_add(&bar[XB_TOPGEN], 1u);
            else XB_SPIN(xb_ld(&bar[XB_TOPGEN]) == tg, bar);
            __builtin_amdgcn_fence(__ATOMIC_ACQUIRE, "agent");
            xb_add(&bar[XB_XGEN(b.x)], 1u);
            asm volatile("s_waitcnt vmcnt(0)" ::: "memory");
        } else {
            XB_SPIN(xb_ld(&bar[XB_XGEN(b.x)]) == gen, bar);
            __builtin_amdgcn_fence(__ATOMIC_ACQUIRE, "agent");
            asm volatile("s_waitcnt vmcnt(0)" ::: "memory");
        }
    }
    __syncthreads();
}


__device__ __forceinline__ void xcd_barrier_local(const XcdBarrier& b, bool t0) {
    asm volatile("s_waitcnt vmcnt(0)" ::: "memory");
    __syncthreads();
    if (t0) {
        unsigned* bar = b.bar;
        const unsigned nloc = b.st[0];
        const unsigned old = xb_add(&bar[XB_LSUB(b.x)], 1u);
        const unsigned gen = old / nloc;
        if (old + 1u == (gen + 1u) * nloc) xb_add(&bar[XB_LGEN(b.x)], 1u);
        else XB_SPIN(xb_ld(&bar[XB_LGEN(b.x)]) == gen, bar);
        __builtin_amdgcn_fence(__ATOMIC_ACQUIRE, "agent");
        asm volatile("s_waitcnt vmcnt(0)" ::: "memory");
    }
    __syncthreads();
}
__device__ __forceinline__ bool xcd_even_partition(unsigned* bar) {
    const unsigned G = gridDim.x; bool ok = (G % 8u) == 0u; unsigned n = 0u;
#pragma unroll
    for (unsigned j = 0; j < 16; ++j) { const unsigned c = xb_ld(&bar[XB_XCNT(j)]); if (c) { ++n; ok = ok && (c * 8u == G) && (j < 8u); } }
    return ok && n == 8u;
}

__global__ void __launch_bounds__(NTHREADS, 2) trunk_fwd(Args ka) {
    extern __shared__ __attribute__((aligned(16))) unsigned char lds_raw[];
    LAS unsigned char* lds = (LAS unsigned char*)lds_raw;
    cg::grid_group grid = cg::this_grid();
    {
        LAS unsigned long long* tw = (LAS unsigned long long*)(lds + LDS_TBL_OFF);
        if (threadIdx.x == 0) {
#pragma unroll
            for (int i = 0; i < 28; ++i) tw[i] = (unsigned long long)ka.in[i];
        }
        __syncthreads();
    }
    volatile LAS unsigned* bst = (volatile LAS unsigned*)(lds + LDS_UNIT_OFF + 16);
    if (threadIdx.x == 0) { bst[0] = 0u; bst[1] = 0u; bst[2] = 0u; bst[3] = 0u; }
    __syncthreads();
    const XcdBarrier xbar = xcd_barrier_post((unsigned*)(ka.ws + WS_CTL) + 4096, bst, threadIdx.x == 0);
#define GSYNC_FULL() xcd_barrier(xbar, tid_w(a.wv) == 0)
#define GSYNC() do { if (part) xcd_barrier_local(xbar, tid_w(a.wv) == 0); else xcd_barrier(xbar, tid_w(a.wv) == 0); } while (0)
    int cv = (int)blockIdx.x; bool part = false;
    Ctx a; a.tbl = (LAS const unsigned long long*)(lds + LDS_TBL_OFF); a.out = ka.out; a.ws = ka.ws; a.wv = __builtin_amdgcn_readfirstlane((int)(threadIdx.x >> 6));
    unsigned char* ws = a.ws;
    bf16_t* hb = (bf16_t*)(ws + WS_HB);
    float* st = (float*)(ws + WS_ST);

    phase_prologue(a, lds);
    grid.sync();
    {
        EpiBf<false> E{(bf16_t*)(ws + WS_KV), 8192, (const float*)(ws + WS_STM), (float*)(ws + WS_KST), 256, nullptr, nullptr, nullptr};
        run_gemm(cv, a.wv, lds, (const bf16_t*)(ws + WS_MEMB), (const bf16_t*)(ws + WS_WKV), MEMROWS, 8192, DM, E);
    }
    for (int l = 0; l < DEPTH; ++l) {
        const unsigned char* wl = ws + WS_W + (size_t)l * W_LAYER;
        {
            EpiBf<true> E{(bf16_t*)(ws + WS_PROJ), NPROJ, st, nullptr, 0, nullptr, inptr(a, 6) + l * 64, inptr(a, 7) + l * 64};
            run_gemm(cv, a.wv, lds, hb, (const bf16_t*)(wl + W_IN), MTOK, NPROJ, DM, E);
        }
        if (l == 0) {
            GSYNC_FULL();
            if (tid_w(a.wv) == 0) bst[3] = xcd_even_partition(xbar.bar) ? 1u : 0u;
            __syncthreads();
            part = bst[3] != 0u;
            if (part) cv = (int)(bst[2] * 8u + (xbar.x & 7u));
        } else GSYNC();
        phase_mixers(a, l, lds, (unsigned)cv & 7u, !part);
        GSYNC();
        {
            EpiRes E{l == 0 ? inptr(a, 0) : a.out, a.out, hb, st};
            run_gemm(cv, a.wv, lds, (const bf16_t*)(ws + WS_MIXED), (const bf16_t*)(wl + W_OUT), MTOK, DM, DM, E);
        }
        GSYNC();
        {
            EpiBf<false> E{(bf16_t*)(ws + WS_QM), DM, st, (float*)(ws + WS_QST), 32, (const float*)(ws + WS_CS) + l * 1024, nullptr, nullptr};
            run_gemm(cv, a.wv, lds, hb, (const bf16_t*)(wl + W_Q), MTOK, DM, DM, E);
        }
        GSYNC();
        phase_xattn(a, l, lds, cv);
        GSYNC();
        {
            EpiRes E{a.out, a.out, hb, st};
            run_gemm(cv, a.wv, lds, (const bf16_t*)(ws + WS_MIXED), (const bf16_t*)(wl + W_O), MTOK, DM, DM, E);
        }
        GSYNC_FULL();
        {
            EpiAct E{(bf16_t*)(ws + WS_ACT), st, inptr(a, 25) + (size_t)l * 3 * DFF, inptr(a, 26) + (size_t)l * DFF, (float*)(ws + WS_SG), (float*)(ws + WS_SU)};
            run_gemm_aperm(cv, a.wv, lds, hb, (const bf16_t*)(wl + W_UP), MTOK, DFF2, DM, E);
        }
        GSYNC();
        phase_ffn_fix(a, l, cv);
        GSYNC();
        {
            EpiRes E{a.out, a.out, (l == DEPTH - 1) ? nullptr : hb, st};
            run_gemm(cv, a.wv, lds, (const bf16_t*)(ws + WS_ACT), (const bf16_t*)(wl + W_DOWN), MTOK, DM, DFF, E);
        }
        if (l < DEPTH - 1) GSYNC_FULL();
    }
}

extern "C" void kernel_launch(void* const* d_in, const int* in_sizes, int n_in, void* d_out, int out_size, void* d_ws, size_t ws_size, hipStream_t stream) {
    static int grid = 0;
    if (grid == 0) {
        if (n_in != 28 || in_sizes[0] != MTOK * DM || out_size != MTOK * DM || ws_size < WS_END) {
            fprintf(stderr, "kernel_launch: unexpected shapes (n_in %d, in0 %d, out %d, ws %zu; need ws >= %zu); nothing launched\n", n_in, n_in > 0 ? in_sizes[0] : -1, out_size, ws_size, (size_t)WS_END);
            grid = -1; return;
        }
        int dev = 0, cus = 0, per_cu = 0;
        hipGetDevice(&dev);
        hipDeviceGetAttribute(&cus, hipDeviceAttributeMultiprocessorCount, dev);
        if (hipFuncSetAttribute((const void*)trunk_fwd, hipFuncAttributeMaxDynamicSharedMemorySize, LDS_BYTES) != hipSuccess) { fprintf(stderr, "kernel_launch: hipFuncSetAttribute failed\n"); grid = -1; return; }
        if (hipOccupancyMaxActiveBlocksPerMultiprocessor(&per_cu, (const void*)trunk_fwd, NTHREADS, LDS_BYTES) != hipSuccess || per_cu < 1) { fprintf(stderr, "kernel_launch: occupancy query says %d blocks per CU\n", per_cu); per_cu = 1; }
        (void)hipGetLastError();
        grid = cus;
    }
    if (grid < 0) return;
    (void)hipMemsetAsync((char*)d_ws + WS_CTL, 0, 65536, stream);
    Args a{};
    for (int i = 0; i < 28; ++i) a.in[i] = (const float*)d_in[i];
    a.out = (float*)d_out; a.ws = (unsigned char*)d_ws;
    void* args[] = {&a};
    hipError_t e = hipLaunchCooperativeKernel((const void*)trunk_fwd, dim3(grid), dim3(NTHREADS), args, LDS_BYTES, stream);
    if (e != hipSuccess) fprintf(stderr, "cooperative launch failed: %s (grid %d)\n", hipGetErrorString(e), grid);
}
```

```cpp
#include <hip/hip_runtime.h>
#include <hip/hip_cooperative_groups.h>
#include <cstdio>
#include <cstdint>
namespace cg = cooperative_groups;
namespace pg8 {
#define PG8_LAS __attribute__((address_space(3)))
typedef unsigned short bf16_t;
typedef short bf16x8 __attribute__((ext_vector_type(8)));
typedef float f32x4 __attribute__((ext_vector_type(4)));
typedef unsigned u32x4 __attribute__((ext_vector_type(4)));
constexpr int BM = 256, BK = 64, HALF = 128, HTB = HALF * BK * 2  , STAGE_BYTES = 8 * HTB, NXCD = 8, WGM = 8;

__host__ __device__ __forceinline__ int lds_byte(int r, int c) { const int st = (r >> 4) * 2 + (c >> 5), rr = r & 15, cc = c & 31, ob = rr * 64 + cc * 2; return st * 1024 + (ob ^ (((ob >> 9) & 1) << 5)); }
__host__ __device__ __forceinline__ void stage_rc(int b, int& R, int& C) { const int st = b / 1024, sb = b % 1024, swz = sb ^ (((sb >> 9) & 1) << 5); R = (st >> 1) * 16 + swz / 64; C = (st & 1) * 32 + (swz % 64) / 2; }
__host__ __device__ __forceinline__ int perm32(int rho) { const int n = rho >> 4, i = rho & 15; return 8 * (i >> 2) + 4 * n + (i & 3); }

struct Unit { int pm, pn; };
struct Gemm { const bf16_t* A; const bf16_t* Bt; int M, N, K; };

struct StaticOrder {
    int nM, nN, nwg, G, c;
    __host__ __device__ void init(int M, int N, int G_, int c_) { nM = M / BM; nN = N / BM; nwg = nM * nN; G = G_; c = c_; }
    __host__ __device__ bool next(int i, Unit& u) const {
        const long L = (long)i * G + c; if (L >= nwg) return false;
        int wgid = (int)L; { const int q = nwg / NXCD, r = nwg % NXCD, xcd = wgid % NXCD, off = wgid / NXCD; wgid = (xcd < r ? xcd * (q + 1) : r * (q + 1) + (xcd - r) * q) + off; }
        const int nig = WGM * nN, gid = wgid / nig, fm = gid * WGM, gsz = (nM - fm) < WGM ? (nM - fm) : WGM;
        u.pm = fm + ((wgid % nig) % gsz); u.pn = (wgid % nig) / gsz; return true;
    }
    __device__ __forceinline__ void a_ready(const Unit&) const {}
    __device__ __forceinline__ void done(const Unit&) const {}
};

__device__ __forceinline__ unsigned cvt_pk_bf16(float lo, float hi) { unsigned r; asm volatile("v_cvt_pk_bf16_f32 %0, %1, %2" : "=v"(r) : "v"(lo), "v"(hi)); return r; }
typedef float f32x2 __attribute__((ext_vector_type(2)));
template <class Epi, class Sched, bool ALIGN_EPI = false, bool SP2 = false, bool APERM = false>
__device__ __forceinline__ void gemm_phase(int tid_in, PG8_LAS unsigned char* lds, const Gemm g, const Sched& S, const Epi& E) {
    int tid_ = tid_in; asm volatile("" : "+v"(tid_));
    const int tid = tid_, wid = __builtin_amdgcn_readfirstlane(tid >> 6), lane = tid & 63, wr = wid >> 2, wc = wid & 3, fr = lane & 15, fq = lane >> 4;
    const int K = g.K, nt = K / BK;
    unsigned voffA[2], voffB[2];
#pragma unroll
    for (int i = 0; i < 2; ++i) { int R, C; stage_rc(tid * 16 + i * 8192, R, C); const int Rb = Epi::PERM ? ((R & ~31) + perm32(R & 31)) : R;
        const int Ra = APERM ? ((16 * (R >> 6) + (R & 15)) * 8 + ((R >> 4) & 3)) : R;
        voffA[i] = (unsigned)(Ra * K + C) * 2u; voffB[i] = (unsigned)(Rb * K + C) * 2u; }
    const size_t kstep = (size_t)(BK * 2);
    const size_t hstep = (size_t)HALF * K * 2;
    const size_t tstep = 2 * hstep;
    const size_t hstepA = APERM ? (size_t)4 * K * 2 : hstep;
    const unsigned ldsw = (unsigned)wid * 1024u;
    const int aoff = lds_byte(wr * 64 + fr, fq * 8), boff = lds_byte(wc * 32 + fr, fq * 8);
#define PG8_SA(b, h) (((b) * 2 + (h)) * HTB)
#define PG8_SB(b, h) ((4 + (b) * 2 + (h)) * HTB)
#define PG8_STAGE(bufoff, gbase, voff) do { _Pragma("unroll") for (int _i = 0; _i < 2; ++_i) \
        __builtin_amdgcn_global_load_lds((const unsigned*)((const char*)(gbase) + (voff)[_i]), (PG8_LAS unsigned*)(lds + (bufoff) + ldsw + _i * 8192), 16, 0, 0); } while (0)
#define PG8_LDA(dst, b, h) do { _Pragma("unroll") for (int m = 0; m < 4; ++m) _Pragma("unroll") for (int k = 0; k < 2; ++k) dst[m][k] = *(const PG8_LAS bf16x8*)(lds + PG8_SA(b, h) + aoff + m * 2048 + k * 1024); } while (0)
#define PG8_LDB(dst, b, h) do { _Pragma("unroll") for (int n = 0; n < 2; ++n) _Pragma("unroll") for (int k = 0; k < 2; ++k) dst[n][k] = *(const PG8_LAS bf16x8*)(lds + PG8_SB(b, h) + boff + n * 2048 + k * 1024); } while (0)
#define PG8_MMA(ai, bj, At, Bt) do { __builtin_amdgcn_s_setprio(1); _Pragma("unroll") for (int m = 0; m < 4; ++m) _Pragma("unroll") for (int n = 0; n < 2; ++n) _Pragma("unroll") for (int k = 0; k < 2; ++k) \
        acc[ai][bj][m][n] = __builtin_amdgcn_mfma_f32_16x16x32_bf16(Bt[n][k], At[m][k], acc[ai][bj][m][n], 0, 0, 0); __builtin_amdgcn_s_setprio(0); } while (0)
#define PG8_WAIT_V(n) asm volatile("s_waitcnt vmcnt(" #n ")" ::: "memory")
#define PG8_WAIT_L(n) asm volatile("s_waitcnt lgkmcnt(" #n ")" ::: "memory")
#define PG8_BAR __builtin_amdgcn_s_barrier()
#define PG8_SCHED __builtin_amdgcn_sched_barrier(0)
    Unit cur, nxt; int ui = 0;
    if (!S.next(0, cur)) return;
    f32x4 acc[2][2][4][2];
#pragma unroll
    for (int a = 0; a < 2; ++a)
#pragma unroll
        for (int b = 0; b < 2; ++b)
#pragma unroll
            for (int m = 0; m < 4; ++m)
#pragma unroll
                for (int n = 0; n < 2; ++n) acc[a][b][m][n] = (f32x4){0.f, 0.f, 0.f, 0.f};
    bf16x8 At[4][2], B0[2][2], B1[2][2];
    const char* cA = (const char*)g.A + (size_t)cur.pm * tstep; const char* cB = (const char*)g.Bt + (size_t)cur.pn * tstep;
    S.a_ready(cur);
    if constexpr (SP2) {
        PG8_STAGE(PG8_SB(0, 0), cB, voffB); PG8_STAGE(PG8_SB(0, 1), cB + hstep, voffB); PG8_STAGE(PG8_SA(0, 0), cA, voffA); PG8_STAGE(PG8_SA(0, 1), cA + hstepA, voffA);
        if (wr == 1) PG8_BAR;
        PG8_WAIT_V(2); PG8_BAR;
        PG8_STAGE(PG8_SB(1, 0), cB + kstep, voffB); PG8_STAGE(PG8_SA(1, 0), cA + kstep, voffA); PG8_STAGE(PG8_SB(1, 1), cB + hstep + kstep, voffB);
        PG8_WAIT_V(6); PG8_BAR;
    } else {
        PG8_STAGE(PG8_SB(0, 0), cB, voffB); PG8_STAGE(PG8_SA(0, 0), cA, voffA); PG8_STAGE(PG8_SB(0, 1), cB + hstep, voffB); PG8_STAGE(PG8_SA(0, 1), cA + hstepA, voffA);
        if (wr == 1) PG8_BAR;
        PG8_WAIT_V(4); PG8_BAR;
        PG8_STAGE(PG8_SB(1, 0), cB + kstep, voffB); PG8_STAGE(PG8_SA(1, 0), cA + kstep, voffA); PG8_STAGE(PG8_SB(1, 1), cB + hstep + kstep, voffB);
        PG8_WAIT_V(6); PG8_BAR;
    }
    for (;;) {
        const bool has_next = S.next(ui + 1, nxt);
        const char* nA = has_next ? (const char*)g.A + (size_t)nxt.pm * tstep : cA; const char* nB = has_next ? (const char*)g.Bt + (size_t)nxt.pn * tstep : cB;
        for (int t = 0; t < nt; t += 2) {
            const bool last = (t == nt - 2);
            const char* a1 = cA + (size_t)(t + 1) * kstep;
            const char* a2 = last ? nA : cA + (size_t)(t + 2) * kstep; const char* b2 = last ? nB : cB + (size_t)(t + 2) * kstep;
            const char* a3 = a2 + kstep; const char* b3 = b2 + kstep;
            if (last && has_next) S.a_ready(nxt);
            if constexpr (SP2) {
            PG8_LDB(B0, 0, 0); PG8_LDB(B1, 0, 1); PG8_SCHED; PG8_LDA(At, 0, 0); PG8_STAGE(PG8_SA(1, 1), a1 + hstepA, voffA);
            PG8_WAIT_V(8); PG8_WAIT_L(0); PG8_BAR; PG8_MMA(0, 0, At, B0); PG8_MMA(0, 1, At, B1); PG8_BAR; PG8_SCHED;
            PG8_LDA(At, 0, 1); PG8_STAGE(PG8_SB(0, 0), b2, voffB); PG8_STAGE(PG8_SB(0, 1), b2 + hstep, voffB); PG8_STAGE(PG8_SA(0, 0), a2, voffA);
            PG8_WAIT_V(8); PG8_WAIT_L(0); PG8_BAR; PG8_MMA(1, 0, At, B0); PG8_MMA(1, 1, At, B1); PG8_BAR; PG8_SCHED;
            PG8_LDB(B0, 1, 0); PG8_LDB(B1, 1, 1); PG8_SCHED; PG8_LDA(At, 1, 0); PG8_STAGE(PG8_SA(0, 1), a2 + hstepA, voffA);
            PG8_WAIT_V(8); PG8_WAIT_L(0); PG8_BAR; PG8_MMA(0, 0, At, B0); PG8_MMA(0, 1, At, B1); PG8_BAR; PG8_SCHED;
            PG8_LDA(At, 1, 1); PG8_STAGE(PG8_SB(1, 0), b3, voffB); PG8_STAGE(PG8_SB(1, 1), b3 + hstep, voffB); PG8_STAGE(PG8_SA(1, 0), a3, voffA);
            PG8_WAIT_V(8); PG8_WAIT_L(0); PG8_BAR; PG8_MMA(1, 0, At, B0); PG8_MMA(1, 1, At, B1); PG8_BAR; PG8_SCHED;
            } else {
            PG8_LDB(B0, 0, 0); PG8_SCHED; PG8_LDA(At, 0, 0); PG8_STAGE(PG8_SA(1, 1), a1 + hstepA, voffA);
            PG8_WAIT_L(8); PG8_BAR; PG8_WAIT_L(0); PG8_MMA(0, 0, At, B0); PG8_BAR; PG8_SCHED;
            PG8_LDB(B1, 0, 1); PG8_STAGE(PG8_SB(0, 0), b2, voffB);
            PG8_BAR; PG8_WAIT_L(0); PG8_MMA(0, 1, At, B1); PG8_BAR;
            PG8_LDA(At, 0, 1); PG8_STAGE(PG8_SA(0, 0), a2, voffA);
            PG8_BAR; PG8_WAIT_L(0); PG8_MMA(1, 0, At, B0); PG8_BAR; PG8_SCHED;
            PG8_STAGE(PG8_SB(0, 1), b2 + hstep, voffB);
            PG8_WAIT_V(6); PG8_BAR; PG8_MMA(1, 1, At, B1); PG8_BAR;
            PG8_LDB(B0, 1, 0); PG8_SCHED; PG8_LDA(At, 1, 0); PG8_STAGE(PG8_SA(0, 1), a2 + hstepA, voffA);
            PG8_WAIT_L(8); PG8_BAR; PG8_WAIT_L(0); PG8_MMA(0, 0, At, B0); PG8_BAR; PG8_SCHED;
            PG8_LDB(B1, 1, 1); PG8_STAGE(PG8_SB(1, 0), b3, voffB);
            PG8_BAR; PG8_WAIT_L(0); PG8_MMA(0, 1, At, B1); PG8_BAR;
            PG8_LDA(At, 1, 1); PG8_STAGE(PG8_SA(1, 0), a3, voffA);
            PG8_BAR; PG8_WAIT_L(0); PG8_MMA(1, 0, At, B0); PG8_BAR; PG8_SCHED;
            PG8_STAGE(PG8_SB(1, 1), b3 + hstep, voffB);
            PG8_WAIT_V(6); PG8_BAR; PG8_MMA(1, 1, At, B1); PG8_BAR;
            }
        }
        if constexpr (ALIGN_EPI) { if (wr == 0) PG8_BAR; }
        if constexpr (!Epi::AFTER_DRAIN) { E(acc, cur, wr, wc, fr, fq); S.done(cur); }
        if (!has_next) break;
#pragma unroll
        for (int a = 0; a < 2; ++a)
#pragma unroll
            for (int b = 0; b < 2; ++b)
#pragma unroll
                for (int m = 0; m < 4; ++m)
#pragma unroll
                    for (int n = 0; n < 2; ++n) acc[a][b][m][n] = (f32x4){0.f, 0.f, 0.f, 0.f};
        cur = nxt; cA = nA; cB = nB; ++ui;
        if constexpr (ALIGN_EPI) { if (wr == 1) PG8_BAR; }
    }
    PG8_WAIT_V(0);
    if constexpr (!ALIGN_EPI) { if (wr == 0) PG8_BAR; }
    PG8_BAR;
    if constexpr (Epi::AFTER_DRAIN) { E.fused(acc, cur, wr, wc, fr, fq, lds, wid, lane); S.done(cur); }
#undef PG8_SA
#undef PG8_SB
#undef PG8_STAGE
#undef PG8_LDA
#undef PG8_LDB
#undef PG8_MMA
#undef PG8_WAIT_V
#undef PG8_WAIT_L
#undef PG8_BAR
#undef PG8_SCHED
}
}

using pg8::bf16_t; using pg8::bf16x8; using pg8::f32x4; using pg8::u32x4;
typedef unsigned u32x2 __attribute__((ext_vector_type(2)));
using pg8::f32x2;
typedef short s16x4 __attribute__((ext_vector_type(4)));
#define LAS __attribute__((address_space(3)))

constexpr int NTHREADS = 512;
constexpr int MTOK = 65536, DM = 1024, SEQ = 2048, NBATCH = 32, DEPTH = 4;
constexpr int NPROJ = 2304;
constexpr int INW = 2176;
constexpr int DFF = 2816, DFF2 = 5632;
constexpr int MEMROWS = 8192;
constexpr int MHALF = 32768;
constexpr float EPSF = 1e-6f;
constexpr float LOG2E = 1.4426950408889634f;
constexpr int LDS_BYTES = 155648;
constexpr int LDS_UNIT_OFF = 155648 - 64;
constexpr int LDS_TBL_OFF = 155648 - 512;

constexpr size_t MiB = 1u << 20;
constexpr size_t WS_CTL = 0;
constexpr size_t WS_ST = 1 * MiB;
constexpr size_t WS_STM = 5 * MiB;
constexpr size_t WS_CS = 5 * MiB + 512 * 1024;
constexpr size_t WS_KST = 6 * MiB;
constexpr size_t WS_QST = 14 * MiB;
constexpr size_t WS_MEMB = 22 * MiB;
constexpr size_t WS_W = 38 * MiB;
constexpr size_t W_LAYER = 27 * MiB;
constexpr size_t W_IN = 0, W_OUT = (size_t)(4.5 * MiB), W_Q = (size_t)(6.5 * MiB), W_O = (size_t)(8.5 * MiB), W_UP = (size_t)(10.5 * MiB), W_DOWN = (size_t)(21.5 * MiB);
constexpr size_t WS_WKV = WS_W + 4 * W_LAYER;
constexpr size_t WS_HB = 162 * MiB;
constexpr size_t WS_KV = 290 * MiB;
constexpr size_t WS_BIG = 418 * MiB;
constexpr size_t WS_PROJ = WS_BIG;
constexpr size_t WS_MIXED = WS_BIG + 288 * MiB;
constexpr size_t WS_QM = WS_MIXED + 128 * MiB;
constexpr size_t WS_ACT = WS_BIG;
constexpr size_t WS_SG = WS_BIG + 352 * MiB;
constexpr size_t WS_SU = WS_BIG + 376 * MiB;
constexpr size_t WS_END = WS_QM + 128 * MiB;
static_assert(WS_WKV + 16 * MiB <= WS_HB, "ws map");
static_assert(WS_SU + 12 * MiB <= WS_END, "ws map");

struct Args { const float* in[28]; float* out; unsigned char* ws; };
struct Ctx { LAS const unsigned long long* tbl; float* out; unsigned char* ws; int wv; };
__device__ __forceinline__ const float* inptr(const Ctx& c, int i) {
    const unsigned long long v = c.tbl[i];
    const unsigned lo = __builtin_amdgcn_readfirstlane((unsigned)v), hi = __builtin_amdgcn_readfirstlane((unsigned)(v >> 32));
    return (const float*)(((unsigned long long)hi << 32) | lo);
}

__device__ __forceinline__ float bf2f(unsigned short b) { return __uint_as_float(((unsigned)b) << 16); }
__device__ __forceinline__ float bflo(unsigned w) { return __uint_as_float(w << 16); }
__device__ __forceinline__ float bfhi(unsigned w) { return __uint_as_float(w & 0xffff0000u); }
__device__ __forceinline__ unsigned pkbf(float lo, float hi) { unsigned r; asm("v_cvt_pk_bf16_f32 %0, %1, %2" : "=v"(r) : "v"(lo), "v"(hi)); return r; }
__device__ __forceinline__ unsigned short f2bf(float f) { return (unsigned short)(pkbf(f, 0.f) & 0xffffu); }
__device__ __forceinline__ float shx(float v, int lane, int m) { return __int_as_float(__builtin_amdgcn_ds_bpermute((lane ^ m) << 2, __float_as_int(v))); }
__device__ __forceinline__ float shi(float v, int src) { return __int_as_float(__builtin_amdgcn_ds_bpermute(src << 2, __float_as_int(v))); }
__device__ __forceinline__ float wave_sum(float v, int lane) {
#pragma unroll
    for (int o = 1; o < 64; o <<= 1) v += shx(v, lane, o);
    return v;
}
__device__ __forceinline__ float sigmoidf_(float x) { return __builtin_amdgcn_rcpf(1.0f + __builtin_amdgcn_exp2f(-LOG2E * x)); }
__device__ __forceinline__ float gelu_tanh(float x) {
    const float u2 = (-2.0f * 0.7978845608028654f * LOG2E) * (x + 0.044715f * x * x * x);
    return x * __builtin_amdgcn_rcpf(1.0f + __builtin_amdgcn_exp2f(u2));
}
__device__ __forceinline__ LAS unsigned char* lds_l(LAS unsigned char* p) { unsigned v = (unsigned)(uintptr_t)p; asm volatile("" : "+s"(v)); return (LAS unsigned char*)(uintptr_t)v; }
__device__ __forceinline__ int tid_w(int wv) { int t = (wv << 6) + (int)__builtin_amdgcn_mbcnt_hi(~0u, __builtin_amdgcn_mbcnt_lo(~0u, 0u)); asm volatile("" : "+v"(t)); return t; }
__device__ __forceinline__ s16x4 vtr(LAS const unsigned char* p) {
    typedef short v4i16_t __attribute__((ext_vector_type(4)));
    return __builtin_bit_cast(s16x4, __builtin_amdgcn_ds_read_tr16_b64_v4i16((LAS v4i16_t*)p));
}

#define LBAR() do { asm volatile("s_waitcnt lgkmcnt(0)" ::: "memory"); __builtin_amdgcn_s_barrier(); asm volatile("" ::: "memory"); } while (0)

template <bool QKN> struct EpiBf {
    static constexpr bool PERM = true, AFTER_DRAIN = false;
    bf16_t* O; int ldc; const float* st; float* pst; int npg; const float* cs; const float* qg; const float* kg;
    __device__ __forceinline__ void operator()(const f32x4 (&acc)[2][2][4][2], const pg8::Unit& u, int wr, int wc, int fr, int fq) const {
        const int lane = fq * 16 + fr;
        int kind = 0; const float* gsel = nullptr;
        if (QKN) { const int c0 = u.pn * 256 + 64 * wc; if (c0 >= 256 && c0 < 640) { kind = 1; gsel = qg; } else if (c0 >= 640 && c0 < 1024) { kind = 2; gsel = kg; } }
        const int rbase = u.pm * 256 + wr * 64 + fr;
        float rloc[2];
#pragma unroll
        for (int k = 0; k < 2; ++k) {
            const int i = 2 * fq + k, r = rbase + (i >> 2) * 128 + (i & 3) * 16;
            const f32x4* sp = (const f32x4*)(st + (size_t)r * 16);
            const f32x4 s0 = sp[0], s1 = sp[1], s2 = sp[2], s3 = sp[3];
            const float ssum = ((s0[0] + s0[1]) + (s0[2] + s0[3])) + ((s1[0] + s1[1]) + (s1[2] + s1[3])) + ((s2[0] + s2[1]) + (s2[2] + s2[3])) + ((s3[0] + s3[1]) + (s3[2] + s3[3]));
            rloc[k] = rsqrtf(ssum * (1.0f / 1024.0f) + EPSF);
        }
        f32x4 cf[2][2];
#pragma unroll
        for (int bj = 0; bj < 2; ++bj)
#pragma unroll
            for (int n = 0; n < 2; ++n) {
                cf[bj][n] = (f32x4){1.f, 1.f, 1.f, 1.f};
                if (QKN) { if (kind != 0) cf[bj][n] = *(const f32x4*)(gsel + 32 * bj + 8 * fq + 4 * n); }
                else if (cs) cf[bj][n] = *(const f32x4*)(cs + u.pn * 256 + bj * 128 + wc * 32 + 8 * fq + 4 * n);
            }
#pragma unroll
        for (int ai = 0; ai < 2; ++ai)
#pragma unroll
            for (int m = 0; m < 4; ++m) {
                const int r = rbase + ai * 128 + m * 16;
                const float rsv = shi(rloc[m & 1], (ai * 2 + (m >> 1)) * 16 + fr);
                f32x4 v[2][2];
#pragma unroll
                for (int bj = 0; bj < 2; ++bj)
#pragma unroll
                    for (int n = 0; n < 2; ++n) v[bj][n] = acc[ai][bj][m][n] * rsv;
                if (QKN) {
                    if (kind != 0) {
                        float ss = 0.f;
#pragma unroll
                        for (int bj = 0; bj < 2; ++bj)
#pragma unroll
                            for (int n = 0; n < 2; ++n) ss += (v[bj][n][0] * v[bj][n][0] + v[bj][n][1] * v[bj][n][1]) + (v[bj][n][2] * v[bj][n][2] + v[bj][n][3] * v[bj][n][3]);
                        ss += shx(ss, lane, 16); ss += shx(ss, lane, 32);
                        float rn = rsqrtf(ss * (1.0f / 64.0f) + EPSF);
                        if (kind == 1) rn *= 0.125f * LOG2E;
#pragma unroll
                        for (int bj = 0; bj < 2; ++bj)
#pragma unroll
                            for (int n = 0; n < 2; ++n) v[bj][n] = v[bj][n] * rn * cf[bj][n];
                    }
                } else {
                    if (pst) {
#pragma unroll
                        for (int bj = 0; bj < 2; ++bj) {
                            float ss = (v[bj][0][0] * v[bj][0][0] + v[bj][0][1] * v[bj][0][1]) + (v[bj][0][2] * v[bj][0][2] + v[bj][0][3] * v[bj][0][3])
                                     + (v[bj][1][0] * v[bj][1][0] + v[bj][1][1] * v[bj][1][1]) + (v[bj][1][2] * v[bj][1][2] + v[bj][1][3] * v[bj][1][3]);
                            ss += shx(ss, lane, 16); ss += shx(ss, lane, 32);
                            if (fq == 0) pst[(size_t)r * npg + (u.pn * 8 + bj * 4 + wc)] = ss;
                        }
                    }
                    if (cs) {
#pragma unroll
                        for (int bj = 0; bj < 2; ++bj)
#pragma unroll
                            for (int n = 0; n < 2; ++n) v[bj][n] = v[bj][n] * cf[bj][n];
                    }
                }
#pragma unroll
                for (int bj = 0; bj < 2; ++bj) {
                    const int col = QKN ? (u.pn * 256 + 64 * wc + 32 * bj + 8 * fq) : (u.pn * 256 + 128 * bj + 32 * wc + 8 * fq);
                    u32x4 w; w.x = pkbf(v[bj][0][0], v[bj][0][1]); w.y = pkbf(v[bj][0][2], v[bj][0][3]); w.z = pkbf(v[bj][1][0], v[bj][1][1]); w.w = pkbf(v[bj][1][2], v[bj][1][3]);
                    *(u32x4*)(O + (size_t)r * ldc + col) = w;
                }
            }
    }
};

struct EpiRes {
    static constexpr bool PERM = false, AFTER_DRAIN = false;
    const float* resid; float* out; bf16_t* hb; float* st;
    __device__ __forceinline__ void operator()(const f32x4 (&acc)[2][2][4][2], const pg8::Unit& u, int wr, int wc, int fr, int fq) const {
        const int lane = fq * 16 + fr;
        const int rbase = u.pm * 256 + wr * 64 + fr, cbase = u.pn * 256 + wc * 32 + 4 * fq;
        f32x4 pre[3][2][2];
#define EPIRES_LOAD(I) do { const size_t ro_ = (size_t)(rbase + ((I) >> 2) * 128 + ((I) & 3) * 16) * DM + cbase; \
            _Pragma("unroll") for (int bj = 0; bj < 2; ++bj) _Pragma("unroll") for (int n = 0; n < 2; ++n) pre[(I) % 3][bj][n] = *(const f32x4*)(resid + ro_ + bj * 128 + n * 16); } while (0)
        EPIRES_LOAD(0); EPIRES_LOAD(1); EPIRES_LOAD(2);
#pragma unroll
        for (int i = 0; i < 8; ++i) {
            const int ai = i >> 2, m = i & 3;
            const int r = rbase + ai * 128 + m * 16;
            float ss = 0.f;
            f32x4 v[2][2];
#pragma unroll
            for (int bj = 0; bj < 2; ++bj)
#pragma unroll
                for (int n = 0; n < 2; ++n) v[bj][n] = pre[i % 3][bj][n] + acc[ai][bj][m][n];
            asm volatile("" ::: "memory");
            if (i + 3 < 8) EPIRES_LOAD(i + 3);
            asm volatile("" ::: "memory");
#pragma unroll
            for (int bj = 0; bj < 2; ++bj)
#pragma unroll
                for (int n = 0; n < 2; ++n) {
                    const size_t off = (size_t)r * DM + cbase + bj * 128 + n * 16;
                    *(f32x4*)(out + off) = v[bj][n];
                    if (hb) {
                        u32x2 w; w.x = pkbf(v[bj][n][0], v[bj][n][1]); w.y = pkbf(v[bj][n][2], v[bj][n][3]);
                        *(u32x2*)(hb + off) = w;
                        ss += (v[bj][n][0] * v[bj][n][0] + v[bj][n][1] * v[bj][n][1]) + (v[bj][n][2] * v[bj][n][2] + v[bj][n][3] * v[bj][n][3]);
                    }
                }
            if (hb) {
                ss += shx(ss, lane, 16); ss += shx(ss, lane, 32);
                if (fq == 0) st[(size_t)r * 16 + u.pn * 4 + wc] = ss;
            }
        }
#undef EPIRES_LOAD
    }
};

struct EpiAct {
    static constexpr bool PERM = true, AFTER_DRAIN = false;
    bf16_t* act; const float* st; const float* cw; const float* cb; float* sg; float* su;
    __device__ __forceinline__ void operator()(const f32x4 (&acc)[2][2][4][2], const pg8::Unit& u, int wr, int wc, int fr, int fq) const {
        const int lane = fq * 16 + fr;
        const int tok0 = u.pm * 256 + (16 * wr + fr) * 8;
        const int f0 = u.pn * 128 + 32 * wc + 8 * fq;
        f32x2 W0[4], W1[4], W2[4], BBv[4];
#pragma unroll
        for (int q = 0; q < 4; ++q) {
            W0[q] = *(const f32x2*)(cw + f0 + 2 * q); W1[q] = *(const f32x2*)(cw + DFF + f0 + 2 * q);
            W2[q] = *(const f32x2*)(cw + 2 * DFF + f0 + 2 * q); BBv[q] = *(const f32x2*)(cb + f0 + 2 * q);
        }
        float rloc[2], rs[8];
#pragma unroll
        for (int k = 0; k < 2; ++k) {
            const f32x4* sp = (const f32x4*)(st + (size_t)(tok0 + 2 * fq + k) * 16);
            const f32x4 s0 = sp[0], s1 = sp[1], s2 = sp[2], s3 = sp[3];
            const float ssum = ((s0[0] + s0[1]) + (s0[2] + s0[3])) + ((s1[0] + s1[1]) + (s1[2] + s1[3])) + ((s2[0] + s2[1]) + (s2[2] + s2[3])) + ((s3[0] + s3[1]) + (s3[2] + s3[3]));
            rloc[k] = rsqrtf(ssum * (1.0f / 1024.0f) + EPSF);
        }
#pragma unroll
        for (int e = 0; e < 8; ++e) rs[e] = shi(rloc[e & 1], (e >> 1) * 16 + fr);
        float* sgp = sg + ((size_t)u.pm * 8 + wr * 4) * DFF + f0;
        float* sup = su + ((size_t)u.pm * 4 + wr * 2) * DFF + f0;
#pragma unroll
        for (int n = 0; n < 2; ++n) {
            unsigned res[8][2];
#pragma unroll
            for (int ip = 0; ip < 2; ++ip) {
                const int c0 = 4 * n + 2 * ip;
                f32x2 g[8], uu[8];
#pragma unroll
                for (int e = 0; e < 8; ++e) {
                    const f32x2 rv = (f32x2){rs[e], rs[e]};
                    g[e] = (f32x2){acc[e >> 2][0][e & 3][n][2 * ip], acc[e >> 2][0][e & 3][n][2 * ip + 1]} * rv;
                    uu[e] = (f32x2){acc[e >> 2][1][e & 3][n][2 * ip], acc[e >> 2][1][e & 3][n][2 * ip + 1]} * rv;
                }
                const f32x2 p1 = (f32x2){shi(g[7].x, lane - 1), shi(g[7].y, lane - 1)};
                const f32x2 p2 = (f32x2){shi(g[6].x, lane - 1), shi(g[6].y, lane - 1)};
                const f32x2 w0 = W0[2 * n + ip], w1 = W1[2 * n + ip], w2 = W2[2 * n + ip], bb = BBv[2 * n + ip];
                const float K1 = -2.0f * 0.7978845608028654f * LOG2E, K2 = K1 * 0.044715f;
#pragma unroll
                for (int e = 0; e < 8; ++e) {
                    const f32x2 gm1 = (e >= 1) ? g[e >= 1 ? e - 1 : 0] : p1;
                    const f32x2 gm2 = (e >= 2) ? g[e >= 2 ? e - 2 : 0] : (e == 1 ? p1 : p2);
                    const f32x2 cvv = bb + w0 * g[e] + w1 * gm1 + w2 * gm2;
                    const f32x2 t = cvv * (cvv * cvv * K2 + K1);
                    const f32x2 dn = (f32x2){__builtin_amdgcn_exp2f(t.x), __builtin_amdgcn_exp2f(t.y)} + 1.0f;
                    const f32x2 av = cvv * (f32x2){__builtin_amdgcn_rcpf(dn.x), __builtin_amdgcn_rcpf(dn.y)} * uu[e];
                    res[e][ip] = pkbf(av.x, av.y);
                }
                if (fr == 0) { *(f32x2*)(sgp + c0) = g[0]; *(f32x2*)(sgp + DFF + c0) = g[1]; *(f32x2*)(sup + c0) = uu[0]; *(f32x2*)(sup + DFF + c0) = uu[1]; }
                if (fr == 15) { *(f32x2*)(sgp + 2 * DFF + c0) = g[6]; *(f32x2*)(sgp + 3 * DFF + c0) = g[7]; }
            }
#pragma unroll
            for (int e = 0; e < 8; ++e) {
                if (fr == 0 && e < 2) continue;
                u32x2 w; w.x = res[e][0]; w.y = res[e][1];
                *(u32x2*)(act + (size_t)(tok0 + e) * DFF + f0 + 4 * n) = w;
            }
            asm volatile("" ::: "memory");
        }
    }
};

template <class Epi>
__device__ __forceinline__ void run_gemm(int cv, int wv, LAS unsigned char* lds, const bf16_t* A, const bf16_t* Bt, int M, int N, int K, const Epi& E) {
    pg8::Gemm g{A, Bt, M, N, K}; pg8::StaticOrder S; S.init(M, N, (int)gridDim.x, cv);
    pg8::gemm_phase<Epi, pg8::StaticOrder, true, true>(tid_w(wv), lds_l(lds), g, S, E);
}
template <class Epi>
__device__ __forceinline__ void run_gemm_aperm(int cv, int wv, LAS unsigned char* lds, const bf16_t* A, const bf16_t* Bt, int M, int N, int K, const Epi& E) {
    pg8::Gemm g{A, Bt, M, N, K}; pg8::StaticOrder S; S.init(M, N, (int)gridDim.x, cv);
    pg8::gemm_phase<Epi, pg8::StaticOrder, true, true, true>(tid_w(wv), lds_l(lds), g, S, E);
}

__device__ __forceinline__ void transpose_item(const float* W, int ldw, int K, const float* gain, bf16_t* WT, int dst_row0, bool zero, LAS float* scr, int k0, int n0, int lane) {
#pragma unroll 8
    for (int i = 0; i < 32; ++i) {
        const int kk = 2 * i + (lane >> 5);
        float v = 0.f;
        if (!zero) { v = W[(size_t)(k0 + kk) * ldw + n0 + (lane & 31)]; if (gain) v *= gain[k0 + kk]; }
        scr[kk * 33 + (lane & 31)] = v;
    }
    asm volatile("s_waitcnt lgkmcnt(0)" ::: "memory");
    const int c = lane & 7;
#pragma unroll
    for (int j = 0; j < 4; ++j) {
        const int n = (lane >> 3) + 8 * j; const LAS float* s = scr + (8 * c) * 33 + n;
        u32x4 o; o.x = pkbf(s[0 * 33], s[1 * 33]); o.y = pkbf(s[2 * 33], s[3 * 33]); o.z = pkbf(s[4 * 33], s[5 * 33]); o.w = pkbf(s[6 * 33], s[7 * 33]);
        *(u32x4*)(WT + (size_t)(dst_row0 + n) * K + k0 + 8 * c) = o;
    }
    asm volatile("s_waitcnt lgkmcnt(0)" ::: "memory");
}
__device__ __forceinline__ void rows4_to_bf16(const float* x, bf16_t* o, float* stp, int m0, int mstep, int mend, int lane) {
    f32x4 v[4][4];
#pragma unroll
    for (int q = 0; q < 4; ++q) {
        const int m = m0 + q * mstep;
        const f32x4* xr = (const f32x4*)(x + (size_t)(m < mend ? m : m0) * DM) + lane;
#pragma unroll
        for (int j = 0; j < 4; ++j) v[q][j] = xr[64 * j];
    }
#pragma unroll
    for (int q = 0; q < 4; ++q) {
        const int m = m0 + q * mstep;
        float s = 0.f;
#pragma unroll
        for (int j = 0; j < 4; ++j) s += (v[q][j][0] * v[q][j][0] + v[q][j][1] * v[q][j][1]) + (v[q][j][2] * v[q][j][2] + v[q][j][3] * v[q][j][3]);
        s = wave_sum(s, lane);
        if (m < mend) {
            u32x2* o8 = (u32x2*)(o + (size_t)m * DM) + lane;
#pragma unroll
            for (int j = 0; j < 4; ++j) { u32x2 w; w.x = pkbf(v[q][j][0], v[q][j][1]); w.y = pkbf(v[q][j][2], v[q][j][3]); o8[64 * j] = w; }
            if (lane < 16) stp[(size_t)m * 16 + lane] = (lane == 0) ? s : 0.f;
        }
    }
}
__device__ __forceinline__ void phase_prologue(const Ctx& a, LAS unsigned char* lds) {
    lds = lds_l(lds);
    const int tid = tid_w(a.wv), lane = tid & 63, wave = tid >> 6;
    LAS float* scr = (LAS float*)(lds + wave * 16384);
    const int gw = blockIdx.x * 8 + wave, NGW = gridDim.x * 8;
    unsigned char* ws = a.ws;
    constexpr int I_IN = 16 * 72, I_SQ = 16 * 32, I_UP = 16 * 176, I_DN = 44 * 32, I_KV = 16 * 64;
    constexpr int I_LAYER = I_IN + 3 * I_SQ + I_UP + I_DN + I_KV;
    for (int it = gw; it < DEPTH * I_LAYER; it += NGW) {
        const int l = it / I_LAYER; int r = it % I_LAYER;
        bf16_t* wl = (bf16_t*)(ws + WS_W + (size_t)l * W_LAYER);
        if (r < I_IN) {
            const int kb = r / 72, nb = r % 72, n0 = nb * 32;
            const int dst = (n0 & ~255) + 128 * ((n0 >> 5) & 1) + 32 * ((n0 >> 6) & 3);
            transpose_item(inptr(a, 3) + (size_t)l * DM * INW, INW, DM, inptr(a, 2) + l * DM, (bf16_t*)((unsigned char*)wl + W_IN), dst, n0 >= INW, scr, kb * 64, n0, lane);
            continue;
        }
        r -= I_IN;
        if (r < I_SQ) { transpose_item(inptr(a, 15) + (size_t)l * DM * DM, DM, DM, nullptr, (bf16_t*)((unsigned char*)wl + W_OUT), (r % 32) * 32, false, scr, (r / 32) * 64, (r % 32) * 32, lane); continue; }
        r -= I_SQ;
        if (r < I_SQ) { transpose_item(inptr(a, 18) + (size_t)l * DM * DM, DM, DM, inptr(a, 16) + l * DM, (bf16_t*)((unsigned char*)wl + W_Q), (r % 32) * 32, false, scr, (r / 32) * 64, (r % 32) * 32, lane); continue; }
        r -= I_SQ;
        if (r < I_SQ) { transpose_item(inptr(a, 22) + (size_t)l * DM * DM, DM, DM, nullptr, (bf16_t*)((unsigned char*)wl + W_O), (r % 32) * 32, false, scr, (r / 32) * 64, (r % 32) * 32, lane); continue; }
        r -= I_SQ;
        if (r < I_UP) { transpose_item(inptr(a, 24) + (size_t)l * DM * DFF2, DFF2, DM, inptr(a, 23) + l * DM, (bf16_t*)((unsigned char*)wl + W_UP), ((((r % 176) * 32) % DFF) / 128) * 256 + 128 * (((r % 176) * 32) / DFF) + (((r % 176) * 32) % DFF) % 128, false, scr, (r / 176) * 64, (r % 176) * 32, lane); continue; }
        r -= I_UP;
        if (r < I_DN) { transpose_item(inptr(a, 27) + (size_t)l * DFF * DM, DM, DFF, nullptr, (bf16_t*)((unsigned char*)wl + W_DOWN), (r % 32) * 32, false, scr, (r / 32) * 64, (r % 32) * 32, lane); continue; }
        r -= I_DN;
        transpose_item(inptr(a, 19) + (size_t)l * DM * 2048, 2048, DM, inptr(a, 17) + l * DM, (bf16_t*)(ws + WS_WKV), l * 2048 + (r % 64) * 32, false, scr, (r / 64) * 64, (r % 64) * 32, lane);
    }
    for (int i = blockIdx.x * NTHREADS + tid; i < DEPTH * DM; i += gridDim.x * NTHREADS) { const int l = i >> 10, dd = i & 255; ((float*)(ws + WS_CS))[i] = inptr(a, 20)[l * 256 + dd] * inptr(a, 21)[l * 256 + dd] * (0.0625f * LOG2E); }
    for (int m = gw; m < MTOK; m += 4 * NGW) rows4_to_bf16(inptr(a, 0), (bf16_t*)(ws + WS_HB), (float*)(ws + WS_ST), m, NGW, MTOK, lane);
    for (int m = gw; m < MEMROWS; m += 4 * NGW) rows4_to_bf16(inptr(a, 1), (bf16_t*)(ws + WS_MEMB), (float*)(ws + WS_STM), m, NGW, MEMROWS, lane);
}

__device__ __forceinline__ void lru_unit(const Ctx& a, int l, int b, int g, LAS unsigned char* lds) {
    lds = lds_l(lds);
    const int tid = tid_w(a.wv), lane = tid & 63, wave = tid >> 6, l15 = lane & 15, gq = lane >> 4;
    LAS unsigned char* XT = lds;
    LAS unsigned char* XCB = lds + 19008;
    LAS float* XCF = (LAS float*)(lds + 37440);
    LAS float* AA = (LAS float*)(lds + 70208);
    LAS float* BB = (LAS float*)(lds + 102976);
    LAS unsigned char* WT = lds + 135744;
    const bf16_t* proj = (const bf16_t*)(a.ws + WS_PROJ) + (size_t)b * SEQ * NPROJ;
    bf16_t* mixed = (bf16_t*)(a.ws + WS_MIXED) + (size_t)b * SEQ * DM;
    const float* wa = inptr(a, 10) + ((size_t)l * 6 + g) * 4096; const float* wx = inptr(a, 12) + ((size_t)l * 6 + g) * 4096;
    for (int k = 0; k < 16; ++k) {
        const int idx = tid + 512 * k, which = idx >> 12, cp = (idx >> 6) & 63, c = idx & 63;
        const float v = which ? wx[cp * 64 + c] : wa[cp * 64 + c];
        *(LAS unsigned short*)(WT + (which * 64 + c) * 144 + cp * 2) = f2bf(v);
    }
    const int cch = tid & 63, ch = g * 64 + cch;
    float cw[4];
#pragma unroll
    for (int j = 0; j < 4; ++j) cw[j] = inptr(a, 8)[((size_t)l * 4 + j) * 384 + ch];
    const float cb = inptr(a, 9)[l * 384 + ch];
    float gba[4], gbx[4], gsp[4];
#pragma unroll
    for (int nt = 0; nt < 4; ++nt) {
        const int c2 = l * 384 + g * 64 + 16 * nt + l15;
        gba[nt] = inptr(a, 11)[c2]; gbx[nt] = inptr(a, 13)[c2];
        const float z = -inptr(a, 14)[c2];
        gsp[nt] = (8.0f * LOG2E) * (fmaxf(z, 0.f) + log1pf(__expf(-fabsf(z))));
    }
#pragma unroll
    for (int j = 0; j < 4; ++j) { asm volatile("" : "+v"(cw[j])); asm volatile("" : "+v"(gba[j])); asm volatile("" : "+v"(gbx[j])); asm volatile("" : "+v"(gsp[j])); }
    float cbv = cb; asm volatile("" : "+v"(cbv));
    float hcar = 0.f;
    const bf16_t* xsrc = proj + 1408 + g * 64;
    const bf16_t* ysrc = proj + 1792 + g * 64;
    u32x4 xr[3];
#pragma unroll
    for (int k = 0; k < 3; ++k) {
        const int idx = tid + 512 * k, row = idx >> 3, cv = idx & 7, tok = row - 3;
        xr[k] = (idx < 1048 && tok >= 0) ? *(const u32x4*)(xsrc + (size_t)tok * NPROJ + cv * 8) : (u32x4){0u, 0u, 0u, 0u};
    }
#pragma unroll 1
    for (int ck = 0; ck < 16; ++ck) {
        const int t0 = ck * 128;
#pragma unroll
        for (int k = 0; k < 3; ++k) { const int idx = tid + 512 * k, row = idx >> 3, cv = idx & 7; if (idx < 1048) *(LAS u32x4*)(XT + row * 144 + cv * 16) = xr[k]; }
        u32x4 yr[2];
#pragma unroll
        for (int k = 0; k < 2; ++k) { const int idx = lane + 64 * k, row = 16 * wave + (idx >> 3), cv = idx & 7; yr[k] = *(const u32x4*)(ysrc + (size_t)(t0 + row) * NPROJ + cv * 8); }
        if (ck < 15) {
#pragma unroll
            for (int k = 0; k < 3; ++k) {
                const int idx = tid + 512 * k, row = idx >> 3, cv = idx & 7, tok = t0 + 128 - 3 + row;
                xr[k] = (idx < 1048) ? *(const u32x4*)(xsrc + (size_t)tok * NPROJ + cv * 8) : (u32x4){0u, 0u, 0u, 0u};
            }
        }
        LBAR();
#pragma unroll 4
        for (int k = 0; k < 16; ++k) {
            const int t = 16 * wave + k;
            float xc = cbv;
#pragma unroll
            for (int j = 0; j < 4; ++j) xc += cw[j] * bf2f(*(LAS const unsigned short*)(XT + (t + 3 - j) * 144 + cch * 2));
            XCF[t * 64 + cch] = xc;
            *(LAS unsigned short*)(XCB + t * 144 + cch * 2) = f2bf(xc);
        }
        asm volatile("s_waitcnt lgkmcnt(0)" ::: "memory");
        {
            f32x4 acc[8];
#pragma unroll
            for (int nt = 0; nt < 8; ++nt) acc[nt] = (f32x4){0.f, 0.f, 0.f, 0.f};
#pragma unroll
            for (int ks = 0; ks < 2; ++ks) {
                const bf16x8 af = *(LAS const bf16x8*)(XCB + (16 * wave + l15) * 144 + (32 * ks + 8 * gq) * 2);
#pragma unroll
                for (int nt = 0; nt < 8; ++nt) {
                    const bf16x8 bfr = *(LAS const bf16x8*)(WT + (16 * nt + l15) * 144 + (32 * ks + 8 * gq) * 2);
                    acc[nt] = __builtin_amdgcn_mfma_f32_16x16x32_bf16(af, bfr, acc[nt], 0, 0, 0);
                }
            }
#pragma unroll
            for (int nt = 0; nt < 4; ++nt)
#pragma unroll
                for (int rg = 0; rg < 4; ++rg) {
                    const int t = 16 * wave + 4 * gq + rg, c = 16 * nt + l15;
                    const float r = sigmoidf_(acc[nt][rg] + gba[nt]), ig = sigmoidf_(acc[nt + 4][rg] + gbx[nt]);
                    const float av = __builtin_amdgcn_exp2f(-r * gsp[nt]);
                    const float xcv = XCF[t * 64 + c];
                    AA[t * 64 + c] = av;
                    BB[t * 64 + c] = __builtin_amdgcn_sqrtf(fmaxf(1.0f - av * av, 0.f)) * (ig * xcv);
                }
        }
        asm volatile("s_waitcnt lgkmcnt(0)" ::: "memory");
        {
            float av[16], bv[16];
#pragma unroll
            for (int t = 0; t < 16; ++t) { av[t] = AA[(16 * wave + t) * 64 + lane]; bv[t] = BB[(16 * wave + t) * 64 + lane]; }
            float hl = 0.f, pl = 1.f;
#pragma unroll
            for (int t = 0; t < 16; ++t) { hl = av[t] * hl + bv[t]; pl *= av[t]; bv[t] = hl; av[t] = pl; }
            { LAS float* sw = (LAS float*)(XCB + 16 * wave * 144); sw[lane] = pl; sw[64 + lane] = hl; }
            LBAR();
            float cin = hcar, mycin = 0.f;
#pragma unroll
            for (int w2 = 0; w2 < 8; ++w2) { const LAS float* sw = (const LAS float*)(XCB + 16 * w2 * 144); if (w2 == wave) mycin = cin; cin = sw[lane] * cin + sw[64 + lane]; }
            hcar = cin;
#pragma unroll
            for (int t = 0; t < 16; ++t) BB[(16 * wave + t) * 64 + lane] = bv[t] + av[t] * mycin;
        }
        asm volatile("s_waitcnt lgkmcnt(0)" ::: "memory");
#pragma unroll
        for (int k = 0; k < 2; ++k) {
            const int idx = lane + 64 * k, row = 16 * wave + (idx >> 3), cv = idx & 7;
            const f32x4 h0 = *(LAS const f32x4*)(BB + row * 64 + cv * 8), h1 = *(LAS const f32x4*)(BB + row * 64 + cv * 8 + 4);
            u32x4 w;
            w.x = pkbf(h0[0] * gelu_tanh(bflo(yr[k].x)), h0[1] * gelu_tanh(bfhi(yr[k].x)));
            w.y = pkbf(h0[2] * gelu_tanh(bflo(yr[k].y)), h0[3] * gelu_tanh(bfhi(yr[k].y)));
            w.z = pkbf(h1[0] * gelu_tanh(bflo(yr[k].z)), h1[1] * gelu_tanh(bfhi(yr[k].z)));
            w.w = pkbf(h1[2] * gelu_tanh(bflo(yr[k].w)), h1[3] * gelu_tanh(bfhi(yr[k].w)));
            *(u32x4*)(mixed + (size_t)(t0 + row) * DM + 640 + g * 64 + cv * 8) = w;
        }
    }
}

__device__ __forceinline__ void pool_unit(const Ctx& a, int l, int b, int tc, LAS unsigned char* lds) {
    lds = lds_l(lds);
    const int tid = tid_w(a.wv), lane = tid & 63, wave = tid >> 6, l15 = lane & 15, gq = lane >> 4;
    LAS float* U = (LAS float*)lds;
    LAS unsigned char* PB = lds + 80896;
    LAS unsigned char* WT = lds + 114688;
    const int t0 = tc * 64;
    const bf16_t* proj = (const bf16_t*)(a.ws + WS_PROJ) + (size_t)b * SEQ * NPROJ;
    bf16_t* mixed = (bf16_t*)(a.ws + WS_MIXED) + (size_t)b * SEQ * DM;
    for (int k = 0; k < 5; ++k) {
        const int idx = tid + 512 * k;
        if (idx < 79 * 32) {
            const int tt = idx >> 5, cv = idx & 31, t = t0 - 15 + tt;
            u32x4 v = (u32x4){0u, 0u, 0u, 0u};
            if (t >= 0) v = *(const u32x4*)(proj + (size_t)t * NPROJ + cv * 8);
            LAS f32x4* up = (LAS f32x4*)(U + tt * 256 + cv * 8);
            up[0] = (f32x4){bflo(v.x), bfhi(v.x), bflo(v.y), bfhi(v.y)};
            up[1] = (f32x4){bflo(v.z), bfhi(v.z), bflo(v.w), bfhi(v.w)};
        }
    }
    {
        const float* pw = inptr(a, 4) + (size_t)l * 16384;
        for (int k = 0; k < 32; ++k) {
            const int idx = tid + 512 * k, g = idx >> 12, c = (idx >> 6) & 63, d = idx & 63;
            *(LAS unsigned short*)(WT + (g * 64 + d) * 144 + c * 2) = f2bf(pw[idx]);
        }
    }
    LBAR();
    {
        const int c = tid & 255, half = tid >> 8, g = c >> 6, w = 2 << g;
        for (int q = 0; q < 32; ++q) {
            const int tt = half * 32 + q, t = t0 + tt;
            float s = 0.f;
            for (int j = 0; j < w; ++j) s += U[(tt + 15 - j) * 256 + c];
            const float cnt = (float)((t + 1 < w) ? (t + 1) : w);
            *(LAS unsigned short*)(PB + tt * 528 + c * 2) = f2bf(s * __builtin_amdgcn_rcpf(cnt) - U[(tt + 15) * 256 + c]);
        }
    }
    LBAR();
    {
        const int tt = wave & 3, gp = wave >> 2;
        const float* psc = inptr(a, 5) + l * 256;
#pragma unroll 1
        for (int gi = 0; gi < 2; ++gi) {
            const int g = gp * 2 + gi;
            f32x4 acc[4];
#pragma unroll
            for (int nt = 0; nt < 4; ++nt) acc[nt] = (f32x4){0.f, 0.f, 0.f, 0.f};
#pragma unroll
            for (int ks = 0; ks < 2; ++ks) {
                const bf16x8 af = *(LAS const bf16x8*)(PB + (16 * tt + l15) * 528 + (g * 64 + 32 * ks + 8 * gq) * 2);
#pragma unroll
                for (int nt = 0; nt < 4; ++nt) {
                    const bf16x8 bfr = *(LAS const bf16x8*)(WT + (g * 64 + 16 * nt + l15) * 144 + (32 * ks + 8 * gq) * 2);
                    acc[nt] = __builtin_amdgcn_mfma_f32_16x16x32_bf16(af, bfr, acc[nt], 0, 0, 0);
                }
            }
#pragma unroll
            for (int nt = 0; nt < 4; ++nt) {
                const int dcol = g * 64 + 16 * nt + l15;
                const float sc = psc[dcol];
#pragma unroll
                for (int rg = 0; rg < 4; ++rg) mixed[(size_t)(t0 + 16 * tt + 4 * gq + rg) * DM + dcol] = f2bf(acc[nt][rg] * sc);
            }
        }
    }
}

__device__ __forceinline__ void dattn_unit(const Ctx& a, int b, int h, int tb, LAS unsigned char* lds) {
    lds = lds_l(lds);
    const int tid = tid_w(a.wv), lane = tid & 63, wave = tid >> 6, l15 = lane & 15, gq = lane >> 4;
    LAS float* OACC = (LAS float*)lds;
    LAS float* DEN = (LAS float*)(lds + 65536);
    LAS unsigned char* vst = lds + 66560 + wave * 4608;
    const int t0 = tb * 256;
    const bf16_t* projb = (const bf16_t*)(a.ws + WS_PROJ) + (size_t)b * SEQ * NPROJ;
    bf16_t* mixed = (bf16_t*)(a.ws + WS_MIXED) + (size_t)b * SEQ * DM;
    const float slope2 = exp2f(-8.0f * (float)(h + 1) / 6.0f) * LOG2E;
    const int trq = (l15 >> 2), trp = (l15 & 3);
#pragma unroll 1
    for (int pi = 0; pi < 3; ++pi) {
        const int d = 1 << (2 * pi);
        const float sl = slope2 * (float)d;
#pragma unroll 1
        for (int ii = 0; ii < 2; ++ii) {
            const int it = 2 * wave + ii, rr = it % d, jj = it / d, tq0 = t0 + rr + 16 * d * jj;
            const unsigned char* pbytes = (const unsigned char*)projb;
            const unsigned qoff = (unsigned)(tq0 + d * l15) * (unsigned)(NPROJ * 2) + (unsigned)((256 + h * 64 + 8 * gq) * 2);
            const bf16x8 qf0 = *(const bf16x8*)(pbytes + qoff), qf1 = *(const bf16x8*)(pbytes + qoff + 64);
            bf16x8 kf[6][2];
            const int kmin = (640 + h * 64 + 8 * gq) * 2;
            const int koff0 = (tq0 + d * (l15 - 128)) * (NPROJ * 2) + kmin;
            const int kstep = d * 16 * (NPROJ * 2);
#define DATTN_KLOAD(KT) do { if ((KT) < 9) { int ko_ = koff0 + (KT) * kstep; ko_ = ko_ < kmin ? kmin : ko_; \
                kf[(KT) % 6][0] = *(const bf16x8*)(pbytes + (unsigned)ko_); kf[(KT) % 6][1] = *(const bf16x8*)(pbytes + (unsigned)ko_ + 64); } } while (0)
            DATTN_KLOAD(0); DATTN_KLOAD(1); DATTN_KLOAD(2); DATTN_KLOAD(3); DATTN_KLOAD(4); DATTN_KLOAD(5);
            u32x4 vreg[3][4];
            const int vmin = (1024 + h * 64 + (lane & 7) * 8) * 2, vmax = (SEQ - 1) * (NPROJ * 2) + vmin;
            const int voff0 = (tq0 + d * ((lane >> 3) - 128)) * (NPROJ * 2) + vmin;
            const int vstep = d * 8 * (NPROJ * 2);
#define DATTN_VLOAD(PP) do { _Pragma("unroll") for (int ps = 0; ps < 4; ++ps) { \
                    int vo_ = voff0 + (4 * (PP) + 2 * (ps >> 1) + (ps & 1)) * vstep; vo_ = vo_ < vmin ? vmin : (vo_ > vmax ? vmax : vo_); \
                    vreg[(PP) % 3][ps] = *(const u32x4*)(pbytes + (unsigned)vo_); } } while (0)
            DATTN_VLOAD(0); DATTN_VLOAD(1); DATTN_VLOAD(2);
            f32x4 o[4];
#pragma unroll
            for (int dt = 0; dt < 4; ++dt) o[dt] = (f32x4){0.f, 0.f, 0.f, 0.f};
            float den = 0.f;
            int dbase = l15 + 128 - 4 * gq; asm volatile("" : "+v"(dbase));
            float fbase = (float)dbase; asm volatile("" : "+v"(fbase));
            const float nb0 = -sl * fbase;
#pragma unroll
            for (int pp = 0; pp < 5; ++pp) {
                __builtin_amdgcn_sched_barrier(0);
#pragma unroll
                for (int ps = 0; ps < 4; ++ps) { const int idx = ps * 64 + lane, row = idx >> 3, chk = idx & 7; *(LAS u32x4*)(vst + row * 144 + chk * 16) = vreg[pp % 3][ps]; }
                if (pp + 3 < 5) { asm volatile("" ::: "memory"); DATTN_VLOAD(pp + 3); }
                const bool skip = (tq0 + d * (16 * (2 * pp + 1 - 8) + 15) < 0);
                f32x4 sacc[2];
#pragma unroll
                for (int T = 0; T < 2; ++T) {
                    const int kt = 2 * pp + T;
                    sacc[T] = (f32x4){0.f, 0.f, 0.f, 0.f};
                    if (kt < 9 && !skip) {
                        sacc[T] = __builtin_amdgcn_mfma_f32_16x16x32_bf16(kf[kt % 6][0], qf0, sacc[T], 0, 0, 0);
                        sacc[T] = __builtin_amdgcn_mfma_f32_16x16x32_bf16(kf[kt % 6][1], qf1, sacc[T], 0, 0, 0);
                    }
                }
                if (pp + 3 < 5) { asm volatile("" ::: "memory"); DATTN_KLOAD(2 * pp + 6); DATTN_KLOAD(2 * pp + 7); }
                if (skip) continue;
                float p[2][4];
#pragma unroll
                for (int T = 0; T < 2; ++T) {
                    const int kt = 2 * pp + T;
                    if (kt >= 9) { p[T][0] = 0.f; p[T][1] = 0.f; p[T][2] = 0.f; p[T][3] = 0.f; }
                    else if (kt == 0 || kt == 8 || (tq0 + d * 16 * (kt - 8) < 0)) {
#pragma unroll
                        for (int rg = 0; rg < 4; ++rg) {
                            const int dist = dbase - (16 * kt + rg);
                            const int tkk = tq0 + d * (l15 - dist);
                            const bool valid = (dist >= 0) && (dist <= 128) && (tkk >= 0);
                            const float pv = valid ? __builtin_amdgcn_exp2f(sacc[T][rg] + fmaf(sl, (float)(16 * kt + rg), nb0)) : 0.f;
                            p[T][rg] = pv; den += pv;
                        }
                    } else {
#pragma unroll
                        for (int rg = 0; rg < 4; ++rg) {
                            const float pv = __builtin_amdgcn_exp2f(sacc[T][rg] + fmaf(sl, (float)(16 * kt + rg), nb0));
                            p[T][rg] = pv; den += pv;
                        }
                    }
                }
                u32x4 pw; pw.x = pkbf(p[0][0], p[0][1]); pw.y = pkbf(p[0][2], p[0][3]); pw.z = pkbf(p[1][0], p[1][1]); pw.w = pkbf(p[1][2], p[1][3]);
                const bf16x8 pfrag = __builtin_bit_cast(bf16x8, pw);
#pragma unroll
                for (int dt = 0; dt < 4; ++dt) {
                    const s16x4 lo = vtr(vst + (4 * gq + trq) * 144 + (16 * dt + 4 * trp) * 2);
                    const s16x4 hi = vtr(vst + (16 + 4 * gq + trq) * 144 + (16 * dt + 4 * trp) * 2);
                    const bf16x8 vf = (bf16x8){lo[0], lo[1], lo[2], lo[3], hi[0], hi[1], hi[2], hi[3]};
                    o[dt] = __builtin_amdgcn_mfma_f32_16x16x32_bf16(pfrag, vf, o[dt], 0, 0, 0);
                }
            }
            den += shx(den, lane, 16); den += shx(den, lane, 32);
#pragma unroll
            for (int dt = 0; dt < 4; ++dt)
#pragma unroll
                for (int rg = 0; rg < 4; ++rg) {
                    const int tl = (tq0 - t0) + d * (4 * gq + rg), idx = tl * 64 + 16 * dt + l15;
                    if (pi == 0) OACC[idx] = o[dt][rg]; else OACC[idx] += o[dt][rg];
                }
            if (gq == 0) { const int tl = (tq0 - t0) + d * l15; if (pi == 0) DEN[tl] = den; else DEN[tl] += den; }
        }
        LBAR();
    }
#pragma unroll
    for (int k = 0; k < 4; ++k) {
        const int idx = tid + 512 * k, tl = idx >> 3, c8 = (idx & 7) * 8;
        const f32x4 x0 = *(LAS const f32x4*)(OACC + tl * 64 + c8), x1 = *(LAS const f32x4*)(OACC + tl * 64 + c8 + 4);
        const float r = __builtin_amdgcn_rcpf(DEN[tl]);
        u32x4 w; w.x = pkbf(x0[0] * r, x0[1] * r); w.y = pkbf(x0[2] * r, x0[3] * r); w.z = pkbf(x1[0] * r, x1[1] * r); w.w = pkbf(x1[2] * r, x1[3] * r);
        *(u32x4*)(mixed + (size_t)(t0 + tl) * DM + 256 + h * 64 + c8) = w;
    }
}

__device__ __forceinline__ void phase_mixers(const Ctx& a, int l, LAS unsigned char* lds, unsigned xq, bool steal) {
    unsigned* ctr = (unsigned*)(a.ws + WS_CTL) + 64 * l;
    lds = lds_l(lds);
    LAS int* sun = (LAS int*)(lds + LDS_UNIT_OFF);
    const unsigned nk = steal ? 8u : 1u;
    int stage = 0;
    for (;;) {
        __syncthreads();
        if (tid_w(a.wv) == 0) {
            int code = -1;
            for (; stage < 3 && code < 0; ) {
                const int nq = stage == 0 ? 24 : (stage == 1 ? 192 : 128);
                for (unsigned k = 0; k < nk && code < 0; ++k) {
                    const unsigned x2 = (xq + k) & 7u;
                    const int u = (int)atomicAdd(ctr + 8 * stage + x2, 1u);
                    if (u < nq) code = (stage == 0 ? 0 : (stage == 1 ? 1000 : 10000)) + (int)x2 * nq + u;
                }
                if (code < 0) ++stage;
            }
            *sun = code;
        }
        __syncthreads();
        const int code = *sun;
        if (code < 0) break;
        if (code < 1000) lru_unit(a, l, code / 6, code % 6, lds);
        else if (code < 10000) { const int v = code - 1000; dattn_unit(a, v / 48, (v % 48) / 8, v % 8, lds); }
        else { const int v = code - 10000; pool_unit(a, l, v / 32, v % 32, lds); }
    }
}

__device__ __forceinline__ void phase_xattn(const Ctx& a, int l, LAS unsigned char* lds, int cv) {
    lds = lds_l(lds);
    const int tid = tid_w(a.wv), lane = tid & 63, wave = tid >> 6, l15 = lane & 15, gq = lane >> 4;
    LAS unsigned char* KL = lds;
    LAS unsigned char* VL = lds + 16896;
    LAS float* RK = (LAS float*)(lds + 68608);
    const bf16_t* qm = (const bf16_t*)(a.ws + WS_QM);
    const float* qst = (const float*)(a.ws + WS_QST);
    const bf16_t* kv = (const bf16_t*)(a.ws + WS_KV);
    const float* kst = (const float*)(a.ws + WS_KST);
    bf16_t* om = (bf16_t*)(a.ws + WS_MIXED);
    const int trq = (l15 >> 2), trp = (l15 & 3);
    for (int xu = cv; xu < NBATCH * 4 * 16; xu += gridDim.x) {
        const int xr = xu >> 3, b = 4 * (xu & 7) + (xr >> 6), h = (xr >> 4) & 3, qb = xr & 15;
        LBAR();
        if (tid < 256) {
            const f32x4* kp = (const f32x4*)(kst + (size_t)(b * 256 + tid) * 256 + l * 64 + h * 8);
            const f32x4 k0 = kp[0], k1 = kp[1];
            RK[tid] = rsqrtf((((k0[0] + k0[1]) + (k0[2] + k0[3])) + ((k1[0] + k1[1]) + (k1[2] + k1[3]))) * (1.0f / 256.0f) + EPSF);
        }
        const bf16_t* kvb = kv + (size_t)(b * 256) * 8192 + l * 2048 + h * 256;
        u32x4 kpre[2], vpre[2];
#pragma unroll
        for (int k = 0; k < 2; ++k) {
            const int idx = tid + 512 * k, row = idx >> 5, chk = idx & 31;
            const bf16_t* src = kvb + (size_t)row * 8192 + chk * 8;
            kpre[k] = *(const u32x4*)src; vpre[k] = *(const u32x4*)(src + 1024);
        }
        const size_t qrow = (size_t)b * SEQ + qb * 128 + wave * 16 + l15;
        bf16x8 qf[8];
#pragma unroll
        for (int ks = 0; ks < 8; ++ks) qf[ks] = *(const bf16x8*)(qm + qrow * DM + h * 256 + 32 * ks + 8 * gq);
        float rq;
        { const f32x4* qp = (const f32x4*)(qst + qrow * 32 + h * 8); const f32x4 q0 = qp[0], q1 = qp[1];
          rq = rsqrtf((((q0[0] + q0[1]) + (q0[2] + q0[3])) + ((q1[0] + q1[1]) + (q1[2] + q1[3]))) * (1.0f / 256.0f) + EPSF); }
        f32x4 o[16];
#pragma unroll
        for (int dt = 0; dt < 16; ++dt) o[dt] = (f32x4){0.f, 0.f, 0.f, 0.f};
        float den = 0.f;
#pragma unroll
        for (int ks = 0; ks < 8; ++ks) asm volatile("" : "+v"(qf[ks]));
        asm volatile("" : "+v"(rq));
#pragma unroll
        for (int k = 0; k < 2; ++k) {
            const int idx = tid + 512 * k, row = idx >> 5, chk = idx & 31;
            *(LAS u32x4*)(KL + row * 528 + chk * 16) = kpre[k];
            *(LAS u32x4*)(VL + row * 544 + chk * 16) = vpre[k];
            const bf16_t* src = kvb + (size_t)(32 + row) * 8192 + chk * 8;
            kpre[k] = *(const u32x4*)src; vpre[k] = *(const u32x4*)(src + 1024);
        }
#pragma unroll 1
        for (int c = 0; c < 8; ++c) {
            LBAR();
            const int bo = (c & 1) * 34304, bn = 34304 - bo;
            if (c < 7) {
#pragma unroll
                for (int k = 0; k < 2; ++k) {
                    const int idx = tid + 512 * k, row = idx >> 5, chk = idx & 31;
                    *(LAS u32x4*)(KL + bn + row * 528 + chk * 16) = kpre[k];
                    *(LAS u32x4*)(VL + bn + row * 544 + chk * 16) = vpre[k];
                }
                if (c < 6) {
#pragma unroll
                    for (int k = 0; k < 2; ++k) {
                        const int idx = tid + 512 * k, row = idx >> 5, chk = idx & 31;
                        const bf16_t* src = kvb + (size_t)(32 * (c + 2) + row) * 8192 + chk * 8;
                        kpre[k] = *(const u32x4*)src; vpre[k] = *(const u32x4*)(src + 1024);
                    }
                }
            }
            LAS unsigned char* KLc = KL + bo; LAS unsigned char* VLc = VL + bo;
            float p[2][4];
#pragma unroll
            for (int T = 0; T < 2; ++T) {
                f32x4 s = (f32x4){0.f, 0.f, 0.f, 0.f};
#pragma unroll
                for (int ks = 0; ks < 8; ++ks) {
                    const bf16x8 kf = *(LAS const bf16x8*)(KLc + (16 * T + l15) * 528 + (32 * ks + 8 * gq) * 2);
                    s = __builtin_amdgcn_mfma_f32_16x16x32_bf16(kf, qf[ks], s, 0, 0, 0);
                }
                const f32x4 rk4 = *(LAS const f32x4*)(RK + 32 * c + 16 * T + 4 * gq);
#pragma unroll
                for (int rg = 0; rg < 4; ++rg) { const float pv = __builtin_amdgcn_exp2f(s[rg] * rq * rk4[rg]); p[T][rg] = pv; den += pv; }
            }
            u32x4 pw; pw.x = pkbf(p[0][0], p[0][1]); pw.y = pkbf(p[0][2], p[0][3]); pw.z = pkbf(p[1][0], p[1][1]); pw.w = pkbf(p[1][2], p[1][3]);
            const bf16x8 pfrag = __builtin_bit_cast(bf16x8, pw);
#pragma unroll
            for (int dt = 0; dt < 16; ++dt) {
                const s16x4 lo = vtr(VLc + (4 * gq + trq) * 544 + (16 * dt + 4 * trp) * 2);
                const s16x4 hi = vtr(VLc + (16 + 4 * gq + trq) * 544 + (16 * dt + 4 * trp) * 2);
                const bf16x8 vf = (bf16x8){lo[0], lo[1], lo[2], lo[3], hi[0], hi[1], hi[2], hi[3]};
                o[dt] = __builtin_amdgcn_mfma_f32_16x16x32_bf16(pfrag, vf, o[dt], 0, 0, 0);
            }
        }
        den += shx(den, lane, 16); den += shx(den, lane, 32);
        float inv[4];
#pragma unroll
        for (int rg = 0; rg < 4; ++rg) inv[rg] = 1.0f / shi(den, 4 * gq + rg);
        LAS unsigned char* OST = lds + 71680 + wave * 8448;
#pragma unroll
        for (int dt = 0; dt < 16; ++dt)
#pragma unroll
            for (int rg = 0; rg < 4; ++rg) *(LAS unsigned short*)(OST + (4 * gq + rg) * 528 + (16 * dt + l15) * 2) = f2bf(o[dt][rg] * inv[rg]);
        asm volatile("s_waitcnt lgkmcnt(0)" ::: "memory");
        const size_t orow0 = (size_t)b * SEQ + qb * 128 + wave * 16;
#pragma unroll
        for (int k = 0; k < 8; ++k) {
            const int idx = k * 64 + lane, row = idx >> 5, chk = idx & 31;
            const u32x4 w = *(LAS const u32x4*)(OST + row * 528 + chk * 16);
            *(u32x4*)(om + (orow0 + row) * DM + h * 256 + chk * 8) = w;
        }
        asm volatile("s_waitcnt lgkmcnt(0)" ::: "memory");
    }
}

__device__ __forceinline__ void phase_ffn_fix(const Ctx& a, int l, int cv) {
    const float* sg = (const float*)(a.ws + WS_SG); const float* su = (const float*)(a.ws + WS_SU);
    bf16_t* act = (bf16_t*)(a.ws + WS_ACT);
    const float* cw = inptr(a, 25) + (size_t)l * 3 * DFF; const float* cb = inptr(a, 26) + (size_t)l * DFF;
    const int per_x = 32 * 4 * (DFF / 4);
    for (int wi = (cv >> 3) * NTHREADS + tid_w(a.wv); wi < per_x; wi += (gridDim.x >> 3) * NTHREADS) {
        const int f = (wi % (DFF / 4)) * 4, j = (wi / (DFF / 4)) & 3, pm = 32 * (cv & 7) + wi / (DFF / 4) / 4, wr = j >> 1, e = j & 1;
        const float* sgt = sg + (size_t)pm * 8 * DFF + f;
        const f32x4 z = (f32x4){0.f, 0.f, 0.f, 0.f};
        const bool hasprev = (pm & 7) != 0;
        const f32x4 prev7 = hasprev ? *(const f32x4*)(sgt - (size_t)8 * DFF + 7 * DFF) : z;
        const f32x4 prev6 = hasprev ? *(const f32x4*)(sgt - (size_t)8 * DFF + 6 * DFF) : z;
        const f32x4 gc = *(const f32x4*)(sgt + (size_t)(wr * 4 + e) * DFF);
        f32x4 gm1, gm2;
        if (e == 1) { gm1 = *(const f32x4*)(sgt + (size_t)(wr * 4) * DFF); gm2 = wr ? *(const f32x4*)(sgt + (size_t)3 * DFF) : prev7; }
        else { gm1 = wr ? *(const f32x4*)(sgt + (size_t)3 * DFF) : prev7; gm2 = wr ? *(const f32x4*)(sgt + (size_t)2 * DFF) : prev6; }
        const f32x4 uu = *(const f32x4*)(su + ((size_t)pm * 4 + wr * 2 + e) * DFF + f);
        const f32x4 w0 = *(const f32x4*)(cw + f), w1 = *(const f32x4*)(cw + DFF + f), w2 = *(const f32x4*)(cw + 2 * DFF + f), bb = *(const f32x4*)(cb + f);
        float r[4];
#pragma unroll
        for (int i = 0; i < 4; ++i) r[i] = gelu_tanh(bb[i] + w0[i] * gc[i] + w1[i] * gm1[i] + w2[i] * gm2[i]) * uu[i];
        u32x2 w; w.x = pkbf(r[0], r[1]); w.y = pkbf(r[2], r[3]);
        *(u32x2*)(act + (size_t)(pm * 256 + wr * 128 + e) * DFF + f) = w;
    }
}

#define GAS __attribute__((address_space(1)))

typedef GAS unsigned gu32;
typedef GAS unsigned long long gu64;
#define RLX_AGENT __ATOMIC_RELAXED, __HIP_MEMORY_SCOPE_AGENT
#define LDS_WAIT() asm volatile("s_waitcnt lgkmcnt(0)" ::: "memory")
#define VM_WAIT() asm volatile("s_waitcnt vmcnt(0)" ::: "memory")
__device__ __forceinline__ unsigned long long rt() { return __builtin_amdgcn_s_memrealtime(); }
#define XB_TMO      128
#define XB_XCNT(j)  (256  + 64 * (j))
#define XB_XSUB(j)  (1280 + 64 * (j))
#define XB_XGEN(j)  (2304 + 64 * (j))
#define XB_TOP      3328
#define XB_TOPGEN   3392
#define XB_LSUB(j)  (3456 + 64 * (j))
#define XB_LGEN(j)  (4480 + 64 * (j))
#define XCD_BAR_WORDS 5504
#define XB_SPIN_CAP (1u << 18)

__device__ __forceinline__ unsigned xb_ld(unsigned* p)              { return __hip_atomic_load(p, __ATOMIC_RELAXED, __HIP_MEMORY_SCOPE_AGENT); }
__device__ __forceinline__ unsigned xb_add(unsigned* p, unsigned v) { return __hip_atomic_fetch_add(p, v, __ATOMIC_RELAXED, __HIP_MEMORY_SCOPE_AGENT); }
__device__ __forceinline__ unsigned xb_xcc_id() { return (unsigned)__builtin_amdgcn_s_getreg((3 << 11) | 20) & 0xFu; }
#define XB_SPIN(cond, bar) do { unsigned _sp = 0; while (cond) { __builtin_amdgcn_s_sleep(1); \
    if ((++_sp & 255u) == 0u) { if (xb_ld(&(bar)[XB_TMO])) break; if (_sp > XB_SPIN_CAP) { atomicAdd(&(bar)[XB_TMO], 1u); break; } } } } while (0)

struct XcdBarrier {
    unsigned* bar; unsigned x;
    volatile LAS unsigned* st;
};

__device__ __forceinline__ XcdBarrier xcd_barrier_post(unsigned* bar, volatile LAS unsigned* st, bool t0) {
    XcdBarrier b; b.bar = bar; b.x = xb_xcc_id(); b.st = st;
    if (t0) st[2] = xb_add(&bar[XB_XCNT(b.x)], 1u);
    return b;
}
__device__ __forceinline__ void xcd_barrier_complete(unsigned* bar, unsigned x, unsigned& nloc, unsigned& nx) {
    const unsigned G = gridDim.x * gridDim.y * gridDim.z;
    unsigned sum, cnt, mine, sp = 0u;
    for (;;) {
        sum = 0u; cnt = 0u; mine = 0u;
#pragma unroll
        for (unsigned j = 0; j < 16; ++j) { const unsigned c = xb_ld(&bar[XB_XCNT(j)]); sum += c; cnt += (c > 0u) ? 1u : 0u; mine = (j == x) ? c : mine; }
        if (sum == G) break;
        __builtin_amdgcn_s_sleep(1);
        if ((++sp & 255u) == 0u) { if (xb_ld(&bar[XB_TMO])) break; if (sp > XB_SPIN_CAP) { atomicAdd(&bar[XB_TMO], 1u); break; } }
    }
    nloc = mine > 0u ? mine : 1u; nx = cnt > 0u ? cnt : 1u;
}

__device__ __forceinline__ void xcd_barrier(const XcdBarrier& b, bool t0) {
    asm volatile("s_waitcnt vmcnt(0)" ::: "memory");
    __syncthreads();
    if (t0) {
        unsigned* bar = b.bar;
        __builtin_amdgcn_s_waitcnt(0);
        unsigned nloc = b.st[0], nx = b.st[1];
        if (nloc == 0u) { xcd_barrier_complete(bar, b.x, nloc, nx); b.st[0] = nloc; b.st[1] = nx; }
        const unsigned old = xb_add(&bar[XB_XSUB(b.x)], 1u);
        const unsigned gen = old / nloc;
        if (old + 1u == (gen + 1u) * nloc) {
            __builtin_amdgcn_fence(__ATOMIC_RELEASE, "agent");
            asm volatile("s_waitcnt vmcnt(0)" ::: "memory");
            const unsigned og = xb_add(&bar[XB_TOP], 1u);
            const unsigned tg = og / nx;
            if (og + 1u == (tg + 1u) * nx) xb_add(&bar[XB_TOPGEN], 1u);
            else XB_SPIN(xb_ld(&bar[XB_TOPGEN]) == tg, bar);
            __builtin_amdgcn_fence(__ATOMIC_ACQUIRE, "agent");
            xb_add(&bar[XB_XGEN(b.x)], 1u);
            asm volatile("s_waitcnt vmcnt(0)" ::: "memory");
        } else {
            XB_SPIN(xb_ld(&bar[XB_XGEN(b.x)]) == gen, bar);
            __builtin_amdgcn_fence(__ATOMIC_ACQUIRE, "agent");
            asm volatile("s_waitcnt vmcnt(0)" ::: "memory");
        }
    }
    __syncthreads();
}


__device__ __forceinline__ void xcd_barrier_local(const XcdBarrier& b, bool t0) {
    asm volatile("s_waitcnt vmcnt(0)" ::: "memory");
    __syncthreads();
    if (t0) {
        unsigned* bar = b.bar;
        const unsigned nloc = b.st[0];
        const unsigned old = xb_add(&bar[XB_LSUB(b.x)], 1u);
        const unsigned gen = old / nloc;
        if (old + 1u == (gen + 1u) * nloc) xb_add(&bar[XB_LGEN(b.x)], 1u);
        else XB_SPIN(xb_ld(&bar[XB_LGEN(b.x)]) == gen, bar);
        __builtin_amdgcn_fence(__ATOMIC_ACQUIRE, "agent");
        asm volatile("s_waitcnt vmcnt(0)" ::: "memory");
    }
    __syncthreads();
}
__device__ __forceinline__ bool xcd_even_partition(unsigned* bar) {
    const unsigned G = gridDim.x; bool ok = (G % 8u) == 0u; unsigned n = 0u;
#pragma unroll
    for (unsigned j = 0; j < 16; ++j) { const unsigned c = xb_ld(&bar[XB_XCNT(j)]); if (c) { ++n; ok = ok && (c * 8u == G) && (j < 8u); } }
    return ok && n == 8u;
}

__global__ void __launch_bounds__(NTHREADS, 2) trunk_fwd(Args ka) {
    extern __shared__ __attribute__((aligned(16))) unsigned char lds_raw[];
    LAS unsigned char* lds = (LAS unsigned char*)lds_raw;
    cg::grid_group grid = cg::this_grid();
    {
        LAS unsigned long long* tw = (LAS unsigned long long*)(lds + LDS_TBL_OFF);
        if (threadIdx.x == 0) {
#pragma unroll
            for (int i = 0; i < 28; ++i) tw[i] = (unsigned long long)ka.in[i];
        }
        __syncthreads();
    }
    volatile LAS unsigned* bst = (volatile LAS unsigned*)(lds + LDS_UNIT_OFF + 16);
    if (threadIdx.x == 0) { bst[0] = 0u; bst[1] = 0u; bst[2] = 0u; bst[3] = 0u; }
    __syncthreads();
    const XcdBarrier xbar = xcd_barrier_post((unsigned*)(ka.ws + WS_CTL) + 4096, bst, threadIdx.x == 0);
#define GSYNC_FULL() xcd_barrier(xbar, tid_w(a.wv) == 0)
#define GSYNC() do { if (part) xcd_barrier_local(xbar, tid_w(a.wv) == 0); else xcd_barrier(xbar, tid_w(a.wv) == 0); } while (0)
    int cv = (int)blockIdx.x; bool part = false;
    Ctx a; a.tbl = (LAS const unsigned long long*)(lds + LDS_TBL_OFF); a.out = ka.out; a.ws = ka.ws; a.wv = __builtin_amdgcn_readfirstlane((int)(threadIdx.x >> 6));
    unsigned char* ws = a.ws;
    bf16_t* hb = (bf16_t*)(ws + WS_HB);
    float* st = (float*)(ws + WS_ST);

    phase_prologue(a, lds);
    grid.sync();
    {
        EpiBf<false> E{(bf16_t*)(ws + WS_KV), 8192, (const float*)(ws + WS_STM), (float*)(ws + WS_KST), 256, nullptr, nullptr, nullptr};
        run_gemm(cv, a.wv, lds, (const bf16_t*)(ws + WS_MEMB), (const bf16_t*)(ws + WS_WKV), MEMROWS, 8192, DM, E);
    }
    for (int l = 0; l < DEPTH; ++l) {
        const unsigned char* wl = ws + WS_W + (size_t)l * W_LAYER;
        {
            EpiBf<true> E{(bf16_t*)(ws + WS_PROJ), NPROJ, st, nullptr, 0, nullptr, inptr(a, 6) + l * 64, inptr(a, 7) + l * 64};
            run_gemm(cv, a.wv, lds, hb, (const bf16_t*)(wl + W_IN), MTOK, NPROJ, DM, E);
        }
        if (l == 0) {
            GSYNC_FULL();
            if (tid_w(a.wv) == 0) bst[3] = xcd_even_partition(xbar.bar) ? 1u : 0u;
            __syncthreads();
            part = bst[3] != 0u;
            if (part) cv = (int)(bst[2] * 8u + (xbar.x & 7u));
        } else GSYNC();
        phase_mixers(a, l, lds, (unsigned)cv & 7u, !part);
        GSYNC();
        {
            EpiRes E{l == 0 ? inptr(a, 0) : a.out, a.out, hb, st};
            run_gemm(cv, a.wv, lds, (const bf16_t*)(ws + WS_MIXED), (const bf16_t*)(wl + W_OUT), MTOK, DM, DM, E);
        }
        GSYNC();
        {
            EpiBf<false> E{(bf16_t*)(ws + WS_QM), DM, st, (float*)(ws + WS_QST), 32, (const float*)(ws + WS_CS) + l * 1024, nullptr, nullptr};
            run_gemm(cv, a.wv, lds, hb, (const bf16_t*)(wl + W_Q), MTOK, DM, DM, E);
        }
        GSYNC();
        phase_xattn(a, l, lds, cv);
        GSYNC();
        {
            EpiRes E{a.out, a.out, hb, st};
            run_gemm(cv, a.wv, lds, (const bf16_t*)(ws + WS_MIXED), (const bf16_t*)(wl + W_O), MTOK, DM, DM, E);
        }
        GSYNC_FULL();
        {
            EpiAct E{(bf16_t*)(ws + WS_ACT), st, inptr(a, 25) + (size_t)l * 3 * DFF, inptr(a, 26) + (size_t)l * DFF, (float*)(ws + WS_SG), (float*)(ws + WS_SU)};
            run_gemm_aperm(cv, a.wv, lds, hb, (const bf16_t*)(wl + W_UP), MTOK, DFF2, DM, E);
        }
        GSYNC();
        phase_ffn_fix(a, l, cv);
        GSYNC();
        {
            EpiRes E{a.out, a.out, (l == DEPTH - 1) ? nullptr : hb, st};
            run_gemm(cv, a.wv, lds, (const bf16_t*)(ws + WS_ACT), (const bf16_t*)(wl + W_DOWN), MTOK, DM, DFF, E);
        }
        if (l < DEPTH - 1) GSYNC_FULL();
    }
}

extern "C" void kernel_launch(void* const* d_in, const int* in_sizes, int n_in, void* d_out, int out_size, void* d_ws, size_t ws_size, hipStream_t stream) {
    static int grid = 0;
    if (grid == 0) {
        if (n_in != 28 || in_sizes[0] != MTOK * DM || out_size != MTOK * DM || ws_size < WS_END) {
            fprintf(stderr, "kernel_launch: unexpected shapes (n_in %d, in0 %d, out %d, ws %zu; need ws >= %zu); nothing launched\n", n_in, n_in > 0 ? in_sizes[0] : -1, out_size, ws_size, (size_t)WS_END);
            grid = -1; return;
        }
        int dev = 0, cus = 0, per_cu = 0;
        hipGetDevice(&dev);
        hipDeviceGetAttribute(&cus, hipDeviceAttributeMultiprocessorCount, dev);
        if (hipFuncSetAttribute((const void*)trunk_fwd, hipFuncAttributeMaxDynamicSharedMemorySize, LDS_BYTES) != hipSuccess) { fprintf(stderr, "kernel_launch: hipFuncSetAttribute failed\n"); grid = -1; return; }
        if (hipOccupancyMaxActiveBlocksPerMultiprocessor(&per_cu, (const void*)trunk_fwd, NTHREADS, LDS_BYTES) != hipSuccess || per_cu < 1) { fprintf(stderr, "kernel_launch: occupancy query says %d blocks per CU\n", per_cu); per_cu = 1; }
        (void)hipGetLastError();
        grid = cus;
    }
    if (grid < 0) return;
    (void)hipMemsetAsync((char*)d_ws + WS_CTL, 0, 65536, stream);
    Args a{};
    for (int i = 0; i < 28; ++i) a.in[i] = (const float*)d_in[i];
    a.out = (float*)d_out; a.ws = (unsigned char*)d_ws;
    void* args[] = {&a};
    hipError_t e = hipLaunchCooperativeKernel((const void*)trunk_fwd, dim3(grid), dim3(NTHREADS), args, LDS_BYTES, stream);
    if (e != hipSuccess) fprintf(stderr, "cooperative launch failed: %s (grid %d)\n", hipGetErrorString(e), grid);
}
```

```cpp
#include <hip/hip_runtime.h>
#include <hip/hip_cooperative_groups.h>
#include <cstdio>
#include <cstdint>
namespace cg = cooperative_groups;
namespace pg8 {
#define PG8_LAS __attribute__((address_space(3)))
typedef unsigned short bf16_t;
typedef short bf16x8 __attribute__((ext_vector_type(8)));
typedef float f32x4 __attribute__((ext_vector_type(4)));
typedef unsigned u32x4 __attribute__((ext_vector_type(4)));
constexpr int BM = 256, BK = 64, HALF = 128, HTB = HALF * BK * 2  , STAGE_BYTES = 8 * HTB, NXCD = 8, WGM = 8;

__host__ __device__ __forceinline__ int lds_byte(int r, int c) { const int st = (r >> 4) * 2 + (c >> 5), rr = r & 15, cc = c & 31, ob = rr * 64 + cc * 2; return st * 1024 + (ob ^ (((ob >> 9) & 1) << 5)); }
__host__ __device__ __forceinline__ void stage_rc(int b, int& R, int& C) { const int st = b / 1024, sb = b % 1024, swz = sb ^ (((sb >> 9) & 1) << 5); R = (st >> 1) * 16 + swz / 64; C = (st & 1) * 32 + (swz % 64) / 2; }
__host__ __device__ __forceinline__ int perm32(int rho) { const int n = rho >> 4, i = rho & 15; return 8 * (i >> 2) + 4 * n + (i & 3); }

struct Unit { int pm, pn; };
struct Gemm { const bf16_t* A; const bf16_t* Bt; int M, N, K; };

struct StaticOrder {
    int nM, nN, nwg, G, c;
    __host__ __device__ void init(int M, int N, int G_, int c_) { nM = M / BM; nN = N / BM; nwg = nM * nN; G = G_; c = c_; }
    __host__ __device__ bool next(int i, Unit& u) const {
        const long L = (long)i * G + c; if (L >= nwg) return false;
        int wgid = (int)L; { const int q = nwg / NXCD, r = nwg % NXCD, xcd = wgid % NXCD, off = wgid / NXCD; wgid = (xcd < r ? xcd * (q + 1) : r * (q + 1) + (xcd - r) * q) + off; }
        const int nig = WGM * nN, gid = wgid / nig, fm = gid * WGM, gsz = (nM - fm) < WGM ? (nM - fm) : WGM;
        u.pm = fm + ((wgid % nig) % gsz); u.pn = (wgid % nig) / gsz; return true;
    }
    __device__ __forceinline__ void a_ready(const Unit&) const {}
    __device__ __forceinline__ void done(const Unit&) const {}
};

__device__ __forceinline__ unsigned cvt_pk_bf16(float lo, float hi) { unsigned r; asm volatile("v_cvt_pk_bf16_f32 %0, %1, %2" : "=v"(r) : "v"(lo), "v"(hi)); return r; }
typedef float f32x2 __attribute__((ext_vector_type(2)));
template <class Epi, class Sched, bool ALIGN_EPI = false, bool SP2 = false, bool APERM = false>
__device__ __forceinline__ void gemm_phase(int tid_in, PG8_LAS unsigned char* lds, const Gemm g, const Sched& S, const Epi& E) {
    int tid_ = tid_in; asm volatile("" : "+v"(tid_));
    const int tid = tid_, wid = __builtin_amdgcn_readfirstlane(tid >> 6), lane = tid & 63, wr = wid >> 2, wc = wid & 3, fr = lane & 15, fq = lane >> 4;
    const int K = g.K, nt = K / BK;
    unsigned voffA[2], voffB[2];
#pragma unroll
    for (int i = 0; i < 2; ++i) { int R, C; stage_rc(tid * 16 + i * 8192, R, C); const int Rb = Epi::PERM ? ((R & ~31) + perm32(R & 31)) : R;
        const int Ra = APERM ? ((16 * (R >> 6) + (R & 15)) * 8 + ((R >> 4) & 3)) : R;
        voffA[i] = (unsigned)(Ra * K + C) * 2u; voffB[i] = (unsigned)(Rb * K + C) * 2u; }
    const size_t kstep = (size_t)(BK * 2);
    const size_t hstep = (size_t)HALF * K * 2;
    const size_t tstep = 2 * hstep;
    const size_t hstepA = APERM ? (size_t)4 * K * 2 : hstep;
    const unsigned ldsw = (unsigned)wid * 1024u;
    const int aoff = lds_byte(wr * 64 + fr, fq * 8), boff = lds_byte(wc * 32 + fr, fq * 8);
#define PG8_SA(b, h) (((b) * 2 + (h)) * HTB)
#define PG8_SB(b, h) ((4 + (b) * 2 + (h)) * HTB)
#define PG8_STAGE(bufoff, gbase, voff) do { _Pragma("unroll") for (int _i = 0; _i < 2; ++_i) \
        __builtin_amdgcn_global_load_lds((const unsigned*)((const char*)(gbase) + (voff)[_i]), (PG8_LAS unsigned*)(lds + (bufoff) + ldsw + _i * 8192), 16, 0, 0); } while (0)
#define PG8_LDA(dst, b, h) do { _Pragma("unroll") for (int m = 0; m < 4; ++m) _Pragma("unroll") for (int k = 0; k < 2; ++k) dst[m][k] = *(const PG8_LAS bf16x8*)(lds + PG8_SA(b, h) + aoff + m * 2048 + k * 1024); } while (0)
#define PG8_LDB(dst, b, h) do { _Pragma("unroll") for (int n = 0; n < 2; ++n) _Pragma("unroll") for (int k = 0; k < 2; ++k) dst[n][k] = *(const PG8_LAS bf16x8*)(lds + PG8_SB(b, h) + boff + n * 2048 + k * 1024); } while (0)
#define PG8_MMA(ai, bj, At, Bt) do { __builtin_amdgcn_s_setprio(1); _Pragma("unroll") for (int m = 0; m < 4; ++m) _Pragma("unroll") for (int n = 0; n < 2; ++n) _Pragma("unroll") for (int k = 0; k < 2; ++k) \
        acc[ai][bj][m][n] = __builtin_amdgcn_mfma_f32_16x16x32_bf16(Bt[n][k], At[m][k], acc[ai][bj][m][n], 0, 0, 0); __builtin_amdgcn_s_setprio(0); } while (0)
#define PG8_WAIT_V(n) asm volatile("s_waitcnt vmcnt(" #n ")" ::: "memory")
#define PG8_WAIT_L(n) asm volatile("s_waitcnt lgkmcnt(" #n ")" ::: "memory")
#define PG8_BAR __builtin_amdgcn_s_barrier()
#define PG8_SCHED __builtin_amdgcn_sched_barrier(0)
    Unit cur, nxt; int ui = 0;
    if (!S.next(0, cur)) return;
    f32x4 acc[2][2][4][2];
#pragma unroll
    for (int a = 0; a < 2; ++a)
#pragma unroll
        for (int b = 0; b < 2; ++b)
#pragma unroll
            for (int m = 0; m < 4; ++m)
#pragma unroll
                for (int n = 0; n < 2; ++n) acc[a][b][m][n] = (f32x4){0.f, 0.f, 0.f, 0.f};
    bf16x8 At[4][2], B0[2][2], B1[2][2];
    const char* cA = (const char*)g.A + (size_t)cur.pm * tstep; const char* cB = (const char*)g.Bt + (size_t)cur.pn * tstep;
    S.a_ready(cur);
    if constexpr (SP2) {
        PG8_STAGE(PG8_SB(0, 0), cB, voffB); PG8_STAGE(PG8_SB(0, 1), cB + hstep, voffB); PG8_STAGE(PG8_SA(0, 0), cA, voffA); PG8_STAGE(PG8_SA(0, 1), cA + hstepA, voffA);
        if (wr == 1) PG8_BAR;
        PG8_WAIT_V(2); PG8_BAR;
        PG8_STAGE(PG8_SB(1, 0), cB + kstep, voffB); PG8_STAGE(PG8_SA(1, 0), cA + kstep, voffA); PG8_STAGE(PG8_SB(1, 1), cB + hstep + kstep, voffB);
        PG8_WAIT_V(6); PG8_BAR;
    } else {
        PG8_STAGE(PG8_SB(0, 0), cB, voffB); PG8_STAGE(PG8_SA(0, 0), cA, voffA); PG8_STAGE(PG8_SB(0, 1), cB + hstep, voffB); PG8_STAGE(PG8_SA(0, 1), cA + hstepA, voffA);
        if (wr == 1) PG8_BAR;
        PG8_WAIT_V(4); PG8_BAR;
        PG8_STAGE(PG8_SB(1, 0), cB + kstep, voffB); PG8_STAGE(PG8_SA(1, 0), cA + kstep, voffA); PG8_STAGE(PG8_SB(1, 1), cB + hstep + kstep, voffB);
        PG8_WAIT_V(6); PG8_BAR;
    }
    for (;;) {
        const bool has_next = S.next(ui + 1, nxt);
        const char* nA = has_next ? (const char*)g.A + (size_t)nxt.pm * tstep : cA; const char* nB = has_next ? (const char*)g.Bt + (size_t)nxt.pn * tstep : cB;
        for (int t = 0; t < nt; t += 2) {
            const bool last = (t == nt - 2);
            const char* a1 = cA + (size_t)(t + 1) * kstep;
            const char* a2 = last ? nA : cA + (size_t)(t + 2) * kstep; const char* b2 = last ? nB : cB + (size_t)(t + 2) * kstep;
            const char* a3 = a2 + kstep; const char* b3 = b2 + kstep;
            if (last && has_next) S.a_ready(nxt);
            if constexpr (SP2) {
            PG8_LDB(B0, 0, 0); PG8_LDB(B1, 0, 1); PG8_SCHED; PG8_LDA(At, 0, 0); PG8_STAGE(PG8_SA(1, 1), a1 + hstepA, voffA);
            PG8_WAIT_V(8); PG8_WAIT_L(0); PG8_BAR; PG8_MMA(0, 0, At, B0); PG8_MMA(0, 1, At, B1); PG8_BAR; PG8_SCHED;
            PG8_LDA(At, 0, 1); PG8_STAGE(PG8_SB(0, 0), b2, voffB); PG8_STAGE(PG8_SB(0, 1), b2 + hstep, voffB); PG8_STAGE(PG8_SA(0, 0), a2, voffA);
            PG8_WAIT_V(8); PG8_WAIT_L(0); PG8_BAR; PG8_MMA(1, 0, At, B0); PG8_MMA(1, 1, At, B1); PG8_BAR; PG8_SCHED;
            PG8_LDB(B0, 1, 0); PG8_LDB(B1, 1, 1); PG8_SCHED; PG8_LDA(At, 1, 0); PG8_STAGE(PG8_SA(0, 1), a2 + hstepA, voffA);
            PG8_WAIT_V(8); PG8_WAIT_L(0); PG8_BAR; PG8_MMA(0, 0, At, B0); PG8_MMA(0, 1, At, B1); PG8_BAR; PG8_SCHED;
            PG8_LDA(At, 1, 1); PG8_STAGE(PG8_SB(1, 0), b3, voffB); PG8_STAGE(PG8_SB(1, 1), b3 + hstep, voffB); PG8_STAGE(PG8_SA(1, 0), a3, voffA);
            PG8_WAIT_V(8); PG8_WAIT_L(0); PG8_BAR; PG8_MMA(1, 0, At, B0); PG8_MMA(1, 1, At, B1); PG8_BAR; PG8_SCHED;
            } else {
            PG8_LDB(B0, 0, 0); PG8_SCHED; PG8_LDA(At, 0, 0); PG8_STAGE(PG8_SA(1, 1), a1 + hstepA, voffA);
            PG8_WAIT_L(8); PG8_BAR; PG8_WAIT_L(0); PG8_MMA(0, 0, At, B0); PG8_BAR; PG8_SCHED;
            PG8_LDB(B1, 0, 1); PG8_STAGE(PG8_SB(0, 0), b2, voffB);
            PG8_BAR; PG8_WAIT_L(0); PG8_MMA(0, 1, At, B1); PG8_BAR;
            PG8_LDA(At, 0, 1); PG8_STAGE(PG8_SA(0, 0), a2, voffA);
            PG8_BAR; PG8_WAIT_L(0); PG8_MMA(1, 0, At, B0); PG8_BAR; PG8_SCHED;
            PG8_STAGE(PG8_SB(0, 1), b2 + hstep, voffB);
            PG8_WAIT_V(6); PG8_BAR; PG8_MMA(1, 1, At, B1); PG8_BAR;
            PG8_LDB(B0, 1, 0); PG8_SCHED; PG8_LDA(At, 1, 0); PG8_STAGE(PG8_SA(0, 1), a2 + hstepA, voffA);
            PG8_WAIT_L(8); PG8_BAR; PG8_WAIT_L(0); PG8_MMA(0, 0, At, B0); PG8_BAR; PG8_SCHED;
            PG8_LDB(B1, 1, 1); PG8_STAGE(PG8_SB(1, 0), b3, voffB);
            PG8_BAR; PG8_WAIT_L(0); PG8_MMA(0, 1, At, B1); PG8_BAR;
            PG8_LDA(At, 1, 1); PG8_STAGE(PG8_SA(1, 0), a3, voffA);
            PG8_BAR; PG8_WAIT_L(0); PG8_MMA(1, 0, At, B0); PG8_BAR; PG8_SCHED;
            PG8_STAGE(PG8_SB(1, 1), b3 + hstep, voffB);
            PG8_WAIT_V(6); PG8_BAR; PG8_MMA(1, 1, At, B1); PG8_BAR;
            }
        }
        if constexpr (ALIGN_EPI) { if (wr == 0) PG8_BAR; }
        if constexpr (!Epi::AFTER_DRAIN) { E(acc, cur, wr, wc, fr, fq); S.done(cur); }
        if (!has_next) break;
#pragma unroll
        for (int a = 0; a < 2; ++a)
#pragma unroll
            for (int b = 0; b < 2; ++b)
#pragma unroll
                for (int m = 0; m < 4; ++m)
#pragma unroll
                    for (int n = 0; n < 2; ++n) acc[a][b][m][n] = (f32x4){0.f, 0.f, 0.f, 0.f};
        cur = nxt; cA = nA; cB = nB; ++ui;
        if constexpr (ALIGN_EPI) { if (wr == 1) PG8_BAR; }
    }
    PG8_WAIT_V(0);
    if constexpr (!ALIGN_EPI) { if (wr == 0) PG8_BAR; }
    PG8_BAR;
    if constexpr (Epi::AFTER_DRAIN) { E.fused(acc, cur, wr, wc, fr, fq, lds, wid, lane); S.done(cur); }
#undef PG8_SA
#undef PG8_SB
#undef PG8_STAGE
#undef PG8_LDA
#undef PG8_LDB
#undef PG8_MMA
#undef PG8_WAIT_V
#undef PG8_WAIT_L
#undef PG8_BAR
#undef PG8_SCHED
}
}

using pg8::bf16_t; using pg8::bf16x8; using pg8::f32x4; using pg8::u32x4;
typedef unsigned u32x2 __attribute__((ext_vector_type(2)));
using pg8::f32x2;
typedef short s16x4 __attribute__((ext_vector_type(4)));
#define LAS __attribute__((address_space(3)))

constexpr int NTHREADS = 512;
constexpr int MTOK = 65536, DM = 1024, SEQ = 2048, NBATCH = 32, DEPTH = 4;
constexpr int NPROJ = 2304;
constexpr int INW = 2176;
constexpr int DFF = 2816, DFF2 = 5632;
constexpr int MEMROWS = 8192;
constexpr int MHALF = 32768;
constexpr float EPSF = 1e-6f;
constexpr float LOG2E = 1.4426950408889634f;
constexpr int LDS_BYTES = 155648;
constexpr int LDS_UNIT_OFF = 155648 - 64;
constexpr int LDS_TBL_OFF = 155648 - 512;

constexpr size_t MiB = 1u << 20;
constexpr size_t WS_CTL = 0;
constexpr size_t WS_ST = 1 * MiB;
constexpr size_t WS_STM = 5 * MiB;
constexpr size_t WS_CS = 5 * MiB + 512 * 1024;
constexpr size_t WS_KST = 6 * MiB;
constexpr size_t WS_QST = 14 * MiB;
constexpr size_t WS_MEMB = 22 * MiB;
constexpr size_t WS_W = 38 * MiB;
constexpr size_t W_LAYER = 27 * MiB;
constexpr size_t W_IN = 0, W_OUT = (size_t)(4.5 * MiB), W_Q = (size_t)(6.5 * MiB), W_O = (size_t)(8.5 * MiB), W_UP = (size_t)(10.5 * MiB), W_DOWN = (size_t)(21.5 * MiB);
constexpr size_t WS_WKV = WS_W + 4 * W_LAYER;
constexpr size_t WS_HB = 162 * MiB;
constexpr size_t WS_KV = 290 * MiB;
constexpr size_t WS_BIG = 418 * MiB;
constexpr size_t WS_PROJ = WS_BIG;
constexpr size_t WS_MIXED = WS_BIG + 288 * MiB;
constexpr size_t WS_QM = WS_MIXED + 128 * MiB;
constexpr size_t WS_ACT = WS_BIG;
constexpr size_t WS_SG = WS_BIG + 352 * MiB;
constexpr size_t WS_SU = WS_BIG + 376 * MiB;
constexpr size_t WS_END = WS_QM + 128 * MiB;
static_assert(WS_WKV + 16 * MiB <= WS_HB, "ws map");
static_assert(WS_SU + 12 * MiB <= WS_END, "ws map");

struct Args { const float* in[28]; float* out; unsigned char* ws; };
struct Ctx { LAS const unsigned long long* tbl; float* out; unsigned char* ws; int wv; };
__device__ __forceinline__ const float* inptr(const Ctx& c, int i) {
    const unsigned long long v = c.tbl[i];
    const unsigned lo = __builtin_amdgcn_readfirstlane((unsigned)v), hi = __builtin_amdgcn_readfirstlane((unsigned)(v >> 32));
    return (const float*)(((unsigned long long)hi << 32) | lo);
}

__device__ __forceinline__ float bf2f(unsigned short b) { return __uint_as_float(((unsigned)b) << 16); }
__device__ __forceinline__ float bflo(unsigned w) { return __uint_as_float(w << 16); }
__device__ __forceinline__ float bfhi(unsigned w) { return __uint_as_float(w & 0xffff0000u); }
__device__ __forceinline__ unsigned pkbf(float lo, float hi) { unsigned r; asm("v_cvt_pk_bf16_f32 %0, %1, %2" : "=v"(r) : "v"(lo), "v"(hi)); return r; }
__device__ __forceinline__ unsigned short f2bf(float f) { return (unsigned short)(pkbf(f, 0.f) & 0xffffu); }
__device__ __forceinline__ float shx(float v, int lane, int m) { return __int_as_float(__builtin_amdgcn_ds_bpermute((lane ^ m) << 2, __float_as_int(v))); }
__device__ __forceinline__ float shi(float v, int src) { return __int_as_float(__builtin_amdgcn_ds_bpermute(src << 2, __float_as_int(v))); }
__device__ __forceinline__ float wave_sum(float v, int lane) {
#pragma unroll
    for (int o = 1; o < 64; o <<= 1) v += shx(v, lane, o);
    return v;
}
__device__ __forceinline__ float sigmoidf_(float x) { return __builtin_amdgcn_rcpf(1.0f + __builtin_amdgcn_exp2f(-LOG2E * x)); }
__device__ __forceinline__ float gelu_tanh(float x) {
    const float u2 = (-2.0f * 0.7978845608028654f * LOG2E) * (x + 0.044715f * x * x * x);
    return x * __builtin_amdgcn_rcpf(1.0f + __builtin_amdgcn_exp2f(u2));
}
__device__ __forceinline__ LAS unsigned char* lds_l(LAS unsigned char* p) { unsigned v = (unsigned)(uintptr_t)p; asm volatile("" : "+s"(v)); return (LAS unsigned char*)(uintptr_t)v; }
__device__ __forceinline__ int tid_w(int wv) { int t = (wv << 6) + (int)__builtin_amdgcn_mbcnt_hi(~0u, __builtin_amdgcn_mbcnt_lo(~0u, 0u)); asm volatile("" : "+v"(t)); return t; }
__device__ __forceinline__ pg8::f32x2 gelu_tanh2(pg8::f32x2 x) {
    const float K1 = -2.0f * 0.7978845608028654f * LOG2E, K2 = K1 * 0.044715f;
    const pg8::f32x2 t = x * (x * x * K2 + K1);
    const pg8::f32x2 dn = (pg8::f32x2){__builtin_amdgcn_exp2f(t.x), __builtin_amdgcn_exp2f(t.y)} + 1.0f;
    return x * (pg8::f32x2){__builtin_amdgcn_rcpf(dn.x), __builtin_amdgcn_rcpf(dn.y)};
}
__device__ __forceinline__ s16x4 vtr(LAS const unsigned char* p) {
    typedef short v4i16_t __attribute__((ext_vector_type(4)));
    return __builtin_bit_cast(s16x4, __builtin_amdgcn_ds_read_tr16_b64_v4i16((LAS v4i16_t*)p));
}

#define LBAR() do { asm volatile("s_waitcnt lgkmcnt(0)" ::: "memory"); __builtin_amdgcn_s_barrier(); asm volatile("" ::: "memory"); } while (0)

template <bool QKN> struct EpiBf {
    static constexpr bool PERM = true, AFTER_DRAIN = false;
    bf16_t* O; int ldc; const float* st; float* pst; int npg; const float* cs; const float* qg; const float* kg;
    __device__ __forceinline__ void operator()(const f32x4 (&acc)[2][2][4][2], const pg8::Unit& u, int wr, int wc, int fr, int fq) const {
        const int lane = fq * 16 + fr;
        int kind = 0; const float* gsel = nullptr;
        if (QKN) { const int c0 = u.pn * 256 + 64 * wc; if (c0 >= 256 && c0 < 640) { kind = 1; gsel = qg; } else if (c0 >= 640 && c0 < 1024) { kind = 2; gsel = kg; } }
        const int rbase = u.pm * 256 + wr * 64 + fr;
        float rloc[2];
#pragma unroll
        for (int k = 0; k < 2; ++k) {
            const int i = 2 * fq + k, r = rbase + (i >> 2) * 128 + (i & 3) * 16;
            const f32x4* sp = (const f32x4*)(st + (size_t)r * 16);
            const f32x4 s0 = sp[0], s1 = sp[1], s2 = sp[2], s3 = sp[3];
            const float ssum = ((s0[0] + s0[1]) + (s0[2] + s0[3])) + ((s1[0] + s1[1]) + (s1[2] + s1[3])) + ((s2[0] + s2[1]) + (s2[2] + s2[3])) + ((s3[0] + s3[1]) + (s3[2] + s3[3]));
            rloc[k] = rsqrtf(ssum * (1.0f / 1024.0f) + EPSF);
        }
        f32x4 cf[2][2];
#pragma unroll
        for (int bj = 0; bj < 2; ++bj)
#pragma unroll
            for (int n = 0; n < 2; ++n) {
                cf[bj][n] = (f32x4){1.f, 1.f, 1.f, 1.f};
                if (QKN) { if (kind != 0) cf[bj][n] = *(const f32x4*)(gsel + 32 * bj + 8 * fq + 4 * n); }
                else if (cs) cf[bj][n] = *(const f32x4*)(cs + u.pn * 256 + bj * 128 + wc * 32 + 8 * fq + 4 * n);
            }
#pragma unroll
        for (int ai = 0; ai < 2; ++ai)
#pragma unroll
            for (int m = 0; m < 4; ++m) {
                const int r = rbase + ai * 128 + m * 16;
                const float rsv = shi(rloc[m & 1], (ai * 2 + (m >> 1)) * 16 + fr);
                f32x4 v[2][2];
#pragma unroll
                for (int bj = 0; bj < 2; ++bj)
#pragma unroll
                    for (int n = 0; n < 2; ++n) v[bj][n] = acc[ai][bj][m][n] * rsv;
                if (QKN) {
                    if (kind != 0) {
                        float ss = 0.f;
#pragma unroll
                        for (int bj = 0; bj < 2; ++bj)
#pragma unroll
                            for (int n = 0; n < 2; ++n) ss += (v[bj][n][0] * v[bj][n][0] + v[bj][n][1] * v[bj][n][1]) + (v[bj][n][2] * v[bj][n][2] + v[bj][n][3] * v[bj][n][3]);
                        ss += shx(ss, lane, 16); ss += shx(ss, lane, 32);
                        float rn = rsqrtf(ss * (1.0f / 64.0f) + EPSF);
                        if (kind == 1) rn *= 0.125f * LOG2E;
#pragma unroll
                        for (int bj = 0; bj < 2; ++bj)
#pragma unroll
                            for (int n = 0; n < 2; ++n) v[bj][n] = v[bj][n] * rn * cf[bj][n];
                    }
                } else {
                    if (pst) {
#pragma unroll
                        for (int bj = 0; bj < 2; ++bj) {
                            float ss = (v[bj][0][0] * v[bj][0][0] + v[bj][0][1] * v[bj][0][1]) + (v[bj][0][2] * v[bj][0][2] + v[bj][0][3] * v[bj][0][3])
                                     + (v[bj][1][0] * v[bj][1][0] + v[bj][1][1] * v[bj][1][1]) + (v[bj][1][2] * v[bj][1][2] + v[bj][1][3] * v[bj][1][3]);
                            ss += shx(ss, lane, 16); ss += shx(ss, lane, 32);
                            if (fq == 0) pst[(size_t)r * npg + (u.pn * 8 + bj * 4 + wc)] = ss;
                        }
                    }
                    if (cs) {
#pragma unroll
                        for (int bj = 0; bj < 2; ++bj)
#pragma unroll
                            for (int n = 0; n < 2; ++n) v[bj][n] = v[bj][n] * cf[bj][n];
                    }
                }
#pragma unroll
                for (int bj = 0; bj < 2; ++bj) {
                    const int col = QKN ? (u.pn * 256 + 64 * wc + 32 * bj + 8 * fq) : (u.pn * 256 + 128 * bj + 32 * wc + 8 * fq);
                    u32x4 w; w.x = pkbf(v[bj][0][0], v[bj][0][1]); w.y = pkbf(v[bj][0][2], v[bj][0][3]); w.z = pkbf(v[bj][1][0], v[bj][1][1]); w.w = pkbf(v[bj][1][2], v[bj][1][3]);
                    *(u32x4*)(O + (size_t)r * ldc + col) = w;
                }
            }
    }
};

struct EpiRes {
    static constexpr bool PERM = false, AFTER_DRAIN = false;
    const float* resid; float* out; bf16_t* hb; float* st;
    __device__ __forceinline__ void operator()(const f32x4 (&acc)[2][2][4][2], const pg8::Unit& u, int wr, int wc, int fr, int fq) const {
        const int lane = fq * 16 + fr;
        const int rbase = u.pm * 256 + wr * 64 + fr, cbase = u.pn * 256 + wc * 32 + 4 * fq;
        f32x4 pre[3][2][2];
#define EPIRES_LOAD(I) do { const size_t ro_ = (size_t)(rbase + ((I) >> 2) * 128 + ((I) & 3) * 16) * DM + cbase; \
            _Pragma("unroll") for (int bj = 0; bj < 2; ++bj) _Pragma("unroll") for (int n = 0; n < 2; ++n) pre[(I) % 3][bj][n] = *(const f32x4*)(resid + ro_ + bj * 128 + n * 16); } while (0)
        EPIRES_LOAD(0); EPIRES_LOAD(1); EPIRES_LOAD(2);
#pragma unroll
        for (int i = 0; i < 8; ++i) {
            const int ai = i >> 2, m = i & 3;
            const int r = rbase + ai * 128 + m * 16;
            float ss = 0.f;
            f32x4 v[2][2];
#pragma unroll
            for (int bj = 0; bj < 2; ++bj)
#pragma unroll
                for (int n = 0; n < 2; ++n) v[bj][n] = pre[i % 3][bj][n] + acc[ai][bj][m][n];
            asm volatile("" ::: "memory");
            if (i + 3 < 8) EPIRES_LOAD(i + 3);
            asm volatile("" ::: "memory");
#pragma unroll
            for (int bj = 0; bj < 2; ++bj)
#pragma unroll
                for (int n = 0; n < 2; ++n) {
                    const size_t off = (size_t)r * DM + cbase + bj * 128 + n * 16;
                    *(f32x4*)(out + off) = v[bj][n];
                    if (hb) {
                        u32x2 w; w.x = pkbf(v[bj][n][0], v[bj][n][1]); w.y = pkbf(v[bj][n][2], v[bj][n][3]);
                        *(u32x2*)(hb + off) = w;
                        ss += (v[bj][n][0] * v[bj][n][0] + v[bj][n][1] * v[bj][n][1]) + (v[bj][n][2] * v[bj][n][2] + v[bj][n][3] * v[bj][n][3]);
                    }
                }
            if (hb) {
                ss += shx(ss, lane, 16); ss += shx(ss, lane, 32);
                if (fq == 0) st[(size_t)r * 16 + u.pn * 4 + wc] = ss;
            }
        }
#undef EPIRES_LOAD
    }
};

struct EpiAct {
    static constexpr bool PERM = true, AFTER_DRAIN = false;
    bf16_t* act; const float* st; const float* cw; const float* cb; float* sg; float* su;
    __device__ __forceinline__ void operator()(const f32x4 (&acc)[2][2][4][2], const pg8::Unit& u, int wr, int wc, int fr, int fq) const {
        const int lane = fq * 16 + fr;
        const int tok0 = u.pm * 256 + (16 * wr + fr) * 8;
        const int f0 = u.pn * 128 + 32 * wc + 8 * fq;
        f32x2 W0[4], W1[4], W2[4], BBv[4];
#pragma unroll
        for (int q = 0; q < 4; ++q) {
            W0[q] = *(const f32x2*)(cw + f0 + 2 * q); W1[q] = *(const f32x2*)(cw + DFF + f0 + 2 * q);
            W2[q] = *(const f32x2*)(cw + 2 * DFF + f0 + 2 * q); BBv[q] = *(const f32x2*)(cb + f0 + 2 * q);
        }
        float rloc[2], rs[8];
#pragma unroll
        for (int k = 0; k < 2; ++k) {
            const f32x4* sp = (const f32x4*)(st + (size_t)(tok0 + 2 * fq + k) * 16);
            const f32x4 s0 = sp[0], s1 = sp[1], s2 = sp[2], s3 = sp[3];
            const float ssum = ((s0[0] + s0[1]) + (s0[2] + s0[3])) + ((s1[0] + s1[1]) + (s1[2] + s1[3])) + ((s2[0] + s2[1]) + (s2[2] + s2[3])) + ((s3[0] + s3[1]) + (s3[2] + s3[3]));
            rloc[k] = rsqrtf(ssum * (1.0f / 1024.0f) + EPSF);
        }
#pragma unroll
        for (int e = 0; e < 8; ++e) rs[e] = shi(rloc[e & 1], (e >> 1) * 16 + fr);
        float* sgp = sg + ((size_t)u.pm * 8 + wr * 4) * DFF + f0;
        float* sup = su + ((size_t)u.pm * 4 + wr * 2) * DFF + f0;
#pragma unroll
        for (int n = 0; n < 2; ++n) {
            unsigned res[8][2];
#pragma unroll
            for (int ip = 0; ip < 2; ++ip) {
                const int c0 = 4 * n + 2 * ip;
                f32x2 g[8], uu[8];
#pragma unroll
                for (int e = 0; e < 8; ++e) {
                    const f32x2 rv = (f32x2){rs[e], rs[e]};
                    g[e] = (f32x2){acc[e >> 2][0][e & 3][n][2 * ip], acc[e >> 2][0][e & 3][n][2 * ip + 1]} * rv;
                    uu[e] = (f32x2){acc[e >> 2][1][e & 3][n][2 * ip], acc[e >> 2][1][e & 3][n][2 * ip + 1]} * rv;
                }
                const f32x2 p1 = (f32x2){shi(g[7].x, lane - 1), shi(g[7].y, lane - 1)};
                const f32x2 p2 = (f32x2){shi(g[6].x, lane - 1), shi(g[6].y, lane - 1)};
                const f32x2 w0 = W0[2 * n + ip], w1 = W1[2 * n + ip], w2 = W2[2 * n + ip], bb = BBv[2 * n + ip];
                const float K1 = -2.0f * 0.7978845608028654f * LOG2E, K2 = K1 * 0.044715f;
#pragma unroll
                for (int e = 0; e < 8; ++e) {
                    const f32x2 gm1 = (e >= 1) ? g[e >= 1 ? e - 1 : 0] : p1;
                    const f32x2 gm2 = (e >= 2) ? g[e >= 2 ? e - 2 : 0] : (e == 1 ? p1 : p2);
                    const f32x2 cvv = bb + w0 * g[e] + w1 * gm1 + w2 * gm2;
                    const f32x2 t = cvv * (cvv * cvv * K2 + K1);
                    const f32x2 dn = (f32x2){__builtin_amdgcn_exp2f(t.x), __builtin_amdgcn_exp2f(t.y)} + 1.0f;
                    const f32x2 av = cvv * (f32x2){__builtin_amdgcn_rcpf(dn.x), __builtin_amdgcn_rcpf(dn.y)} * uu[e];
                    res[e][ip] = pkbf(av.x, av.y);
                }
                if (fr == 0) { *(f32x2*)(sgp + c0) = g[0]; *(f32x2*)(sgp + DFF + c0) = g[1]; *(f32x2*)(sup + c0) = uu[0]; *(f32x2*)(sup + DFF + c0) = uu[1]; }
                if (fr == 15) { *(f32x2*)(sgp + 2 * DFF + c0) = g[6]; *(f32x2*)(sgp + 3 * DFF + c0) = g[7]; }
            }
#pragma unroll
            for (int e = 0; e < 8; ++e) {
                if (fr == 0 && e < 2) continue;
                u32x2 w; w.x = res[e][0]; w.y = res[e][1];
                *(u32x2*)(act + (size_t)(tok0 + e) * DFF + f0 + 4 * n) = w;
            }
            asm volatile("" ::: "memory");
        }
    }
};

template <class Epi>
__device__ __forceinline__ void run_gemm(int cv, int wv, LAS unsigned char* lds, const bf16_t* A, const bf16_t* Bt, int M, int N, int K, const Epi& E) {
    pg8::Gemm g{A, Bt, M, N, K}; pg8::StaticOrder S; S.init(M, N, (int)gridDim.x, cv);
    pg8::gemm_phase<Epi, pg8::StaticOrder, true, true>(tid_w(wv), lds_l(lds), g, S, E);
}
template <class Epi>
__device__ __forceinline__ void run_gemm_aperm(int cv, int wv, LAS unsigned char* lds, const bf16_t* A, const bf16_t* Bt, int M, int N, int K, const Epi& E) {
    pg8::Gemm g{A, Bt, M, N, K}; pg8::StaticOrder S; S.init(M, N, (int)gridDim.x, cv);
    pg8::gemm_phase<Epi, pg8::StaticOrder, true, true, true>(tid_w(wv), lds_l(lds), g, S, E);
}

__device__ __forceinline__ void transpose_item(const float* W, int ldw, int K, const float* gain, bf16_t* WT, int dst_row0, bool zero, LAS float* scr, int k0, int n0, int lane) {
#pragma unroll 8
    for (int i = 0; i < 32; ++i) {
        const int kk = 2 * i + (lane >> 5);
        float v = 0.f;
        if (!zero) { v = W[(size_t)(k0 + kk) * ldw + n0 + (lane & 31)]; if (gain) v *= gain[k0 + kk]; }
        scr[kk * 33 + (lane & 31)] = v;
    }
    asm volatile("s_waitcnt lgkmcnt(0)" ::: "memory");
    const int c = lane & 7;
#pragma unroll
    for (int j = 0; j < 4; ++j) {
        const int n = (lane >> 3) + 8 * j; const LAS float* s = scr + (8 * c) * 33 + n;
        u32x4 o; o.x = pkbf(s[0 * 33], s[1 * 33]); o.y = pkbf(s[2 * 33], s[3 * 33]); o.z = pkbf(s[4 * 33], s[5 * 33]); o.w = pkbf(s[6 * 33], s[7 * 33]);
        *(u32x4*)(WT + (size_t)(dst_row0 + n) * K + k0 + 8 * c) = o;
    }
    asm volatile("s_waitcnt lgkmcnt(0)" ::: "memory");
}
__device__ __forceinline__ void rows4_to_bf16(const float* x, bf16_t* o, float* stp, int m0, int mstep, int mend, int lane) {
    f32x4 v[4][4];
#pragma unroll
    for (int q = 0; q < 4; ++q) {
        const int m = m0 + q * mstep;
        const f32x4* xr = (const f32x4*)(x + (size_t)(m < mend ? m : m0) * DM) + lane;
#pragma unroll
        for (int j = 0; j < 4; ++j) v[q][j] = xr[64 * j];
    }
#pragma unroll
    for (int q = 0; q < 4; ++q) {
        const int m = m0 + q * mstep;
        float s = 0.f;
#pragma unroll
        for (int j = 0; j < 4; ++j) s += (v[q][j][0] * v[q][j][0] + v[q][j][1] * v[q][j][1]) + (v[q][j][2] * v[q][j][2] + v[q][j][3] * v[q][j][3]);
        s = wave_sum(s, lane);
        if (m < mend) {
            u32x2* o8 = (u32x2*)(o + (size_t)m * DM) + lane;
#pragma unroll
            for (int j = 0; j < 4; ++j) { u32x2 w; w.x = pkbf(v[q][j][0], v[q][j][1]); w.y = pkbf(v[q][j][2], v[q][j][3]); o8[64 * j] = w; }
            if (lane < 16) stp[(size_t)m * 16 + lane] = (lane == 0) ? s : 0.f;
        }
    }
}
__device__ __forceinline__ void phase_prologue(const Ctx& a, LAS unsigned char* lds) {
    lds = lds_l(lds);
    const int tid = tid_w(a.wv), lane = tid & 63, wave = tid >> 6;
    LAS float* scr = (LAS float*)(lds + wave * 16384);
    const int gw = blockIdx.x * 8 + wave, NGW = gridDim.x * 8;
    unsigned char* ws = a.ws;
    constexpr int I_IN = 16 * 72, I_SQ = 16 * 32, I_UP = 16 * 176, I_DN = 44 * 32, I_KV = 16 * 64;
    constexpr int I_LAYER = I_IN + 3 * I_SQ + I_UP + I_DN + I_KV;
    for (int it = gw; it < DEPTH * I_LAYER; it += NGW) {
        const int l = it / I_LAYER; int r = it % I_LAYER;
        bf16_t* wl = (bf16_t*)(ws + WS_W + (size_t)l * W_LAYER);
        if (r < I_IN) {
            const int kb = r / 72, nb = r % 72, n0 = nb * 32;
            const int dst = (n0 & ~255) + 128 * ((n0 >> 5) & 1) + 32 * ((n0 >> 6) & 3);
            transpose_item(inptr(a, 3) + (size_t)l * DM * INW, INW, DM, inptr(a, 2) + l * DM, (bf16_t*)((unsigned char*)wl + W_IN), dst, n0 >= INW, scr, kb * 64, n0, lane);
            continue;
        }
        r -= I_IN;
        if (r < I_SQ) { transpose_item(inptr(a, 15) + (size_t)l * DM * DM, DM, DM, nullptr, (bf16_t*)((unsigned char*)wl + W_OUT), (r % 32) * 32, false, scr, (r / 32) * 64, (r % 32) * 32, lane); continue; }
        r -= I_SQ;
        if (r < I_SQ) { transpose_item(inptr(a, 18) + (size_t)l * DM * DM, DM, DM, inptr(a, 16) + l * DM, (bf16_t*)((unsigned char*)wl + W_Q), (r % 32) * 32, false, scr, (r / 32) * 64, (r % 32) * 32, lane); continue; }
        r -= I_SQ;
        if (r < I_SQ) { transpose_item(inptr(a, 22) + (size_t)l * DM * DM, DM, DM, nullptr, (bf16_t*)((unsigned char*)wl + W_O), (r % 32) * 32, false, scr, (r / 32) * 64, (r % 32) * 32, lane); continue; }
        r -= I_SQ;
        if (r < I_UP) { transpose_item(inptr(a, 24) + (size_t)l * DM * DFF2, DFF2, DM, inptr(a, 23) + l * DM, (bf16_t*)((unsigned char*)wl + W_UP), ((((r % 176) * 32) % DFF) / 128) * 256 + 128 * (((r % 176) * 32) / DFF) + (((r % 176) * 32) % DFF) % 128, false, scr, (r / 176) * 64, (r % 176) * 32, lane); continue; }
        r -= I_UP;
        if (r < I_DN) { transpose_item(inptr(a, 27) + (size_t)l * DFF * DM, DM, DFF, nullptr, (bf16_t*)((unsigned char*)wl + W_DOWN), (r % 32) * 32, false, scr, (r / 32) * 64, (r % 32) * 32, lane); continue; }
        r -= I_DN;
        transpose_item(inptr(a, 19) + (size_t)l * DM * 2048, 2048, DM, inptr(a, 17) + l * DM, (bf16_t*)(ws + WS_WKV), l * 2048 + (r % 64) * 32, false, scr, (r / 64) * 64, (r % 64) * 32, lane);
    }
    for (int i = blockIdx.x * NTHREADS + tid; i < DEPTH * DM; i += gridDim.x * NTHREADS) { const int l = i >> 10, dd = i & 255; ((float*)(ws + WS_CS))[i] = inptr(a, 20)[l * 256 + dd] * inptr(a, 21)[l * 256 + dd] * (0.0625f * LOG2E); }
    for (int m = gw; m < MTOK; m += 4 * NGW) rows4_to_bf16(inptr(a, 0), (bf16_t*)(ws + WS_HB), (float*)(ws + WS_ST), m, NGW, MTOK, lane);
    for (int m = gw; m < MEMROWS; m += 4 * NGW) rows4_to_bf16(inptr(a, 1), (bf16_t*)(ws + WS_MEMB), (float*)(ws + WS_STM), m, NGW, MEMROWS, lane);
}

__device__ __forceinline__ void lru_unit(const Ctx& a, int l, int b, int g, LAS unsigned char* lds) {
    lds = lds_l(lds);
    const int tid = tid_w(a.wv), lane = tid & 63, wave = tid >> 6, l15 = lane & 15, gq = lane >> 4;
    LAS unsigned char* XT = lds;
    LAS unsigned char* XCB = lds + 19008;
    LAS float* XCF = (LAS float*)(lds + 37440);
    LAS float* AA = (LAS float*)(lds + 70208);
    LAS float* BB = (LAS float*)(lds + 102976);
    LAS unsigned char* WT = lds + 135744;
    const bf16_t* proj = (const bf16_t*)(a.ws + WS_PROJ) + (size_t)b * SEQ * NPROJ;
    bf16_t* mixed = (bf16_t*)(a.ws + WS_MIXED) + (size_t)b * SEQ * DM;
    const float* wa = inptr(a, 10) + ((size_t)l * 6 + g) * 4096; const float* wx = inptr(a, 12) + ((size_t)l * 6 + g) * 4096;
    for (int k = 0; k < 16; ++k) {
        const int idx = tid + 512 * k, which = idx >> 12, cp = (idx >> 6) & 63, c = idx & 63;
        const float v = which ? wx[cp * 64 + c] : wa[cp * 64 + c];
        *(LAS unsigned short*)(WT + (which * 64 + c) * 144 + cp * 2) = f2bf(v);
    }
    const int cch = tid & 63, ch = g * 64 + cch;
    float cw[4];
#pragma unroll
    for (int j = 0; j < 4; ++j) cw[j] = inptr(a, 8)[((size_t)l * 4 + j) * 384 + ch];
    const float cb = inptr(a, 9)[l * 384 + ch];
    float gba[4], gbx[4], gsp[4];
#pragma unroll
    for (int nt = 0; nt < 4; ++nt) {
        const int c2 = l * 384 + g * 64 + 16 * nt + l15;
        gba[nt] = inptr(a, 11)[c2]; gbx[nt] = inptr(a, 13)[c2];
        const float z = -inptr(a, 14)[c2];
        gsp[nt] = (8.0f * LOG2E) * (fmaxf(z, 0.f) + log1pf(__expf(-fabsf(z))));
    }
#pragma unroll
    for (int j = 0; j < 4; ++j) { asm volatile("" : "+v"(cw[j])); asm volatile("" : "+v"(gba[j])); asm volatile("" : "+v"(gbx[j])); asm volatile("" : "+v"(gsp[j])); }
    float cbv = cb; asm volatile("" : "+v"(cbv));
    float hcar = 0.f;
    const bf16_t* xsrc = proj + 1408 + g * 64;
    const bf16_t* ysrc = proj + 1792 + g * 64;
    u32x4 xr[3];
#pragma unroll
    for (int k = 0; k < 3; ++k) {
        const int idx = tid + 512 * k, row = idx >> 3, cv = idx & 7, tok = row - 3;
        xr[k] = (idx < 1048 && tok >= 0) ? *(const u32x4*)(xsrc + (size_t)tok * NPROJ + cv * 8) : (u32x4){0u, 0u, 0u, 0u};
    }
#pragma unroll 1
    for (int ck = 0; ck < 16; ++ck) {
        const int t0 = ck * 128;
#pragma unroll
        for (int k = 0; k < 3; ++k) { const int idx = tid + 512 * k, row = idx >> 3, cv = idx & 7; if (idx < 1048) *(LAS u32x4*)(XT + row * 144 + cv * 16) = xr[k]; }
        u32x4 yr[2];
#pragma unroll
        for (int k = 0; k < 2; ++k) { const int idx = lane + 64 * k, row = 16 * wave + (idx >> 3), cv = idx & 7; yr[k] = *(const u32x4*)(ysrc + (size_t)(t0 + row) * NPROJ + cv * 8); }
        if (ck < 15) {
#pragma unroll
            for (int k = 0; k < 3; ++k) {
                const int idx = tid + 512 * k, row = idx >> 3, cv = idx & 7, tok = t0 + 128 - 3 + row;
                xr[k] = (idx < 1048) ? *(const u32x4*)(xsrc + (size_t)tok * NPROJ + cv * 8) : (u32x4){0u, 0u, 0u, 0u};
            }
        }
        LBAR();
#pragma unroll 4
        for (int k = 0; k < 16; ++k) {
            const int t = 16 * wave + k;
            float xc = cbv;
#pragma unroll
            for (int j = 0; j < 4; ++j) xc += cw[j] * bf2f(*(LAS const unsigned short*)(XT + (t + 3 - j) * 144 + cch * 2));
            XCF[t * 64 + cch] = xc;
            *(LAS unsigned short*)(XCB + t * 144 + cch * 2) = f2bf(xc);
        }
        asm volatile("s_waitcnt lgkmcnt(0)" ::: "memory");
        {
            f32x4 acc[8];
#pragma unroll
            for (int nt = 0; nt < 8; ++nt) acc[nt] = (f32x4){0.f, 0.f, 0.f, 0.f};
#pragma unroll
            for (int ks = 0; ks < 2; ++ks) {
                const bf16x8 af = *(LAS const bf16x8*)(XCB + (16 * wave + l15) * 144 + (32 * ks + 8 * gq) * 2);
#pragma unroll
                for (int nt = 0; nt < 8; ++nt) {
                    const bf16x8 bfr = *(LAS const bf16x8*)(WT + (16 * nt + l15) * 144 + (32 * ks + 8 * gq) * 2);
                    acc[nt] = __builtin_amdgcn_mfma_f32_16x16x32_bf16(af, bfr, acc[nt], 0, 0, 0);
                }
            }
#pragma unroll
            for (int nt = 0; nt < 4; ++nt)
#pragma unroll
                for (int rg = 0; rg < 4; ++rg) {
                    const int t = 16 * wave + 4 * gq + rg, c = 16 * nt + l15;
                    const float r = sigmoidf_(acc[nt][rg] + gba[nt]), ig = sigmoidf_(acc[nt + 4][rg] + gbx[nt]);
                    const float av = __builtin_amdgcn_exp2f(-r * gsp[nt]);
                    const float xcv = XCF[t * 64 + c];
                    AA[t * 64 + c] = av;
                    BB[t * 64 + c] = __builtin_amdgcn_sqrtf(fmaxf(1.0f - av * av, 0.f)) * (ig * xcv);
                }
        }
        asm volatile("s_waitcnt lgkmcnt(0)" ::: "memory");
        {
            float av[16], bv[16];
#pragma unroll
            for (int t = 0; t < 16; ++t) { av[t] = AA[(16 * wave + t) * 64 + lane]; bv[t] = BB[(16 * wave + t) * 64 + lane]; }
            float hl = 0.f, pl = 1.f;
#pragma unroll
            for (int t = 0; t < 16; ++t) { hl = av[t] * hl + bv[t]; pl *= av[t]; bv[t] = hl; av[t] = pl; }
            { LAS float* sw = (LAS float*)(XCB + 16 * wave * 144); sw[lane] = pl; sw[64 + lane] = hl; }
            LBAR();
            float cin = hcar, mycin = 0.f;
#pragma unroll
            for (int w2 = 0; w2 < 8; ++w2) { const LAS float* sw = (const LAS float*)(XCB + 16 * w2 * 144); if (w2 == wave) mycin = cin; cin = sw[lane] * cin + sw[64 + lane]; }
            hcar = cin;
#pragma unroll
            for (int t = 0; t < 16; ++t) BB[(16 * wave + t) * 64 + lane] = bv[t] + av[t] * mycin;
        }
        asm volatile("s_waitcnt lgkmcnt(0)" ::: "memory");
#pragma unroll
        for (int k = 0; k < 2; ++k) {
            const int idx = lane + 64 * k, row = 16 * wave + (idx >> 3), cv = idx & 7;
            const f32x4 h0 = *(LAS const f32x4*)(BB + row * 64 + cv * 8), h1 = *(LAS const f32x4*)(BB + row * 64 + cv * 8 + 4);
            u32x4 w;
            { const f32x2 a = gelu_tanh2((f32x2){bflo(yr[k].x), bfhi(yr[k].x)}) * (f32x2){h0[0], h0[1]}; w.x = pkbf(a.x, a.y); }
            { const f32x2 a = gelu_tanh2((f32x2){bflo(yr[k].y), bfhi(yr[k].y)}) * (f32x2){h0[2], h0[3]}; w.y = pkbf(a.x, a.y); }
            { const f32x2 a = gelu_tanh2((f32x2){bflo(yr[k].z), bfhi(yr[k].z)}) * (f32x2){h1[0], h1[1]}; w.z = pkbf(a.x, a.y); }
            { const f32x2 a = gelu_tanh2((f32x2){bflo(yr[k].w), bfhi(yr[k].w)}) * (f32x2){h1[2], h1[3]}; w.w = pkbf(a.x, a.y); }
            *(u32x4*)(mixed + (size_t)(t0 + row) * DM + 640 + g * 64 + cv * 8) = w;
        }
    }
}

__device__ __forceinline__ void pool_unit(const Ctx& a, int l, int b, int tc, LAS unsigned char* lds) {
    lds = lds_l(lds);
    const int tid = tid_w(a.wv), lane = tid & 63, wave = tid >> 6, l15 = lane & 15, gq = lane >> 4;
    LAS float* U = (LAS float*)lds;
    LAS unsigned char* PB = lds + 80896;
    LAS unsigned char* WT = lds + 114688;
    const int t0 = tc * 64;
    const bf16_t* proj = (const bf16_t*)(a.ws + WS_PROJ) + (size_t)b * SEQ * NPROJ;
    bf16_t* mixed = (bf16_t*)(a.ws + WS_MIXED) + (size_t)b * SEQ * DM;
    for (int k = 0; k < 5; ++k) {
        const int idx = tid + 512 * k;
        if (idx < 79 * 32) {
            const int tt = idx >> 5, cv = idx & 31, t = t0 - 15 + tt;
            u32x4 v = (u32x4){0u, 0u, 0u, 0u};
            if (t >= 0) v = *(const u32x4*)(proj + (size_t)t * NPROJ + cv * 8);
            LAS f32x4* up = (LAS f32x4*)(U + tt * 256 + cv * 8);
            up[0] = (f32x4){bflo(v.x), bfhi(v.x), bflo(v.y), bfhi(v.y)};
            up[1] = (f32x4){bflo(v.z), bfhi(v.z), bflo(v.w), bfhi(v.w)};
        }
    }
    {
        const float* pw = inptr(a, 4) + (size_t)l * 16384;
        for (int k = 0; k < 32; ++k) {
            const int idx = tid + 512 * k, g = idx >> 12, c = (idx >> 6) & 63, d = idx & 63;
            *(LAS unsigned short*)(WT + (g * 64 + d) * 144 + c * 2) = f2bf(pw[idx]);
        }
    }
    LBAR();
    {
        const int c = tid & 255, half = tid >> 8, g = c >> 6, w = 2 << g;
        for (int q = 0; q < 32; ++q) {
            const int tt = half * 32 + q, t = t0 + tt;
            float s = 0.f;
            for (int j = 0; j < w; ++j) s += U[(tt + 15 - j) * 256 + c];
            const float cnt = (float)((t + 1 < w) ? (t + 1) : w);
            *(LAS unsigned short*)(PB + tt * 528 + c * 2) = f2bf(s * __builtin_amdgcn_rcpf(cnt) - U[(tt + 15) * 256 + c]);
        }
    }
    LBAR();
    {
        const int tt = wave & 3, gp = wave >> 2;
        const float* psc = inptr(a, 5) + l * 256;
#pragma unroll 1
        for (int gi = 0; gi < 2; ++gi) {
            const int g = gp * 2 + gi;
            f32x4 acc[4];
#pragma unroll
            for (int nt = 0; nt < 4; ++nt) acc[nt] = (f32x4){0.f, 0.f, 0.f, 0.f};
#pragma unroll
            for (int ks = 0; ks < 2; ++ks) {
                const bf16x8 af = *(LAS const bf16x8*)(PB + (16 * tt + l15) * 528 + (g * 64 + 32 * ks + 8 * gq) * 2);
#pragma unroll
                for (int nt = 0; nt < 4; ++nt) {
                    const bf16x8 bfr = *(LAS const bf16x8*)(WT + (g * 64 + 16 * nt + l15) * 144 + (32 * ks + 8 * gq) * 2);
                    acc[nt] = __builtin_amdgcn_mfma_f32_16x16x32_bf16(af, bfr, acc[nt], 0, 0, 0);
                }
            }
#pragma unroll
            for (int nt = 0; nt < 4; ++nt) {
                const int dcol = g * 64 + 16 * nt + l15;
                const float sc = psc[dcol];
#pragma unroll
                for (int rg = 0; rg < 4; ++rg) mixed[(size_t)(t0 + 16 * tt + 4 * gq + rg) * DM + dcol] = f2bf(acc[nt][rg] * sc);
            }
        }
    }
}

__device__ __forceinline__ void dattn_unit(const Ctx& a, int b, int h, int tb, LAS unsigned char* lds) {
    lds = lds_l(lds);
    const int tid = tid_w(a.wv), lane = tid & 63, wave = tid >> 6, l15 = lane & 15, gq = lane >> 4;
    LAS float* OACC = (LAS float*)lds;
    LAS float* DEN = (LAS float*)(lds + 65536);
    LAS unsigned char* vst = lds + 66560 + wave * 4608;
    const int t0 = tb * 256;
    const bf16_t* projb = (const bf16_t*)(a.ws + WS_PROJ) + (size_t)b * SEQ * NPROJ;
    bf16_t* mixed = (bf16_t*)(a.ws + WS_MIXED) + (size_t)b * SEQ * DM;
    const float slope2 = exp2f(-8.0f * (float)(h + 1) / 6.0f) * LOG2E;
    const int trq = (l15 >> 2), trp = (l15 & 3);
#pragma unroll 1
    for (int pi = 0; pi < 3; ++pi) {
        const int d = 1 << (2 * pi);
        const float sl = slope2 * (float)d;
#pragma unroll 1
        for (int ii = 0; ii < 2; ++ii) {
            const int it = 2 * wave + ii, rr = it % d, jj = it / d, tq0 = t0 + rr + 16 * d * jj;
            const unsigned char* pbytes = (const unsigned char*)projb;
            const unsigned qoff = (unsigned)(tq0 + d * l15) * (unsigned)(NPROJ * 2) + (unsigned)((256 + h * 64 + 8 * gq) * 2);
            const bf16x8 qf0 = *(const bf16x8*)(pbytes + qoff), qf1 = *(const bf16x8*)(pbytes + qoff + 64);
            bf16x8 kf[6][2];
            const int kmin = (640 + h * 64 + 8 * gq) * 2;
            const int koff0 = (tq0 + d * (l15 - 128)) * (NPROJ * 2) + kmin;
            const int kstep = d * 16 * (NPROJ * 2);
#define DATTN_KLOAD(KT) do { if ((KT) < 9) { int ko_ = koff0 + (KT) * kstep; ko_ = ko_ < kmin ? kmin : ko_; \
                kf[(KT) % 6][0] = *(const bf16x8*)(pbytes + (unsigned)ko_); kf[(KT) % 6][1] = *(const bf16x8*)(pbytes + (unsigned)ko_ + 64); } } while (0)
            DATTN_KLOAD(0); DATTN_KLOAD(1); DATTN_KLOAD(2); DATTN_KLOAD(3); DATTN_KLOAD(4); DATTN_KLOAD(5);
            u32x4 vreg[3][4];
            const int vmin = (1024 + h * 64 + (lane & 7) * 8) * 2, vmax = (SEQ - 1) * (NPROJ * 2) + vmin;
            const int voff0 = (tq0 + d * ((lane >> 3) - 128)) * (NPROJ * 2) + vmin;
            const int vstep = d * 8 * (NPROJ * 2);
#define DATTN_VLOAD(PP) do { _Pragma("unroll") for (int ps = 0; ps < 4; ++ps) { \
                    int vo_ = voff0 + (4 * (PP) + 2 * (ps >> 1) + (ps & 1)) * vstep; vo_ = vo_ < vmin ? vmin : (vo_ > vmax ? vmax : vo_); \
                    vreg[(PP) % 3][ps] = *(const u32x4*)(pbytes + (unsigned)vo_); } } while (0)
            DATTN_VLOAD(0); DATTN_VLOAD(1); DATTN_VLOAD(2);
            f32x4 o[4];
#pragma unroll
            for (int dt = 0; dt < 4; ++dt) o[dt] = (f32x4){0.f, 0.f, 0.f, 0.f};
            float den = 0.f;
            int dbase = l15 + 128 - 4 * gq; asm volatile("" : "+v"(dbase));
            float fbase = (float)dbase; asm volatile("" : "+v"(fbase));
            const float nb0 = -sl * fbase;
#pragma unroll
            for (int pp = 0; pp < 5; ++pp) {
                __builtin_amdgcn_sched_barrier(0);
#pragma unroll
                for (int ps = 0; ps < 4; ++ps) { const int idx = ps * 64 + lane, row = idx >> 3, chk = idx & 7; *(LAS u32x4*)(vst + row * 144 + chk * 16) = vreg[pp % 3][ps]; }
                if (pp + 3 < 5) { asm volatile("" ::: "memory"); DATTN_VLOAD(pp + 3); }
                const bool skip = (tq0 + d * (16 * (2 * pp + 1 - 8) + 15) < 0);
                f32x4 sacc[2];
#pragma unroll
                for (int T = 0; T < 2; ++T) {
                    const int kt = 2 * pp + T;
                    sacc[T] = (f32x4){0.f, 0.f, 0.f, 0.f};
                    if (kt < 9 && !skip) {
                        sacc[T] = __builtin_amdgcn_mfma_f32_16x16x32_bf16(kf[kt % 6][0], qf0, sacc[T], 0, 0, 0);
                        sacc[T] = __builtin_amdgcn_mfma_f32_16x16x32_bf16(kf[kt % 6][1], qf1, sacc[T], 0, 0, 0);
                    }
                }
                if (pp + 3 < 5) { asm volatile("" ::: "memory"); DATTN_KLOAD(2 * pp + 6); DATTN_KLOAD(2 * pp + 7); }
                if (skip) continue;
                float p[2][4];
#pragma unroll
                for (int T = 0; T < 2; ++T) {
                    const int kt = 2 * pp + T;
                    if (kt >= 9) { p[T][0] = 0.f; p[T][1] = 0.f; p[T][2] = 0.f; p[T][3] = 0.f; }
                    else if (kt == 0 || kt == 8 || (tq0 + d * 16 * (kt - 8) < 0)) {
#pragma unroll
                        for (int rg = 0; rg < 4; ++rg) {
                            const int dist = dbase - (16 * kt + rg);
                            const int tkk = tq0 + d * (l15 - dist);
                            const bool valid = (dist >= 0) && (dist <= 128) && (tkk >= 0);
                            const float pv = valid ? __builtin_amdgcn_exp2f(sacc[T][rg] + fmaf(sl, (float)(16 * kt + rg), nb0)) : 0.f;
                            p[T][rg] = pv; den += pv;
                        }
                    } else {
#pragma unroll
                        for (int rg = 0; rg < 4; ++rg) {
                            const float pv = __builtin_amdgcn_exp2f(sacc[T][rg] + fmaf(sl, (float)(16 * kt + rg), nb0));
                            p[T][rg] = pv; den += pv;
                        }
                    }
                }
                u32x4 pw; pw.x = pkbf(p[0][0], p[0][1]); pw.y = pkbf(p[0][2], p[0][3]); pw.z = pkbf(p[1][0], p[1][1]); pw.w = pkbf(p[1][2], p[1][3]);
                const bf16x8 pfrag = __builtin_bit_cast(bf16x8, pw);
#pragma unroll
                for (int dt = 0; dt < 4; ++dt) {
                    const s16x4 lo = vtr(vst + (4 * gq + trq) * 144 + (16 * dt + 4 * trp) * 2);
                    const s16x4 hi = vtr(vst + (16 + 4 * gq + trq) * 144 + (16 * dt + 4 * trp) * 2);
                    const bf16x8 vf = (bf16x8){lo[0], lo[1], lo[2], lo[3], hi[0], hi[1], hi[2], hi[3]};
                    o[dt] = __builtin_amdgcn_mfma_f32_16x16x32_bf16(pfrag, vf, o[dt], 0, 0, 0);
                }
            }
            den += shx(den, lane, 16); den += shx(den, lane, 32);
#pragma unroll
            for (int dt = 0; dt < 4; ++dt)
#pragma unroll
                for (int rg = 0; rg < 4; ++rg) {
                    const int tl = (tq0 - t0) + d * (4 * gq + rg), idx = tl * 64 + 16 * dt + l15;
                    if (pi == 0) OACC[idx] = o[dt][rg]; else OACC[idx] += o[dt][rg];
                }
            if (gq == 0) { const int tl = (tq0 - t0) + d * l15; if (pi == 0) DEN[tl] = den; else DEN[tl] += den; }
        }
        LBAR();
    }
#pragma unroll
    for (int k = 0; k < 4; ++k) {
        const int idx = tid + 512 * k, tl = idx >> 3, c8 = (idx & 7) * 8;
        const f32x4 x0 = *(LAS const f32x4*)(OACC + tl * 64 + c8), x1 = *(LAS const f32x4*)(OACC + tl * 64 + c8 + 4);
        const float r = __builtin_amdgcn_rcpf(DEN[tl]);
        u32x4 w; w.x = pkbf(x0[0] * r, x0[1] * r); w.y = pkbf(x0[2] * r, x0[3] * r); w.z = pkbf(x1[0] * r, x1[1] * r); w.w = pkbf(x1[2] * r, x1[3] * r);
        *(u32x4*)(mixed + (size_t)(t0 + tl) * DM + 256 + h * 64 + c8) = w;
    }
}

__device__ __forceinline__ void phase_mixers(const Ctx& a, int l, LAS unsigned char* lds, unsigned xq, bool steal) {
    unsigned* ctr = (unsigned*)(a.ws + WS_CTL) + 64 * l;
    lds = lds_l(lds);
    LAS int* sun = (LAS int*)(lds + LDS_UNIT_OFF);
    const unsigned nk = steal ? 8u : 1u;
    int stage = 0;
    for (;;) {
        __syncthreads();
        if (tid_w(a.wv) == 0) {
            int code = -1;
            for (; stage < 3 && code < 0; ) {
                const int nq = stage == 0 ? 24 : (stage == 1 ? 192 : 128);
                for (unsigned k = 0; k < nk && code < 0; ++k) {
                    const unsigned x2 = (xq + k) & 7u;
                    const int u = (int)atomicAdd(ctr + 8 * stage + x2, 1u);
                    if (u < nq) code = (stage == 0 ? 0 : (stage == 1 ? 1000 : 10000)) + (int)x2 * nq + u;
                }
                if (code < 0) ++stage;
            }
            *sun = code;
        }
        __syncthreads();
        const int code = *sun;
        if (code < 0) break;
        if (code < 1000) lru_unit(a, l, code / 6, code % 6, lds);
        else if (code < 10000) { const int v = code - 1000; dattn_unit(a, v / 48, (v % 48) / 8, v % 8, lds); }
        else { const int v = code - 10000; pool_unit(a, l, v / 32, v % 32, lds); }
    }
}

__device__ __forceinline__ void phase_xattn(const Ctx& a, int l, LAS unsigned char* lds, int cv) {
    lds = lds_l(lds);
    const int tid = tid_w(a.wv), lane = tid & 63, wave = tid >> 6, l15 = lane & 15, gq = lane >> 4;
    LAS unsigned char* KL = lds;
    LAS unsigned char* VL = lds + 16896;
    LAS float* RK = (LAS float*)(lds + 68608);
    const bf16_t* qm = (const bf16_t*)(a.ws + WS_QM);
    const float* qst = (const float*)(a.ws + WS_QST);
    const bf16_t* kv = (const bf16_t*)(a.ws + WS_KV);
    const float* kst = (const float*)(a.ws + WS_KST);
    bf16_t* om = (bf16_t*)(a.ws + WS_MIXED);
    const int trq = (l15 >> 2), trp = (l15 & 3);
    for (int xu = cv; xu < NBATCH * 4 * 16; xu += gridDim.x) {
        const int xr = xu >> 3, b = 4 * (xu & 7) + (xr >> 6), h = (xr >> 4) & 3, qb = xr & 15;
        LBAR();
        if (tid < 256) {
            const f32x4* kp = (const f32x4*)(kst + (size_t)(b * 256 + tid) * 256 + l * 64 + h * 8);
            const f32x4 k0 = kp[0], k1 = kp[1];
            RK[tid] = rsqrtf((((k0[0] + k0[1]) + (k0[2] + k0[3])) + ((k1[0] + k1[1]) + (k1[2] + k1[3]))) * (1.0f / 256.0f) + EPSF);
        }
        const bf16_t* kvb = kv + (size_t)(b * 256) * 8192 + l * 2048 + h * 256;
        u32x4 kpre[2], vpre[2];
#pragma unroll
        for (int k = 0; k < 2; ++k) {
            const int idx = tid + 512 * k, row = idx >> 5, chk = idx & 31;
            const bf16_t* src = kvb + (size_t)row * 8192 + chk * 8;
            kpre[k] = *(const u32x4*)src; vpre[k] = *(const u32x4*)(src + 1024);
        }
        const size_t qrow = (size_t)b * SEQ + qb * 128 + wave * 16 + l15;
        bf16x8 qf[8];
#pragma unroll
        for (int ks = 0; ks < 8; ++ks) qf[ks] = *(const bf16x8*)(qm + qrow * DM + h * 256 + 32 * ks + 8 * gq);
        float rq;
        { const f32x4* qp = (const f32x4*)(qst + qrow * 32 + h * 8); const f32x4 q0 = qp[0], q1 = qp[1];
          rq = rsqrtf((((q0[0] + q0[1]) + (q0[2] + q0[3])) + ((q1[0] + q1[1]) + (q1[2] + q1[3]))) * (1.0f / 256.0f) + EPSF); }
        f32x4 o[16];
#pragma unroll
        for (int dt = 0; dt < 16; ++dt) o[dt] = (f32x4){0.f, 0.f, 0.f, 0.f};
        float den = 0.f;
#pragma unroll
        for (int ks = 0; ks < 8; ++ks) asm volatile("" : "+v"(qf[ks]));
        asm volatile("" : "+v"(rq));
#pragma unroll
        for (int k = 0; k < 2; ++k) {
            const int idx = tid + 512 * k, row = idx >> 5, chk = idx & 31;
            *(LAS u32x4*)(KL + row * 528 + chk * 16) = kpre[k];
            *(LAS u32x4*)(VL + row * 544 + chk * 16) = vpre[k];
            const bf16_t* src = kvb + (size_t)(32 + row) * 8192 + chk * 8;
            kpre[k] = *(const u32x4*)src; vpre[k] = *(const u32x4*)(src + 1024);
        }
#pragma unroll 1
        for (int c = 0; c < 8; ++c) {
            LBAR();
            const int bo = (c & 1) * 34304, bn = 34304 - bo;
            if (c < 7) {
#pragma unroll
                for (int k = 0; k < 2; ++k) {
                    const int idx = tid + 512 * k, row = idx >> 5, chk = idx & 31;
                    *(LAS u32x4*)(KL + bn + row * 528 + chk * 16) = kpre[k];
                    *(LAS u32x4*)(VL + bn + row * 544 + chk * 16) = vpre[k];
                }
                if (c < 6) {
#pragma unroll
                    for (int k = 0; k < 2; ++k) {
                        const int idx = tid + 512 * k, row = idx >> 5, chk = idx & 31;
                        const bf16_t* src = kvb + (size_t)(32 * (c + 2) + row) * 8192 + chk * 8;
                        kpre[k] = *(const u32x4*)src; vpre[k] = *(const u32x4*)(src + 1024);
                    }
                }
            }
            LAS unsigned char* KLc = KL + bo; LAS unsigned char* VLc = VL + bo;
            float p[2][4];
#pragma unroll
            for (int T = 0; T < 2; ++T) {
                f32x4 s = (f32x4){0.f, 0.f, 0.f, 0.f};
#pragma unroll
                for (int ks = 0; ks < 8; ++ks) {
                    const bf16x8 kf = *(LAS const bf16x8*)(KLc + (16 * T + l15) * 528 + (32 * ks + 8 * gq) * 2);
                    s = __builtin_amdgcn_mfma_f32_16x16x32_bf16(kf, qf[ks], s, 0, 0, 0);
                }
                const f32x4 rk4 = *(LAS const f32x4*)(RK + 32 * c + 16 * T + 4 * gq);
                const f32x4 sa = s * (rk4 * rq);
#pragma unroll
                for (int rg = 0; rg < 4; ++rg) { const float pv = __builtin_amdgcn_exp2f(sa[rg]); p[T][rg] = pv; den += pv; }
            }
            u32x4 pw; pw.x = pkbf(p[0][0], p[0][1]); pw.y = pkbf(p[0][2], p[0][3]); pw.z = pkbf(p[1][0], p[1][1]); pw.w = pkbf(p[1][2], p[1][3]);
            const bf16x8 pfrag = __builtin_bit_cast(bf16x8, pw);
#pragma unroll
            for (int dt = 0; dt < 16; ++dt) {
                const s16x4 lo = vtr(VLc + (4 * gq + trq) * 544 + (16 * dt + 4 * trp) * 2);
                const s16x4 hi = vtr(VLc + (16 + 4 * gq + trq) * 544 + (16 * dt + 4 * trp) * 2);
                const bf16x8 vf = (bf16x8){lo[0], lo[1], lo[2], lo[3], hi[0], hi[1], hi[2], hi[3]};
                o[dt] = __builtin_amdgcn_mfma_f32_16x16x32_bf16(pfrag, vf, o[dt], 0, 0, 0);
            }
        }
        den += shx(den, lane, 16); den += shx(den, lane, 32);
        float inv[4];
#pragma unroll
        for (int rg = 0; rg < 4; ++rg) inv[rg] = 1.0f / shi(den, 4 * gq + rg);
        LAS unsigned char* OST = lds + 71680 + wave * 8448;
#pragma unroll
        for (int dt = 0; dt < 16; ++dt)
#pragma unroll
            for (int rg = 0; rg < 4; ++rg) *(LAS unsigned short*)(OST + (4 * gq + rg) * 528 + (16 * dt + l15) * 2) = f2bf(o[dt][rg] * inv[rg]);
        asm volatile("s_waitcnt lgkmcnt(0)" ::: "memory");
        const size_t orow0 = (size_t)b * SEQ + qb * 128 + wave * 16;
#pragma unroll
        for (int k = 0; k < 8; ++k) {
            const int idx = k * 64 + lane, row = idx >> 5, chk = idx & 31;
            const u32x4 w = *(LAS const u32x4*)(OST + row * 528 + chk * 16);
            *(u32x4*)(om + (orow0 + row) * DM + h * 256 + chk * 8) = w;
        }
        asm volatile("s_waitcnt lgkmcnt(0)" ::: "memory");
    }
}

__device__ __forceinline__ void phase_ffn_fix(const Ctx& a, int l, int cv) {
    const float* sg = (const float*)(a.ws + WS_SG); const float* su = (const float*)(a.ws + WS_SU);
    bf16_t* act = (bf16_t*)(a.ws + WS_ACT);
    const float* cw = inptr(a, 25) + (size_t)l * 3 * DFF; const float* cb = inptr(a, 26) + (size_t)l * DFF;
    const int per_x = 32 * 4 * (DFF / 4);
    for (int wi = (cv >> 3) * NTHREADS + tid_w(a.wv); wi < per_x; wi += (gridDim.x >> 3) * NTHREADS) {
        const int f = (wi % (DFF / 4)) * 4, j = (wi / (DFF / 4)) & 3, pm = 32 * (cv & 7) + wi / (DFF / 4) / 4, wr = j >> 1, e = j & 1;
        const float* sgt = sg + (size_t)pm * 8 * DFF + f;
        const f32x4 z = (f32x4){0.f, 0.f, 0.f, 0.f};
        const bool hasprev = (pm & 7) != 0;
        const f32x4 prev7 = hasprev ? *(const f32x4*)(sgt - (size_t)8 * DFF + 7 * DFF) : z;
        const f32x4 prev6 = hasprev ? *(const f32x4*)(sgt - (size_t)8 * DFF + 6 * DFF) : z;
        const f32x4 gc = *(const f32x4*)(sgt + (size_t)(wr * 4 + e) * DFF);
        f32x4 gm1, gm2;
        if (e == 1) { gm1 = *(const f32x4*)(sgt + (size_t)(wr * 4) * DFF); gm2 = wr ? *(const f32x4*)(sgt + (size_t)3 * DFF) : prev7; }
        else { gm1 = wr ? *(const f32x4*)(sgt + (size_t)3 * DFF) : prev7; gm2 = wr ? *(const f32x4*)(sgt + (size_t)2 * DFF) : prev6; }
        const f32x4 uu = *(const f32x4*)(su + ((size_t)pm * 4 + wr * 2 + e) * DFF + f);
        const f32x4 w0 = *(const f32x4*)(cw + f), w1 = *(const f32x4*)(cw + DFF + f), w2 = *(const f32x4*)(cw + 2 * DFF + f), bb = *(const f32x4*)(cb + f);
        float r[4];
#pragma unroll
        for (int i = 0; i < 4; ++i) r[i] = gelu_tanh(bb[i] + w0[i] * gc[i] + w1[i] * gm1[i] + w2[i] * gm2[i]) * uu[i];
        u32x2 w; w.x = pkbf(r[0], r[1]); w.y = pkbf(r[2], r[3]);
        *(u32x2*)(act + (size_t)(pm * 256 + wr * 128 + e) * DFF + f) = w;
    }
}

#define GAS __attribute__((address_space(1)))

typedef GAS unsigned gu32;
typedef GAS unsigned long long gu64;
#define RLX_AGENT __ATOMIC_RELAXED, __HIP_MEMORY_SCOPE_AGENT
#define LDS_WAIT() asm volatile("s_waitcnt lgkmcnt(0)" ::: "memory")
#define VM_WAIT() asm volatile("s_waitcnt vmcnt(0)" ::: "memory")
__device__ __forceinline__ unsigned long long rt() { return __builtin_amdgcn_s_memrealtime(); }
#define XB_TMO      128
#define XB_XCNT(j)  (256  + 64 * (j))
#define XB_XSUB(j)  (1280 + 64 * (j))
#define XB_XGEN(j)  (2304 + 64 * (j))
#define XB_TOP      3328
#define XB_TOPGEN   3392
#define XB_LSUB(j)  (3456 + 64 * (j))
#define XB_LGEN(j)  (4480 + 64 * (j))
#define XCD_BAR_WORDS 5504
#define XB_SPIN_CAP (1u << 18)

__device__ __forceinline__ unsigned xb_ld(unsigned* p)              { return __hip_atomic_load(p, __ATOMIC_RELAXED, __HIP_MEMORY_SCOPE_AGENT); }
__device__ __forceinline__ unsigned xb_add(unsigned* p, unsigned v) { return __hip_atomic_fetch_add(p, v, __ATOMIC_RELAXED, __HIP_MEMORY_SCOPE_AGENT); }
__device__ __forceinline__ unsigned xb_xcc_id() { return (unsigned)__builtin_amdgcn_s_getreg((3 << 11) | 20) & 0xFu; }
#define XB_SPIN(cond, bar) do { unsigned _sp = 0; while (cond) { __builtin_amdgcn_s_sleep(1); \
    if ((++_sp & 255u) == 0u) { if (xb_ld(&(bar)[XB_TMO])) break; if (_sp > XB_SPIN_CAP) { atomicAdd(&(bar)[XB_TMO], 1u); break; } } } } while (0)

struct XcdBarrier {
    unsigned* bar; unsigned x;
    volatile LAS unsigned* st;
};

__device__ __forceinline__ XcdBarrier xcd_barrier_post(unsigned* bar, volatile LAS unsigned* st, bool t0) {
    XcdBarrier b; b.bar = bar; b.x = xb_xcc_id(); b.st = st;
    if (t0) st[2] = xb_add(&bar[XB_XCNT(b.x)], 1u);
    return b;
}
__device__ __forceinline__ void xcd_barrier_complete(unsigned* bar, unsigned x, unsigned& nloc, unsigned& nx) {
    const unsigned G = gridDim.x * gridDim.y * gridDim.z;
    unsigned sum, cnt, mine, sp = 0u;
    for (;;) {
        sum = 0u; cnt = 0u; mine = 0u;
#pragma unroll
        for (unsigned j = 0; j < 16; ++j) { const unsigned c = xb_ld(&bar[XB_XCNT(j)]); sum += c; cnt += (c > 0u) ? 1u : 0u; mine = (j == x) ? c : mine; }
        if (sum == G) break;
        __builtin_amdgcn_s_sleep(1);
        if ((++sp & 255u) == 0u) { if (xb_ld(&bar[XB_TMO])) break; if (sp > XB_SPIN_CAP) { atomicAdd(&bar[XB_TMO], 1u); break; } }
    }
    nloc = mine > 0u ? mine : 1u; nx = cnt > 0u ? cnt : 1u;
}

__device__ __forceinline__ void xcd_barrier(const XcdBarrier& b, bool t0) {
    asm volatile("s_waitcnt vmcnt(0)" ::: "memory");
    __syncthreads();
    if (t0) {
        unsigned* bar = b.bar;
        __builtin_amdgcn_s_waitcnt(0);
        unsigned nloc = b.st[0], nx = b.st[1];
        if (nloc == 0u) { xcd_barrier_complete(bar, b.x, nloc, nx); b.st[0] = nloc; b.st[1] = nx; }
        const unsigned old = xb_add(&bar[XB_XSUB(b.x)], 1u);
        const unsigned gen = old / nloc;
        if (old + 1u == (gen + 1u) * nloc) {
            __builtin_amdgcn_fence(__ATOMIC_RELEASE, "agent");
            asm volatile("s_waitcnt vmcnt(0)" ::: "memory");
            const unsigned og = xb_add(&bar[XB_TOP], 1u);
            const unsigned tg = og / nx;
            if (og + 1u == (tg + 1u) * nx) xb_add(&bar[XB_TOPGEN], 1u);
            else XB_SPIN(xb_ld(&bar[XB_TOPGEN]) == tg, bar);
            __builtin_amdgcn_fence(__ATOMIC_ACQUIRE, "agent");
            xb_add(&bar[XB_XGEN(b.x)], 1u);
            asm volatile("s_waitcnt vmcnt(0)" ::: "memory");
        } else {
            XB_SPIN(xb_ld(&bar[XB_XGEN(b.x)]) == gen, bar);
            __builtin_amdgcn_fence(__ATOMIC_ACQUIRE, "agent");
            asm volatile("s_waitcnt vmcnt(0)" ::: "memory");
        }
    }
    __syncthreads();
}


__device__ __forceinline__ void xcd_barrier_local(const XcdBarrier& b, bool t0) {
    asm volatile("s_waitcnt vmcnt(0)" ::: "memory");
    __syncthreads();
    if (t0) {
        unsigned* bar = b.bar;
        const unsigned nloc = b.st[0];
        const unsigned old = xb_add(&bar[XB_LSUB(b.x)], 1u);
        const unsigned gen = old / nloc;
        if (old + 1u == (gen + 1u) * nloc) xb_add(&bar[XB_LGEN(b.x)], 1u);
        else XB_SPIN(xb_ld(&bar[XB_LGEN(b.x)]) == gen, bar);
        __builtin_amdgcn_fence(__ATOMIC_ACQUIRE, "agent");
        asm volatile("s_waitcnt vmcnt(0)" ::: "memory");
    }
    __syncthreads();
}
__device__ __forceinline__ bool xcd_even_partition(unsigned* bar) {
    const unsigned G = gridDim.x; bool ok = (G % 8u) == 0u; unsigned n = 0u;
#pragma unroll
    for (unsigned j = 0; j < 16; ++j) { const unsigned c = xb_ld(&bar[XB_XCNT(j)]); if (c) { ++n; ok = ok && (c * 8u == G) && (j < 8u); } }
    return ok && n == 8u;
}

__global__ void __launch_bounds__(NTHREADS, 2) trunk_fwd(Args ka) {
    extern __shared__ __attribute__((aligned(16))) unsigned char lds_raw[];
    LAS unsigned char* lds = (LAS unsigned char*)lds_raw;
    cg::grid_group grid = cg::this_grid();
    {
        LAS unsigned long long* tw = (LAS unsigned long long*)(lds + LDS_TBL_OFF);
        if (threadIdx.x == 0) {
#pragma unroll
            for (int i = 0; i < 28; ++i) tw[i] = (unsigned long long)ka.in[i];
        }
        __syncthreads();
    }
    volatile LAS unsigned* bst = (volatile LAS unsigned*)(lds + LDS_UNIT_OFF + 16);
    if (threadIdx.x == 0) { bst[0] = 0u; bst[1] = 0u; bst[2] = 0u; bst[3] = 0u; }
    __syncthreads();
    const XcdBarrier xbar = xcd_barrier_post((unsigned*)(ka.ws + WS_CTL) + 4096, bst, threadIdx.x == 0);
#define GSYNC_FULL() xcd_barrier(xbar, tid_w(a.wv) == 0)
#define GSYNC() do { if (part) xcd_barrier_local(xbar, tid_w(a.wv) == 0); else xcd_barrier(xbar, tid_w(a.wv) == 0); } while (0)
    int cv = (int)blockIdx.x; bool part = false;
    Ctx a; a.tbl = (LAS const unsigned long long*)(lds + LDS_TBL_OFF); a.out = ka.out; a.ws = ka.ws; a.wv = __builtin_amdgcn_readfirstlane((int)(threadIdx.x >> 6));
    unsigned char* ws = a.ws;
    bf16_t* hb = (bf16_t*)(ws + WS_HB);
    float* st = (float*)(ws + WS_ST);

    phase_prologue(a, lds);
    grid.sync();
    {
        EpiBf<false> E{(bf16_t*)(ws + WS_KV), 8192, (const float*)(ws + WS_STM), (float*)(ws + WS_KST), 256, nullptr, nullptr, nullptr};
        run_gemm(cv, a.wv, lds, (const bf16_t*)(ws + WS_MEMB), (const bf16_t*)(ws + WS_WKV), MEMROWS, 8192, DM, E);
    }
    for (int l = 0; l < DEPTH; ++l) {
        const unsigned char* wl = ws + WS_W + (size_t)l * W_LAYER;
        {
            EpiBf<true> E{(bf16_t*)(ws + WS_PROJ), NPROJ, st, nullptr, 0, nullptr, inptr(a, 6) + l * 64, inptr(a, 7) + l * 64};
            run_gemm(cv, a.wv, lds, hb, (const bf16_t*)(wl + W_IN), MTOK, NPROJ, DM, E);
        }
        if (l == 0) {
            GSYNC_FULL();
            if (tid_w(a.wv) == 0) bst[3] = xcd_even_partition(xbar.bar) ? 1u : 0u;
            __syncthreads();
            part = bst[3] != 0u;
            if (part) cv = (int)(bst[2] * 8u + (xbar.x & 7u));
        } else GSYNC();
        phase_mixers(a, l, lds, (unsigned)cv & 7u, !part);
        GSYNC();
        {
            EpiRes E{l == 0 ? inptr(a, 0) : a.out, a.out, hb, st};
            run_gemm(cv, a.wv, lds, (const bf16_t*)(ws + WS_MIXED), (const bf16_t*)(wl + W_OUT), MTOK, DM, DM, E);
        }
        GSYNC();
        {
            EpiBf<false> E{(bf16_t*)(ws + WS_QM), DM, st, (float*)(ws + WS_QST), 32, (const float*)(ws + WS_CS) + l * 1024, nullptr, nullptr};
            run_gemm(cv, a.wv, lds, hb, (const bf16_t*)(wl + W_Q), MTOK, DM, DM, E);
        }
        GSYNC();
        phase_xattn(a, l, lds, cv);
        GSYNC();
        {
            EpiRes E{a.out, a.out, hb, st};
            run_gemm(cv, a.wv, lds, (const bf16_t*)(ws + WS_MIXED), (const bf16_t*)(wl + W_O), MTOK, DM, DM, E);
        }
        GSYNC_FULL();
        {
            EpiAct E{(bf16_t*)(ws + WS_ACT), st, inptr(a, 25) + (size_t)l * 3 * DFF, inptr(a, 26) + (size_t)l * DFF, (float*)(ws + WS_SG), (float*)(ws + WS_SU)};
            run_gemm_aperm(cv, a.wv, lds, hb, (const bf16_t*)(wl + W_UP), MTOK, DFF2, DM, E);
        }
        GSYNC();
        phase_ffn_fix(a, l, cv);
        GSYNC();
        {
            EpiRes E{a.out, a.out, (l == DEPTH - 1) ? nullptr : hb, st};
            run_gemm(cv, a.wv, lds, (const bf16_t*)(ws + WS_ACT), (const bf16_t*)(wl + W_DOWN), MTOK, DM, DFF, E);
        }
        if (l < DEPTH - 1) GSYNC_FULL();
    }
}

extern "C" void kernel_launch(void* const* d_in, const int* in_sizes, int n_in, void* d_out, int out_size, void* d_ws, size_t ws_size, hipStream_t stream) {
    static int grid = 0;
    if (grid == 0) {
        if (n_in != 28 || in_sizes[0] != MTOK * DM || out_size != MTOK * DM || ws_size < WS_END) {
            fprintf(stderr, "kernel_launch: unexpected shapes (n_in %d, in0 %d, out %d, ws %zu; need ws >= %zu); nothing launched\n", n_in, n_in > 0 ? in_sizes[0] : -1, out_size, ws_size, (size_t)WS_END);
            grid = -1; return;
        }
        int dev = 0, cus = 0, per_cu = 0;
        hipGetDevice(&dev);
        hipDeviceGetAttribute(&cus, hipDeviceAttributeMultiprocessorCount, dev);
        if (hipFuncSetAttribute((const void*)trunk_fwd, hipFuncAttributeMaxDynamicSharedMemorySize, LDS_BYTES) != hipSuccess) { fprintf(stderr, "kernel_launch: hipFuncSetAttribute failed\n"); grid = -1; return; }
        if (hipOccupancyMaxActiveBlocksPerMultiprocessor(&per_cu, (const void*)trunk_fwd, NTHREADS, LDS_BYTES) != hipSuccess || per_cu < 1) { fprintf(stderr, "kernel_launch: occupancy query says %d blocks per CU\n", per_cu); per_cu = 1; }
        (void)hipGetLastError();
        grid = cus;
    }
    if (grid < 0) return;
    (void)hipMemsetAsync((char*)d_ws + WS_CTL, 0, 65536, stream);
    Args a{};
    for (int i = 0; i < 28; ++i) a.in[i] = (const float*)d_in[i];
    a.out = (float*)d_out; a.ws = (unsigned char*)d_ws;
    void* args[] = {&a};
    hipError_t e = hipLaunchCooperativeKernel((const void*)trunk_fwd, dim3(grid), dim3(NTHREADS), args, LDS_BYTES, stream);
    if (e != hipSuccess) fprintf(stderr, "cooperative launch failed: %s (grid %d)\n", hipGetErrorString(e), grid);
}
```
